# Optimizing an MI355X kernel written in HIP

```python
import jax, jax.numpy as jnp
from jax import lax
import numpy as np

D_MODEL = 1024
BATCH = 1
SEQ = 16384
DEPTH = 4
DEC_BATCH = 2
DEC_SEQ = 16384
PAST_LEN = 128

MLA_HEADS = 8
NOPE_DIM = 64
ROPE_DIM = 32
QK_DIM = NOPE_DIM + ROPE_DIM
MLA_V_DIM = 64
Q_LORA = 256
KV_LORA = 128
MLA_WIDTH = MLA_HEADS * MLA_V_DIM
ROPE_THETA = 10000.0
Q_BLOCK = 128
GLA_HEADS = 4
GLA_KEY = D_MODEL // 2
GLA_VAL = D_MODEL
GLA_DK = GLA_KEY // GLA_HEADS
GLA_DV = GLA_VAL // GLA_HEADS
GATE_RANK = 16
GATE_NORM = 16.0
CHUNK = 64
D_FF = 2816
EPS = 1e-6
P_IN = Q_LORA + KV_LORA + ROPE_DIM + 2 * GLA_KEY + GLA_VAL + 2 * GATE_RANK + GLA_VAL + 2 * D_MODEL

kernel_name = "hybrid_mla_gla_macaron_encoder"


def _rmsnorm(x, g):
    xf = x.astype(jnp.float32)
    y = xf * lax.rsqrt(jnp.mean(xf * xf, axis=-1, keepdims=True) + EPS)
    return (y * g.astype(jnp.float32)).astype(x.dtype)


def _swiglu(u, w_in, w_out):
    a, b = jnp.split(u @ w_in, 2, axis=-1)
    return (jax.nn.silu(a) * b) @ w_out


def _rope_tables(s):
    inv_freq = 1.0 / (ROPE_THETA ** (jnp.arange(0, ROPE_DIM, 2, dtype=jnp.float32) / ROPE_DIM))
    ang = jnp.arange(s, dtype=jnp.float32)[:, None] * inv_freq[None, :]
    return jnp.cos(ang)[:, None, :], jnp.sin(ang)[:, None, :]


def _rope(x, cos, sin):
    half = ROPE_DIM // 2
    c, s = cos.astype(x.dtype), sin.astype(x.dtype)
    x1, x2 = x[..., :half], x[..., half:]
    return jnp.concatenate([x1 * c - x2 * s, x2 * c + x1 * s], axis=-1)


def _mla(cq, ckv, kpe, q_norm_g, w_uq, kv_norm_g, w_ukv):
    b, s, _ = cq.shape
    cos, sin = _rope_tables(s)
    q = (_rmsnorm(cq, q_norm_g) @ w_uq).reshape(b, s, MLA_HEADS, QK_DIM)
    q = jnp.concatenate([q[..., :NOPE_DIM], _rope(q[..., NOPE_DIM:], cos, sin)], axis=-1)
    kv = (_rmsnorm(ckv, kv_norm_g) @ w_ukv).reshape(b, s, MLA_HEADS, NOPE_DIM + MLA_V_DIM)
    k_nope, v = kv[..., :NOPE_DIM], kv[..., NOPE_DIM:]
    k_pe = _rope(kpe[:, :, None, :], cos, sin)
    k = jnp.concatenate([k_nope, jnp.broadcast_to(k_pe, (b, s, MLA_HEADS, ROPE_DIM))], axis=-1)
    scale = QK_DIM ** -0.5
    nq = s // Q_BLOCK
    qb = q.reshape(b, nq, Q_BLOCK, MLA_HEADS, QK_DIM).transpose(1, 0, 2, 3, 4)

    def attend(q_blk):
        sc = jnp.einsum('bqhd,bkhd->bhqk', q_blk, k).astype(jnp.float32) * scale
        p = jax.nn.softmax(sc, axis=-1).astype(v.dtype)
        return jnp.einsum('bhqk,bkhd->bqhd', p, v)

    o = lax.map(attend, qb)
    return o.transpose(1, 0, 2, 3, 4).reshape(b, s, MLA_WIDTH)


def _gla_chunked(q, k, v, g):
    b, s, h, dk = q.shape
    dv = v.shape[-1]
    n = s // CHUNK
    to_c = lambda t: t.reshape(b, n, CHUNK, h, t.shape[-1]).transpose(0, 3, 1, 2, 4)
    q, k, v, g = to_c(q), to_c(k), to_c(v), to_c(g)
    cb = jnp.cumsum(g, axis=3)
    cb_last = cb[:, :, :, -1:, :]
    q_t = q * jnp.exp(cb)
    k_t = k * jnp.exp(-cb)
    k_s = k * jnp.exp(cb_last - cb)
    mask = jnp.tril(jnp.ones((CHUNK, CHUNK), dtype=bool))
    att = jnp.where(mask, jnp.einsum('bhncd,bhned->bhnce', q_t, k_t), 0.0)
    o_intra = jnp.einsum('bhnce,bhnev->bhncv', att, v)
    u = jnp.einsum('bhncd,bhncv->bhndv', k_s, v)
    decay = jnp.exp(cb_last[:, :, :, 0, :])

    def step(state, inp):
        d, uc = inp
        return d[..., None] * state + uc, state

    init = jnp.zeros((b, h, dk, dv), jnp.float32)
    _, s_prev = lax.scan(step, init, (jnp.moveaxis(decay, 2, 0), jnp.moveaxis(u, 2, 0)))
    s_prev = jnp.moveaxis(s_prev, 0, 2)
    o = o_intra + jnp.einsum('bhncd,bhndv->bhncv', q_t, s_prev)
    return o.transpose(0, 2, 3, 1, 4).reshape(b, s, h, dv)


def _gla(gq, gk, gv, ga, gog, wa2_f, ba_f, wa2_b, ba_b, norm_g):
    b, s, _ = gq.shape
    f32 = jnp.float32
    q = gq.reshape(b, s, GLA_HEADS, GLA_DK).astype(f32) * (GLA_DK ** -0.5)
    k = gk.reshape(b, s, GLA_HEADS, GLA_DK).astype(f32)
    v = gv.reshape(b, s, GLA_HEADS, GLA_DV).astype(f32)
    ga_f, ga_b = ga[..., :GATE_RANK], ga[..., GATE_RANK:]
    g_f = (jax.nn.log_sigmoid((ga_f @ wa2_f + ba_f).astype(f32)) / GATE_NORM).reshape(b, s, GLA_HEADS, GLA_DK)
    g_b = (jax.nn.log_sigmoid((ga_b @ wa2_b + ba_b).astype(f32)) / GATE_NORM).reshape(b, s, GLA_HEADS, GLA_DK)
    fl = lambda t: jnp.flip(t, axis=1)
    o = _gla_chunked(q, k, v, g_f) + fl(_gla_chunked(fl(q), fl(k), fl(v), fl(g_b)))
    o = _rmsnorm(o, norm_g)
    o = o * jax.nn.silu(gog.reshape(b, s, GLA_HEADS, GLA_DV).astype(f32))
    return o.reshape(b, s, GLA_VAL).astype(gq.dtype)


def _split_in(z):
    sizes = (Q_LORA, KV_LORA, ROPE_DIM, GLA_KEY, GLA_KEY, GLA_VAL, 2 * GATE_RANK, GLA_VAL, 2 * D_MODEL)
    idx = np.cumsum(sizes)[:-1].tolist()
    return jnp.split(z, idx, axis=-1)


def _trunk(x, ffn1_pre_g, ffn1_w_in, ffn1_w_out, ffn1_post_g, mix_pre_g, w_in,
           q_norm_g, w_uq, kv_norm_g, w_ukv, w_oa, gla_wa2_f, gla_ba_f, gla_wa2_b, gla_ba_b,
           gla_norm_g, w_ob, w_out, mix_post_g, ffn2_pre_g, ffn2_w_in, ffn2_w_out, ffn2_post_g):
    for l in range(DEPTH):
        x = x + 0.5 * _rmsnorm(_swiglu(_rmsnorm(x, ffn1_pre_g[l]), ffn1_w_in[l], ffn1_w_out[l]), ffn1_post_g[l])
        u = _rmsnorm(x, mix_pre_g[l])
        cq, ckv, kpe, gq, gk, gv, ga, gog, bg = _split_in(u @ w_in[l])
        o_a = _mla(cq, ckv, kpe, q_norm_g[l], w_uq[l], kv_norm_g[l], w_ukv[l]) @ w_oa[l]
        o_b = _gla(gq, gk, gv, ga, gog, gla_wa2_f[l], gla_ba_f[l], gla_wa2_b[l], gla_ba_b[l], gla_norm_g[l]) @ w_ob[l]
        gate = jax.nn.sigmoid(bg)
        merged = gate[..., :D_MODEL] * o_a + gate[..., D_MODEL:] * o_b
        x = x + _rmsnorm(merged @ w_out[l], mix_post_g[l])
        x = x + 0.5 * _rmsnorm(_swiglu(_rmsnorm(x, ffn2_pre_g[l]), ffn2_w_in[l], ffn2_w_out[l]), ffn2_post_g[l])
    return x


def setup_inputs(seed: int = 0) -> dict:
    key = jax.random.key(seed)
    ks = iter(jax.random.split(key, 32))
    nrm = lambda shape, fan_in: jax.random.normal(next(ks), shape, jnp.float32) * (fan_in ** -0.5)
    gain = lambda n: 1.0 + 0.05 * jax.random.normal(next(ks), (DEPTH, n), jnp.float32)
    bias = lambda n: 0.01 * jax.random.normal(next(ks), (DEPTH, n), jnp.float32)
    return {
        "x_prompt": jax.random.normal(next(ks), (BATCH, SEQ, D_MODEL), jnp.float32),
        "x_sample": jax.random.normal(next(ks), (DEC_BATCH, DEC_SEQ, D_MODEL), jnp.float32),
        "ffn1_pre_g": gain(D_MODEL),
        "ffn1_w_in": nrm((DEPTH, D_MODEL, 2 * D_FF), D_MODEL),
        "ffn1_w_out": nrm((DEPTH, D_FF, D_MODEL), D_FF),
        "ffn1_post_g": gain(D_MODEL),
        "mix_pre_g": gain(D_MODEL),
        "w_in": nrm((DEPTH, D_MODEL, P_IN), D_MODEL),
        "q_norm_g": gain(Q_LORA),
        "w_uq": nrm((DEPTH, Q_LORA, MLA_HEADS * QK_DIM), Q_LORA),
        "kv_norm_g": gain(KV_LORA),
        "w_ukv": nrm((DEPTH, KV_LORA, MLA_HEADS * (NOPE_DIM + MLA_V_DIM)), KV_LORA),
        "w_oa": nrm((DEPTH, MLA_WIDTH, D_MODEL), MLA_WIDTH),
        "gla_wa2_f": nrm((DEPTH, GATE_RANK, GLA_KEY), GATE_RANK),
        "gla_ba_f": bias(GLA_KEY),
        "gla_wa2_b": nrm((DEPTH, GATE_RANK, GLA_KEY), GATE_RANK),
        "gla_ba_b": bias(GLA_KEY),
        "gla_norm_g": gain(GLA_DV),
        "w_ob": nrm((DEPTH, GLA_VAL, D_MODEL), GLA_VAL),
        "w_out": nrm((DEPTH, D_MODEL, D_MODEL), D_MODEL),
        "mix_post_g": gain(D_MODEL),
        "ffn2_pre_g": gain(D_MODEL),
        "ffn2_w_in": nrm((DEPTH, D_MODEL, 2 * D_FF), D_MODEL),
        "ffn2_w_out": nrm((DEPTH, D_FF, D_MODEL), D_FF),
        "ffn2_post_g": gain(D_MODEL),
    }


def reference(x_prompt, x_sample, ffn1_pre_g, ffn1_w_in, ffn1_w_out, ffn1_post_g, mix_pre_g, w_in,
              q_norm_g, w_uq, kv_norm_g, w_ukv, w_oa, gla_wa2_f, gla_ba_f, gla_wa2_b, gla_ba_b,
              gla_norm_g, w_ob, w_out, mix_post_g, ffn2_pre_g, ffn2_w_in, ffn2_w_out, ffn2_post_g):
    y_prompt = _trunk(x_prompt, ffn1_pre_g, ffn1_w_in, ffn1_w_out, ffn1_post_g, mix_pre_g, w_in,
                      q_norm_g, w_uq, kv_norm_g, w_ukv, w_oa, gla_wa2_f, gla_ba_f, gla_wa2_b, gla_ba_b,
                      gla_norm_g, w_ob, w_out, mix_post_g, ffn2_pre_g, ffn2_w_in, ffn2_w_out, ffn2_post_g)
    y_sample = _trunk(x_sample, ffn1_pre_g, ffn1_w_in, ffn1_w_out, ffn1_post_g, mix_pre_g, w_in,
                      q_norm_g, w_uq, kv_norm_g, w_ukv, w_oa, gla_wa2_f, gla_ba_f, gla_wa2_b, gla_ba_b,
                      gla_norm_g, w_ob, w_out, mix_post_g, ffn2_pre_g, ffn2_w_in, ffn2_w_out, ffn2_post_g)
    return (y_prompt, y_sample)
```

```cpp
#include <hip/hip_runtime.h>
#include <hip/hip_cooperative_groups.h>
#include <cstdio>
namespace cg = cooperative_groups;

typedef unsigned short u16;
typedef short bf16x8 __attribute__((ext_vector_type(8)));
typedef short s16x4 __attribute__((ext_vector_type(4)));
typedef float f32x16 __attribute__((ext_vector_type(16)));
typedef __bf16 bf2_t __attribute__((ext_vector_type(2)));
typedef float f2_t __attribute__((ext_vector_type(2)));
typedef unsigned u32x4 __attribute__((ext_vector_type(4)));
#define DI __device__ __forceinline__
#define MFMA(a, b, c) __builtin_amdgcn_mfma_f32_32x32x16_bf16((a), (b), (c), 0, 0, 0)

constexpr int SEQ = 16384;
constexpr int NSEQ = 3;
constexpr int MALL = SEQ * NSEQ;
constexpr int DM = 1024;
constexpr int DFF = 2816;
constexpr int NFF2 = 5632;
constexpr int PIN = 5568;
constexpr int ZLD = 5632;
constexpr int Z_CQ = 0, Z_CKV = 256, Z_KPE = 384, Z_GQ = 416, Z_GK = 928, Z_GV = 1440, Z_GA = 2464, Z_GOG = 2496, Z_BG = 3520;
constexpr float EPS = 1e-6f;
constexpr int NCHUNK = SEQ / 64;

constexpr size_t W_FFN1_IN = 0;
constexpr size_t W_FFN1_OUT = W_FFN1_IN + (size_t)NFF2 * DM;
constexpr size_t W_IN = W_FFN1_OUT + (size_t)DM * DFF;
constexpr size_t W_UQ = W_IN + (size_t)ZLD * DM;
constexpr size_t W_KN = W_UQ + (size_t)768 * 256;
constexpr size_t W_V = W_KN + (size_t)512 * 128;
constexpr size_t W_OA = W_V + (size_t)512 * 128;
constexpr size_t W_OB = W_OA + (size_t)DM * 512;
constexpr size_t W_OUT = W_OB + (size_t)DM * DM;
constexpr size_t W_FFN2_IN = W_OUT + (size_t)DM * DM;
constexpr size_t W_FFN2_OUT = W_FFN2_IN + (size_t)NFF2 * DM;
constexpr size_t W_END = W_FFN2_OUT + (size_t)DM * DFF;

constexpr size_t al256(size_t x) { return (x + 255) & ~(size_t)255; }
constexpr size_t OFF_WB = 0;
constexpr size_t OFF_ROPE = al256(OFF_WB + W_END * 2);
constexpr size_t OFF_H = al256(OFF_ROPE + (size_t)SEQ * 32 * 4);
constexpr size_t OFF_Y = al256(OFF_H + (size_t)MALL * DM * 2);
constexpr size_t OFF_ACT = al256(OFF_Y + (size_t)MALL * DM * 2);
constexpr size_t OFF_Z = OFF_ACT;
constexpr size_t OFF_Q = al256(OFF_Z + (size_t)SEQ * ZLD * 2);
constexpr size_t OFF_KN = al256(OFF_Q + (size_t)SEQ * 768 * 2);
constexpr size_t OFF_VT = al256(OFF_KN + (size_t)SEQ * 512 * 2);
constexpr size_t OFF_KPE = al256(OFF_VT + (size_t)SEQ * 512 * 2);
constexpr size_t OFF_OA = al256(OFF_KPE + (size_t)SEQ * 32 * 2);
constexpr size_t OFF_MIXEND = al256(OFF_OA + (size_t)SEQ * 512 * 2);
constexpr size_t OFF_ACTEND = al256(OFF_ACT + (size_t)MALL * DFF * 2);
static_assert(OFF_MIXEND <= OFF_ACTEND, "mixer scratch must fit in act");
constexpr size_t OFF_ST = OFF_ACTEND;
constexpr size_t OFF_DEC = al256(OFF_ST + (size_t)NCHUNK * 4 * 2 * 256 * 128 * 2);
constexpr size_t OFF_GC = al256(OFF_DEC + (size_t)NCHUNK * 4 * 2 * 128 * 4);
constexpr size_t OFF_OG = al256(OFF_GC + (size_t)2 * SEQ * 512 * 4);
constexpr size_t OFF_MG = al256(OFF_OG + (size_t)SEQ * DM * 2);
constexpr size_t OFF_END = al256(OFF_MG + (size_t)SEQ * DM * 2);
constexpr size_t OFF_BAR = OFF_END;
static_assert(OFF_BAR + 16384 <= (size_t)768 * 1024 * 1024, "workspace overflow");

struct Params {
  const float* in[25];
  float* out;
  char* ws;
};

DI unsigned pk2(float a, float b) { f2_t v = {a, b}; return __builtin_bit_cast(unsigned, __builtin_convertvector(v, bf2_t)); }
DI u16 f2bf(float a) { return (u16)(pk2(a, 0.f) & 0xffffu); }
DI float bf2f(u16 v) { return __uint_as_float(((unsigned)v) << 16); }
DI float bflo(unsigned v) { return __uint_as_float(v << 16); }
DI float bfhi(unsigned v) { return __uint_as_float(v & 0xffff0000u); }
DI float wave_sum(float v) {
#pragma unroll
  for (int o = 32; o >= 1; o >>= 1) v += __shfl_xor(v, o);
  return v;
}
DI int opaque_tid() { int t = threadIdx.x; asm volatile("" : "+v"(t)); return t; }
DI const float* in_ptr(const Params& p, int k) { asm volatile("" : "+s"(k)); return p.in[k]; }
DI int crow(int i, int h) { return (i & 3) + 8 * (i >> 2) + 4 * h; }
DI float sigmoidf_(float x) { return 1.f / (1.f + __expf(-x)); }
DI float siluf_(float x) { return x / (1.f + __expf(-x)); }


#define XB_TMO      128
#define XB_XCNT(j)  (256  + 64 * (j))
#define XB_XSUB(j)  (1280 + 64 * (j))
#define XB_XGEN(j)  (2304 + 64 * (j))
#define XB_TOP      3328
#define XB_TOPGEN   3392
#define XCD_BAR_WORDS 3456
#define XB_SPIN_CAP (1u << 18)
#define LAS __attribute__((address_space(3)))

__device__ __forceinline__ unsigned xb_ld(unsigned* p)              { return __hip_atomic_load(p, __ATOMIC_RELAXED, __HIP_MEMORY_SCOPE_AGENT); }
__device__ __forceinline__ unsigned xb_add(unsigned* p, unsigned v) { return __hip_atomic_fetch_add(p, v, __ATOMIC_RELAXED, __HIP_MEMORY_SCOPE_AGENT); }
__device__ __forceinline__ unsigned xb_xcc_id() { return (unsigned)__builtin_amdgcn_s_getreg((3 << 11) | 20) & 0xFu; }
#define XB_SPIN(cond, bar) do { unsigned _sp = 0; while (cond) { __builtin_amdgcn_s_sleep(1); \
    if ((++_sp & 255u) == 0u) { if (xb_ld(&(bar)[XB_TMO])) break; if (_sp > XB_SPIN_CAP) { atomicAdd(&(bar)[XB_TMO], 1u); break; } } } } while (0)

struct XcdBarrier {
    unsigned* bar; unsigned x;
    volatile LAS unsigned* st;
};

__device__ __forceinline__ XcdBarrier xcd_barrier_post(unsigned* bar, volatile LAS unsigned* st) {
    XcdBarrier b; b.bar = bar; b.x = xb_xcc_id(); b.st = st;
    if (threadIdx.x == 0) (void)xb_add(&bar[XB_XCNT(b.x)], 1u);
    return b;
}
__device__ __forceinline__ void xcd_barrier_complete(unsigned* bar, unsigned x, unsigned& nloc, unsigned& nx) {
    const unsigned G = gridDim.x * gridDim.y * gridDim.z;
    unsigned sum, cnt, mine, sp = 0u;
    for (;;) {
        sum = 0u; cnt = 0u; mine = 0u;
#pragma unroll
        for (unsigned j = 0; j < 16; ++j) { const unsigned c = xb_ld(&bar[XB_XCNT(j)]); sum += c; cnt += (c > 0u) ? 1u : 0u; mine = (j == x) ? c : mine; }
        if (sum == G) break;
        __builtin_amdgcn_s_sleep(1);
        if ((++sp & 255u) == 0u) { if (xb_ld(&bar[XB_TMO])) break; if (sp > XB_SPIN_CAP) { atomicAdd(&bar[XB_TMO], 1u); break; } }
    }
    nloc = mine > 0u ? mine : 1u; nx = cnt > 0u ? cnt : 1u;
}

__device__ __forceinline__ void xcd_barrier(const XcdBarrier& b) {
    asm volatile("s_waitcnt vmcnt(0)" ::: "memory");
    __syncthreads();
    int tid0_ = threadIdx.x; asm volatile("" : "+v"(tid0_));
    if (tid0_ == 0) {
        unsigned* bar = b.bar; asm volatile("" : "+s"(bar));
        unsigned bx_ = b.x; asm volatile("" : "+s"(bx_));
        __builtin_amdgcn_s_waitcnt(0);
        unsigned nloc = b.st[0], nx = b.st[1];
        if (nloc == 0u) { xcd_barrier_complete(bar, bx_, nloc, nx); b.st[0] = nloc; b.st[1] = nx; }
        const unsigned old = xb_add(&bar[XB_XSUB(bx_)], 1u);
        const unsigned gen = old / nloc;
        if (old + 1u == (gen + 1u) * nloc) {
            __builtin_amdgcn_fence(__ATOMIC_RELEASE, "agent");
            asm volatile("s_waitcnt vmcnt(0)" ::: "memory");
            const unsigned og = xb_add(&bar[XB_TOP], 1u);
            const unsigned tg = og / nx;
            if (og + 1u == (tg + 1u) * nx) xb_add(&bar[XB_TOPGEN], 1u);
            else XB_SPIN(xb_ld(&bar[XB_TOPGEN]) == tg, bar);
            __builtin_amdgcn_fence(__ATOMIC_ACQUIRE, "agent");
            xb_add(&bar[XB_XGEN(bx_)], 1u);
            asm volatile("s_waitcnt vmcnt(0)" ::: "memory");
        } else {
            XB_SPIN(xb_ld(&bar[XB_XGEN(bx_)]) == gen, bar);
            __builtin_amdgcn_fence(__ATOMIC_ACQUIRE, "agent");
            asm volatile("s_waitcnt vmcnt(0)" ::: "memory");
        }
    }
    __syncthreads();
}

constexpr int LROW = 72;
constexpr int GEMM_LDS = 2 * 128 * LROW * 2;

struct Acc { f32x16 a[4][2]; };

DI void acc_zero(Acc& c) {
#pragma unroll
  for (int i = 0; i < 4; ++i)
#pragma unroll
    for (int j = 0; j < 2; ++j)
#pragma unroll
      for (int k = 0; k < 16; ++k) c.a[i][j][k] = 0.f;
}

DI void gll16(const u16* g, char* l) {
  __builtin_amdgcn_global_load_lds((const __attribute__((address_space(1))) unsigned*)g,
                                   (__attribute__((address_space(3))) unsigned*)l, 16, 0, 0);
}
DI void gemm_kloop(const u16* __restrict__ A, int lda, const u16* __restrict__ B, int ldb, int K, u16* smem, Acc& c) {
  const int t = opaque_tid();
  const int lane = t & 63, w = t >> 6, r = lane & 31, h = lane >> 5;
  const int wm = w >> 1, wn = w & 1;
  char* lds = (char*)smem;
  const int nk = K >> 5;
  const int row0 = t >> 2, c0 = t & 3;
  const int sw0 = (c0 ^ ((row0 >> 2) & 3)) * 8;
  const u16* ga0 = A + (size_t)row0 * lda + sw0;
  const u16* gb0 = B + (size_t)row0 * ldb + sw0;
  const size_t a64 = (size_t)64 * lda, b64 = (size_t)64 * ldb;
  const int loff = t * 16;
#define GEMM_ISSUE(kt_, st_)                                         \
  do {                                                               \
    const int kk_ = ((kt_) < nk ? (kt_) : (nk - 1)) * 32;            \
    char* sp_ = lds + (st_) * 24576 + loff;                          \
    gll16(ga0 + kk_, sp_);                                           \
    gll16(ga0 + a64 + kk_, sp_ + 4096);                              \
    gll16(ga0 + 2 * a64 + kk_, sp_ + 8192);                          \
    gll16(ga0 + 3 * a64 + kk_, sp_ + 12288);                         \
    gll16(gb0 + kk_, sp_ + 16384);                                   \
    gll16(gb0 + b64 + kk_, sp_ + 20480);                             \
  } while (0)
  __syncthreads();
  GEMM_ISSUE(0, 0);
  GEMM_ISSUE(1, 1);
  const int fsw = (r >> 2) & 3;
  const int aoff = (wm * 128 + r) * 64, boff = 16384 + (wn * 64 + r) * 64;
  int scur = 0, snext = 2;
  for (int kt = 0; kt < nk; ++kt) {
    asm volatile("s_waitcnt vmcnt(6)" ::: "memory");
    __builtin_amdgcn_s_barrier();
    asm volatile("" ::: "memory");
    GEMM_ISSUE(kt + 2, snext);
    __builtin_amdgcn_sched_barrier(0);
    const char* st = lds + scur * 24576;
#pragma unroll
    for (int ks = 0; ks < 2; ++ks) {
      const int q = ((ks * 2 + h) ^ fsw) * 16;
      bf16x8 fa[4], fb[2];
#pragma unroll
      for (int i = 0; i < 4; ++i) fa[i] = *(const bf16x8*)(st + aoff + i * 2048 + q);
#pragma unroll
      for (int i = 0; i < 2; ++i) fb[i] = *(const bf16x8*)(st + boff + i * 2048 + q);
#pragma unroll
      for (int i = 0; i < 4; ++i)
#pragma unroll
        for (int j = 0; j < 2; ++j) c.a[i][j] = MFMA(fa[i], fb[j], c.a[i][j]);
    }
    __builtin_amdgcn_sched_barrier(0);
    snext = scur;
    scur = (scur == 2) ? 0 : scur + 1;
  }
  asm volatile("s_waitcnt vmcnt(0)" ::: "memory");
  __builtin_amdgcn_s_barrier();
  asm volatile("" ::: "memory");
#undef GEMM_ISSUE
}

DI void row_scales(const u16* __restrict__ base, int ld, int K, float* sc, int NR) {
  const int t = opaque_tid();
  const int row = (NR == 256) ? t : (t >> 1);
  const int part = (NR == 256) ? 0 : (t & 1);
  const int len = (NR == 256) ? K : (K / 2);
  const u16* p = base + (size_t)row * ld + part * len;
  float ss = 0.f;
  for (int i0 = 0; i0 < len / 8; i0 += 8) {
    u32x4 v[8];
#pragma unroll
    for (int i = 0; i < 8; ++i) v[i] = *(const u32x4*)(p + (i0 + i) * 8);
#pragma unroll
    for (int i = 0; i < 8; ++i)
#pragma unroll
      for (int j = 0; j < 4; ++j) { float a = bflo(v[i][j]), b = bfhi(v[i][j]); ss += a * a + b * b; }
  }
  if (NR != 256) ss += __shfl_xor(ss, 1);
  if (part == 0) sc[row] = rsqrtf(ss / (float)K + EPS);
}


template <int NI, class V, class R>
DI void epi_store(u16* smem, V val, R rowfn) {
  const int t = opaque_tid();
  const int lane = t & 63, w = t >> 6, r = lane & 31, h = lane >> 5;
  char* reg = (char*)smem + w * 18432;
#pragma unroll
  for (int mi = 0; mi < 4; ++mi)
#pragma unroll
    for (int ni = 0; ni < NI; ++ni)
#pragma unroll
      for (int i = 0; i < 16; ++i)
        *(u16*)(reg + (mi * 32 + crow(i, h)) * 144 + (ni * 32 + r) * 2) = f2bf(val(mi, ni, i));
  __builtin_amdgcn_sched_barrier(0);
  constexpr int CPR = NI * 4;
  constexpr int RPI = 64 / CPR;
  const int rr = lane / CPR, ch = lane % CPR;
#pragma unroll
  for (int k = 0; k < 128 / RPI; ++k) {
    const int row = k * RPI + rr;
    u32x4 v = *(const u32x4*)(reg + row * 144 + ch * 16);
    rowfn(row, ch * 8, v);
  }
}

DI void tile_coords(int id, int MT, int NT, int& tm, int& tn) {
  const int per = 32 * NT;
  const int sr = id / per, rem = id - sr * per;
  tn = rem >> 5;
  tm = sr * 32 + (rem & 31);
}

#define EPI_LOOP                                   \
  _Pragma("unroll") for (int mi = 0; mi < 4; ++mi) \
  _Pragma("unroll") for (int ni = 0; ni < 2; ++ni) \
  _Pragma("unroll") for (int i = (__builtin_amdgcn_sched_barrier(0), 0); i < 16; ++i)

constexpr int SMEM_BYTES = 74752;

__global__ void __launch_bounds__(256, 2) fwd_megakernel(Params p) {
  cg::grid_group grid = cg::this_grid();
  __shared__ __attribute__((aligned(16))) char smem_raw[SMEM_BYTES];
  u16* smem = (u16*)smem_raw;
  const int G = gridDim.x, bid = blockIdx.x;
  __shared__ uint4 xb_words;
  if (threadIdx.x == 0) xb_words = make_uint4(0u, 0u, 0u, 0u);
  __syncthreads();
  XcdBarrier xb = xcd_barrier_post((unsigned*)(p.ws + OFF_BAR), (volatile LAS unsigned*)&xb_words);

  char* ws = p.ws;
#define Wb ((u16*)(ws + OFF_WB))
#define ropec ((float*)(ws + OFF_ROPE))
#define ropes (((float*)(ws + OFF_ROPE)) + SEQ * 16)
#define Hb ((u16*)(ws + OFF_H))
#define Yb ((u16*)(ws + OFF_Y))
#define ACT ((u16*)(ws + OFF_ACT))
#define Z ((u16*)(ws + OFF_Z))
#define Qb ((u16*)(ws + OFF_Q))
#define KN ((u16*)(ws + OFF_KN))
#define VT ((u16*)(ws + OFF_VT))
#define KPE ((u16*)(ws + OFF_KPE))
#define OA ((u16*)(ws + OFF_OA))
#define ST ((u16*)(ws + OFF_ST))
#define DEC ((float*)(ws + OFF_DEC))
#define GC ((float*)(ws + OFF_GC))
#define OG ((u16*)(ws + OFF_OG))
#define MG ((u16*)(ws + OFF_MG))
  float* X = p.out;

  auto convert_weights = [&](int l) __attribute__((always_inline)) {
    const int t = opaque_tid();
    const int lane = t & 63, w = t >> 6, r = lane & 31, h = lane >> 5;
    const int wm = w >> 1, wn = w & 1;
    (void)lane; (void)r; (void)h; (void)wm; (void)wn;
    float* tile = (float*)smem_raw;
    for (int mat = 0; mat < 11; ++mat) {
      const float* src; int K, N; size_t dst; int map; const float* ksc = nullptr;
      switch (mat) {
        case 0: src = in_ptr(p, 3) + (size_t)l * DM * NFF2; K = DM; N = NFF2; dst = W_FFN1_IN; map = 1; break;
        case 1: src = in_ptr(p, 4) + (size_t)l * DFF * DM; K = DFF; N = DM; dst = W_FFN1_OUT; map = 0; break;
        case 2: src = in_ptr(p, 7) + (size_t)l * DM * PIN; K = DM; N = PIN; dst = W_IN; map = 0; break;
        case 3: src = in_ptr(p, 9) + (size_t)l * 256 * 768; K = 256; N = 768; dst = W_UQ; map = 0; ksc = in_ptr(p, 8) + l * 256; break;
        case 4: src = in_ptr(p, 11) + (size_t)l * 128 * 1024; K = 128; N = 1024; dst = W_KN; map = 2; ksc = in_ptr(p, 10) + l * 128; break;
        case 5: src = in_ptr(p, 12) + (size_t)l * 512 * DM; K = 512; N = DM; dst = W_OA; map = 0; break;
        case 6: src = in_ptr(p, 18) + (size_t)l * DM * DM; K = DM; N = DM; dst = W_OB; map = 0; break;
        case 7: src = in_ptr(p, 19) + (size_t)l * DM * DM; K = DM; N = DM; dst = W_OUT; map = 0; break;
        case 8: src = in_ptr(p, 22) + (size_t)l * DM * NFF2; K = DM; N = NFF2; dst = W_FFN2_IN; map = 1; break;
        case 9: src = in_ptr(p, 23) + (size_t)l * DFF * DM; K = DFF; N = DM; dst = W_FFN2_OUT; map = 0; break;
        default: src = nullptr; K = DM; N = 64; dst = W_IN + (size_t)PIN * DM; map = 3; break;
      }
      const int kt_n = K / 64, nt_n = N / 64;
      for (int id = bid; id < kt_n * nt_n; id += G) {
        const int kt = id % kt_n, nt = id / kt_n;
        const int k0 = kt * 64, n0 = nt * 64;
        __syncthreads();
        if (map != 3) {
#pragma unroll
          for (int i = 0; i < 4; ++i) {
            const int kk = (t >> 4) + 16 * i, nn = (t & 15) * 4;
            float4 v = *(const float4*)(src + (size_t)(k0 + kk) * N + n0 + nn);
            float sc = ksc ? ksc[k0 + kk] : 1.f;
            tile[kk * 65 + nn + 0] = v.x * sc; tile[kk * 65 + nn + 1] = v.y * sc;
            tile[kk * 65 + nn + 2] = v.z * sc; tile[kk * 65 + nn + 3] = v.w * sc;
          }
        }
        __syncthreads();
        const int nl = t >> 2, kc = (t & 3) * 16;
        const int n = n0 + nl;
        size_t drow;
        if (map == 0) drow = dst + (size_t)n * K;
        else if (map == 1) { const int isb = n >= DFF; const int j = n - isb * DFF; drow = dst + (size_t)((j >> 5) * 64 + isb * 32 + (j & 31)) * K; }
        else if (map == 2) { const int hd = n >> 7, cc = n & 127; drow = (cc < 64) ? (W_KN + (size_t)(hd * 64 + cc) * K) : (W_V + (size_t)(hd * 64 + cc - 64) * K); }
        else drow = dst + (size_t)nl * K;
        unsigned o[8];
#pragma unroll
        for (int j = 0; j < 8; ++j) {
          float a = (map == 3) ? 0.f : tile[(kc + 2 * j) * 65 + nl];
          float b = (map == 3) ? 0.f : tile[(kc + 2 * j + 1) * 65 + nl];
          o[j] = pk2(a, b);
        }
        uint4* dp = (uint4*)(Wb + drow + k0 + kc);
        dp[0] = make_uint4(o[0], o[1], o[2], o[3]);
        dp[1] = make_uint4(o[4], o[5], o[6], o[7]);
      }
    }
  };

  auto rn_pass = [&](int mode, float coef, const float* post_g, const float* pre_g) __attribute__((always_inline)) {
    const int t = opaque_tid();
    const int lane = t & 63, w = t >> 6, r = lane & 31, h = lane >> 5;
    const int wm = w >> 1, wn = w & 1;
    (void)lane; (void)r; (void)h; (void)wm; (void)wn;
    const int gw = bid * 4 + w, nw = G * 4;
    for (int row = gw; row < MALL; row += nw) {
      const float* xs;
      if (mode == 0) xs = (row < SEQ) ? (in_ptr(p, 0) + (size_t)row * DM) : (in_ptr(p, 1) + (size_t)(row - SEQ) * DM);
      else xs = X + (size_t)row * DM;
      float4 xv[4];
#pragma unroll
      for (int i = 0; i < 4; ++i) xv[i] = *(const float4*)(xs + lane * 4 + 256 * i);
      if (mode == 1) {
        float yv[16];
        float ss = 0.f;
#pragma unroll
        for (int i = 0; i < 4; ++i) {
          uint2 u = *(const uint2*)(Yb + (size_t)row * DM + lane * 4 + 256 * i);
          yv[4 * i + 0] = bflo(u.x); yv[4 * i + 1] = bfhi(u.x); yv[4 * i + 2] = bflo(u.y); yv[4 * i + 3] = bfhi(u.y);
        }
#pragma unroll
        for (int i = 0; i < 16; ++i) ss += yv[i] * yv[i];
        ss = wave_sum(ss);
        const float ry = rsqrtf(ss * (1.f / DM) + EPS) * coef;
#pragma unroll
        for (int i = 0; i < 4; ++i) {
          float4 g = *(const float4*)(post_g + lane * 4 + 256 * i);
          xv[i].x += yv[4 * i + 0] * ry * g.x; xv[i].y += yv[4 * i + 1] * ry * g.y;
          xv[i].z += yv[4 * i + 2] * ry * g.z; xv[i].w += yv[4 * i + 3] * ry * g.w;
        }
      }
#pragma unroll
      for (int i = 0; i < 4; ++i) *(float4*)(X + (size_t)row * DM + lane * 4 + 256 * i) = xv[i];
      if (pre_g) {
        float ss = 0.f;
#pragma unroll
        for (int i = 0; i < 4; ++i) ss += xv[i].x * xv[i].x + xv[i].y * xv[i].y + xv[i].z * xv[i].z + xv[i].w * xv[i].w;
        ss = wave_sum(ss);
        const float rx = rsqrtf(ss * (1.f / DM) + EPS);
#pragma unroll
        for (int i = 0; i < 4; ++i) {
          float4 g = *(const float4*)(pre_g + lane * 4 + 256 * i);
          uint2 o;
          o.x = pk2(xv[i].x * rx * g.x, xv[i].y * rx * g.y);
          o.y = pk2(xv[i].z * rx * g.z, xv[i].w * rx * g.w);
          *(uint2*)(Hb + (size_t)row * DM + lane * 4 + 256 * i) = o;
        }
      }
    }
  };

  auto ffn_in = [&](size_t woff) __attribute__((always_inline)) {
    const int t = opaque_tid();
    const int lane = t & 63, w = t >> 6, r = lane & 31, h = lane >> 5;
    const int wm = w >> 1, wn = w & 1;
    (void)lane; (void)r; (void)h; (void)wm; (void)wn;
    const int MT = MALL / 256, NT = NFF2 / 128;
    for (int id = bid; id < MT * NT; id += G) {
      int tm, tn; tile_coords(id, MT, NT, tm, tn);
      const int m0 = tm * 256, n0 = tn * 128;
      Acc c; acc_zero(c);
      gemm_kloop(Hb + (size_t)m0 * DM, DM, Wb + woff + (size_t)n0 * DM, DM, DM, smem, c);
#ifdef DUP_KLOOP
      acc_zero(c);
      gemm_kloop(Hb + (size_t)m0 * DM, DM, Wb + woff + (size_t)n0 * DM, DM, DM, smem, c);
#endif
      const int jb0 = ((n0 + wn * 64) >> 6) * 32;
      const unsigned obase = (unsigned)((m0 + wm * 128) * DFF + jb0);
      epi_store<1>(smem,
        [&](int mi, int ni, int i) { return siluf_(c.a[mi][0][i]) * c.a[mi][1][i]; },
        [&](int row, int col, u32x4 v) { *(u32x4*)(ACT + obase + (unsigned)(row * DFF + col)) = v; });
    }
  };
  auto gemm_plain = [&](const u16* A, int lda, int K, const u16* Bt, u16* C, int ldc, int M, int N) __attribute__((always_inline)) {
    const int t = opaque_tid();
    const int lane = t & 63, w = t >> 6, r = lane & 31, h = lane >> 5;
    const int wm = w >> 1, wn = w & 1;
    (void)lane; (void)r; (void)h; (void)wm; (void)wn;
    const int MT = M / 256, NT = N / 128;
    for (int id = bid; id < MT * NT; id += G) {
      int tm, tn; tile_coords(id, MT, NT, tm, tn);
      const int m0 = tm * 256, n0 = tn * 128;
      Acc c; acc_zero(c);
      gemm_kloop(A + (size_t)m0 * lda, lda, Bt + (size_t)n0 * K, K, K, smem, c);
      const unsigned obase = (unsigned)((m0 + wm * 128) * ldc + n0 + wn * 64);
      epi_store<2>(smem,
        [&](int mi, int ni, int i) { return c.a[mi][ni][i]; },
        [&](int row, int col, u32x4 v) { *(u32x4*)(C + obase + (unsigned)(row * ldc + col)) = v; });
    }
  };

  auto prep_phase = [&](int l) __attribute__((always_inline)) {
    const int t = opaque_tid();
    const int lane = t & 63, w = t >> 6, r = lane & 31, h = lane >> 5;
    const int wm = w >> 1, wn = w & 1;
    (void)lane; (void)r; (void)h; (void)wm; (void)wn;
    float* sc = (float*)(smem_raw + 2 * GEMM_LDS);
    const int NQ = 64 * 6, NK = 64 * 4, NV = 2 * 128, NPE = 64, NG1 = NCHUNK * 4;
    const float qscale = 0.10206207261596577f * 1.4426950408889634f;
    {
      for (int id = bid; id < NG1; id += G) {
        const int t = opaque_tid();
        const int lane = t & 63, w = t >> 6, r = lane & 31, h = lane >> 5;
        const int wm = w >> 1, wn = w & 1;
        (void)lane; (void)r; (void)h; (void)wm; (void)wn;
        const int n = id >> 2, hd = id & 3;
        const int t0 = n * 64;
        u16* ksT = smem;
        u16* vT = smem + 2 * 128 * LROW;
        u16* sk = vT;
        float* sga = (float*)(smem_raw + 55296);
        __syncthreads();
        {
          const int cc = t >> 2, part = t & 3;
          const u16* kp = Z + (size_t)(t0 + cc) * ZLD + Z_GK + hd * 128 + part * 32;
#pragma unroll
          for (int j = 0; j < 4; ++j) *(u32x4*)(sk + cc * 128 + part * 32 + j * 8) = *(const u32x4*)(kp + j * 8);
          u32x4 gv = *(const u32x4*)(Z + (size_t)(t0 + cc) * ZLD + Z_GA + part * 8);
#pragma unroll
          for (int k = 0; k < 4; ++k) { sga[cc * 32 + part * 8 + 2 * k] = bflo(gv[k]); sga[cc * 32 + part * 8 + 2 * k + 1] = bfhi(gv[k]); }
        }
        __syncthreads();
        {
          const int dir = t >> 7, d = t & 127;
          const float* wa2 = (dir ? in_ptr(p, 15) : in_ptr(p, 13)) + (size_t)l * 16 * 512 + hd * 128 + d;
          const float ba = ((dir ? in_ptr(p, 16) : in_ptr(p, 14)) + (size_t)l * 512)[hd * 128 + d];
          float wcol[16];
#pragma unroll
          for (int rr = 0; rr < 16; ++rr) wcol[rr] = wa2[rr * 512];
          const float* gar = sga + dir * 16;
          float tot = 0.f;
          for (int cc = 0; cc < 64; ++cc) {
            float pre = ba;
#pragma unroll
            for (int rr = 0; rr < 16; ++rr) pre += gar[cc * 32 + rr] * wcol[rr];
            tot += (fminf(pre, 0.f) - __logf(1.f + __expf(-fabsf(pre)))) * (1.f / 16.f);
          }
          DEC[((size_t)(n * 4 + hd) * 2 + dir) * 128 + d] = __expf(tot);
          float* gc = GC + (size_t)dir * SEQ * 512 + (size_t)t0 * 512 + hd * 128 + d;
          float cb = 0.f;
          u16* krow_out = ksT + (dir * 128 + d) * LROW;
          for (int ci = 0; ci < 64; ++ci) {
            const int cc = dir ? (63 - ci) : ci;
            float pre = ba;
#pragma unroll
            for (int rr = 0; rr < 16; ++rr) pre += gar[cc * 32 + rr] * wcol[rr];
            cb += (fminf(pre, 0.f) - __logf(1.f + __expf(-fabsf(pre)))) * (1.f / 16.f);
            gc[cc * 512] = cb;
            krow_out[cc] = f2bf(bf2f(sk[cc * 128 + d]) * __expf(tot - cb));
          }
        }
        for (int half = 0; half < 2; ++half) {
          __syncthreads();
          {
            const int cc = t & 63, part = t >> 6;
#pragma unroll
            for (int q = 0; q < 4; ++q) {
              const int cg8 = (part * 4 + q) * 8;
              uint4 v = *(const uint4*)(Z + (size_t)(t0 + cc) * ZLD + Z_GV + hd * 256 + half * 128 + cg8);
              unsigned u[4] = {v.x, v.y, v.z, v.w};
#pragma unroll
              for (int j = 0; j < 4; ++j) {
                vT[(cg8 + 2 * j) * LROW + cc] = (u16)(u[j] & 0xffffu);
                vT[(cg8 + 2 * j + 1) * LROW + cc] = (u16)(u[j] >> 16);
              }
            }
          }
          __syncthreads();
#pragma unroll
          for (int dir = 0; dir < 2; ++dir) {
            f32x16 acc[4];
#pragma unroll
            for (int j = 0; j < 4; ++j)
#pragma unroll
              for (int k = 0; k < 16; ++k) acc[j][k] = 0.f;
#pragma unroll
            for (int ks = 0; ks < 4; ++ks) {
              bf16x8 fa = *(const bf16x8*)(vT + (w * 32 + r) * LROW + ks * 16 + h * 8);
#pragma unroll
              for (int nt = 0; nt < 4; ++nt) {
                bf16x8 fb = *(const bf16x8*)(ksT + (dir * 128 + nt * 32 + r) * LROW + ks * 16 + h * 8);
                acc[nt] = MFMA(fb, fa, acc[nt]);
              }
            }
            u16* stp = ST + ((size_t)(n * 4 + hd) * 2 + dir) * 32768;
#pragma unroll
            for (int nt = 0; nt < 4; ++nt)
#pragma unroll
              for (int g4 = 0; g4 < 4; ++g4) {
                uint2 o;
                o.x = pk2(acc[nt][4 * g4 + 0], acc[nt][4 * g4 + 1]);
                o.y = pk2(acc[nt][4 * g4 + 2], acc[nt][4 * g4 + 3]);
                *(uint2*)(stp + (unsigned)((half * 128 + w * 32 + r) * 128 + nt * 32 + 8 * g4 + 4 * h)) = o;
              }
          }
        }
      }
      for (int q = bid; q < NQ; q += G) {
        const int t = opaque_tid();
        const int lane = t & 63, w = t >> 6, r = lane & 31, h = lane >> 5;
        const int wm = w >> 1, wn = w & 1;
        (void)lane; (void)r; (void)h; (void)wm; (void)wn;
        const int tm = q / 6, tn = q % 6;
        const int m0 = tm * 256, n0 = tn * 128;
        __syncthreads();
        row_scales(Z + (size_t)m0 * ZLD + Z_CQ, ZLD, 256, sc, 256);
        Acc c; acc_zero(c);
        gemm_kloop(Z + (size_t)m0 * ZLD + Z_CQ, ZLD, Wb + W_UQ + (size_t)n0 * 256, 256, 256, smem, c);
        {
          const unsigned obase = (unsigned)((m0 + wm * 128) * 768 + n0 + wn * 64);
          epi_store<2>(smem,
            [&](int mi, int ni, int i) {
              const int cb0 = n0 + wn * 64 + ni * 32;
              const bool rope = ((cb0 >> 5) % 3) == 2;
              const int rl = wm * 128 + mi * 32 + crow(i, h);
              float v = c.a[mi][ni][i] * sc[rl];
              const float pv = __shfl_xor(v, 16);
              if (rope) {
                const int row = m0 + rl;
                const float cs = ropec[row * 16 + (r & 15)], sn = ropes[row * 16 + (r & 15)];
                v = (r < 16) ? (v * cs - pv * sn) : (v * cs + pv * sn);
              }
              return v * qscale;
            },
            [&](int row, int col, u32x4 v) { *(u32x4*)(Qb + obase + (unsigned)(row * 768 + col)) = v; });
        }
      }
      for (int q = G - 1 - bid; q < NK; q += G) {
        const int t = opaque_tid();
        const int lane = t & 63, w = t >> 6, r = lane & 31, h = lane >> 5;
        const int wm = w >> 1, wn = w & 1;
        (void)lane; (void)r; (void)h; (void)wm; (void)wn;
        const int tm = q >> 2, tn = q & 3;
        const int m0 = tm * 256, n0 = tn * 128;
        __syncthreads();
        row_scales(Z + (size_t)m0 * ZLD + Z_CKV, ZLD, 128, sc, 256);
        Acc c; acc_zero(c);
        gemm_kloop(Z + (size_t)m0 * ZLD + Z_CKV, ZLD, Wb + W_KN + (size_t)n0 * 128, 128, 128, smem, c);
        {
          const unsigned obase = (unsigned)((m0 + wm * 128) * 512 + n0 + wn * 64);
          epi_store<2>(smem,
            [&](int mi, int ni, int i) { return c.a[mi][ni][i] * sc[wm * 128 + mi * 32 + crow(i, h)]; },
            [&](int row, int col, u32x4 v) { *(u32x4*)(KN + obase + (unsigned)(row * 512 + col)) = v; });
        }
      }
      for (int q = G - 1 - bid; q < NV; q += G) {
        const int t = opaque_tid();
        const int lane = t & 63, w = t >> 6, r = lane & 31, h = lane >> 5;
        const int wm = w >> 1, wn = w & 1;
        (void)lane; (void)r; (void)h; (void)wm; (void)wn;
        const int tm = q & 1, tn = q >> 1;
        const int m0 = tm * 256, n0 = tn * 128;
        __syncthreads();
        row_scales(Z + (size_t)n0 * ZLD + Z_CKV, ZLD, 128, sc, 128);
        Acc c; acc_zero(c);
        gemm_kloop(Wb + W_V + (size_t)m0 * 128, 128, Z + (size_t)n0 * ZLD + Z_CKV, ZLD, 128, smem, c);
        {
          const unsigned obase = (unsigned)((m0 + wm * 128) * SEQ + n0 + wn * 64);
          epi_store<2>(smem,
            [&](int mi, int ni, int i) { return c.a[mi][ni][i] * sc[wn * 64 + ni * 32 + r]; },
            [&](int row, int col, u32x4 v) { *(u32x4*)(VT + obase + (unsigned)(row * SEQ + col)) = v; });
        }
      }
      for (int q = G - 1 - bid; q < NPE; q += G) {
        const int t = opaque_tid();
        const int lane = t & 63, w = t >> 6, r = lane & 31, h = lane >> 5;
        const int wm = w >> 1, wn = w & 1;
        (void)lane; (void)r; (void)h; (void)wm; (void)wn;
        const int tok = q * 256 + t;
        const u16* src = Z + (size_t)tok * ZLD + Z_KPE;
        float v[32];
#pragma unroll
        for (int j = 0; j < 4; ++j) {
          uint4 u = *(const uint4*)(src + j * 8);
          unsigned uu[4] = {u.x, u.y, u.z, u.w};
#pragma unroll
          for (int k = 0; k < 4; ++k) { v[j * 8 + 2 * k] = bflo(uu[k]); v[j * 8 + 2 * k + 1] = bfhi(uu[k]); }
        }
        float o[32];
#pragma unroll
        for (int i = 0; i < 16; ++i) {
          const float cs = ropec[tok * 16 + i], sn = ropes[tok * 16 + i];
          o[i] = v[i] * cs - v[i + 16] * sn;
          o[i + 16] = v[i + 16] * cs + v[i] * sn;
        }
#pragma unroll
        for (int j = 0; j < 4; ++j) {
          uint4 u;
          u.x = pk2(o[j * 8 + 0], o[j * 8 + 1]); u.y = pk2(o[j * 8 + 2], o[j * 8 + 3]);
          u.z = pk2(o[j * 8 + 4], o[j * 8 + 5]); u.w = pk2(o[j * 8 + 6], o[j * 8 + 7]);
          *(uint4*)(KPE + (size_t)tok * 32 + j * 8) = u;
        }
      }
    }
  };

  auto attn_phase = [&](bool do_scan) __attribute__((always_inline)) {
    const int t = opaque_tid();
    const int lane = t & 63, w = t >> 6, r = lane & 31, h = lane >> 5;
    const int wm = w >> 1, wn = w & 1;
    (void)lane; (void)r; (void)h; (void)wm; (void)wn;
    if (do_scan) for (int id = bid; id < 512; id += G) {
      const int e = id * 256 + t;
      const int d2 = e & 63, v = (e >> 6) & 255, dir = (e >> 14) & 1, hd = e >> 15;
      float s0 = 0.f, s1 = 0.f;
      for (int i = 0; i < NCHUNK; ++i) {
        const int n = dir ? (NCHUNK - 1 - i) : i;
        const size_t base = ((size_t)(n * 4 + hd) * 2 + dir);
        unsigned* sp = (unsigned*)(ST + base * 32768 + (size_t)v * 128 + 2 * d2);
        const unsigned u = *sp;
        const float2 dc = *(const float2*)(DEC + base * 128 + 2 * d2);
        *sp = pk2(s0, s1);
        s0 = dc.x * s0 + bflo(u);
        s1 = dc.y * s1 + bfhi(u);
      }
    }
    constexpr int KROW = 104;
    constexpr int ABUF = 64 * KROW + 64 * LROW;
    u16* sK = smem;
    u16* sV = smem + 64 * KROW;
    for (int id = bid; id < 8 * 64; id += G) {
      const int hd = id & 7, qb = id >> 3;
      const int q0 = qb * 256 + w * 64;
      bf16x8 bq[2][6];
#pragma unroll
      for (int qt = 0; qt < 2; ++qt)
#pragma unroll
        for (int ks = 0; ks < 6; ++ks) bq[qt][ks] = *(const bf16x8*)(Qb + (size_t)(q0 + qt * 32 + r) * 768 + hd * 96 + ks * 16 + h * 8);
      f32x16 O[2][2];
#pragma unroll
      for (int j = 0; j < 2; ++j)
#pragma unroll
        for (int qt = 0; qt < 2; ++qt)
#pragma unroll
          for (int k = 0; k < 16; ++k) O[j][qt][k] = 0.f;
      float m[2] = {0.f, 0.f}, lsum[2] = {0.f, 0.f};
      const int kr = t >> 2, kc = t & 3;
      const u16* knp = KN + (size_t)kr * 512 + hd * 64 + kc * 16;
      const u16* kpp = KPE + (size_t)kr * 32 + kc * 8;
      const u16* vpp = VT + (size_t)(hd * 64 + kr) * SEQ + kc * 16;
      u32x4 rk[3], rv[2];
      rk[0] = *(const u32x4*)(knp);
      rk[1] = *(const u32x4*)(knp + 8);
      rk[2] = *(const u32x4*)(kpp);
      rv[0] = *(const u32x4*)(vpp);
      rv[1] = *(const u32x4*)(vpp + 8);
      __syncthreads();
      *(u32x4*)(sK + kr * KROW + kc * 16) = rk[0];
      *(u32x4*)(sK + kr * KROW + kc * 16 + 8) = rk[1];
      *(u32x4*)(sK + kr * KROW + 64 + kc * 8) = rk[2];
      *(u32x4*)(sV + kr * LROW + kc * 16) = rv[0];
      *(u32x4*)(sV + kr * LROW + kc * 16 + 8) = rv[1];
      rk[0] = *(const u32x4*)(knp + (size_t)64 * 512);
      rk[1] = *(const u32x4*)(knp + (size_t)64 * 512 + 8);
      rk[2] = *(const u32x4*)(kpp + (size_t)64 * 32);
      rv[0] = *(const u32x4*)(vpp + 64);
      rv[1] = *(const u32x4*)(vpp + 64 + 8);
      __syncthreads();
      int cur = 0;
      for (int key0 = 0; key0 < SEQ; key0 += 64) {
        const u16* cK = sK + cur * ABUF;
        const u16* cV = sV + cur * ABUF;
        {
          u16* nK = sK + (cur ^ 1) * ABUF;
          u16* nV = sV + (cur ^ 1) * ABUF;
          *(u32x4*)(nK + kr * KROW + kc * 16) = rk[0];
          *(u32x4*)(nK + kr * KROW + kc * 16 + 8) = rk[1];
          *(u32x4*)(nK + kr * KROW + 64 + kc * 8) = rk[2];
          *(u32x4*)(nV + kr * LROW + kc * 16) = rv[0];
          *(u32x4*)(nV + kr * LROW + kc * 16 + 8) = rv[1];
          const int kn = (key0 + 128 < SEQ) ? (key0 + 128) : key0;
          rk[0] = *(const u32x4*)(knp + (size_t)kn * 512);
          rk[1] = *(const u32x4*)(knp + (size_t)kn * 512 + 8);
          rk[2] = *(const u32x4*)(kpp + (size_t)kn * 32);
          rv[0] = *(const u32x4*)(vpp + kn);
          rv[1] = *(const u32x4*)(vpp + kn + 8);
        }
        __builtin_amdgcn_sched_barrier(0);
        f32x16 S[2][2];
#pragma unroll
        for (int kt = 0; kt < 2; ++kt)
#pragma unroll
          for (int qt = 0; qt < 2; ++qt)
#pragma unroll
            for (int k = 0; k < 16; ++k) S[kt][qt][k] = -m[qt];
#pragma unroll
        for (int ks = 0; ks < 6; ++ks)
#pragma unroll
          for (int kt = 0; kt < 2; ++kt) {
            bf16x8 fa = *(const bf16x8*)(cK + (kt * 32 + r) * KROW + ks * 16 + h * 8);
            S[kt][0] = MFMA(fa, bq[0][ks], S[kt][0]);
            S[kt][1] = MFMA(fa, bq[1][ks], S[kt][1]);
          }
        bf16x8 pf[2][4];
#pragma unroll
        for (int qt = 0; qt < 2; ++qt) {
          float mloc = S[0][qt][0];
#pragma unroll
          for (int kt = 0; kt < 2; ++kt)
#pragma unroll
            for (int k = 0; k < 16; ++k) mloc = fmaxf(mloc, S[kt][qt][k]);
          mloc = fmaxf(mloc, __shfl_xor(mloc, 32));
          if (__builtin_amdgcn_ballot_w64(mloc > 0.f) != 0ull) {
            const float delta = fmaxf(mloc, 0.f);
            const float alpha = __builtin_amdgcn_exp2f(-delta);
            m[qt] += delta;
            lsum[qt] *= alpha;
#pragma unroll
            for (int j = 0; j < 2; ++j)
#pragma unroll
              for (int k = 0; k < 16; ++k) O[j][qt][k] *= alpha;
#pragma unroll
            for (int kt = 0; kt < 2; ++kt)
#pragma unroll
              for (int k = 0; k < 16; ++k) S[kt][qt][k] -= delta;
          }
          float ps = 0.f;
#pragma unroll
          for (int kt = 0; kt < 2; ++kt)
#pragma unroll
            for (int k = 0; k < 16; ++k) { S[kt][qt][k] = __builtin_amdgcn_exp2f(S[kt][qt][k]); ps += S[kt][qt][k]; }
          lsum[qt] += ps;
#pragma unroll
          for (int s2 = 0; s2 < 4; ++s2) {
            const int kt = s2 >> 1, sx = s2 & 1;
            unsigned pw[4];
#pragma unroll
            for (int j = 0; j < 4; ++j) pw[j] = pk2(S[kt][qt][8 * sx + 2 * j], S[kt][qt][8 * sx + 2 * j + 1]);
            pf[qt][s2] = __builtin_bit_cast(bf16x8, make_uint4(pw[0], pw[1], pw[2], pw[3]));
          }
        }
#pragma unroll
        for (int s2 = 0; s2 < 4; ++s2) {
          const int kt = s2 >> 1, sx = s2 & 1;
#pragma unroll
          for (int dt = 0; dt < 2; ++dt) {
            const u16* vp = cV + (dt * 32 + r) * LROW + kt * 32 + 16 * sx + 4 * h;
            uint2 lo = *(const uint2*)(vp);
            uint2 hi = *(const uint2*)(vp + 8);
            bf16x8 fv = __builtin_bit_cast(bf16x8, make_uint4(lo.x, lo.y, hi.x, hi.y));
            O[dt][0] = MFMA(fv, pf[0][s2], O[dt][0]);
            O[dt][1] = MFMA(fv, pf[1][s2], O[dt][1]);
          }
        }
        cur ^= 1;
        __syncthreads();
      }
#pragma unroll
      for (int qt = 0; qt < 2; ++qt) {
        const float lt = lsum[qt] + __shfl_xor(lsum[qt], 32);
        const float inv = 1.f / lt;
#pragma unroll
        for (int dt = 0; dt < 2; ++dt)
#pragma unroll
          for (int g4 = 0; g4 < 4; ++g4) {
            uint2 o;
            o.x = pk2(O[dt][qt][4 * g4 + 0] * inv, O[dt][qt][4 * g4 + 1] * inv);
            o.y = pk2(O[dt][qt][4 * g4 + 2] * inv, O[dt][qt][4 * g4 + 3] * inv);
            *(uint2*)(OA + (size_t)(q0 + qt * 32 + r) * 512 + hd * 64 + dt * 32 + 8 * g4 + 4 * h) = o;
          }
      }
    }
  };

  auto gla_out_phase = [&](int l) __attribute__((always_inline)) {
    const int t = opaque_tid();
    const int lane = t & 63, w = t >> 6, r = lane & 31, h = lane >> 5;
    const int wm = w >> 1, wn = w & 1;
    (void)lane; (void)r; (void)h; (void)wm; (void)wn;
    constexpr int QROW = 136;
    u16* sQ = smem;
    u16* sKt = smem + 64 * QROW;
    u16* sVT = smem + 2 * 64 * QROW;
    float* sred = (float*)(smem + 2 * 64 * QROW + 256 * LROW);
    u16* sO = smem;
    constexpr int OROW = 264;
    const float qs = 0.08838834764831845f;
    const int cs = w & 1, vh = w >> 1;
    for (int id = bid; id < NCHUNK * 4; id += G) {
      const int n = id >> 2, hd = id & 3;
      const int t0 = n * 64;
      __syncthreads();
      {
        const int cc = t & 63, part = t >> 6;
#pragma unroll
        for (int q = 0; q < 8; ++q) {
          const int cg8 = (part * 8 + q) * 8;
          uint4 v = *(const uint4*)(Z + (size_t)(t0 + cc) * ZLD + Z_GV + hd * 256 + cg8);
          unsigned u[4] = {v.x, v.y, v.z, v.w};
#pragma unroll
          for (int j = 0; j < 4; ++j) {
            sVT[(cg8 + 2 * j) * LROW + cc] = (u16)(u[j] & 0xffffu);
            sVT[(cg8 + 2 * j + 1) * LROW + cc] = (u16)(u[j] >> 16);
          }
        }
      }
      f32x16 acc[4];
#pragma unroll
      for (int j = 0; j < 4; ++j)
#pragma unroll
        for (int k = 0; k < 16; ++k) acc[j][k] = 0.f;
      for (int dir = 0; dir < 2; ++dir) {
        __syncthreads();
        {
          const int cc = t >> 2, dp = (t & 3) * 32;
          const u16* qp = Z + (size_t)(t0 + cc) * ZLD + Z_GQ + hd * 128 + dp;
          const u16* kp = Z + (size_t)(t0 + cc) * ZLD + Z_GK + hd * 128 + dp;
          const float* gp = GC + (size_t)dir * SEQ * 512 + (size_t)(t0 + cc) * 512 + hd * 128 + dp;
#pragma unroll
          for (int j = 0; j < 4; ++j) {
            uint4 qv = *(const uint4*)(qp + j * 8);
            uint4 kv = *(const uint4*)(kp + j * 8);
            float4 g0 = *(const float4*)(gp + j * 8);
            float4 g1 = *(const float4*)(gp + j * 8 + 4);
            const float gg[8] = {g0.x, g0.y, g0.z, g0.w, g1.x, g1.y, g1.z, g1.w};
            const unsigned qu[4] = {qv.x, qv.y, qv.z, qv.w};
            const unsigned ku[4] = {kv.x, kv.y, kv.z, kv.w};
            unsigned qo[4], ko[4];
#pragma unroll
            for (int k = 0; k < 4; ++k) {
              const float e0 = __expf(gg[2 * k]), e1 = __expf(gg[2 * k + 1]);
              qo[k] = pk2(bflo(qu[k]) * qs * e0, bfhi(qu[k]) * qs * e1);
              ko[k] = pk2(bflo(ku[k]) / e0, bfhi(ku[k]) / e1);
            }
            *(uint4*)(sQ + cc * QROW + dp + j * 8) = make_uint4(qo[0], qo[1], qo[2], qo[3]);
            *(uint4*)(sKt + cc * QROW + dp + j * 8) = make_uint4(ko[0], ko[1], ko[2], ko[3]);
            __builtin_amdgcn_sched_barrier(0);
          }
        }
        __syncthreads();
        const u16* bqp = sQ + (cs * 32 + r) * QROW + h * 8;
        f32x16 at[2];
#pragma unroll
        for (int et = 0; et < 2; ++et) {
#pragma unroll
          for (int k = 0; k < 16; ++k) at[et][k] = 0.f;
#pragma unroll
          for (int ks = 0; ks < 8; ++ks) {
            bf16x8 fa = *(const bf16x8*)(sKt + (et * 32 + r) * QROW + ks * 16 + h * 8);
            bf16x8 fbq = *(const bf16x8*)(bqp + ks * 16);
            at[et] = MFMA(fa, fbq, at[et]);
          }
          const int cidx = cs * 32 + r;
#pragma unroll
          for (int k = 0; k < 16; ++k) {
            const int e = et * 32 + crow(k, h);
            const bool keep = dir ? (e >= cidx) : (e <= cidx);
            at[et][k] = keep ? at[et][k] : 0.f;
          }
        }
#pragma unroll
        for (int s2 = 0; s2 < 4; ++s2) {
          const int et = s2 >> 1, s = s2 & 1;
          unsigned pw[4];
#pragma unroll
          for (int j = 0; j < 4; ++j) pw[j] = pk2(at[et][8 * s + 2 * j], at[et][8 * s + 2 * j + 1]);
          bf16x8 pf = __builtin_bit_cast(bf16x8, make_uint4(pw[0], pw[1], pw[2], pw[3]));
#pragma unroll
          for (int mt = 0; mt < 4; ++mt) {
            const u16* vp = sVT + (vh * 128 + mt * 32 + r) * LROW + et * 32 + 16 * s + 4 * h;
            uint2 lo = *(const uint2*)(vp);
            uint2 hi = *(const uint2*)(vp + 8);
            bf16x8 fv = __builtin_bit_cast(bf16x8, make_uint4(lo.x, lo.y, hi.x, hi.y));
            acc[mt] = MFMA(fv, pf, acc[mt]);
          }
        }
        const u16* stp = ST + ((size_t)(n * 4 + hd) * 2 + dir) * 32768;
        {
          bf16x8 fs[2][4];
#pragma unroll
          for (int ks = 0; ks < 4; ++ks) fs[0][ks] = *(const bf16x8*)(stp + (size_t)(vh * 128 + r) * 128 + ks * 16 + h * 8);
#pragma unroll
          for (int bb = 0; bb < 8; ++bb) {
            const int mt = bb >> 1, kb = bb & 1;
            if (bb + 1 < 8) {
              const int mt1 = (bb + 1) >> 1, kb1 = (bb + 1) & 1;
#pragma unroll
              for (int ks = 0; ks < 4; ++ks) fs[(bb + 1) & 1][ks] = *(const bf16x8*)(stp + (size_t)(vh * 128 + mt1 * 32 + r) * 128 + (kb1 * 4 + ks) * 16 + h * 8);
            }
            __builtin_amdgcn_sched_barrier(0);
#pragma unroll
            for (int ks = 0; ks < 4; ++ks) { bf16x8 fbq = *(const bf16x8*)(bqp + (kb * 4 + ks) * 16); acc[mt] = MFMA(fs[bb & 1][ks], fbq, acc[mt]); }
            __builtin_amdgcn_sched_barrier(0);
          }
        }
      }
      float ss = 0.f;
#pragma unroll
      for (int mt = 0; mt < 4; ++mt)
#pragma unroll
        for (int k = 0; k < 16; ++k) ss += acc[mt][k] * acc[mt][k];
      ss += __shfl_xor(ss, 32);
      if (h == 0) sred[vh * 64 + cs * 32 + r] = ss;
      __syncthreads();
      const float rs = rsqrtf((sred[cs * 32 + r] + sred[64 + cs * 32 + r]) * (1.f / 256.f) + EPS);
#pragma unroll
      for (int mt = 0; mt < 4; ++mt)
#pragma unroll
        for (int g4 = 0; g4 < 4; ++g4) {
          uint2 o;
          o.x = pk2(acc[mt][4 * g4 + 0] * rs, acc[mt][4 * g4 + 1] * rs);
          o.y = pk2(acc[mt][4 * g4 + 2] * rs, acc[mt][4 * g4 + 3] * rs);
          *(uint2*)(sO + (cs * 32 + r) * OROW + vh * 128 + mt * 32 + 8 * g4 + 4 * h) = o;
        }
      __syncthreads();
      {
        const int t3 = opaque_tid();
        const int cc = t3 >> 2, vp0 = (t3 & 3) * 64;
        const float* ng = in_ptr(p, 17) + (size_t)l * 256;
#pragma unroll
        for (int j = 0; j < 8; ++j) {
          const int v0 = vp0 + j * 8;
          uint4 ov = *(const uint4*)(sO + cc * OROW + v0);
          uint4 gv = *(const uint4*)(Z + (size_t)(t0 + cc) * ZLD + Z_GOG + hd * 256 + v0);
          float4 n0 = *(const float4*)(ng + v0), n1 = *(const float4*)(ng + v0 + 4);
          const float nn[8] = {n0.x, n0.y, n0.z, n0.w, n1.x, n1.y, n1.z, n1.w};
          const unsigned ou[4] = {ov.x, ov.y, ov.z, ov.w};
          const unsigned gu[4] = {gv.x, gv.y, gv.z, gv.w};
          unsigned res[4];
#pragma unroll
          for (int k = 0; k < 4; ++k)
            res[k] = pk2(bflo(ou[k]) * nn[2 * k] * siluf_(bflo(gu[k])), bfhi(ou[k]) * nn[2 * k + 1] * siluf_(bfhi(gu[k])));
          *(uint4*)(OG + (size_t)(t0 + cc) * DM + hd * 256 + v0) = make_uint4(res[0], res[1], res[2], res[3]);
        }
      }
    }
  };

  auto merge_phase = [&]() __attribute__((always_inline)) {
    const int t = opaque_tid();
    const int lane = t & 63, w = t >> 6, r = lane & 31, h = lane >> 5;
    const int wm = w >> 1, wn = w & 1;
    (void)lane; (void)r; (void)h; (void)wm; (void)wn;
    const int MT = SEQ / 256, NT = DM / 128;
    for (int id = bid; id < MT * NT; id += G) {
      int tm, tn; tile_coords(id, MT, NT, tm, tn);
      const int m0 = tm * 256, n0 = tn * 128;
      Acc c; acc_zero(c);
      gemm_kloop(OA + (size_t)m0 * 512, 512, Wb + W_OA + (size_t)n0 * 512, 512, 512, smem, c);
      {
        const unsigned zbase = (unsigned)((m0 + wm * 128) * ZLD + Z_BG + n0 + wn * 64);
        const unsigned obase = (unsigned)((m0 + wm * 128) * DM + n0 + wn * 64);
        epi_store<2>(smem,
          [&](int mi, int ni, int i) { return c.a[mi][ni][i]; },
          [&](int row, int col, u32x4 v) {
            const u32x4 g = *(const u32x4*)(Z + zbase + (unsigned)(row * ZLD + col));
            u32x4 o;
#pragma unroll
            for (int k = 0; k < 4; ++k) o[k] = pk2(bflo(v[k]) * sigmoidf_(bflo(g[k])), bfhi(v[k]) * sigmoidf_(bfhi(g[k])));
            *(u32x4*)(MG + obase + (unsigned)(row * DM + col)) = o;
          });
      }
      acc_zero(c);
      gemm_kloop(OG + (size_t)m0 * DM, DM, Wb + W_OB + (size_t)n0 * DM, DM, DM, smem, c);
      {
        const int t2 = opaque_tid();
        const int wm2 = t2 >> 7, wn2 = (t2 >> 6) & 1;
        const unsigned zbase = (unsigned)((m0 + wm2 * 128) * ZLD + Z_BG + DM + n0 + wn2 * 64);
        const unsigned obase = (unsigned)((m0 + wm2 * 128) * DM + n0 + wn2 * 64);
        epi_store<2>(smem,
          [&](int mi, int ni, int i) { return c.a[mi][ni][i]; },
          [&](int row, int col, u32x4 v) {
            const u32x4 g = *(const u32x4*)(Z + zbase + (unsigned)(row * ZLD + col));
            const u32x4 pm = *(const u32x4*)(MG + obase + (unsigned)(row * DM + col));
            u32x4 o;
#pragma unroll
            for (int k = 0; k < 4; ++k)
              o[k] = pk2(bflo(pm[k]) + bflo(v[k]) * sigmoidf_(bflo(g[k])), bfhi(pm[k]) + bfhi(v[k]) * sigmoidf_(bfhi(g[k])));
            *(u32x4*)(MG + obase + (unsigned)(row * DM + col)) = o;
          });
      }
    }
  };

  for (int i = bid * 256 + opaque_tid(); i < SEQ * 16; i += G * 256) {
    const int pos = i >> 4, j = i & 15;
    const float inv_freq = exp2f(-(float)j * 0.8304820237218406f);
    const float angf = (float)pos * inv_freq;
    double a = (double)angf;
    const double twopi = 6.283185307179586476925286766559;
    a -= twopi * rint(a / twopi);
    const float af = (float)a;
    ropec[i] = __cosf(af);
    ropes[i] = __sinf(af);
  }
  convert_weights(0);
  rn_pass(0, 0.f, nullptr, in_ptr(p, 2));
  grid.sync();

  for (int l = 0; l < 4; ++l) {
    ffn_in(W_FFN1_IN);
#ifdef DUP_FFNIN
    xcd_barrier(xb);
    ffn_in(W_FFN1_IN);
#endif
    xcd_barrier(xb);
    gemm_plain(ACT, DFF, DFF, Wb + W_FFN1_OUT, Yb, DM, MALL, DM);
    xcd_barrier(xb);
    rn_pass(1, 0.5f, in_ptr(p, 5) + l * DM, in_ptr(p, 6) + l * DM);
    xcd_barrier(xb);
    for (int s = 0; s < NSEQ; ++s) {
      gemm_plain(Hb + (size_t)s * SEQ * DM, DM, DM, Wb + W_IN, Z, ZLD, SEQ, ZLD);
      xcd_barrier(xb);
      prep_phase(l);
#ifdef DUP_PREP
      xcd_barrier(xb);
      prep_phase(l);
#endif
      xcd_barrier(xb);
      attn_phase(true);
#ifdef DUP_ATTN
      xcd_barrier(xb);
      attn_phase(false);
#endif
      xcd_barrier(xb);
      gla_out_phase(l);
#ifdef DUP_GLAOUT
      xcd_barrier(xb);
      gla_out_phase(l);
#endif
      xcd_barrier(xb);
      merge_phase();
      xcd_barrier(xb);
      gemm_plain(MG, DM, DM, Wb + W_OUT, Yb + (size_t)s * SEQ * DM, DM, SEQ, DM);
      xcd_barrier(xb);
    }
    rn_pass(1, 1.0f, in_ptr(p, 20) + l * DM, in_ptr(p, 21) + l * DM);
    xcd_barrier(xb);
    ffn_in(W_FFN2_IN);
    xcd_barrier(xb);
    gemm_plain(ACT, DFF, DFF, Wb + W_FFN2_OUT, Yb, DM, MALL, DM);
    xcd_barrier(xb);
    rn_pass(1, 0.5f, in_ptr(p, 24) + l * DM, (l < 3) ? (in_ptr(p, 2) + (l + 1) * DM) : nullptr);
    if (l < 3) convert_weights(l + 1);
    xcd_barrier(xb);
  }
}

extern "C" void kernel_launch(void* const* d_in, const int* in_sizes, int n_in, void* d_out,
                              int out_size, void* d_ws, size_t ws_size, hipStream_t stream) {
  static int grid_blocks = 0;
  if (!grid_blocks) {
    int dev = 0, cus = 0, per_cu = 0;
    (void)hipGetDevice(&dev);
    (void)hipDeviceGetAttribute(&cus, hipDeviceAttributeMultiprocessorCount, dev);
    (void)hipOccupancyMaxActiveBlocksPerMultiprocessor(&per_cu, fwd_megakernel, 256, 0);
    if (per_cu > 2) per_cu = 2;
    if (per_cu < 1) per_cu = 1;
    grid_blocks = cus * per_cu;
  }
  Params p{};
  for (int i = 0; i < 25; ++i) p.in[i] = (const float*)d_in[i];
  p.out = (float*)d_out;
  p.ws = (char*)d_ws;
  (void)hipMemsetAsync((char*)d_ws + OFF_BAR, 0, XCD_BAR_WORDS * 4, stream);
  void* args[] = {&p};
  hipError_t e = hipLaunchCooperativeKernel((void*)fwd_megakernel, dim3(grid_blocks), dim3(256), args, 0, stream);
  if (e != hipSuccess) fprintf(stderr, "cooperative launch failed: %s (grid %d)\n", hipGetErrorString(e), grid_blocks);
}
```

```cpp
#include <hip/hip_runtime.h>
#include <hip/hip_cooperative_groups.h>
#include <cstdio>
namespace cg = cooperative_groups;

typedef unsigned short u16;
typedef short bf16x8 __attribute__((ext_vector_type(8)));
typedef short s16x4 __attribute__((ext_vector_type(4)));
typedef float f32x16 __attribute__((ext_vector_type(16)));
typedef __bf16 bf2_t __attribute__((ext_vector_type(2)));
typedef float f2_t __attribute__((ext_vector_type(2)));
typedef unsigned u32x4 __attribute__((ext_vector_type(4)));
#define DI __device__ __forceinline__
#define MFMA(a, b, c) __builtin_amdgcn_mfma_f32_32x32x16_bf16((a), (b), (c), 0, 0, 0)

constexpr int SEQ = 16384;
constexpr int NSEQ = 3;
constexpr int MALL = SEQ * NSEQ;
constexpr int DM = 1024;
constexpr int DFF = 2816;
constexpr int NFF2 = 5632;
constexpr int PIN = 5568;
constexpr int ZLD = 5632;
constexpr int Z_CQ = 0, Z_CKV = 256, Z_KPE = 384, Z_GQ = 416, Z_GK = 928, Z_GV = 1440, Z_GA = 2464, Z_GOG = 2496, Z_BG = 3520;
constexpr float EPS = 1e-6f;
constexpr int NCHUNK = SEQ / 64;

constexpr size_t W_FFN1_IN = 0;
constexpr size_t W_FFN1_OUT = W_FFN1_IN + (size_t)NFF2 * DM;
constexpr size_t W_IN = W_FFN1_OUT + (size_t)DM * DFF;
constexpr size_t W_UQ = W_IN + (size_t)ZLD * DM;
constexpr size_t W_KN = W_UQ + (size_t)768 * 256;
constexpr size_t W_V = W_KN + (size_t)512 * 128;
constexpr size_t W_OA = W_V + (size_t)512 * 128;
constexpr size_t W_OB = W_OA + (size_t)DM * 512;
constexpr size_t W_OUT = W_OB + (size_t)DM * DM;
constexpr size_t W_FFN2_IN = W_OUT + (size_t)DM * DM;
constexpr size_t W_FFN2_OUT = W_FFN2_IN + (size_t)NFF2 * DM;
constexpr size_t W_END = W_FFN2_OUT + (size_t)DM * DFF;

constexpr size_t al256(size_t x) { return (x + 255) & ~(size_t)255; }
constexpr size_t OFF_WB = 0;
constexpr size_t OFF_ROPE = al256(OFF_WB + W_END * 2);
constexpr size_t OFF_H = al256(OFF_ROPE + (size_t)SEQ * 32 * 4);
constexpr size_t OFF_Y = al256(OFF_H + (size_t)MALL * DM * 2);
constexpr size_t OFF_ACT = al256(OFF_Y + (size_t)MALL * DM * 2);
constexpr size_t OFF_Z = OFF_ACT;
constexpr size_t OFF_Q = al256(OFF_Z + (size_t)SEQ * ZLD * 2);
constexpr size_t OFF_KN = al256(OFF_Q + (size_t)SEQ * 768 * 2);
constexpr size_t OFF_VT = al256(OFF_KN + (size_t)SEQ * 512 * 2);
constexpr size_t OFF_KPE = al256(OFF_VT + (size_t)SEQ * 512 * 2);
constexpr size_t OFF_OA = al256(OFF_KPE + (size_t)SEQ * 32 * 2);
constexpr size_t OFF_MIXEND = al256(OFF_OA + (size_t)SEQ * 512 * 2);
constexpr size_t OFF_ACTEND = al256(OFF_ACT + (size_t)MALL * DFF * 2);
static_assert(OFF_MIXEND <= OFF_ACTEND, "mixer scratch must fit in act");
constexpr size_t OFF_ST = OFF_ACTEND;
constexpr size_t OFF_DEC = al256(OFF_ST + (size_t)NCHUNK * 4 * 2 * 256 * 128 * 2);
constexpr size_t OFF_GC = al256(OFF_DEC + (size_t)NCHUNK * 4 * 2 * 128 * 4);
constexpr size_t OFF_OG = al256(OFF_GC + (size_t)2 * SEQ * 512 * 4);
constexpr size_t OFF_MG = al256(OFF_OG + (size_t)SEQ * DM * 2);
constexpr size_t OFF_END = al256(OFF_MG + (size_t)SEQ * DM * 2);
constexpr size_t OFF_BAR = OFF_END;
static_assert(OFF_BAR + 16384 <= (size_t)768 * 1024 * 1024, "workspace overflow");

struct Params {
  const float* in[25];
  float* out;
  char* ws;
};

DI unsigned pk2(float a, float b) { f2_t v = {a, b}; return __builtin_bit_cast(unsigned, __builtin_convertvector(v, bf2_t)); }
DI u16 f2bf(float a) { return (u16)(pk2(a, 0.f) & 0xffffu); }
DI float bf2f(u16 v) { return __uint_as_float(((unsigned)v) << 16); }
DI float bflo(unsigned v) { return __uint_as_float(v << 16); }
DI float bfhi(unsigned v) { return __uint_as_float(v & 0xffff0000u); }
DI float wave_sum(float v) {
#pragma unroll
  for (int o = 32; o >= 1; o >>= 1) v += __shfl_xor(v, o);
  return v;
}
DI int opaque_tid() { int t = threadIdx.x; asm volatile("" : "+v"(t)); return t; }
DI const float* in_ptr(const Params& p, int k) { asm volatile("" : "+s"(k)); return p.in[k]; }
DI int crow(int i, int h) { return (i & 3) + 8 * (i >> 2) + 4 * h; }
DI float sigmoidf_(float x) { return 1.f / (1.f + __expf(-x)); }
DI float siluf_(float x) { return x / (1.f + __expf(-x)); }


#define XB_TMO      128
#define XB_XCNT(j)  (256  + 64 * (j))
#define XB_XSUB(j)  (1280 + 64 * (j))
#define XB_XGEN(j)  (2304 + 64 * (j))
#define XB_TOP      3328
#define XB_TOPGEN   3392
#define XCD_BAR_WORDS 3456
#define XB_SPIN_CAP (1u << 18)
#define LAS __attribute__((address_space(3)))

__device__ __forceinline__ unsigned xb_ld(unsigned* p)              { return __hip_atomic_load(p, __ATOMIC_RELAXED, __HIP_MEMORY_SCOPE_AGENT); }
__device__ __forceinline__ unsigned xb_add(unsigned* p, unsigned v) { return __hip_atomic_fetch_add(p, v, __ATOMIC_RELAXED, __HIP_MEMORY_SCOPE_AGENT); }
__device__ __forceinline__ unsigned xb_xcc_id() { return (unsigned)__builtin_amdgcn_s_getreg((3 << 11) | 20) & 0xFu; }
#define XB_SPIN(cond, bar) do { unsigned _sp = 0; while (cond) { __builtin_amdgcn_s_sleep(1); \
    if ((++_sp & 255u) == 0u) { if (xb_ld(&(bar)[XB_TMO])) break; if (_sp > XB_SPIN_CAP) { atomicAdd(&(bar)[XB_TMO], 1u); break; } } } } while (0)

struct XcdBarrier {
    unsigned* bar; unsigned x;
    volatile LAS unsigned* st;
};

__device__ __forceinline__ XcdBarrier xcd_barrier_post(unsigned* bar, volatile LAS unsigned* st) {
    XcdBarrier b; b.bar = bar; b.x = xb_xcc_id(); b.st = st;
    if (threadIdx.x == 0) (void)xb_add(&bar[XB_XCNT(b.x)], 1u);
    return b;
}
__device__ __forceinline__ void xcd_barrier_complete(unsigned* bar, unsigned x, unsigned& nloc, unsigned& nx) {
    const unsigned G = gridDim.x * gridDim.y * gridDim.z;
    unsigned sum, cnt, mine, sp = 0u;
    for (;;) {
        sum = 0u; cnt = 0u; mine = 0u;
#pragma unroll
        for (unsigned j = 0; j < 16; ++j) { const unsigned c = xb_ld(&bar[XB_XCNT(j)]); sum += c; cnt += (c > 0u) ? 1u : 0u; mine = (j == x) ? c : mine; }
        if (sum == G) break;
        __builtin_amdgcn_s_sleep(1);
        if ((++sp & 255u) == 0u) { if (xb_ld(&bar[XB_TMO])) break; if (sp > XB_SPIN_CAP) { atomicAdd(&bar[XB_TMO], 1u); break; } }
    }
    nloc = mine > 0u ? mine : 1u; nx = cnt > 0u ? cnt : 1u;
}

__device__ __forceinline__ void xcd_barrier(const XcdBarrier& b) {
    asm volatile("s_waitcnt vmcnt(0)" ::: "memory");
    __syncthreads();
    int tid0_ = threadIdx.x; asm volatile("" : "+v"(tid0_));
    if (tid0_ == 0) {
        unsigned* bar = b.bar; asm volatile("" : "+s"(bar));
        unsigned bx_ = b.x; asm volatile("" : "+s"(bx_));
        __builtin_amdgcn_s_waitcnt(0);
        unsigned nloc = b.st[0], nx = b.st[1];
        if (nloc == 0u) { xcd_barrier_complete(bar, bx_, nloc, nx); b.st[0] = nloc; b.st[1] = nx; }
        const unsigned old = xb_add(&bar[XB_XSUB(bx_)], 1u);
        const unsigned gen = old / nloc;
        if (old + 1u == (gen + 1u) * nloc) {
            __builtin_amdgcn_fence(__ATOMIC_RELEASE, "agent");
            asm volatile("s_waitcnt vmcnt(0)" ::: "memory");
            const unsigned og = xb_add(&bar[XB_TOP], 1u);
            const unsigned tg = og / nx;
            if (og + 1u == (tg + 1u) * nx) xb_add(&bar[XB_TOPGEN], 1u);
            else XB_SPIN(xb_ld(&bar[XB_TOPGEN]) == tg, bar);
            __builtin_amdgcn_fence(__ATOMIC_ACQUIRE, "agent");
            xb_add(&bar[XB_XGEN(bx_)], 1u);
            asm volatile("s_waitcnt vmcnt(0)" ::: "memory");
        } else {
            XB_SPIN(xb_ld(&bar[XB_XGEN(bx_)]) == gen, bar);
            __builtin_amdgcn_fence(__ATOMIC_ACQUIRE, "agent");
            asm volatile("s_waitcnt vmcnt(0)" ::: "memory");
        }
    }
    __syncthreads();
}

constexpr int LROW = 72;
constexpr int GEMM_LDS = 2 * 128 * LROW * 2;

struct Acc { f32x16 a[4][2]; };

DI void acc_zero(Acc& c) {
#pragma unroll
  for (int i = 0; i < 4; ++i)
#pragma unroll
    for (int j = 0; j < 2; ++j)
#pragma unroll
      for (int k = 0; k < 16; ++k) c.a[i][j][k] = 0.f;
}

DI void gll16(const u16* g, char* l) {
  __builtin_amdgcn_global_load_lds((const __attribute__((address_space(1))) unsigned*)g,
                                   (__attribute__((address_space(3))) unsigned*)l, 16, 0, 0);
}
DI void gemm_kloop(const u16* __restrict__ A, int lda, const u16* __restrict__ B, int ldb, int K, u16* smem, Acc& c) {
  const int t = opaque_tid();
  const int lane = t & 63, w = t >> 6, r = lane & 31, h = lane >> 5;
  const int wm = w >> 1, wn = w & 1;
  char* lds = (char*)smem;
  const int nk = K >> 5;
  const int row0 = t >> 2, c0 = t & 3;
  const int sw0 = (c0 ^ ((row0 >> 2) & 3)) * 8;
  const u16* ga0 = A + (size_t)row0 * lda + sw0;
  const u16* gb0 = B + (size_t)row0 * ldb + sw0;
  const size_t a64 = (size_t)64 * lda, b64 = (size_t)64 * ldb;
  const int loff = t * 16;
#define GEMM_ISSUE(kt_, st_)                                         \
  do {                                                               \
    const int kk_ = ((kt_) < nk ? (kt_) : (nk - 1)) * 32;            \
    char* sp_ = lds + (st_) * 24576 + loff;                          \
    gll16(ga0 + kk_, sp_);                                           \
    gll16(ga0 + a64 + kk_, sp_ + 4096);                              \
    gll16(ga0 + 2 * a64 + kk_, sp_ + 8192);                          \
    gll16(ga0 + 3 * a64 + kk_, sp_ + 12288);                         \
    gll16(gb0 + kk_, sp_ + 16384);                                   \
    gll16(gb0 + b64 + kk_, sp_ + 20480);                             \
  } while (0)
  __syncthreads();
  GEMM_ISSUE(0, 0);
  GEMM_ISSUE(1, 1);
  const int fsw = (r >> 2) & 3;
  const int aoff = (wm * 128 + r) * 64, boff = 16384 + (wn * 64 + r) * 64;
  int scur = 0, snext = 2;
  for (int kt = 0; kt < nk; ++kt) {
    asm volatile("s_waitcnt vmcnt(6)" ::: "memory");
    __builtin_amdgcn_s_barrier();
    asm volatile("" ::: "memory");
    GEMM_ISSUE(kt + 2, snext);
    __builtin_amdgcn_sched_barrier(0);
    const char* st = lds + scur * 24576;
#pragma unroll
    for (int ks = 0; ks < 2; ++ks) {
      const int q = ((ks * 2 + h) ^ fsw) * 16;
      bf16x8 fa[4], fb[2];
#pragma unroll
      for (int i = 0; i < 4; ++i) fa[i] = *(const bf16x8*)(st + aoff + i * 2048 + q);
#pragma unroll
      for (int i = 0; i < 2; ++i) fb[i] = *(const bf16x8*)(st + boff + i * 2048 + q);
#pragma unroll
      for (int i = 0; i < 4; ++i)
#pragma unroll
        for (int j = 0; j < 2; ++j) c.a[i][j] = MFMA(fa[i], fb[j], c.a[i][j]);
    }
    __builtin_amdgcn_sched_barrier(0);
    snext = scur;
    scur = (scur == 2) ? 0 : scur + 1;
  }
  asm volatile("s_waitcnt vmcnt(0)" ::: "memory");
  __builtin_amdgcn_s_barrier();
  asm volatile("" ::: "memory");
#undef GEMM_ISSUE
}

DI void row_scales(const u16* __restrict__ base, int ld, int K, float* sc, int NR) {
  const int t = opaque_tid();
  const int row = (NR == 256) ? t : (t >> 1);
  const int part = (NR == 256) ? 0 : (t & 1);
  const int len = (NR == 256) ? K : (K / 2);
  const u16* p = base + (size_t)row * ld + part * len;
  float ss = 0.f;
  for (int i = 0; i < len / 8; ++i) {
    u32x4 v = *(const u32x4*)(p + i * 8);
#pragma unroll
    for (int j = 0; j < 4; ++j) { float a = bflo(v[j]), b = bfhi(v[j]); ss += a * a + b * b; }
  }
  if (NR != 256) ss += __shfl_xor(ss, 1);
  if (part == 0) sc[row] = rsqrtf(ss / (float)K + EPS);
}


template <int NI, class V, class R>
DI void epi_store(u16* smem, V val, R rowfn) {
  const int t = opaque_tid();
  const int lane = t & 63, w = t >> 6, r = lane & 31, h = lane >> 5;
  char* reg = (char*)smem + w * 18432;
#pragma unroll
  for (int mi = 0; mi < 4; ++mi)
#pragma unroll
    for (int ni = 0; ni < NI; ++ni)
#pragma unroll
      for (int i = 0; i < 16; ++i)
        *(u16*)(reg + (mi * 32 + crow(i, h)) * 144 + (ni * 32 + r) * 2) = f2bf(val(mi, ni, i));
  __builtin_amdgcn_sched_barrier(0);
  constexpr int CPR = NI * 4;
  constexpr int RPI = 64 / CPR;
  const int rr = lane / CPR, ch = lane % CPR;
#pragma unroll
  for (int k = 0; k < 128 / RPI; ++k) {
    const int row = k * RPI + rr;
    u32x4 v = *(const u32x4*)(reg + row * 144 + ch * 16);
    rowfn(row, ch * 8, v);
  }
}

DI void tile_coords(int id, int MT, int NT, int& tm, int& tn) {
  const int per = 32 * NT;
  const int sr = id / per, rem = id - sr * per;
  tn = rem >> 5;
  tm = sr * 32 + (rem & 31);
}

#define EPI_LOOP                                   \
  _Pragma("unroll") for (int mi = 0; mi < 4; ++mi) \
  _Pragma("unroll") for (int ni = 0; ni < 2; ++ni) \
  _Pragma("unroll") for (int i = (__builtin_amdgcn_sched_barrier(0), 0); i < 16; ++i)

constexpr int SMEM_BYTES = 74752;

__global__ void __launch_bounds__(256, 2) fwd_megakernel(Params p) {
  cg::grid_group grid = cg::this_grid();
  __shared__ __attribute__((aligned(16))) char smem_raw[SMEM_BYTES];
  u16* smem = (u16*)smem_raw;
  const int G = gridDim.x, bid = blockIdx.x;
  __shared__ uint4 xb_words;
  if (threadIdx.x == 0) xb_words = make_uint4(0u, 0u, 0u, 0u);
  __syncthreads();
  XcdBarrier xb = xcd_barrier_post((unsigned*)(p.ws + OFF_BAR), (volatile LAS unsigned*)&xb_words);

  char* ws = p.ws;
#define Wb ((u16*)(ws + OFF_WB))
#define ropec ((float*)(ws + OFF_ROPE))
#define ropes (((float*)(ws + OFF_ROPE)) + SEQ * 16)
#define Hb ((u16*)(ws + OFF_H))
#define Yb ((u16*)(ws + OFF_Y))
#define ACT ((u16*)(ws + OFF_ACT))
#define Z ((u16*)(ws + OFF_Z))
#define Qb ((u16*)(ws + OFF_Q))
#define KN ((u16*)(ws + OFF_KN))
#define VT ((u16*)(ws + OFF_VT))
#define KPE ((u16*)(ws + OFF_KPE))
#define OA ((u16*)(ws + OFF_OA))
#define ST ((u16*)(ws + OFF_ST))
#define DEC ((float*)(ws + OFF_DEC))
#define GC ((float*)(ws + OFF_GC))
#define OG ((u16*)(ws + OFF_OG))
#define MG ((u16*)(ws + OFF_MG))
  float* X = p.out;

  auto convert_weights = [&](int l) __attribute__((always_inline)) {
    const int t = opaque_tid();
    const int lane = t & 63, w = t >> 6, r = lane & 31, h = lane >> 5;
    const int wm = w >> 1, wn = w & 1;
    (void)lane; (void)r; (void)h; (void)wm; (void)wn;
    float* tile = (float*)smem_raw;
    for (int mat = 0; mat < 11; ++mat) {
      const float* src; int K, N; size_t dst; int map; const float* ksc = nullptr;
      switch (mat) {
        case 0: src = in_ptr(p, 3) + (size_t)l * DM * NFF2; K = DM; N = NFF2; dst = W_FFN1_IN; map = 1; break;
        case 1: src = in_ptr(p, 4) + (size_t)l * DFF * DM; K = DFF; N = DM; dst = W_FFN1_OUT; map = 0; break;
        case 2: src = in_ptr(p, 7) + (size_t)l * DM * PIN; K = DM; N = PIN; dst = W_IN; map = 0; break;
        case 3: src = in_ptr(p, 9) + (size_t)l * 256 * 768; K = 256; N = 768; dst = W_UQ; map = 0; ksc = in_ptr(p, 8) + l * 256; break;
        case 4: src = in_ptr(p, 11) + (size_t)l * 128 * 1024; K = 128; N = 1024; dst = W_KN; map = 2; ksc = in_ptr(p, 10) + l * 128; break;
        case 5: src = in_ptr(p, 12) + (size_t)l * 512 * DM; K = 512; N = DM; dst = W_OA; map = 0; break;
        case 6: src = in_ptr(p, 18) + (size_t)l * DM * DM; K = DM; N = DM; dst = W_OB; map = 0; break;
        case 7: src = in_ptr(p, 19) + (size_t)l * DM * DM; K = DM; N = DM; dst = W_OUT; map = 0; break;
        case 8: src = in_ptr(p, 22) + (size_t)l * DM * NFF2; K = DM; N = NFF2; dst = W_FFN2_IN; map = 1; break;
        case 9: src = in_ptr(p, 23) + (size_t)l * DFF * DM; K = DFF; N = DM; dst = W_FFN2_OUT; map = 0; break;
        default: src = nullptr; K = DM; N = 64; dst = W_IN + (size_t)PIN * DM; map = 3; break;
      }
      const int kt_n = K / 64, nt_n = N / 64;
      for (int id = bid; id < kt_n * nt_n; id += G) {
        const int kt = id % kt_n, nt = id / kt_n;
        const int k0 = kt * 64, n0 = nt * 64;
        __syncthreads();
        if (map != 3) {
#pragma unroll
          for (int i = 0; i < 4; ++i) {
            const int kk = (t >> 4) + 16 * i, nn = (t & 15) * 4;
            float4 v = *(const float4*)(src + (size_t)(k0 + kk) * N + n0 + nn);
            float sc = ksc ? ksc[k0 + kk] : 1.f;
            tile[kk * 65 + nn + 0] = v.x * sc; tile[kk * 65 + nn + 1] = v.y * sc;
            tile[kk * 65 + nn + 2] = v.z * sc; tile[kk * 65 + nn + 3] = v.w * sc;
          }
        }
        __syncthreads();
        const int nl = t >> 2, kc = (t & 3) * 16;
        const int n = n0 + nl;
        size_t drow;
        if (map == 0) drow = dst + (size_t)n * K;
        else if (map == 1) { const int isb = n >= DFF; const int j = n - isb * DFF; drow = dst + (size_t)((j >> 5) * 64 + isb * 32 + (j & 31)) * K; }
        else if (map == 2) { const int hd = n >> 7, cc = n & 127; drow = (cc < 64) ? (W_KN + (size_t)(hd * 64 + cc) * K) : (W_V + (size_t)(hd * 64 + cc - 64) * K); }
        else drow = dst + (size_t)nl * K;
        unsigned o[8];
#pragma unroll
        for (int j = 0; j < 8; ++j) {
          float a = (map == 3) ? 0.f : tile[(kc + 2 * j) * 65 + nl];
          float b = (map == 3) ? 0.f : tile[(kc + 2 * j + 1) * 65 + nl];
          o[j] = pk2(a, b);
        }
        uint4* dp = (uint4*)(Wb + drow + k0 + kc);
        dp[0] = make_uint4(o[0], o[1], o[2], o[3]);
        dp[1] = make_uint4(o[4], o[5], o[6], o[7]);
      }
    }
  };

  auto rn_pass = [&](int mode, float coef, const float* post_g, const float* pre_g) __attribute__((always_inline)) {
    const int t = opaque_tid();
    const int lane = t & 63, w = t >> 6, r = lane & 31, h = lane >> 5;
    const int wm = w >> 1, wn = w & 1;
    (void)lane; (void)r; (void)h; (void)wm; (void)wn;
    const int gw = bid * 4 + w, nw = G * 4;
    for (int row = gw; row < MALL; row += nw) {
      const float* xs;
      if (mode == 0) xs = (row < SEQ) ? (in_ptr(p, 0) + (size_t)row * DM) : (in_ptr(p, 1) + (size_t)(row - SEQ) * DM);
      else xs = X + (size_t)row * DM;
      float4 xv[4];
#pragma unroll
      for (int i = 0; i < 4; ++i) xv[i] = *(const float4*)(xs + lane * 4 + 256 * i);
      if (mode == 1) {
        float yv[16];
        float ss = 0.f;
#pragma unroll
        for (int i = 0; i < 4; ++i) {
          uint2 u = *(const uint2*)(Yb + (size_t)row * DM + lane * 4 + 256 * i);
          yv[4 * i + 0] = bflo(u.x); yv[4 * i + 1] = bfhi(u.x); yv[4 * i + 2] = bflo(u.y); yv[4 * i + 3] = bfhi(u.y);
        }
#pragma unroll
        for (int i = 0; i < 16; ++i) ss += yv[i] * yv[i];
        ss = wave_sum(ss);
        const float ry = rsqrtf(ss * (1.f / DM) + EPS) * coef;
#pragma unroll
        for (int i = 0; i < 4; ++i) {
          float4 g = *(const float4*)(post_g + lane * 4 + 256 * i);
          xv[i].x += yv[4 * i + 0] * ry * g.x; xv[i].y += yv[4 * i + 1] * ry * g.y;
          xv[i].z += yv[4 * i + 2] * ry * g.z; xv[i].w += yv[4 * i + 3] * ry * g.w;
        }
      }
#pragma unroll
      for (int i = 0; i < 4; ++i) *(float4*)(X + (size_t)row * DM + lane * 4 + 256 * i) = xv[i];
      if (pre_g) {
        float ss = 0.f;
#pragma unroll
        for (int i = 0; i < 4; ++i) ss += xv[i].x * xv[i].x + xv[i].y * xv[i].y + xv[i].z * xv[i].z + xv[i].w * xv[i].w;
        ss = wave_sum(ss);
        const float rx = rsqrtf(ss * (1.f / DM) + EPS);
#pragma unroll
        for (int i = 0; i < 4; ++i) {
          float4 g = *(const float4*)(pre_g + lane * 4 + 256 * i);
          uint2 o;
          o.x = pk2(xv[i].x * rx * g.x, xv[i].y * rx * g.y);
          o.y = pk2(xv[i].z * rx * g.z, xv[i].w * rx * g.w);
          *(uint2*)(Hb + (size_t)row * DM + lane * 4 + 256 * i) = o;
        }
      }
    }
  };

  auto ffn_in = [&](size_t woff) __attribute__((always_inline)) {
    const int t = opaque_tid();
    const int lane = t & 63, w = t >> 6, r = lane & 31, h = lane >> 5;
    const int wm = w >> 1, wn = w & 1;
    (void)lane; (void)r; (void)h; (void)wm; (void)wn;
    const int MT = MALL / 256, NT = NFF2 / 128;
    for (int id = bid; id < MT * NT; id += G) {
      int tm, tn; tile_coords(id, MT, NT, tm, tn);
      const int m0 = tm * 256, n0 = tn * 128;
      Acc c; acc_zero(c);
      gemm_kloop(Hb + (size_t)m0 * DM, DM, Wb + woff + (size_t)n0 * DM, DM, DM, smem, c);
#ifdef DUP_KLOOP
      acc_zero(c);
      gemm_kloop(Hb + (size_t)m0 * DM, DM, Wb + woff + (size_t)n0 * DM, DM, DM, smem, c);
#endif
      const int jb0 = ((n0 + wn * 64) >> 6) * 32;
      const unsigned obase = (unsigned)((m0 + wm * 128) * DFF + jb0);
      epi_store<1>(smem,
        [&](int mi, int ni, int i) { return siluf_(c.a[mi][0][i]) * c.a[mi][1][i]; },
        [&](int row, int col, u32x4 v) { *(u32x4*)(ACT + obase + (unsigned)(row * DFF + col)) = v; });
    }
  };
  auto gemm_plain = [&](const u16* A, int lda, int K, const u16* Bt, u16* C, int ldc, int M, int N) __attribute__((always_inline)) {
    const int t = opaque_tid();
    const int lane = t & 63, w = t >> 6, r = lane & 31, h = lane >> 5;
    const int wm = w >> 1, wn = w & 1;
    (void)lane; (void)r; (void)h; (void)wm; (void)wn;
    const int MT = M / 256, NT = N / 128;
    for (int id = bid; id < MT * NT; id += G) {
      int tm, tn; tile_coords(id, MT, NT, tm, tn);
      const int m0 = tm * 256, n0 = tn * 128;
      Acc c; acc_zero(c);
      gemm_kloop(A + (size_t)m0 * lda, lda, Bt + (size_t)n0 * K, K, K, smem, c);
      const unsigned obase = (unsigned)((m0 + wm * 128) * ldc + n0 + wn * 64);
      epi_store<2>(smem,
        [&](int mi, int ni, int i) { return c.a[mi][ni][i]; },
        [&](int row, int col, u32x4 v) { *(u32x4*)(C + obase + (unsigned)(row * ldc + col)) = v; });
    }
  };

  auto prep_phase = [&](int l) __attribute__((always_inline)) {
    const int t = opaque_tid();
    const int lane = t & 63, w = t >> 6, r = lane & 31, h = lane >> 5;
    const int wm = w >> 1, wn = w & 1;
    (void)lane; (void)r; (void)h; (void)wm; (void)wn;
    float* sc = (float*)(smem_raw + 2 * GEMM_LDS);
    const int NQ = 64 * 6, NK = 64 * 4, NV = 2 * 128, NPE = 64, NG1 = NCHUNK * 4;
    const float qscale = 0.10206207261596577f * 1.4426950408889634f;
    {
      for (int id = bid; id < NG1; id += G) {
        const int t = opaque_tid();
        const int lane = t & 63, w = t >> 6, r = lane & 31, h = lane >> 5;
        const int wm = w >> 1, wn = w & 1;
        (void)lane; (void)r; (void)h; (void)wm; (void)wn;
        const int n = id >> 2, hd = id & 3;
        const int t0 = n * 64;
        u16* ksT = smem;
        u16* vT = smem + 2 * 128 * LROW;
        u16* sk = vT;
        float* sga = (float*)(smem_raw + 55296);
        __syncthreads();
        {
          const int cc = t >> 2, part = t & 3;
          const u16* kp = Z + (size_t)(t0 + cc) * ZLD + Z_GK + hd * 128 + part * 32;
#pragma unroll
          for (int j = 0; j < 4; ++j) *(u32x4*)(sk + cc * 128 + part * 32 + j * 8) = *(const u32x4*)(kp + j * 8);
          u32x4 gv = *(const u32x4*)(Z + (size_t)(t0 + cc) * ZLD + Z_GA + part * 8);
#pragma unroll
          for (int k = 0; k < 4; ++k) { sga[cc * 32 + part * 8 + 2 * k] = bflo(gv[k]); sga[cc * 32 + part * 8 + 2 * k + 1] = bfhi(gv[k]); }
        }
        __syncthreads();
        {
          const int dir = t >> 7, d = t & 127;
          const float* wa2 = (dir ? in_ptr(p, 15) : in_ptr(p, 13)) + (size_t)l * 16 * 512 + hd * 128 + d;
          const float ba = ((dir ? in_ptr(p, 16) : in_ptr(p, 14)) + (size_t)l * 512)[hd * 128 + d];
          float wcol[16];
#pragma unroll
          for (int rr = 0; rr < 16; ++rr) wcol[rr] = wa2[rr * 512];
          const float* gar = sga + dir * 16;
          float tot = 0.f;
          for (int cc = 0; cc < 64; ++cc) {
            float pre = ba;
#pragma unroll
            for (int rr = 0; rr < 16; ++rr) pre += gar[cc * 32 + rr] * wcol[rr];
            tot += (fminf(pre, 0.f) - __logf(1.f + __expf(-fabsf(pre)))) * (1.f / 16.f);
          }
          DEC[((size_t)(n * 4 + hd) * 2 + dir) * 128 + d] = __expf(tot);
          float* gc = GC + (size_t)dir * SEQ * 512 + (size_t)t0 * 512 + hd * 128 + d;
          float cb = 0.f;
          u16* krow_out = ksT + (dir * 128 + d) * LROW;
          for (int ci = 0; ci < 64; ++ci) {
            const int cc = dir ? (63 - ci) : ci;
            float pre = ba;
#pragma unroll
            for (int rr = 0; rr < 16; ++rr) pre += gar[cc * 32 + rr] * wcol[rr];
            cb += (fminf(pre, 0.f) - __logf(1.f + __expf(-fabsf(pre)))) * (1.f / 16.f);
            gc[cc * 512] = cb;
            krow_out[cc] = f2bf(bf2f(sk[cc * 128 + d]) * __expf(tot - cb));
          }
        }
        for (int half = 0; half < 2; ++half) {
          __syncthreads();
          {
            const int cc = t & 63, part = t >> 6;
#pragma unroll
            for (int q = 0; q < 4; ++q) {
              const int cg8 = (part * 4 + q) * 8;
              uint4 v = *(const uint4*)(Z + (size_t)(t0 + cc) * ZLD + Z_GV + hd * 256 + half * 128 + cg8);
              unsigned u[4] = {v.x, v.y, v.z, v.w};
#pragma unroll
              for (int j = 0; j < 4; ++j) {
                vT[(cg8 + 2 * j) * LROW + cc] = (u16)(u[j] & 0xffffu);
                vT[(cg8 + 2 * j + 1) * LROW + cc] = (u16)(u[j] >> 16);
              }
            }
          }
          __syncthreads();
#pragma unroll
          for (int dir = 0; dir < 2; ++dir) {
            f32x16 acc[4];
#pragma unroll
            for (int j = 0; j < 4; ++j)
#pragma unroll
              for (int k = 0; k < 16; ++k) acc[j][k] = 0.f;
#pragma unroll
            for (int ks = 0; ks < 4; ++ks) {
              bf16x8 fa = *(const bf16x8*)(vT + (w * 32 + r) * LROW + ks * 16 + h * 8);
#pragma unroll
              for (int nt = 0; nt < 4; ++nt) {
                bf16x8 fb = *(const bf16x8*)(ksT + (dir * 128 + nt * 32 + r) * LROW + ks * 16 + h * 8);
                acc[nt] = MFMA(fb, fa, acc[nt]);
              }
            }
            u16* stp = ST + ((size_t)(n * 4 + hd) * 2 + dir) * 32768;
#pragma unroll
            for (int nt = 0; nt < 4; ++nt)
#pragma unroll
              for (int g4 = 0; g4 < 4; ++g4) {
                uint2 o;
                o.x = pk2(acc[nt][4 * g4 + 0], acc[nt][4 * g4 + 1]);
                o.y = pk2(acc[nt][4 * g4 + 2], acc[nt][4 * g4 + 3]);
                *(uint2*)(stp + (unsigned)((half * 128 + w * 32 + r) * 128 + nt * 32 + 8 * g4 + 4 * h)) = o;
              }
          }
        }
      }
      for (int q = bid; q < NQ; q += G) {
        const int t = opaque_tid();
        const int lane = t & 63, w = t >> 6, r = lane & 31, h = lane >> 5;
        const int wm = w >> 1, wn = w & 1;
        (void)lane; (void)r; (void)h; (void)wm; (void)wn;
        const int tm = q / 6, tn = q % 6;
        const int m0 = tm * 256, n0 = tn * 128;
        __syncthreads();
        row_scales(Z + (size_t)m0 * ZLD + Z_CQ, ZLD, 256, sc, 256);
        Acc c; acc_zero(c);
        gemm_kloop(Z + (size_t)m0 * ZLD + Z_CQ, ZLD, Wb + W_UQ + (size_t)n0 * 256, 256, 256, smem, c);
        {
          const unsigned obase = (unsigned)((m0 + wm * 128) * 768 + n0 + wn * 64);
          epi_store<2>(smem,
            [&](int mi, int ni, int i) {
              const int cb0 = n0 + wn * 64 + ni * 32;
              const bool rope = ((cb0 >> 5) % 3) == 2;
              const int rl = wm * 128 + mi * 32 + crow(i, h);
              float v = c.a[mi][ni][i] * sc[rl];
              const float pv = __shfl_xor(v, 16);
              if (rope) {
                const int row = m0 + rl;
                const float cs = ropec[row * 16 + (r & 15)], sn = ropes[row * 16 + (r & 15)];
                v = (r < 16) ? (v * cs - pv * sn) : (v * cs + pv * sn);
              }
              return v * qscale;
            },
            [&](int row, int col, u32x4 v) { *(u32x4*)(Qb + obase + (unsigned)(row * 768 + col)) = v; });
        }
      }
      for (int q = (bid + G - (NQ % G)) % G; q < NK; q += G) {
        const int t = opaque_tid();
        const int lane = t & 63, w = t >> 6, r = lane & 31, h = lane >> 5;
        const int wm = w >> 1, wn = w & 1;
        (void)lane; (void)r; (void)h; (void)wm; (void)wn;
        const int tm = q >> 2, tn = q & 3;
        const int m0 = tm * 256, n0 = tn * 128;
        __syncthreads();
        row_scales(Z + (size_t)m0 * ZLD + Z_CKV, ZLD, 128, sc, 256);
        Acc c; acc_zero(c);
        gemm_kloop(Z + (size_t)m0 * ZLD + Z_CKV, ZLD, Wb + W_KN + (size_t)n0 * 128, 128, 128, smem, c);
        {
          const unsigned obase = (unsigned)((m0 + wm * 128) * 512 + n0 + wn * 64);
          epi_store<2>(smem,
            [&](int mi, int ni, int i) { return c.a[mi][ni][i] * sc[wm * 128 + mi * 32 + crow(i, h)]; },
            [&](int row, int col, u32x4 v) { *(u32x4*)(KN + obase + (unsigned)(row * 512 + col)) = v; });
        }
      }
      for (int q = (bid + G - ((NQ + NK) % G)) % G; q < NV; q += G) {
        const int t = opaque_tid();
        const int lane = t & 63, w = t >> 6, r = lane & 31, h = lane >> 5;
        const int wm = w >> 1, wn = w & 1;
        (void)lane; (void)r; (void)h; (void)wm; (void)wn;
        const int tm = q & 1, tn = q >> 1;
        const int m0 = tm * 256, n0 = tn * 128;
        __syncthreads();
        row_scales(Z + (size_t)n0 * ZLD + Z_CKV, ZLD, 128, sc, 128);
        Acc c; acc_zero(c);
        gemm_kloop(Wb + W_V + (size_t)m0 * 128, 128, Z + (size_t)n0 * ZLD + Z_CKV, ZLD, 128, smem, c);
        {
          const unsigned obase = (unsigned)((m0 + wm * 128) * SEQ + n0 + wn * 64);
          epi_store<2>(smem,
            [&](int mi, int ni, int i) { return c.a[mi][ni][i] * sc[wn * 64 + ni * 32 + r]; },
            [&](int row, int col, u32x4 v) { *(u32x4*)(VT + obase + (unsigned)(row * SEQ + col)) = v; });
        }
      }
      for (int q = (bid + G - ((NQ + NK + NV) % G)) % G; q < NPE; q += G) {
        const int t = opaque_tid();
        const int lane = t & 63, w = t >> 6, r = lane & 31, h = lane >> 5;
        const int wm = w >> 1, wn = w & 1;
        (void)lane; (void)r; (void)h; (void)wm; (void)wn;
        const int tok = q * 256 + t;
        const u16* src = Z + (size_t)tok * ZLD + Z_KPE;
        float v[32];
#pragma unroll
        for (int j = 0; j < 4; ++j) {
          uint4 u = *(const uint4*)(src + j * 8);
          unsigned uu[4] = {u.x, u.y, u.z, u.w};
#pragma unroll
          for (int k = 0; k < 4; ++k) { v[j * 8 + 2 * k] = bflo(uu[k]); v[j * 8 + 2 * k + 1] = bfhi(uu[k]); }
        }
        float o[32];
#pragma unroll
        for (int i = 0; i < 16; ++i) {
          const float cs = ropec[tok * 16 + i], sn = ropes[tok * 16 + i];
          o[i] = v[i] * cs - v[i + 16] * sn;
          o[i + 16] = v[i + 16] * cs + v[i] * sn;
        }
#pragma unroll
        for (int j = 0; j < 4; ++j) {
          uint4 u;
          u.x = pk2(o[j * 8 + 0], o[j * 8 + 1]); u.y = pk2(o[j * 8 + 2], o[j * 8 + 3]);
          u.z = pk2(o[j * 8 + 4], o[j * 8 + 5]); u.w = pk2(o[j * 8 + 6], o[j * 8 + 7]);
          *(uint4*)(KPE + (size_t)tok * 32 + j * 8) = u;
        }
      }
    }
  };

  auto attn_phase = [&](bool do_scan) __attribute__((always_inline)) {
    const int t = opaque_tid();
    const int lane = t & 63, w = t >> 6, r = lane & 31, h = lane >> 5;
    const int wm = w >> 1, wn = w & 1;
    (void)lane; (void)r; (void)h; (void)wm; (void)wn;
    if (do_scan) for (int id = bid; id < 512; id += G) {
      const int e = id * 256 + t;
      const int d2 = e & 63, v = (e >> 6) & 255, dir = (e >> 14) & 1, hd = e >> 15;
      float s0 = 0.f, s1 = 0.f;
      const size_t eoff = (size_t)v * 128 + 2 * d2;
      for (int i0 = 0; i0 < NCHUNK; i0 += 16) {
        unsigned uu[16];
        float2 dd[16];
#pragma unroll
        for (int j = 0; j < 16; ++j) {
          const int n = dir ? (NCHUNK - 1 - (i0 + j)) : (i0 + j);
          const size_t base = ((size_t)(n * 4 + hd) * 2 + dir);
          uu[j] = *(const unsigned*)(ST + base * 32768 + eoff);
          dd[j] = *(const float2*)(DEC + base * 128 + 2 * d2);
        }
#pragma unroll
        for (int j = 0; j < 16; ++j) {
          const int n = dir ? (NCHUNK - 1 - (i0 + j)) : (i0 + j);
          const size_t base = ((size_t)(n * 4 + hd) * 2 + dir);
          *(unsigned*)(ST + base * 32768 + eoff) = pk2(s0, s1);
          s0 = dd[j].x * s0 + bflo(uu[j]);
          s1 = dd[j].y * s1 + bfhi(uu[j]);
        }
      }
    }
    constexpr int KROW = 104;
    constexpr int ABUF = 64 * KROW + 64 * LROW;
    u16* sK = smem;
    u16* sV = smem + 64 * KROW;
    for (int id = bid; id < 8 * 64; id += G) {
      const int hd = id & 7, qb = id >> 3;
      const int q0 = qb * 256 + w * 64;
      bf16x8 bq[2][6];
#pragma unroll
      for (int qt = 0; qt < 2; ++qt)
#pragma unroll
        for (int ks = 0; ks < 6; ++ks) bq[qt][ks] = *(const bf16x8*)(Qb + (size_t)(q0 + qt * 32 + r) * 768 + hd * 96 + ks * 16 + h * 8);
      f32x16 O[2][2];
#pragma unroll
      for (int j = 0; j < 2; ++j)
#pragma unroll
        for (int qt = 0; qt < 2; ++qt)
#pragma unroll
          for (int k = 0; k < 16; ++k) O[j][qt][k] = 0.f;
      float m[2] = {0.f, 0.f}, lsum[2] = {0.f, 0.f};
      const int kr = t >> 2, kc = t & 3;
      const u16* knp = KN + (size_t)kr * 512 + hd * 64 + kc * 16;
      const u16* kpp = KPE + (size_t)kr * 32 + kc * 8;
      const u16* vpp = VT + (size_t)(hd * 64 + kr) * SEQ + kc * 16;
      u32x4 rk[3], rv[2];
      rk[0] = *(const u32x4*)(knp);
      rk[1] = *(const u32x4*)(knp + 8);
      rk[2] = *(const u32x4*)(kpp);
      rv[0] = *(const u32x4*)(vpp);
      rv[1] = *(const u32x4*)(vpp + 8);
      __syncthreads();
      *(u32x4*)(sK + kr * KROW + kc * 16) = rk[0];
      *(u32x4*)(sK + kr * KROW + kc * 16 + 8) = rk[1];
      *(u32x4*)(sK + kr * KROW + 64 + kc * 8) = rk[2];
      *(u32x4*)(sV + kr * LROW + kc * 16) = rv[0];
      *(u32x4*)(sV + kr * LROW + kc * 16 + 8) = rv[1];
      rk[0] = *(const u32x4*)(knp + (size_t)64 * 512);
      rk[1] = *(const u32x4*)(knp + (size_t)64 * 512 + 8);
      rk[2] = *(const u32x4*)(kpp + (size_t)64 * 32);
      rv[0] = *(const u32x4*)(vpp + 64);
      rv[1] = *(const u32x4*)(vpp + 64 + 8);
      __syncthreads();
      int cur = 0;
      for (int key0 = 0; key0 < SEQ; key0 += 64) {
        const u16* cK = sK + cur * ABUF;
        const u16* cV = sV + cur * ABUF;
        {
          u16* nK = sK + (cur ^ 1) * ABUF;
          u16* nV = sV + (cur ^ 1) * ABUF;
          *(u32x4*)(nK + kr * KROW + kc * 16) = rk[0];
          *(u32x4*)(nK + kr * KROW + kc * 16 + 8) = rk[1];
          *(u32x4*)(nK + kr * KROW + 64 + kc * 8) = rk[2];
          *(u32x4*)(nV + kr * LROW + kc * 16) = rv[0];
          *(u32x4*)(nV + kr * LROW + kc * 16 + 8) = rv[1];
          const int kn = (key0 + 128 < SEQ) ? (key0 + 128) : key0;
          rk[0] = *(const u32x4*)(knp + (size_t)kn * 512);
          rk[1] = *(const u32x4*)(knp + (size_t)kn * 512 + 8);
          rk[2] = *(const u32x4*)(kpp + (size_t)kn * 32);
          rv[0] = *(const u32x4*)(vpp + kn);
          rv[1] = *(const u32x4*)(vpp + kn + 8);
        }
        __builtin_amdgcn_sched_barrier(0);
        f32x16 S[2][2];
#pragma unroll
        for (int kt = 0; kt < 2; ++kt)
#pragma unroll
          for (int qt = 0; qt < 2; ++qt)
#pragma unroll
            for (int k = 0; k < 16; ++k) S[kt][qt][k] = -m[qt];
#pragma unroll
        for (int ks = 0; ks < 6; ++ks)
#pragma unroll
          for (int kt = 0; kt < 2; ++kt) {
            bf16x8 fa = *(const bf16x8*)(cK + (kt * 32 + r) * KROW + ks * 16 + h * 8);
            S[kt][0] = MFMA(fa, bq[0][ks], S[kt][0]);
            S[kt][1] = MFMA(fa, bq[1][ks], S[kt][1]);
          }
        bf16x8 pf[2][4];
#pragma unroll
        for (int qt = 0; qt < 2; ++qt) {
          float mloc = S[0][qt][0];
#pragma unroll
          for (int kt = 0; kt < 2; ++kt)
#pragma unroll
            for (int k = 0; k < 16; ++k) mloc = fmaxf(mloc, S[kt][qt][k]);
          mloc = fmaxf(mloc, __shfl_xor(mloc, 32));
          if (__builtin_amdgcn_ballot_w64(mloc > 0.f) != 0ull) {
            const float delta = fmaxf(mloc, 0.f);
            const float alpha = __builtin_amdgcn_exp2f(-delta);
            m[qt] += delta;
            lsum[qt] *= alpha;
#pragma unroll
            for (int j = 0; j < 2; ++j)
#pragma unroll
              for (int k = 0; k < 16; ++k) O[j][qt][k] *= alpha;
#pragma unroll
            for (int kt = 0; kt < 2; ++kt)
#pragma unroll
              for (int k = 0; k < 16; ++k) S[kt][qt][k] -= delta;
          }
          float ps = 0.f;
#pragma unroll
          for (int kt = 0; kt < 2; ++kt)
#pragma unroll
            for (int k = 0; k < 16; ++k) { S[kt][qt][k] = __builtin_amdgcn_exp2f(S[kt][qt][k]); ps += S[kt][qt][k]; }
          lsum[qt] += ps;
#pragma unroll
          for (int s2 = 0; s2 < 4; ++s2) {
            const int kt = s2 >> 1, sx = s2 & 1;
            unsigned pw[4];
#pragma unroll
            for (int j = 0; j < 4; ++j) pw[j] = pk2(S[kt][qt][8 * sx + 2 * j], S[kt][qt][8 * sx + 2 * j + 1]);
            pf[qt][s2] = __builtin_bit_cast(bf16x8, make_uint4(pw[0], pw[1], pw[2], pw[3]));
          }
        }
#pragma unroll
        for (int s2 = 0; s2 < 4; ++s2) {
          const int kt = s2 >> 1, sx = s2 & 1;
#pragma unroll
          for (int dt = 0; dt < 2; ++dt) {
            const u16* vp = cV + (dt * 32 + r) * LROW + kt * 32 + 16 * sx + 4 * h;
            uint2 lo = *(const uint2*)(vp);
            uint2 hi = *(const uint2*)(vp + 8);
            bf16x8 fv = __builtin_bit_cast(bf16x8, make_uint4(lo.x, lo.y, hi.x, hi.y));
            O[dt][0] = MFMA(fv, pf[0][s2], O[dt][0]);
            O[dt][1] = MFMA(fv, pf[1][s2], O[dt][1]);
          }
        }
        cur ^= 1;
        __syncthreads();
      }
#pragma unroll
      for (int qt = 0; qt < 2; ++qt) {
        const float lt = lsum[qt] + __shfl_xor(lsum[qt], 32);
        const float inv = 1.f / lt;
#pragma unroll
        for (int dt = 0; dt < 2; ++dt)
#pragma unroll
          for (int g4 = 0; g4 < 4; ++g4) {
            uint2 o;
            o.x = pk2(O[dt][qt][4 * g4 + 0] * inv, O[dt][qt][4 * g4 + 1] * inv);
            o.y = pk2(O[dt][qt][4 * g4 + 2] * inv, O[dt][qt][4 * g4 + 3] * inv);
            *(uint2*)(OA + (size_t)(q0 + qt * 32 + r) * 512 + hd * 64 + dt * 32 + 8 * g4 + 4 * h) = o;
          }
      }
    }
  };

  auto gla_out_phase = [&](int l) __attribute__((always_inline)) {
    const int t = opaque_tid();
    const int lane = t & 63, w = t >> 6, r = lane & 31, h = lane >> 5;
    const int wm = w >> 1, wn = w & 1;
    (void)lane; (void)r; (void)h; (void)wm; (void)wn;
    constexpr int QROW = 136;
    u16* sQ = smem;
    u16* sKt = smem + 64 * QROW;
    u16* sVT = smem + 2 * 64 * QROW;
    float* sred = (float*)(smem + 2 * 64 * QROW + 256 * LROW);
    u16* sO = smem;
    constexpr int OROW = 264;
    const float qs = 0.08838834764831845f;
    const int cs = w & 1, vh = w >> 1;
    for (int id = bid; id < NCHUNK * 4; id += G) {
      const int n = id >> 2, hd = id & 3;
      const int t0 = n * 64;
      __syncthreads();
      {
        const int cc = t & 63, part = t >> 6;
#pragma unroll
        for (int q = 0; q < 8; ++q) {
          const int cg8 = (part * 8 + q) * 8;
          uint4 v = *(const uint4*)(Z + (size_t)(t0 + cc) * ZLD + Z_GV + hd * 256 + cg8);
          unsigned u[4] = {v.x, v.y, v.z, v.w};
#pragma unroll
          for (int j = 0; j < 4; ++j) {
            sVT[(cg8 + 2 * j) * LROW + cc] = (u16)(u[j] & 0xffffu);
            sVT[(cg8 + 2 * j + 1) * LROW + cc] = (u16)(u[j] >> 16);
          }
        }
      }
      f32x16 acc[4];
#pragma unroll
      for (int j = 0; j < 4; ++j)
#pragma unroll
        for (int k = 0; k < 16; ++k) acc[j][k] = 0.f;
      for (int dir = 0; dir < 2; ++dir) {
        __syncthreads();
        {
          const int cc = t >> 2, dp = (t & 3) * 32;
          const u16* qp = Z + (size_t)(t0 + cc) * ZLD + Z_GQ + hd * 128 + dp;
          const u16* kp = Z + (size_t)(t0 + cc) * ZLD + Z_GK + hd * 128 + dp;
          const float* gp = GC + (size_t)dir * SEQ * 512 + (size_t)(t0 + cc) * 512 + hd * 128 + dp;
#pragma unroll
          for (int j = 0; j < 4; ++j) {
            uint4 qv = *(const uint4*)(qp + j * 8);
            uint4 kv = *(const uint4*)(kp + j * 8);
            float4 g0 = *(const float4*)(gp + j * 8);
            float4 g1 = *(const float4*)(gp + j * 8 + 4);
            const float gg[8] = {g0.x, g0.y, g0.z, g0.w, g1.x, g1.y, g1.z, g1.w};
            const unsigned qu[4] = {qv.x, qv.y, qv.z, qv.w};
            const unsigned ku[4] = {kv.x, kv.y, kv.z, kv.w};
            unsigned qo[4], ko[4];
#pragma unroll
            for (int k = 0; k < 4; ++k) {
              const float e0 = __expf(gg[2 * k]), e1 = __expf(gg[2 * k + 1]);
              qo[k] = pk2(bflo(qu[k]) * qs * e0, bfhi(qu[k]) * qs * e1);
              ko[k] = pk2(bflo(ku[k]) / e0, bfhi(ku[k]) / e1);
            }
            *(uint4*)(sQ + cc * QROW + dp + j * 8) = make_uint4(qo[0], qo[1], qo[2], qo[3]);
            *(uint4*)(sKt + cc * QROW + dp + j * 8) = make_uint4(ko[0], ko[1], ko[2], ko[3]);
            __builtin_amdgcn_sched_barrier(0);
          }
        }
        __syncthreads();
        const u16* bqp = sQ + (cs * 32 + r) * QROW + h * 8;
        f32x16 at[2];
#pragma unroll
        for (int et = 0; et < 2; ++et) {
#pragma unroll
          for (int k = 0; k < 16; ++k) at[et][k] = 0.f;
#pragma unroll
          for (int ks = 0; ks < 8; ++ks) {
            bf16x8 fa = *(const bf16x8*)(sKt + (et * 32 + r) * QROW + ks * 16 + h * 8);
            bf16x8 fbq = *(const bf16x8*)(bqp + ks * 16);
            at[et] = MFMA(fa, fbq, at[et]);
          }
          const int cidx = cs * 32 + r;
#pragma unroll
          for (int k = 0; k < 16; ++k) {
            const int e = et * 32 + crow(k, h);
            const bool keep = dir ? (e >= cidx) : (e <= cidx);
            at[et][k] = keep ? at[et][k] : 0.f;
          }
        }
#pragma unroll
        for (int s2 = 0; s2 < 4; ++s2) {
          const int et = s2 >> 1, s = s2 & 1;
          unsigned pw[4];
#pragma unroll
          for (int j = 0; j < 4; ++j) pw[j] = pk2(at[et][8 * s + 2 * j], at[et][8 * s + 2 * j + 1]);
          bf16x8 pf = __builtin_bit_cast(bf16x8, make_uint4(pw[0], pw[1], pw[2], pw[3]));
#pragma unroll
          for (int mt = 0; mt < 4; ++mt) {
            const u16* vp = sVT + (vh * 128 + mt * 32 + r) * LROW + et * 32 + 16 * s + 4 * h;
            uint2 lo = *(const uint2*)(vp);
            uint2 hi = *(const uint2*)(vp + 8);
            bf16x8 fv = __builtin_bit_cast(bf16x8, make_uint4(lo.x, lo.y, hi.x, hi.y));
            acc[mt] = MFMA(fv, pf, acc[mt]);
          }
        }
        const u16* stp = ST + ((size_t)(n * 4 + hd) * 2 + dir) * 32768;
#pragma unroll
        for (int mt = 0; mt < 4; ++mt) {
#pragma unroll
          for (int kb = 0; kb < 2; ++kb) {
            bf16x8 fs[4];
#pragma unroll
            for (int ks = 0; ks < 4; ++ks) fs[ks] = *(const bf16x8*)(stp + (size_t)(vh * 128 + mt * 32 + r) * 128 + (kb * 4 + ks) * 16 + h * 8);
#pragma unroll
            for (int ks = 0; ks < 4; ++ks) { bf16x8 fbq = *(const bf16x8*)(bqp + (kb * 4 + ks) * 16); acc[mt] = MFMA(fs[ks], fbq, acc[mt]); }
            __builtin_amdgcn_sched_barrier(0);
          }
        }
      }
      float ss = 0.f;
#pragma unroll
      for (int mt = 0; mt < 4; ++mt)
#pragma unroll
        for (int k = 0; k < 16; ++k) ss += acc[mt][k] * acc[mt][k];
      ss += __shfl_xor(ss, 32);
      if (h == 0) sred[vh * 64 + cs * 32 + r] = ss;
      __syncthreads();
      const float rs = rsqrtf((sred[cs * 32 + r] + sred[64 + cs * 32 + r]) * (1.f / 256.f) + EPS);
#pragma unroll
      for (int mt = 0; mt < 4; ++mt)
#pragma unroll
        for (int g4 = 0; g4 < 4; ++g4) {
          uint2 o;
          o.x = pk2(acc[mt][4 * g4 + 0] * rs, acc[mt][4 * g4 + 1] * rs);
          o.y = pk2(acc[mt][4 * g4 + 2] * rs, acc[mt][4 * g4 + 3] * rs);
          *(uint2*)(sO + (cs * 32 + r) * OROW + vh * 128 + mt * 32 + 8 * g4 + 4 * h) = o;
        }
      __syncthreads();
      {
        const int t3 = opaque_tid();
        const int cc = t3 >> 2, vp0 = (t3 & 3) * 64;
        const float* ng = in_ptr(p, 17) + (size_t)l * 256;
#pragma unroll
        for (int j = 0; j < 8; ++j) {
          const int v0 = vp0 + j * 8;
          uint4 ov = *(const uint4*)(sO + cc * OROW + v0);
          uint4 gv = *(const uint4*)(Z + (size_t)(t0 + cc) * ZLD + Z_GOG + hd * 256 + v0);
          float4 n0 = *(const float4*)(ng + v0), n1 = *(const float4*)(ng + v0 + 4);
          const float nn[8] = {n0.x, n0.y, n0.z, n0.w, n1.x, n1.y, n1.z, n1.w};
          const unsigned ou[4] = {ov.x, ov.y, ov.z, ov.w};
          const unsigned gu[4] = {gv.x, gv.y, gv.z, gv.w};
          unsigned res[4];
#pragma unroll
          for (int k = 0; k < 4; ++k)
            res[k] = pk2(bflo(ou[k]) * nn[2 * k] * siluf_(bflo(gu[k])), bfhi(ou[k]) * nn[2 * k + 1] * siluf_(bfhi(gu[k])));
          *(uint4*)(OG + (size_t)(t0 + cc) * DM + hd * 256 + v0) = make_uint4(res[0], res[1], res[2], res[3]);
        }
      }
    }
  };

  auto merge_phase = [&]() __attribute__((always_inline)) {
    const int t = opaque_tid();
    const int lane = t & 63, w = t >> 6, r = lane & 31, h = lane >> 5;
    const int wm = w >> 1, wn = w & 1;
    (void)lane; (void)r; (void)h; (void)wm; (void)wn;
    const int MT = SEQ / 256, NT = DM / 128;
    for (int id = bid; id < MT * NT; id += G) {
      int tm, tn; tile_coords(id, MT, NT, tm, tn);
      const int m0 = tm * 256, n0 = tn * 128;
      Acc c; acc_zero(c);
      gemm_kloop(OA + (size_t)m0 * 512, 512, Wb + W_OA + (size_t)n0 * 512, 512, 512, smem, c);
      {
        const unsigned zbase = (unsigned)((m0 + wm * 128) * ZLD + Z_BG + n0 + wn * 64);
        const unsigned obase = (unsigned)((m0 + wm * 128) * DM + n0 + wn * 64);
        epi_store<2>(smem,
          [&](int mi, int ni, int i) { return c.a[mi][ni][i]; },
          [&](int row, int col, u32x4 v) {
            const u32x4 g = *(const u32x4*)(Z + zbase + (unsigned)(row * ZLD + col));
            u32x4 o;
#pragma unroll
            for (int k = 0; k < 4; ++k) o[k] = pk2(bflo(v[k]) * sigmoidf_(bflo(g[k])), bfhi(v[k]) * sigmoidf_(bfhi(g[k])));
            *(u32x4*)(MG + obase + (unsigned)(row * DM + col)) = o;
          });
      }
      acc_zero(c);
      gemm_kloop(OG + (size_t)m0 * DM, DM, Wb + W_OB + (size_t)n0 * DM, DM, DM, smem, c);
      {
        const int t2 = opaque_tid();
        const int wm2 = t2 >> 7, wn2 = (t2 >> 6) & 1;
        const unsigned zbase = (unsigned)((m0 + wm2 * 128) * ZLD + Z_BG + DM + n0 + wn2 * 64);
        const unsigned obase = (unsigned)((m0 + wm2 * 128) * DM + n0 + wn2 * 64);
        epi_store<2>(smem,
          [&](int mi, int ni, int i) { return c.a[mi][ni][i]; },
          [&](int row, int col, u32x4 v) {
            const u32x4 g = *(const u32x4*)(Z + zbase + (unsigned)(row * ZLD + col));
            const u32x4 pm = *(const u32x4*)(MG + obase + (unsigned)(row * DM + col));
            u32x4 o;
#pragma unroll
            for (int k = 0; k < 4; ++k)
              o[k] = pk2(bflo(pm[k]) + bflo(v[k]) * sigmoidf_(bflo(g[k])), bfhi(pm[k]) + bfhi(v[k]) * sigmoidf_(bfhi(g[k])));
            *(u32x4*)(MG + obase + (unsigned)(row * DM + col)) = o;
          });
      }
    }
  };

  for (int i = bid * 256 + opaque_tid(); i < SEQ * 16; i += G * 256) {
    const int pos = i >> 4, j = i & 15;
    const float inv_freq = exp2f(-(float)j * 0.8304820237218406f);
    const float angf = (float)pos * inv_freq;
    double a = (double)angf;
    const double twopi = 6.283185307179586476925286766559;
    a -= twopi * rint(a / twopi);
    const float af = (float)a;
    ropec[i] = __cosf(af);
    ropes[i] = __sinf(af);
  }
  convert_weights(0);
  rn_pass(0, 0.f, nullptr, in_ptr(p, 2));
  grid.sync();

  for (int l = 0; l < 4; ++l) {
    ffn_in(W_FFN1_IN);
#ifdef DUP_FFNIN
    xcd_barrier(xb);
    ffn_in(W_FFN1_IN);
#endif
    xcd_barrier(xb);
    gemm_plain(ACT, DFF, DFF, Wb + W_FFN1_OUT, Yb, DM, MALL, DM);
    xcd_barrier(xb);
    rn_pass(1, 0.5f, in_ptr(p, 5) + l * DM, in_ptr(p, 6) + l * DM);
    xcd_barrier(xb);
    for (int s = 0; s < NSEQ; ++s) {
      gemm_plain(Hb + (size_t)s * SEQ * DM, DM, DM, Wb + W_IN, Z, ZLD, SEQ, ZLD);
      xcd_barrier(xb);
      prep_phase(l);
#ifdef DUP_PREP
      xcd_barrier(xb);
      prep_phase(l);
#endif
      xcd_barrier(xb);
      attn_phase(true);
#ifdef DUP_ATTN
      xcd_barrier(xb);
      attn_phase(false);
#endif
      xcd_barrier(xb);
      gla_out_phase(l);
#ifdef DUP_GLAOUT
      xcd_barrier(xb);
      gla_out_phase(l);
#endif
      xcd_barrier(xb);
      merge_phase();
      xcd_barrier(xb);
      gemm_plain(MG, DM, DM, Wb + W_OUT, Yb + (size_t)s * SEQ * DM, DM, SEQ, DM);
      xcd_barrier(xb);
    }
    rn_pass(1, 1.0f, in_ptr(p, 20) + l * DM, in_ptr(p, 21) + l * DM);
    xcd_barrier(xb);
    ffn_in(W_FFN2_IN);
    xcd_barrier(xb);
    gemm_plain(ACT, DFF, DFF, Wb + W_FFN2_OUT, Yb, DM, MALL, DM);
    xcd_barrier(xb);
    rn_pass(1, 0.5f, in_ptr(p, 24) + l * DM, (l < 3) ? (in_ptr(p, 2) + (l + 1) * DM) : nullptr);
    if (l < 3) convert_weights(l + 1);
    xcd_barrier(xb);
  }
}

extern "C" void kernel_launch(void* const* d_in, const int* in_sizes, int n_in, void* d_out,
                              int out_size, void* d_ws, size_t ws_size, hipStream_t stream) {
  static int grid_blocks = 0;
  if (!grid_blocks) {
    int dev = 0, cus = 0, per_cu = 0;
    (void)hipGetDevice(&dev);
    (void)hipDeviceGetAttribute(&cus, hipDeviceAttributeMultiprocessorCount, dev);
    (void)hipOccupancyMaxActiveBlocksPerMultiprocessor(&per_cu, fwd_megakernel, 256, 0);
    if (per_cu > 2) per_cu = 2;
    if (per_cu < 1) per_cu = 1;
    grid_blocks = cus * per_cu;
  }
  Params p{};
  for (int i = 0; i < 25; ++i) p.in[i] = (const float*)d_in[i];
  p.out = (float*)d_out;
  p.ws = (char*)d_ws;
  (void)hipMemsetAsync((char*)d_ws + OFF_BAR, 0, XCD_BAR_WORDS * 4, stream);
  void* args[] = {&p};
  hipError_t e = hipLaunchCooperativeKernel((void*)fwd_megakernel, dim3(grid_blocks), dim3(256), args, 0, stream);
  if (e != hipSuccess) fprintf(stderr, "cooperative launch failed: %s (grid %d)\n", hipGetErrorString(e), grid_blocks);
}
```

```cpp
#include <hip/hip_runtime.h>
#include <hip/hip_cooperative_groups.h>
#include <cstdio>
namespace cg = cooperative_groups;

typedef unsigned short u16;
typedef short bf16x8 __attribute__((ext_vector_type(8)));
typedef short s16x4 __attribute__((ext_vector_type(4)));
typedef float f32x16 __attribute__((ext_vector_type(16)));
typedef __bf16 bf2_t __attribute__((ext_vector_type(2)));
typedef float f2_t __attribute__((ext_vector_type(2)));
typedef unsigned u32x4 __attribute__((ext_vector_type(4)));
#define DI __device__ __forceinline__
#define MFMA(a, b, c) __builtin_amdgcn_mfma_f32_32x32x16_bf16((a), (b), (c), 0, 0, 0)

constexpr int SEQ = 16384;
constexpr int NSEQ = 3;
constexpr int MALL = SEQ * NSEQ;
constexpr int DM = 1024;
constexpr int DFF = 2816;
constexpr int NFF2 = 5632;
constexpr int PIN = 5568;
constexpr int ZLD = 5632;
constexpr int Z_CQ = 0, Z_CKV = 256, Z_KPE = 384, Z_GQ = 416, Z_GK = 928, Z_GV = 1440, Z_GA = 2464, Z_GOG = 2496, Z_BG = 3520;
constexpr float EPS = 1e-6f;
constexpr int NCHUNK = SEQ / 64;

constexpr size_t W_FFN1_IN = 0;
constexpr size_t W_FFN1_OUT = W_FFN1_IN + (size_t)NFF2 * DM;
constexpr size_t W_IN = W_FFN1_OUT + (size_t)DM * DFF;
constexpr size_t W_UQ = W_IN + (size_t)ZLD * DM;
constexpr size_t W_KN = W_UQ + (size_t)768 * 256;
constexpr size_t W_V = W_KN + (size_t)512 * 128;
constexpr size_t W_OA = W_V + (size_t)512 * 128;
constexpr size_t W_OB = W_OA + (size_t)DM * 512;
constexpr size_t W_OUT = W_OB + (size_t)DM * DM;
constexpr size_t W_FFN2_IN = W_OUT + (size_t)DM * DM;
constexpr size_t W_FFN2_OUT = W_FFN2_IN + (size_t)NFF2 * DM;
constexpr size_t W_END = W_FFN2_OUT + (size_t)DM * DFF;

constexpr size_t al256(size_t x) { return (x + 255) & ~(size_t)255; }
constexpr size_t OFF_WB = 0;
constexpr size_t OFF_ROPE = al256(OFF_WB + W_END * 2);
constexpr size_t OFF_H = al256(OFF_ROPE + (size_t)SEQ * 32 * 4);
constexpr size_t OFF_Y = al256(OFF_H + (size_t)MALL * DM * 2);
constexpr size_t OFF_ACT = al256(OFF_Y + (size_t)MALL * DM * 2);
constexpr size_t OFF_Z = OFF_ACT;
constexpr size_t OFF_Q = al256(OFF_Z + (size_t)SEQ * ZLD * 2);
constexpr size_t OFF_KN = al256(OFF_Q + (size_t)SEQ * 768 * 2);
constexpr size_t OFF_VT = al256(OFF_KN + (size_t)SEQ * 512 * 2);
constexpr size_t OFF_KPE = al256(OFF_VT + (size_t)SEQ * 512 * 2);
constexpr size_t OFF_OA = al256(OFF_KPE + (size_t)SEQ * 32 * 2);
constexpr size_t OFF_MIXEND = al256(OFF_OA + (size_t)SEQ * 512 * 2);
constexpr size_t OFF_ACTEND = al256(OFF_ACT + (size_t)MALL * DFF * 2);
static_assert(OFF_MIXEND <= OFF_ACTEND, "mixer scratch must fit in act");
constexpr size_t OFF_ST = OFF_ACTEND;
constexpr size_t OFF_DEC = al256(OFF_ST + (size_t)NCHUNK * 4 * 2 * 256 * 128 * 2);
constexpr size_t OFF_GC = al256(OFF_DEC + (size_t)NCHUNK * 4 * 2 * 128 * 4);
constexpr size_t OFF_OG = al256(OFF_GC + (size_t)2 * SEQ * 512 * 4);
constexpr size_t OFF_MG = al256(OFF_OG + (size_t)SEQ * DM * 2);
constexpr size_t OFF_END = al256(OFF_MG + (size_t)SEQ * DM * 2);
constexpr size_t OFF_BAR = OFF_END;
static_assert(OFF_BAR + 16384 <= (size_t)768 * 1024 * 1024, "workspace overflow");

struct Params {
  const float* in[25];
  float* out;
  char* ws;
};

DI unsigned pk2(float a, float b) { f2_t v = {a, b}; return __builtin_bit_cast(unsigned, __builtin_convertvector(v, bf2_t)); }
DI u16 f2bf(float a) { return (u16)(pk2(a, 0.f) & 0xffffu); }
DI float bf2f(u16 v) { return __uint_as_float(((unsigned)v) << 16); }
DI float bflo(unsigned v) { return __uint_as_float(v << 16); }
DI float bfhi(unsigned v) { return __uint_as_float(v & 0xffff0000u); }
DI float wave_sum(float v) {
#pragma unroll
  for (int o = 32; o >= 1; o >>= 1) v += __shfl_xor(v, o);
  return v;
}
DI int opaque_tid() { int t = threadIdx.x; asm volatile("" : "+v"(t)); return t; }
DI const float* in_ptr(const Params& p, int k) { asm volatile("" : "+s"(k)); return p.in[k]; }
DI int crow(int i, int h) { return (i & 3) + 8 * (i >> 2) + 4 * h; }
DI float sigmoidf_(float x) { return 1.f / (1.f + __expf(-x)); }
DI float siluf_(float x) { return x / (1.f + __expf(-x)); }


#define XB_TMO      128
#define XB_XCNT(j)  (256  + 64 * (j))
#define XB_XSUB(j)  (1280 + 64 * (j))
#define XB_XGEN(j)  (2304 + 64 * (j))
#define XB_TOP      3328
#define XB_TOPGEN   3392
#define XCD_BAR_WORDS 3456
#define XB_SPIN_CAP (1u << 18)
#define LAS __attribute__((address_space(3)))

__device__ __forceinline__ unsigned xb_ld(unsigned* p)              { return __hip_atomic_load(p, __ATOMIC_RELAXED, __HIP_MEMORY_SCOPE_AGENT); }
__device__ __forceinline__ unsigned xb_add(unsigned* p, unsigned v) { return __hip_atomic_fetch_add(p, v, __ATOMIC_RELAXED, __HIP_MEMORY_SCOPE_AGENT); }
__device__ __forceinline__ unsigned xb_xcc_id() { return (unsigned)__builtin_amdgcn_s_getreg((3 << 11) | 20) & 0xFu; }
#define XB_SPIN(cond, bar) do { unsigned _sp = 0; while (cond) { __builtin_amdgcn_s_sleep(1); \
    if ((++_sp & 255u) == 0u) { if (xb_ld(&(bar)[XB_TMO])) break; if (_sp > XB_SPIN_CAP) { atomicAdd(&(bar)[XB_TMO], 1u); break; } } } } while (0)

struct XcdBarrier {
    unsigned* bar; unsigned x;
    volatile LAS unsigned* st;
};

__device__ __forceinline__ XcdBarrier xcd_barrier_post(unsigned* bar, volatile LAS unsigned* st) {
    XcdBarrier b; b.bar = bar; b.x = xb_xcc_id(); b.st = st;
    if (threadIdx.x == 0) (void)xb_add(&bar[XB_XCNT(b.x)], 1u);
    return b;
}
__device__ __forceinline__ void xcd_barrier_complete(unsigned* bar, unsigned x, unsigned& nloc, unsigned& nx) {
    const unsigned G = gridDim.x * gridDim.y * gridDim.z;
    unsigned sum, cnt, mine, sp = 0u;
    for (;;) {
        sum = 0u; cnt = 0u; mine = 0u;
#pragma unroll
        for (unsigned j = 0; j < 16; ++j) { const unsigned c = xb_ld(&bar[XB_XCNT(j)]); sum += c; cnt += (c > 0u) ? 1u : 0u; mine = (j == x) ? c : mine; }
        if (sum == G) break;
        __builtin_amdgcn_s_sleep(1);
        if ((++sp & 255u) == 0u) { if (xb_ld(&bar[XB_TMO])) break; if (sp > XB_SPIN_CAP) { atomicAdd(&bar[XB_TMO], 1u); break; } }
    }
    nloc = mine > 0u ? mine : 1u; nx = cnt > 0u ? cnt : 1u;
}

__device__ __forceinline__ void xcd_barrier(const XcdBarrier& b) {
    asm volatile("s_waitcnt vmcnt(0)" ::: "memory");
    __syncthreads();
    int tid0_ = threadIdx.x; asm volatile("" : "+v"(tid0_));
    if (tid0_ == 0) {
        unsigned* bar = b.bar; asm volatile("" : "+s"(bar));
        unsigned bx_ = b.x; asm volatile("" : "+s"(bx_));
        __builtin_amdgcn_s_waitcnt(0);
        unsigned nloc = b.st[0], nx = b.st[1];
        if (nloc == 0u) { xcd_barrier_complete(bar, bx_, nloc, nx); b.st[0] = nloc; b.st[1] = nx; }
        const unsigned old = xb_add(&bar[XB_XSUB(bx_)], 1u);
        const unsigned gen = old / nloc;
        if (old + 1u == (gen + 1u) * nloc) {
            __builtin_amdgcn_fence(__ATOMIC_RELEASE, "agent");
            asm volatile("s_waitcnt vmcnt(0)" ::: "memory");
            const unsigned og = xb_add(&bar[XB_TOP], 1u);
            const unsigned tg = og / nx;
            if (og + 1u == (tg + 1u) * nx) xb_add(&bar[XB_TOPGEN], 1u);
            else XB_SPIN(xb_ld(&bar[XB_TOPGEN]) == tg, bar);
            __builtin_amdgcn_fence(__ATOMIC_ACQUIRE, "agent");
            xb_add(&bar[XB_XGEN(bx_)], 1u);
            asm volatile("s_waitcnt vmcnt(0)" ::: "memory");
        } else {
            XB_SPIN(xb_ld(&bar[XB_XGEN(bx_)]) == gen, bar);
            __builtin_amdgcn_fence(__ATOMIC_ACQUIRE, "agent");
            asm volatile("s_waitcnt vmcnt(0)" ::: "memory");
        }
    }
    __syncthreads();
}

constexpr int LROW = 72;
constexpr int GEMM_LDS = 2 * 128 * LROW * 2;

struct Acc { f32x16 a[4][2]; };

DI void acc_zero(Acc& c) {
#pragma unroll
  for (int i = 0; i < 4; ++i)
#pragma unroll
    for (int j = 0; j < 2; ++j)
#pragma unroll
      for (int k = 0; k < 16; ++k) c.a[i][j][k] = 0.f;
}

DI void gll16(const u16* g, char* l) {
  __builtin_amdgcn_global_load_lds((const __attribute__((address_space(1))) unsigned*)g,
                                   (__attribute__((address_space(3))) unsigned*)l, 16, 0, 0);
}
DI void gemm_kloop(const u16* __restrict__ A, int lda, const u16* __restrict__ B, int ldb, int K, u16* smem, Acc& c) {
  const int t = opaque_tid();
  const int lane = t & 63, w = t >> 6, r = lane & 31, h = lane >> 5;
  const int wm = w >> 1, wn = w & 1;
  char* lds = (char*)smem;
  const int nk = K >> 5;
  const int row0 = t >> 2, c0 = t & 3;
  const int sw0 = (c0 ^ ((row0 >> 2) & 3)) * 8;
  const u16* ga0 = A + (size_t)row0 * lda + sw0;
  const u16* gb0 = B + (size_t)row0 * ldb + sw0;
  const size_t a64 = (size_t)64 * lda, b64 = (size_t)64 * ldb;
  const int loff = t * 16;
#define GEMM_ISSUE(kt_, st_)                                         \
  do {                                                               \
    const int kk_ = ((kt_) < nk ? (kt_) : (nk - 1)) * 32;            \
    char* sp_ = lds + (st_) * 24576 + loff;                          \
    gll16(ga0 + kk_, sp_);                                           \
    gll16(ga0 + a64 + kk_, sp_ + 4096);                              \
    gll16(ga0 + 2 * a64 + kk_, sp_ + 8192);                          \
    gll16(ga0 + 3 * a64 + kk_, sp_ + 12288);                         \
    gll16(gb0 + kk_, sp_ + 16384);                                   \
    gll16(gb0 + b64 + kk_, sp_ + 20480);                             \
  } while (0)
  __syncthreads();
  GEMM_ISSUE(0, 0);
  GEMM_ISSUE(1, 1);
  const int fsw = (r >> 2) & 3;
  const int aoff = (wm * 128 + r) * 64, boff = 16384 + (wn * 64 + r) * 64;
  int scur = 0, snext = 2;
  for (int kt = 0; kt < nk; ++kt) {
    asm volatile("s_waitcnt vmcnt(6)" ::: "memory");
    __builtin_amdgcn_s_barrier();
    asm volatile("" ::: "memory");
    GEMM_ISSUE(kt + 2, snext);
    __builtin_amdgcn_sched_barrier(0);
    const char* st = lds + scur * 24576;
#pragma unroll
    for (int ks = 0; ks < 2; ++ks) {
      const int q = ((ks * 2 + h) ^ fsw) * 16;
      bf16x8 fa[4], fb[2];
#pragma unroll
      for (int i = 0; i < 4; ++i) fa[i] = *(const bf16x8*)(st + aoff + i * 2048 + q);
#pragma unroll
      for (int i = 0; i < 2; ++i) fb[i] = *(const bf16x8*)(st + boff + i * 2048 + q);
#pragma unroll
      for (int i = 0; i < 4; ++i)
#pragma unroll
        for (int j = 0; j < 2; ++j) c.a[i][j] = MFMA(fa[i], fb[j], c.a[i][j]);
    }
    __builtin_amdgcn_sched_barrier(0);
    snext = scur;
    scur = (scur == 2) ? 0 : scur + 1;
  }
  asm volatile("s_waitcnt vmcnt(0)" ::: "memory");
  __builtin_amdgcn_s_barrier();
  asm volatile("" ::: "memory");
#undef GEMM_ISSUE
}

DI void row_scales(const u16* __restrict__ base, int ld, int K, float* sc, int NR) {
  const int t = opaque_tid();
  const int row = (NR == 256) ? t : (t >> 1);
  const int part = (NR == 256) ? 0 : (t & 1);
  const int len = (NR == 256) ? K : (K / 2);
  const u16* p = base + (size_t)row * ld + part * len;
  float ss = 0.f;
  for (int i = 0; i < len / 8; ++i) {
    u32x4 v = *(const u32x4*)(p + i * 8);
#pragma unroll
    for (int j = 0; j < 4; ++j) { float a = bflo(v[j]), b = bfhi(v[j]); ss += a * a + b * b; }
  }
  if (NR != 256) ss += __shfl_xor(ss, 1);
  if (part == 0) sc[row] = rsqrtf(ss / (float)K + EPS);
}


template <int NI, class V, class R>
DI void epi_store(u16* smem, V val, R rowfn) {
  const int t = opaque_tid();
  const int lane = t & 63, w = t >> 6, r = lane & 31, h = lane >> 5;
  char* reg = (char*)smem + w * 18432;
#pragma unroll
  for (int mi = 0; mi < 4; ++mi)
#pragma unroll
    for (int ni = 0; ni < NI; ++ni)
#pragma unroll
      for (int i = 0; i < 16; ++i)
        *(u16*)(reg + (mi * 32 + crow(i, h)) * 144 + (ni * 32 + r) * 2) = f2bf(val(mi, ni, i));
  __builtin_amdgcn_sched_barrier(0);
  constexpr int CPR = NI * 4;
  constexpr int RPI = 64 / CPR;
  const int rr = lane / CPR, ch = lane % CPR;
#pragma unroll
  for (int k = 0; k < 128 / RPI; ++k) {
    const int row = k * RPI + rr;
    u32x4 v = *(const u32x4*)(reg + row * 144 + ch * 16);
    rowfn(row, ch * 8, v);
  }
}

DI void tile_coords(int id, int MT, int NT, int& tm, int& tn) {
  const int per = 32 * NT;
  const int sr = id / per, rem = id - sr * per;
  tn = rem >> 5;
  tm = sr * 32 + (rem & 31);
}

#define EPI_LOOP                                   \
  _Pragma("unroll") for (int mi = 0; mi < 4; ++mi) \
  _Pragma("unroll") for (int ni = 0; ni < 2; ++ni) \
  _Pragma("unroll") for (int i = (__builtin_amdgcn_sched_barrier(0), 0); i < 16; ++i)

constexpr int SMEM_BYTES = 74752;

__global__ void __launch_bounds__(256, 2) fwd_megakernel(Params p) {
  cg::grid_group grid = cg::this_grid();
  __shared__ __attribute__((aligned(16))) char smem_raw[SMEM_BYTES];
  u16* smem = (u16*)smem_raw;
  const int G = gridDim.x, bid = blockIdx.x;
  __shared__ uint4 xb_words;
  if (threadIdx.x == 0) xb_words = make_uint4(0u, 0u, 0u, 0u);
  __syncthreads();
  XcdBarrier xb = xcd_barrier_post((unsigned*)(p.ws + OFF_BAR), (volatile LAS unsigned*)&xb_words);

  char* ws = p.ws;
#define Wb ((u16*)(ws + OFF_WB))
#define ropec ((float*)(ws + OFF_ROPE))
#define ropes (((float*)(ws + OFF_ROPE)) + SEQ * 16)
#define Hb ((u16*)(ws + OFF_H))
#define Yb ((u16*)(ws + OFF_Y))
#define ACT ((u16*)(ws + OFF_ACT))
#define Z ((u16*)(ws + OFF_Z))
#define Qb ((u16*)(ws + OFF_Q))
#define KN ((u16*)(ws + OFF_KN))
#define VT ((u16*)(ws + OFF_VT))
#define KPE ((u16*)(ws + OFF_KPE))
#define OA ((u16*)(ws + OFF_OA))
#define ST ((u16*)(ws + OFF_ST))
#define DEC ((float*)(ws + OFF_DEC))
#define GC ((float*)(ws + OFF_GC))
#define OG ((u16*)(ws + OFF_OG))
#define MG ((u16*)(ws + OFF_MG))
  float* X = p.out;

  auto convert_weights = [&](int l) __attribute__((always_inline)) {
    const int t = opaque_tid();
    const int lane = t & 63, w = t >> 6, r = lane & 31, h = lane >> 5;
    const int wm = w >> 1, wn = w & 1;
    (void)lane; (void)r; (void)h; (void)wm; (void)wn;
    float* tile = (float*)smem_raw;
    for (int mat = 0; mat < 11; ++mat) {
      const float* src; int K, N; size_t dst; int map; const float* ksc = nullptr;
      switch (mat) {
        case 0: src = in_ptr(p, 3) + (size_t)l * DM * NFF2; K = DM; N = NFF2; dst = W_FFN1_IN; map = 1; break;
        case 1: src = in_ptr(p, 4) + (size_t)l * DFF * DM; K = DFF; N = DM; dst = W_FFN1_OUT; map = 0; break;
        case 2: src = in_ptr(p, 7) + (size_t)l * DM * PIN; K = DM; N = PIN; dst = W_IN; map = 0; break;
        case 3: src = in_ptr(p, 9) + (size_t)l * 256 * 768; K = 256; N = 768; dst = W_UQ; map = 0; ksc = in_ptr(p, 8) + l * 256; break;
        case 4: src = in_ptr(p, 11) + (size_t)l * 128 * 1024; K = 128; N = 1024; dst = W_KN; map = 2; ksc = in_ptr(p, 10) + l * 128; break;
        case 5: src = in_ptr(p, 12) + (size_t)l * 512 * DM; K = 512; N = DM; dst = W_OA; map = 0; break;
        case 6: src = in_ptr(p, 18) + (size_t)l * DM * DM; K = DM; N = DM; dst = W_OB; map = 0; break;
        case 7: src = in_ptr(p, 19) + (size_t)l * DM * DM; K = DM; N = DM; dst = W_OUT; map = 0; break;
        case 8: src = in_ptr(p, 22) + (size_t)l * DM * NFF2; K = DM; N = NFF2; dst = W_FFN2_IN; map = 1; break;
        case 9: src = in_ptr(p, 23) + (size_t)l * DFF * DM; K = DFF; N = DM; dst = W_FFN2_OUT; map = 0; break;
        default: src = nullptr; K = DM; N = 64; dst = W_IN + (size_t)PIN * DM; map = 3; break;
      }
      const int kt_n = K / 64, nt_n = N / 64;
      for (int id = bid; id < kt_n * nt_n; id += G) {
        const int kt = id % kt_n, nt = id / kt_n;
        const int k0 = kt * 64, n0 = nt * 64;
        __syncthreads();
        if (map != 3) {
#pragma unroll
          for (int i = 0; i < 4; ++i) {
            const int kk = (t >> 4) + 16 * i, nn = (t & 15) * 4;
            float4 v = *(const float4*)(src + (size_t)(k0 + kk) * N + n0 + nn);
            float sc = ksc ? ksc[k0 + kk] : 1.f;
            tile[kk * 65 + nn + 0] = v.x * sc; tile[kk * 65 + nn + 1] = v.y * sc;
            tile[kk * 65 + nn + 2] = v.z * sc; tile[kk * 65 + nn + 3] = v.w * sc;
          }
        }
        __syncthreads();
        const int nl = t >> 2, kc = (t & 3) * 16;
        const int n = n0 + nl;
        size_t drow;
        if (map == 0) drow = dst + (size_t)n * K;
        else if (map == 1) { const int isb = n >= DFF; const int j = n - isb * DFF; drow = dst + (size_t)((j >> 5) * 64 + isb * 32 + (j & 31)) * K; }
        else if (map == 2) { const int hd = n >> 7, cc = n & 127; drow = (cc < 64) ? (W_KN + (size_t)(hd * 64 + cc) * K) : (W_V + (size_t)(hd * 64 + cc - 64) * K); }
        else drow = dst + (size_t)nl * K;
        unsigned o[8];
#pragma unroll
        for (int j = 0; j < 8; ++j) {
          float a = (map == 3) ? 0.f : tile[(kc + 2 * j) * 65 + nl];
          float b = (map == 3) ? 0.f : tile[(kc + 2 * j + 1) * 65 + nl];
          o[j] = pk2(a, b);
        }
        uint4* dp = (uint4*)(Wb + drow + k0 + kc);
        dp[0] = make_uint4(o[0], o[1], o[2], o[3]);
        dp[1] = make_uint4(o[4], o[5], o[6], o[7]);
      }
    }
  };

  auto rn_pass = [&](int mode, float coef, const float* post_g, const float* pre_g) __attribute__((always_inline)) {
    const int t = opaque_tid();
    const int lane = t & 63, w = t >> 6, r = lane & 31, h = lane >> 5;
    const int wm = w >> 1, wn = w & 1;
    (void)lane; (void)r; (void)h; (void)wm; (void)wn;
    typedef float f4v __attribute__((ext_vector_type(4)));
    typedef unsigned u2v __attribute__((ext_vector_type(2)));
    const int gw = bid * 4 + w, nw = G * 4;
    constexpr int RB = 4;
    f4v pg[4], qg[4];
#pragma unroll
    for (int i = 0; i < 4; ++i) {
      pg[i] = (mode == 1) ? *(const f4v*)(post_g + lane * 4 + 256 * i) : (f4v){0.f, 0.f, 0.f, 0.f};
      qg[i] = pre_g ? *(const f4v*)(pre_g + lane * 4 + 256 * i) : (f4v){0.f, 0.f, 0.f, 0.f};
    }
    for (int row0 = gw; row0 < MALL; row0 += RB * nw) {
      f4v xv[RB][4];
      u2v yu[RB][4];
#pragma unroll
      for (int j = 0; j < RB; ++j) {
        int row = row0 + j * nw;
        if (row >= MALL) row = row0;
        const float* xs;
        if (mode == 0) xs = (row < SEQ) ? (in_ptr(p, 0) + (size_t)row * DM) : (in_ptr(p, 1) + (size_t)(row - SEQ) * DM);
        else xs = X + (size_t)row * DM;
#pragma unroll
        for (int i = 0; i < 4; ++i) xv[j][i] = *(const f4v*)(xs + lane * 4 + 256 * i);
        if (mode == 1) {
#pragma unroll
          for (int i = 0; i < 4; ++i) yu[j][i] = *(const u2v*)(Yb + (size_t)row * DM + lane * 4 + 256 * i);
        }
      }
#pragma unroll
      for (int j = 0; j < RB; ++j) {
        const int row = row0 + j * nw;
        if (row < MALL) {
          if (mode == 1) {
            float yv[16];
            float ss = 0.f;
#pragma unroll
            for (int i = 0; i < 4; ++i) {
              yv[4 * i + 0] = bflo(yu[j][i][0]); yv[4 * i + 1] = bfhi(yu[j][i][0]);
              yv[4 * i + 2] = bflo(yu[j][i][1]); yv[4 * i + 3] = bfhi(yu[j][i][1]);
            }
#pragma unroll
            for (int i = 0; i < 16; ++i) ss += yv[i] * yv[i];
            ss = wave_sum(ss);
            const float ry = rsqrtf(ss * (1.f / DM) + EPS) * coef;
#pragma unroll
            for (int i = 0; i < 4; ++i)
#pragma unroll
              for (int k = 0; k < 4; ++k) xv[j][i][k] += yv[4 * i + k] * ry * pg[i][k];
          }
#pragma unroll
          for (int i = 0; i < 4; ++i) *(f4v*)(X + (size_t)row * DM + lane * 4 + 256 * i) = xv[j][i];
          if (pre_g) {
            float ss = 0.f;
#pragma unroll
            for (int i = 0; i < 4; ++i)
#pragma unroll
              for (int k = 0; k < 4; ++k) ss += xv[j][i][k] * xv[j][i][k];
            ss = wave_sum(ss);
            const float rx = rsqrtf(ss * (1.f / DM) + EPS);
#pragma unroll
            for (int i = 0; i < 4; ++i) {
              u2v o;
              o[0] = pk2(xv[j][i][0] * rx * qg[i][0], xv[j][i][1] * rx * qg[i][1]);
              o[1] = pk2(xv[j][i][2] * rx * qg[i][2], xv[j][i][3] * rx * qg[i][3]);
              *(u2v*)(Hb + (size_t)row * DM + lane * 4 + 256 * i) = o;
            }
          }
        }
      }
    }
  };

  auto ffn_in = [&](size_t woff) __attribute__((always_inline)) {
    const int t = opaque_tid();
    const int lane = t & 63, w = t >> 6, r = lane & 31, h = lane >> 5;
    const int wm = w >> 1, wn = w & 1;
    (void)lane; (void)r; (void)h; (void)wm; (void)wn;
    const int MT = MALL / 256, NT = NFF2 / 128;
    for (int id = bid; id < MT * NT; id += G) {
      int tm, tn; tile_coords(id, MT, NT, tm, tn);
      const int m0 = tm * 256, n0 = tn * 128;
      Acc c; acc_zero(c);
      gemm_kloop(Hb + (size_t)m0 * DM, DM, Wb + woff + (size_t)n0 * DM, DM, DM, smem, c);
#ifdef DUP_KLOOP
      acc_zero(c);
      gemm_kloop(Hb + (size_t)m0 * DM, DM, Wb + woff + (size_t)n0 * DM, DM, DM, smem, c);
#endif
      const int jb0 = ((n0 + wn * 64) >> 6) * 32;
      const unsigned obase = (unsigned)((m0 + wm * 128) * DFF + jb0);
      epi_store<1>(smem,
        [&](int mi, int ni, int i) { return siluf_(c.a[mi][0][i]) * c.a[mi][1][i]; },
        [&](int row, int col, u32x4 v) { *(u32x4*)(ACT + obase + (unsigned)(row * DFF + col)) = v; });
    }
  };
  auto gemm_plain = [&](const u16* A, int lda, int K, const u16* Bt, u16* C, int ldc, int M, int N) __attribute__((always_inline)) {
    const int t = opaque_tid();
    const int lane = t & 63, w = t >> 6, r = lane & 31, h = lane >> 5;
    const int wm = w >> 1, wn = w & 1;
    (void)lane; (void)r; (void)h; (void)wm; (void)wn;
    const int MT = M / 256, NT = N / 128;
    for (int id = bid; id < MT * NT; id += G) {
      int tm, tn; tile_coords(id, MT, NT, tm, tn);
      const int m0 = tm * 256, n0 = tn * 128;
      Acc c; acc_zero(c);
      gemm_kloop(A + (size_t)m0 * lda, lda, Bt + (size_t)n0 * K, K, K, smem, c);
      const unsigned obase = (unsigned)((m0 + wm * 128) * ldc + n0 + wn * 64);
      epi_store<2>(smem,
        [&](int mi, int ni, int i) { return c.a[mi][ni][i]; },
        [&](int row, int col, u32x4 v) { *(u32x4*)(C + obase + (unsigned)(row * ldc + col)) = v; });
    }
  };

  auto prep_phase = [&](int l) __attribute__((always_inline)) {
    const int t = opaque_tid();
    const int lane = t & 63, w = t >> 6, r = lane & 31, h = lane >> 5;
    const int wm = w >> 1, wn = w & 1;
    (void)lane; (void)r; (void)h; (void)wm; (void)wn;
    float* sc = (float*)(smem_raw + 2 * GEMM_LDS);
    const int NQ = 64 * 6, NK = 64 * 4, NV = 2 * 128, NPE = 64, NG1 = NCHUNK * 4;
    const float qscale = 0.10206207261596577f * 1.4426950408889634f;
    {
      for (int id = bid; id < NG1; id += G) {
        const int t = opaque_tid();
        const int lane = t & 63, w = t >> 6, r = lane & 31, h = lane >> 5;
        const int wm = w >> 1, wn = w & 1;
        (void)lane; (void)r; (void)h; (void)wm; (void)wn;
        const int n = id >> 2, hd = id & 3;
        const int t0 = n * 64;
        u16* ksT = smem;
        u16* vT = smem + 2 * 128 * LROW;
        u16* sk = vT;
        float* sga = (float*)(smem_raw + 55296);
        __syncthreads();
        {
          const int cc = t >> 2, part = t & 3;
          const u16* kp = Z + (size_t)(t0 + cc) * ZLD + Z_GK + hd * 128 + part * 32;
#pragma unroll
          for (int j = 0; j < 4; ++j) *(u32x4*)(sk + cc * 128 + part * 32 + j * 8) = *(const u32x4*)(kp + j * 8);
          u32x4 gv = *(const u32x4*)(Z + (size_t)(t0 + cc) * ZLD + Z_GA + part * 8);
#pragma unroll
          for (int k = 0; k < 4; ++k) { sga[cc * 32 + part * 8 + 2 * k] = bflo(gv[k]); sga[cc * 32 + part * 8 + 2 * k + 1] = bfhi(gv[k]); }
        }
        __syncthreads();
        {
          const int dir = t >> 7, d = t & 127;
          const float* wa2 = (dir ? in_ptr(p, 15) : in_ptr(p, 13)) + (size_t)l * 16 * 512 + hd * 128 + d;
          const float ba = ((dir ? in_ptr(p, 16) : in_ptr(p, 14)) + (size_t)l * 512)[hd * 128 + d];
          float wcol[16];
#pragma unroll
          for (int rr = 0; rr < 16; ++rr) wcol[rr] = wa2[rr * 512];
          const float* gar = sga + dir * 16;
          float tot = 0.f;
          for (int cc = 0; cc < 64; ++cc) {
            float pre = ba;
#pragma unroll
            for (int rr = 0; rr < 16; ++rr) pre += gar[cc * 32 + rr] * wcol[rr];
            tot += (fminf(pre, 0.f) - __logf(1.f + __expf(-fabsf(pre)))) * (1.f / 16.f);
          }
          DEC[((size_t)(n * 4 + hd) * 2 + dir) * 128 + d] = __expf(tot);
          float* gc = GC + (size_t)dir * SEQ * 512 + (size_t)t0 * 512 + hd * 128 + d;
          float cb = 0.f;
          u16* krow_out = ksT + (dir * 128 + d) * LROW;
          for (int ci = 0; ci < 64; ++ci) {
            const int cc = dir ? (63 - ci) : ci;
            float pre = ba;
#pragma unroll
            for (int rr = 0; rr < 16; ++rr) pre += gar[cc * 32 + rr] * wcol[rr];
            cb += (fminf(pre, 0.f) - __logf(1.f + __expf(-fabsf(pre)))) * (1.f / 16.f);
            gc[cc * 512] = cb;
            krow_out[cc] = f2bf(bf2f(sk[cc * 128 + d]) * __expf(tot - cb));
          }
        }
        for (int half = 0; half < 2; ++half) {
          __syncthreads();
          {
            const int cc = t & 63, part = t >> 6;
#pragma unroll
            for (int q = 0; q < 4; ++q) {
              const int cg8 = (part * 4 + q) * 8;
              uint4 v = *(const uint4*)(Z + (size_t)(t0 + cc) * ZLD + Z_GV + hd * 256 + half * 128 + cg8);
              unsigned u[4] = {v.x, v.y, v.z, v.w};
#pragma unroll
              for (int j = 0; j < 4; ++j) {
                vT[(cg8 + 2 * j) * LROW + cc] = (u16)(u[j] & 0xffffu);
                vT[(cg8 + 2 * j + 1) * LROW + cc] = (u16)(u[j] >> 16);
              }
            }
          }
          __syncthreads();
#pragma unroll
          for (int dir = 0; dir < 2; ++dir) {
            f32x16 acc[4];
#pragma unroll
            for (int j = 0; j < 4; ++j)
#pragma unroll
              for (int k = 0; k < 16; ++k) acc[j][k] = 0.f;
#pragma unroll
            for (int ks = 0; ks < 4; ++ks) {
              bf16x8 fa = *(const bf16x8*)(vT + (w * 32 + r) * LROW + ks * 16 + h * 8);
#pragma unroll
              for (int nt = 0; nt < 4; ++nt) {
                bf16x8 fb = *(const bf16x8*)(ksT + (dir * 128 + nt * 32 + r) * LROW + ks * 16 + h * 8);
                acc[nt] = MFMA(fb, fa, acc[nt]);
              }
            }
            u16* stp = ST + ((size_t)(n * 4 + hd) * 2 + dir) * 32768;
#pragma unroll
            for (int nt = 0; nt < 4; ++nt)
#pragma unroll
              for (int g4 = 0; g4 < 4; ++g4) {
                uint2 o;
                o.x = pk2(acc[nt][4 * g4 + 0], acc[nt][4 * g4 + 1]);
                o.y = pk2(acc[nt][4 * g4 + 2], acc[nt][4 * g4 + 3]);
                *(uint2*)(stp + (unsigned)((half * 128 + w * 32 + r) * 128 + nt * 32 + 8 * g4 + 4 * h)) = o;
              }
          }
        }
      }
      for (int q = bid; q < NQ; q += G) {
        const int t = opaque_tid();
        const int lane = t & 63, w = t >> 6, r = lane & 31, h = lane >> 5;
        const int wm = w >> 1, wn = w & 1;
        (void)lane; (void)r; (void)h; (void)wm; (void)wn;
        const int tm = q / 6, tn = q % 6;
        const int m0 = tm * 256, n0 = tn * 128;
        __syncthreads();
        row_scales(Z + (size_t)m0 * ZLD + Z_CQ, ZLD, 256, sc, 256);
        Acc c; acc_zero(c);
        gemm_kloop(Z + (size_t)m0 * ZLD + Z_CQ, ZLD, Wb + W_UQ + (size_t)n0 * 256, 256, 256, smem, c);
        {
          const unsigned obase = (unsigned)((m0 + wm * 128) * 768 + n0 + wn * 64);
          epi_store<2>(smem,
            [&](int mi, int ni, int i) {
              const int cb0 = n0 + wn * 64 + ni * 32;
              const bool rope = ((cb0 >> 5) % 3) == 2;
              const int rl = wm * 128 + mi * 32 + crow(i, h);
              float v = c.a[mi][ni][i] * sc[rl];
              const float pv = __shfl_xor(v, 16);
              if (rope) {
                const int row = m0 + rl;
                const float cs = ropec[row * 16 + (r & 15)], sn = ropes[row * 16 + (r & 15)];
                v = (r < 16) ? (v * cs - pv * sn) : (v * cs + pv * sn);
              }
              return v * qscale;
            },
            [&](int row, int col, u32x4 v) { *(u32x4*)(Qb + obase + (unsigned)(row * 768 + col)) = v; });
        }
      }
      for (int q = (bid + G - (NQ % G)) % G; q < NK; q += G) {
        const int t = opaque_tid();
        const int lane = t & 63, w = t >> 6, r = lane & 31, h = lane >> 5;
        const int wm = w >> 1, wn = w & 1;
        (void)lane; (void)r; (void)h; (void)wm; (void)wn;
        const int tm = q >> 2, tn = q & 3;
        const int m0 = tm * 256, n0 = tn * 128;
        __syncthreads();
        row_scales(Z + (size_t)m0 * ZLD + Z_CKV, ZLD, 128, sc, 256);
        Acc c; acc_zero(c);
        gemm_kloop(Z + (size_t)m0 * ZLD + Z_CKV, ZLD, Wb + W_KN + (size_t)n0 * 128, 128, 128, smem, c);
        {
          const unsigned obase = (unsigned)((m0 + wm * 128) * 512 + n0 + wn * 64);
          epi_store<2>(smem,
            [&](int mi, int ni, int i) { return c.a[mi][ni][i] * sc[wm * 128 + mi * 32 + crow(i, h)]; },
            [&](int row, int col, u32x4 v) { *(u32x4*)(KN + obase + (unsigned)(row * 512 + col)) = v; });
        }
      }
      for (int q = (bid + G - ((NQ + NK) % G)) % G; q < NV; q += G) {
        const int t = opaque_tid();
        const int lane = t & 63, w = t >> 6, r = lane & 31, h = lane >> 5;
        const int wm = w >> 1, wn = w & 1;
        (void)lane; (void)r; (void)h; (void)wm; (void)wn;
        const int tm = q & 1, tn = q >> 1;
        const int m0 = tm * 256, n0 = tn * 128;
        __syncthreads();
        row_scales(Z + (size_t)n0 * ZLD + Z_CKV, ZLD, 128, sc, 128);
        Acc c; acc_zero(c);
        gemm_kloop(Wb + W_V + (size_t)m0 * 128, 128, Z + (size_t)n0 * ZLD + Z_CKV, ZLD, 128, smem, c);
        {
          const unsigned obase = (unsigned)((m0 + wm * 128) * SEQ + n0 + wn * 64);
          epi_store<2>(smem,
            [&](int mi, int ni, int i) { return c.a[mi][ni][i] * sc[wn * 64 + ni * 32 + r]; },
            [&](int row, int col, u32x4 v) { *(u32x4*)(VT + obase + (unsigned)(row * SEQ + col)) = v; });
        }
      }
      for (int q = (bid + G - ((NQ + NK + NV) % G)) % G; q < NPE; q += G) {
        const int t = opaque_tid();
        const int lane = t & 63, w = t >> 6, r = lane & 31, h = lane >> 5;
        const int wm = w >> 1, wn = w & 1;
        (void)lane; (void)r; (void)h; (void)wm; (void)wn;
        const int tok = q * 256 + t;
        const u16* src = Z + (size_t)tok * ZLD + Z_KPE;
        float v[32];
#pragma unroll
        for (int j = 0; j < 4; ++j) {
          uint4 u = *(const uint4*)(src + j * 8);
          unsigned uu[4] = {u.x, u.y, u.z, u.w};
#pragma unroll
          for (int k = 0; k < 4; ++k) { v[j * 8 + 2 * k] = bflo(uu[k]); v[j * 8 + 2 * k + 1] = bfhi(uu[k]); }
        }
        float o[32];
#pragma unroll
        for (int i = 0; i < 16; ++i) {
          const float cs = ropec[tok * 16 + i], sn = ropes[tok * 16 + i];
          o[i] = v[i] * cs - v[i + 16] * sn;
          o[i + 16] = v[i + 16] * cs + v[i] * sn;
        }
#pragma unroll
        for (int j = 0; j < 4; ++j) {
          uint4 u;
          u.x = pk2(o[j * 8 + 0], o[j * 8 + 1]); u.y = pk2(o[j * 8 + 2], o[j * 8 + 3]);
          u.z = pk2(o[j * 8 + 4], o[j * 8 + 5]); u.w = pk2(o[j * 8 + 6], o[j * 8 + 7]);
          *(uint4*)(KPE + (size_t)tok * 32 + j * 8) = u;
        }
      }
    }
  };

  auto attn_phase = [&](bool do_scan) __attribute__((always_inline)) {
    const int t = opaque_tid();
    const int lane = t & 63, w = t >> 6, r = lane & 31, h = lane >> 5;
    const int wm = w >> 1, wn = w & 1;
    (void)lane; (void)r; (void)h; (void)wm; (void)wn;
    if (do_scan) for (int id = bid; id < 512; id += G) {
      const int e = id * 256 + t;
      const int d2 = e & 63, v = (e >> 6) & 255, dir = (e >> 14) & 1, hd = e >> 15;
      float s0 = 0.f, s1 = 0.f;
      const size_t eoff = (size_t)v * 128 + 2 * d2;
      for (int i0 = 0; i0 < NCHUNK; i0 += 16) {
        unsigned uu[16];
        float2 dd[16];
#pragma unroll
        for (int j = 0; j < 16; ++j) {
          const int n = dir ? (NCHUNK - 1 - (i0 + j)) : (i0 + j);
          const size_t base = ((size_t)(n * 4 + hd) * 2 + dir);
          uu[j] = *(const unsigned*)(ST + base * 32768 + eoff);
          dd[j] = *(const float2*)(DEC + base * 128 + 2 * d2);
        }
#pragma unroll
        for (int j = 0; j < 16; ++j) {
          const int n = dir ? (NCHUNK - 1 - (i0 + j)) : (i0 + j);
          const size_t base = ((size_t)(n * 4 + hd) * 2 + dir);
          *(unsigned*)(ST + base * 32768 + eoff) = pk2(s0, s1);
          s0 = dd[j].x * s0 + bflo(uu[j]);
          s1 = dd[j].y * s1 + bfhi(uu[j]);
        }
      }
    }
    constexpr int KROW = 104;
    constexpr int ABUF = 64 * KROW + 64 * LROW;
    u16* sK = smem;
    u16* sV = smem + 64 * KROW;
    for (int id = bid; id < 8 * 64; id += G) {
      const int hd = id & 7, qb = id >> 3;
      const int q0 = qb * 256 + w * 64;
      bf16x8 bq[2][6];
#pragma unroll
      for (int qt = 0; qt < 2; ++qt)
#pragma unroll
        for (int ks = 0; ks < 6; ++ks) bq[qt][ks] = *(const bf16x8*)(Qb + (size_t)(q0 + qt * 32 + r) * 768 + hd * 96 + ks * 16 + h * 8);
      f32x16 O[2][2];
#pragma unroll
      for (int j = 0; j < 2; ++j)
#pragma unroll
        for (int qt = 0; qt < 2; ++qt)
#pragma unroll
          for (int k = 0; k < 16; ++k) O[j][qt][k] = 0.f;
      float m[2] = {0.f, 0.f}, lsum[2] = {0.f, 0.f};
      const int kr = t >> 2, kc = t & 3;
      const u16* knp = KN + (size_t)kr * 512 + hd * 64 + kc * 16;
      const u16* kpp = KPE + (size_t)kr * 32 + kc * 8;
      const u16* vpp = VT + (size_t)(hd * 64 + kr) * SEQ + kc * 16;
      u32x4 rk[3], rv[2];
      rk[0] = *(const u32x4*)(knp);
      rk[1] = *(const u32x4*)(knp + 8);
      rk[2] = *(const u32x4*)(kpp);
      rv[0] = *(const u32x4*)(vpp);
      rv[1] = *(const u32x4*)(vpp + 8);
      __syncthreads();
      *(u32x4*)(sK + kr * KROW + kc * 16) = rk[0];
      *(u32x4*)(sK + kr * KROW + kc * 16 + 8) = rk[1];
      *(u32x4*)(sK + kr * KROW + 64 + kc * 8) = rk[2];
      *(u32x4*)(sV + kr * LROW + kc * 16) = rv[0];
      *(u32x4*)(sV + kr * LROW + kc * 16 + 8) = rv[1];
      rk[0] = *(const u32x4*)(knp + (size_t)64 * 512);
      rk[1] = *(const u32x4*)(knp + (size_t)64 * 512 + 8);
      rk[2] = *(const u32x4*)(kpp + (size_t)64 * 32);
      rv[0] = *(const u32x4*)(vpp + 64);
      rv[1] = *(const u32x4*)(vpp + 64 + 8);
      __syncthreads();
      int cur = 0;
      for (int key0 = 0; key0 < SEQ; key0 += 64) {
        const u16* cK = sK + cur * ABUF;
        const u16* cV = sV + cur * ABUF;
        {
          u16* nK = sK + (cur ^ 1) * ABUF;
          u16* nV = sV + (cur ^ 1) * ABUF;
          *(u32x4*)(nK + kr * KROW + kc * 16) = rk[0];
          *(u32x4*)(nK + kr * KROW + kc * 16 + 8) = rk[1];
          *(u32x4*)(nK + kr * KROW + 64 + kc * 8) = rk[2];
          *(u32x4*)(nV + kr * LROW + kc * 16) = rv[0];
          *(u32x4*)(nV + kr * LROW + kc * 16 + 8) = rv[1];
          const int kn = (key0 + 128 < SEQ) ? (key0 + 128) : key0;
          rk[0] = *(const u32x4*)(knp + (size_t)kn * 512);
          rk[1] = *(const u32x4*)(knp + (size_t)kn * 512 + 8);
          rk[2] = *(const u32x4*)(kpp + (size_t)kn * 32);
          rv[0] = *(const u32x4*)(vpp + kn);
          rv[1] = *(const u32x4*)(vpp + kn + 8);
        }
        __builtin_amdgcn_sched_barrier(0);
        f32x16 S[2][2];
#pragma unroll
        for (int kt = 0; kt < 2; ++kt)
#pragma unroll
          for (int qt = 0; qt < 2; ++qt)
#pragma unroll
            for (int k = 0; k < 16; ++k) S[kt][qt][k] = -m[qt];
#pragma unroll
        for (int ks = 0; ks < 6; ++ks)
#pragma unroll
          for (int kt = 0; kt < 2; ++kt) {
            bf16x8 fa = *(const bf16x8*)(cK + (kt * 32 + r) * KROW + ks * 16 + h * 8);
            S[kt][0] = MFMA(fa, bq[0][ks], S[kt][0]);
            S[kt][1] = MFMA(fa, bq[1][ks], S[kt][1]);
          }
        bf16x8 pf[2][4];
#pragma unroll
        for (int qt = 0; qt < 2; ++qt) {
          float mloc = S[0][qt][0];
#pragma unroll
          for (int kt = 0; kt < 2; ++kt)
#pragma unroll
            for (int k = 0; k < 16; ++k) mloc = fmaxf(mloc, S[kt][qt][k]);
          mloc = fmaxf(mloc, __shfl_xor(mloc, 32));
          if (__builtin_amdgcn_ballot_w64(mloc > 0.f) != 0ull) {
            const float delta = fmaxf(mloc, 0.f);
            const float alpha = __builtin_amdgcn_exp2f(-delta);
            m[qt] += delta;
            lsum[qt] *= alpha;
#pragma unroll
            for (int j = 0; j < 2; ++j)
#pragma unroll
              for (int k = 0; k < 16; ++k) O[j][qt][k] *= alpha;
#pragma unroll
            for (int kt = 0; kt < 2; ++kt)
#pragma unroll
              for (int k = 0; k < 16; ++k) S[kt][qt][k] -= delta;
          }
          float ps = 0.f;
#pragma unroll
          for (int kt = 0; kt < 2; ++kt)
#pragma unroll
            for (int k = 0; k < 16; ++k) { S[kt][qt][k] = __builtin_amdgcn_exp2f(S[kt][qt][k]); ps += S[kt][qt][k]; }
          lsum[qt] += ps;
#pragma unroll
          for (int s2 = 0; s2 < 4; ++s2) {
            const int kt = s2 >> 1, sx = s2 & 1;
            unsigned pw[4];
#pragma unroll
            for (int j = 0; j < 4; ++j) pw[j] = pk2(S[kt][qt][8 * sx + 2 * j], S[kt][qt][8 * sx + 2 * j + 1]);
            pf[qt][s2] = __builtin_bit_cast(bf16x8, make_uint4(pw[0], pw[1], pw[2], pw[3]));
          }
        }
#pragma unroll
        for (int s2 = 0; s2 < 4; ++s2) {
          const int kt = s2 >> 1, sx = s2 & 1;
#pragma unroll
          for (int dt = 0; dt < 2; ++dt) {
            const u16* vp = cV + (dt * 32 + r) * LROW + kt * 32 + 16 * sx + 4 * h;
            uint2 lo = *(const uint2*)(vp);
            uint2 hi = *(const uint2*)(vp + 8);
            bf16x8 fv = __builtin_bit_cast(bf16x8, make_uint4(lo.x, lo.y, hi.x, hi.y));
            O[dt][0] = MFMA(fv, pf[0][s2], O[dt][0]);
            O[dt][1] = MFMA(fv, pf[1][s2], O[dt][1]);
          }
        }
        cur ^= 1;
        __syncthreads();
      }
#pragma unroll
      for (int qt = 0; qt < 2; ++qt) {
        const float lt = lsum[qt] + __shfl_xor(lsum[qt], 32);
        const float inv = 1.f / lt;
#pragma unroll
        for (int dt = 0; dt < 2; ++dt)
#pragma unroll
          for (int g4 = 0; g4 < 4; ++g4) {
            uint2 o;
            o.x = pk2(O[dt][qt][4 * g4 + 0] * inv, O[dt][qt][4 * g4 + 1] * inv);
            o.y = pk2(O[dt][qt][4 * g4 + 2] * inv, O[dt][qt][4 * g4 + 3] * inv);
            *(uint2*)(OA + (size_t)(q0 + qt * 32 + r) * 512 + hd * 64 + dt * 32 + 8 * g4 + 4 * h) = o;
          }
      }
    }
  };

  auto gla_out_phase = [&](int l) __attribute__((always_inline)) {
    const int t = opaque_tid();
    const int lane = t & 63, w = t >> 6, r = lane & 31, h = lane >> 5;
    const int wm = w >> 1, wn = w & 1;
    (void)lane; (void)r; (void)h; (void)wm; (void)wn;
    constexpr int QROW = 136;
    u16* sQ = smem;
    u16* sKt = smem + 64 * QROW;
    u16* sVT = smem + 2 * 64 * QROW;
    float* sred = (float*)(smem + 2 * 64 * QROW + 256 * LROW);
    u16* sO = smem;
    constexpr int OROW = 264;
    const float qs = 0.08838834764831845f;
    const int cs = w & 1, vh = w >> 1;
    for (int id = bid; id < NCHUNK * 4; id += G) {
      const int n = id >> 2, hd = id & 3;
      const int t0 = n * 64;
      __syncthreads();
      {
        const int cc = t & 63, part = t >> 6;
#pragma unroll
        for (int q = 0; q < 8; ++q) {
          const int cg8 = (part * 8 + q) * 8;
          uint4 v = *(const uint4*)(Z + (size_t)(t0 + cc) * ZLD + Z_GV + hd * 256 + cg8);
          unsigned u[4] = {v.x, v.y, v.z, v.w};
#pragma unroll
          for (int j = 0; j < 4; ++j) {
            sVT[(cg8 + 2 * j) * LROW + cc] = (u16)(u[j] & 0xffffu);
            sVT[(cg8 + 2 * j + 1) * LROW + cc] = (u16)(u[j] >> 16);
          }
        }
      }
      f32x16 acc[4];
#pragma unroll
      for (int j = 0; j < 4; ++j)
#pragma unroll
        for (int k = 0; k < 16; ++k) acc[j][k] = 0.f;
      for (int dir = 0; dir < 2; ++dir) {
        __syncthreads();
        {
          const int cc = t >> 2, dp = (t & 3) * 32;
          const u16* qp = Z + (size_t)(t0 + cc) * ZLD + Z_GQ + hd * 128 + dp;
          const u16* kp = Z + (size_t)(t0 + cc) * ZLD + Z_GK + hd * 128 + dp;
          const float* gp = GC + (size_t)dir * SEQ * 512 + (size_t)(t0 + cc) * 512 + hd * 128 + dp;
#pragma unroll
          for (int j = 0; j < 4; ++j) {
            uint4 qv = *(const uint4*)(qp + j * 8);
            uint4 kv = *(const uint4*)(kp + j * 8);
            float4 g0 = *(const float4*)(gp + j * 8);
            float4 g1 = *(const float4*)(gp + j * 8 + 4);
            const float gg[8] = {g0.x, g0.y, g0.z, g0.w, g1.x, g1.y, g1.z, g1.w};
            const unsigned qu[4] = {qv.x, qv.y, qv.z, qv.w};
            const unsigned ku[4] = {kv.x, kv.y, kv.z, kv.w};
            unsigned qo[4], ko[4];
#pragma unroll
            for (int k = 0; k < 4; ++k) {
              const float e0 = __expf(gg[2 * k]), e1 = __expf(gg[2 * k + 1]);
              qo[k] = pk2(bflo(qu[k]) * qs * e0, bfhi(qu[k]) * qs * e1);
              ko[k] = pk2(bflo(ku[k]) / e0, bfhi(ku[k]) / e1);
            }
            *(uint4*)(sQ + cc * QROW + dp + j * 8) = make_uint4(qo[0], qo[1], qo[2], qo[3]);
            *(uint4*)(sKt + cc * QROW + dp + j * 8) = make_uint4(ko[0], ko[1], ko[2], ko[3]);
            __builtin_amdgcn_sched_barrier(0);
          }
        }
        __syncthreads();
        const u16* bqp = sQ + (cs * 32 + r) * QROW + h * 8;
        f32x16 at[2];
#pragma unroll
        for (int et = 0; et < 2; ++et) {
#pragma unroll
          for (int k = 0; k < 16; ++k) at[et][k] = 0.f;
#pragma unroll
          for (int ks = 0; ks < 8; ++ks) {
            bf16x8 fa = *(const bf16x8*)(sKt + (et * 32 + r) * QROW + ks * 16 + h * 8);
            bf16x8 fbq = *(const bf16x8*)(bqp + ks * 16);
            at[et] = MFMA(fa, fbq, at[et]);
          }
          const int cidx = cs * 32 + r;
#pragma unroll
          for (int k = 0; k < 16; ++k) {
            const int e = et * 32 + crow(k, h);
            const bool keep = dir ? (e >= cidx) : (e <= cidx);
            at[et][k] = keep ? at[et][k] : 0.f;
          }
        }
#pragma unroll
        for (int s2 = 0; s2 < 4; ++s2) {
          const int et = s2 >> 1, s = s2 & 1;
          unsigned pw[4];
#pragma unroll
          for (int j = 0; j < 4; ++j) pw[j] = pk2(at[et][8 * s + 2 * j], at[et][8 * s + 2 * j + 1]);
          bf16x8 pf = __builtin_bit_cast(bf16x8, make_uint4(pw[0], pw[1], pw[2], pw[3]));
#pragma unroll
          for (int mt = 0; mt < 4; ++mt) {
            const u16* vp = sVT + (vh * 128 + mt * 32 + r) * LROW + et * 32 + 16 * s + 4 * h;
            uint2 lo = *(const uint2*)(vp);
            uint2 hi = *(const uint2*)(vp + 8);
            bf16x8 fv = __builtin_bit_cast(bf16x8, make_uint4(lo.x, lo.y, hi.x, hi.y));
            acc[mt] = MFMA(fv, pf, acc[mt]);
          }
        }
        const u16* stp = ST + ((size_t)(n * 4 + hd) * 2 + dir) * 32768;
#pragma unroll
        for (int mt = 0; mt < 4; ++mt) {
#pragma unroll
          for (int kb = 0; kb < 2; ++kb) {
            bf16x8 fs[4];
#pragma unroll
            for (int ks = 0; ks < 4; ++ks) fs[ks] = *(const bf16x8*)(stp + (size_t)(vh * 128 + mt * 32 + r) * 128 + (kb * 4 + ks) * 16 + h * 8);
#pragma unroll
            for (int ks = 0; ks < 4; ++ks) { bf16x8 fbq = *(const bf16x8*)(bqp + (kb * 4 + ks) * 16); acc[mt] = MFMA(fs[ks], fbq, acc[mt]); }
            __builtin_amdgcn_sched_barrier(0);
          }
        }
      }
      float ss = 0.f;
#pragma unroll
      for (int mt = 0; mt < 4; ++mt)
#pragma unroll
        for (int k = 0; k < 16; ++k) ss += acc[mt][k] * acc[mt][k];
      ss += __shfl_xor(ss, 32);
      if (h == 0) sred[vh * 64 + cs * 32 + r] = ss;
      __syncthreads();
      const float rs = rsqrtf((sred[cs * 32 + r] + sred[64 + cs * 32 + r]) * (1.f / 256.f) + EPS);
#pragma unroll
      for (int mt = 0; mt < 4; ++mt)
#pragma unroll
        for (int g4 = 0; g4 < 4; ++g4) {
          uint2 o;
          o.x = pk2(acc[mt][4 * g4 + 0] * rs, acc[mt][4 * g4 + 1] * rs);
          o.y = pk2(acc[mt][4 * g4 + 2] * rs, acc[mt][4 * g4 + 3] * rs);
          *(uint2*)(sO + (cs * 32 + r) * OROW + vh * 128 + mt * 32 + 8 * g4 + 4 * h) = o;
        }
      __syncthreads();
      {
        const int t3 = opaque_tid();
        const int cc = t3 >> 2, vp0 = (t3 & 3) * 64;
        const float* ng = in_ptr(p, 17) + (size_t)l * 256;
#pragma unroll
        for (int j = 0; j < 8; ++j) {
          const int v0 = vp0 + j * 8;
          uint4 ov = *(const uint4*)(sO + cc * OROW + v0);
          uint4 gv = *(const uint4*)(Z + (size_t)(t0 + cc) * ZLD + Z_GOG + hd * 256 + v0);
          float4 n0 = *(const float4*)(ng + v0), n1 = *(const float4*)(ng + v0 + 4);
          const float nn[8] = {n0.x, n0.y, n0.z, n0.w, n1.x, n1.y, n1.z, n1.w};
          const unsigned ou[4] = {ov.x, ov.y, ov.z, ov.w};
          const unsigned gu[4] = {gv.x, gv.y, gv.z, gv.w};
          unsigned res[4];
#pragma unroll
          for (int k = 0; k < 4; ++k)
            res[k] = pk2(bflo(ou[k]) * nn[2 * k] * siluf_(bflo(gu[k])), bfhi(ou[k]) * nn[2 * k + 1] * siluf_(bfhi(gu[k])));
          *(uint4*)(OG + (size_t)(t0 + cc) * DM + hd * 256 + v0) = make_uint4(res[0], res[1], res[2], res[3]);
        }
      }
    }
  };

  auto merge_phase = [&]() __attribute__((always_inline)) {
    const int t = opaque_tid();
    const int lane = t & 63, w = t >> 6, r = lane & 31, h = lane >> 5;
    const int wm = w >> 1, wn = w & 1;
    (void)lane; (void)r; (void)h; (void)wm; (void)wn;
    const int MT = SEQ / 256, NT = DM / 128;
    for (int id = bid; id < MT * NT; id += G) {
      int tm, tn; tile_coords(id, MT, NT, tm, tn);
      const int m0 = tm * 256, n0 = tn * 128;
      Acc c; acc_zero(c);
      gemm_kloop(OA + (size_t)m0 * 512, 512, Wb + W_OA + (size_t)n0 * 512, 512, 512, smem, c);
      {
        const unsigned zbase = (unsigned)((m0 + wm * 128) * ZLD + Z_BG + n0 + wn * 64);
        const unsigned obase = (unsigned)((m0 + wm * 128) * DM + n0 + wn * 64);
        epi_store<2>(smem,
          [&](int mi, int ni, int i) { return c.a[mi][ni][i]; },
          [&](int row, int col, u32x4 v) {
            const u32x4 g = *(const u32x4*)(Z + zbase + (unsigned)(row * ZLD + col));
            u32x4 o;
#pragma unroll
            for (int k = 0; k < 4; ++k) o[k] = pk2(bflo(v[k]) * sigmoidf_(bflo(g[k])), bfhi(v[k]) * sigmoidf_(bfhi(g[k])));
            *(u32x4*)(MG + obase + (unsigned)(row * DM + col)) = o;
          });
      }
      acc_zero(c);
      gemm_kloop(OG + (size_t)m0 * DM, DM, Wb + W_OB + (size_t)n0 * DM, DM, DM, smem, c);
      {
        const int t2 = opaque_tid();
        const int wm2 = t2 >> 7, wn2 = (t2 >> 6) & 1;
        const unsigned zbase = (unsigned)((m0 + wm2 * 128) * ZLD + Z_BG + DM + n0 + wn2 * 64);
        const unsigned obase = (unsigned)((m0 + wm2 * 128) * DM + n0 + wn2 * 64);
        epi_store<2>(smem,
          [&](int mi, int ni, int i) { return c.a[mi][ni][i]; },
          [&](int row, int col, u32x4 v) {
            const u32x4 g = *(const u32x4*)(Z + zbase + (unsigned)(row * ZLD + col));
            const u32x4 pm = *(const u32x4*)(MG + obase + (unsigned)(row * DM + col));
            u32x4 o;
#pragma unroll
            for (int k = 0; k < 4; ++k)
              o[k] = pk2(bflo(pm[k]) + bflo(v[k]) * sigmoidf_(bflo(g[k])), bfhi(pm[k]) + bfhi(v[k]) * sigmoidf_(bfhi(g[k])));
            *(u32x4*)(MG + obase + (unsigned)(row * DM + col)) = o;
          });
      }
    }
  };

  for (int i = bid * 256 + opaque_tid(); i < SEQ * 16; i += G * 256) {
    const int pos = i >> 4, j = i & 15;
    const float inv_freq = exp2f(-(float)j * 0.8304820237218406f);
    const float angf = (float)pos * inv_freq;
    double a = (double)angf;
    const double twopi = 6.283185307179586476925286766559;
    a -= twopi * rint(a / twopi);
    const float af = (float)a;
    ropec[i] = __cosf(af);
    ropes[i] = __sinf(af);
  }
  convert_weights(0);
  rn_pass(0, 0.f, nullptr, in_ptr(p, 2));
  grid.sync();

  for (int l = 0; l < 4; ++l) {
    ffn_in(W_FFN1_IN);
#ifdef DUP_FFNIN
    xcd_barrier(xb);
    ffn_in(W_FFN1_IN);
#endif
    xcd_barrier(xb);
    gemm_plain(ACT, DFF, DFF, Wb + W_FFN1_OUT, Yb, DM, MALL, DM);
    xcd_barrier(xb);
    rn_pass(1, 0.5f, in_ptr(p, 5) + l * DM, in_ptr(p, 6) + l * DM);
    xcd_barrier(xb);
    for (int s = 0; s < NSEQ; ++s) {
      gemm_plain(Hb + (size_t)s * SEQ * DM, DM, DM, Wb + W_IN, Z, ZLD, SEQ, ZLD);
      xcd_barrier(xb);
      prep_phase(l);
#ifdef DUP_PREP
      xcd_barrier(xb);
      prep_phase(l);
#endif
      xcd_barrier(xb);
      attn_phase(true);
#ifdef DUP_ATTN
      xcd_barrier(xb);
      attn_phase(false);
#endif
      xcd_barrier(xb);
      gla_out_phase(l);
#ifdef DUP_GLAOUT
      xcd_barrier(xb);
      gla_out_phase(l);
#endif
      xcd_barrier(xb);
      merge_phase();
      xcd_barrier(xb);
      gemm_plain(MG, DM, DM, Wb + W_OUT, Yb + (size_t)s * SEQ * DM, DM, SEQ, DM);
      xcd_barrier(xb);
    }
    rn_pass(1, 1.0f, in_ptr(p, 20) + l * DM, in_ptr(p, 21) + l * DM);
    xcd_barrier(xb);
    ffn_in(W_FFN2_IN);
    xcd_barrier(xb);
    gemm_plain(ACT, DFF, DFF, Wb + W_FFN2_OUT, Yb, DM, MALL, DM);
    xcd_barrier(xb);
    rn_pass(1, 0.5f, in_ptr(p, 24) + l * DM, (l < 3) ? (in_ptr(p, 2) + (l + 1) * DM) : nullptr);
    if (l < 3) convert_weights(l + 1);
    xcd_barrier(xb);
  }
}

extern "C" void kernel_launch(void* const* d_in, const int* in_sizes, int n_in, void* d_out,
                              int out_size, void* d_ws, size_t ws_size, hipStream_t stream) {
  static int grid_blocks = 0;
  if (!grid_blocks) {
    int dev = 0, cus = 0, per_cu = 0;
    (void)hipGetDevice(&dev);
    (void)hipDeviceGetAttribute(&cus, hipDeviceAttributeMultiprocessorCount, dev);
    (void)hipOccupancyMaxActiveBlocksPerMultiprocessor(&per_cu, fwd_megakernel, 256, 0);
    if (per_cu > 2) per_cu = 2;
    if (per_cu < 1) per_cu = 1;
    grid_blocks = cus * per_cu;
  }
  Params p{};
  for (int i = 0; i < 25; ++i) p.in[i] = (const float*)d_in[i];
  p.out = (float*)d_out;
  p.ws = (char*)d_ws;
  (void)hipMemsetAsync((char*)d_ws + OFF_BAR, 0, XCD_BAR_WORDS * 4, stream);
  void* args[] = {&p};
  hipError_t e = hipLaunchCooperativeKernel((void*)fwd_megakernel, dim3(grid_blocks), dim3(256), args, 0, stream);
  if (e != hipSuccess) fprintf(stderr, "cooperative launch failed: %s (grid %d)\n", hipGetErrorString(e), grid_blocks);
}
```

```cpp
#include <hip/hip_runtime.h>
#include <hip/hip_cooperative_groups.h>
#include <cstdio>
namespace cg = cooperative_groups;

typedef unsigned short u16;
typedef short bf16x8 __attribute__((ext_vector_type(8)));
typedef short s16x4 __attribute__((ext_vector_type(4)));
typedef float f32x16 __attribute__((ext_vector_type(16)));
typedef __bf16 bf2_t __attribute__((ext_vector_type(2)));
typedef float f2_t __attribute__((ext_vector_type(2)));
typedef unsigned u32x4 __attribute__((ext_vector_type(4)));
#define DI __device__ __forceinline__
#define MFMA(a, b, c) __builtin_amdgcn_mfma_f32_32x32x16_bf16((a), (b), (c), 0, 0, 0)

constexpr int SEQ = 16384;
constexpr int NSEQ = 3;
constexpr int MALL = SEQ * NSEQ;
constexpr int DM = 1024;
constexpr int DFF = 2816;
constexpr int NFF2 = 5632;
constexpr int PIN = 5568;
constexpr int ZLD = 5632;
constexpr int Z_CQ = 0, Z_CKV = 256, Z_KPE = 384, Z_GQ = 416, Z_GK = 928, Z_GV = 1440, Z_GA = 2464, Z_GOG = 2496, Z_BG = 3520;
constexpr float EPS = 1e-6f;
constexpr int NCHUNK = SEQ / 64;

constexpr size_t W_FFN1_IN = 0;
constexpr size_t W_FFN1_OUT = W_FFN1_IN + (size_t)NFF2 * DM;
constexpr size_t W_IN = W_FFN1_OUT + (size_t)DM * DFF;
constexpr size_t W_UQ = W_IN + (size_t)ZLD * DM;
constexpr size_t W_KN = W_UQ + (size_t)768 * 256;
constexpr size_t W_V = W_KN + (size_t)512 * 128;
constexpr size_t W_OA = W_V + (size_t)512 * 128;
constexpr size_t W_OB = W_OA + (size_t)DM * 512;
constexpr size_t W_OUT = W_OB + (size_t)DM * DM;
constexpr size_t W_FFN2_IN = W_OUT + (size_t)DM * DM;
constexpr size_t W_FFN2_OUT = W_FFN2_IN + (size_t)NFF2 * DM;
constexpr size_t W_END = W_FFN2_OUT + (size_t)DM * DFF;

constexpr size_t al256(size_t x) { return (x + 255) & ~(size_t)255; }
constexpr size_t OFF_WB = 0;
constexpr size_t OFF_ROPE = al256(OFF_WB + W_END * 2);
constexpr size_t OFF_H = al256(OFF_ROPE + (size_t)SEQ * 32 * 4);
constexpr size_t OFF_Y = al256(OFF_H + (size_t)MALL * DM * 2);
constexpr size_t OFF_ACT = al256(OFF_Y + (size_t)MALL * DM * 2);
constexpr size_t OFF_Z = OFF_ACT;
constexpr size_t OFF_Q = al256(OFF_Z + (size_t)SEQ * ZLD * 2);
constexpr size_t OFF_KN = al256(OFF_Q + (size_t)SEQ * 768 * 2);
constexpr size_t OFF_VT = al256(OFF_KN + (size_t)SEQ * 512 * 2);
constexpr size_t OFF_KPE = al256(OFF_VT + (size_t)SEQ * 512 * 2);
constexpr size_t OFF_OA = al256(OFF_KPE + (size_t)SEQ * 32 * 2);
constexpr size_t OFF_MIXEND = al256(OFF_OA + (size_t)SEQ * 512 * 2);
constexpr size_t OFF_ACTEND = al256(OFF_ACT + (size_t)MALL * DFF * 2);
static_assert(OFF_MIXEND <= OFF_ACTEND, "mixer scratch must fit in act");
constexpr size_t OFF_ST = OFF_ACTEND;
constexpr size_t OFF_DEC = al256(OFF_ST + (size_t)NCHUNK * 4 * 2 * 256 * 128 * 2);
constexpr size_t OFF_GC = al256(OFF_DEC + (size_t)NCHUNK * 4 * 2 * 128 * 4);
constexpr size_t OFF_OG = al256(OFF_GC + (size_t)2 * SEQ * 512 * 4);
constexpr size_t OFF_MG = al256(OFF_OG + (size_t)SEQ * DM * 2);
constexpr size_t OFF_END = al256(OFF_MG + (size_t)SEQ * DM * 2);
constexpr size_t OFF_BAR = OFF_END;
static_assert(OFF_BAR + 16384 <= (size_t)768 * 1024 * 1024, "workspace overflow");

struct Params {
  const float* in[25];
  float* out;
  char* ws;
};

DI unsigned pk2(float a, float b) { f2_t v = {a, b}; return __builtin_bit_cast(unsigned, __builtin_convertvector(v, bf2_t)); }
DI u16 f2bf(float a) { return (u16)(pk2(a, 0.f) & 0xffffu); }
DI float bf2f(u16 v) { return __uint_as_float(((unsigned)v) << 16); }
DI float bflo(unsigned v) { return __uint_as_float(v << 16); }
DI float bfhi(unsigned v) { return __uint_as_float(v & 0xffff0000u); }
DI float wave_sum(float v) {
#pragma unroll
  for (int o = 32; o >= 1; o >>= 1) v += __shfl_xor(v, o);
  return v;
}
DI int opaque_tid() { int t = threadIdx.x; asm volatile("" : "+v"(t)); return t; }
DI const float* in_ptr(const Params& p, int k) { asm volatile("" : "+s"(k)); return p.in[k]; }
DI int crow(int i, int h) { return (i & 3) + 8 * (i >> 2) + 4 * h; }
DI float sigmoidf_(float x) { return 1.f / (1.f + __expf(-x)); }
DI float siluf_(float x) { return x / (1.f + __expf(-x)); }


#define XB_TMO      128
#define XB_XCNT(j)  (256  + 64 * (j))
#define XB_XSUB(j)  (1280 + 64 * (j))
#define XB_XGEN(j)  (2304 + 64 * (j))
#define XB_TOP      3328
#define XB_TOPGEN   3392
#define XCD_BAR_WORDS 3456
#define XB_SPIN_CAP (1u << 18)
#define LAS __attribute__((address_space(3)))

__device__ __forceinline__ unsigned xb_ld(unsigned* p)              { return __hip_atomic_load(p, __ATOMIC_RELAXED, __HIP_MEMORY_SCOPE_AGENT); }
__device__ __forceinline__ unsigned xb_add(unsigned* p, unsigned v) { return __hip_atomic_fetch_add(p, v, __ATOMIC_RELAXED, __HIP_MEMORY_SCOPE_AGENT); }
__device__ __forceinline__ unsigned xb_xcc_id() { return (unsigned)__builtin_amdgcn_s_getreg((3 << 11) | 20) & 0xFu; }
#define XB_SPIN(cond, bar) do { unsigned _sp = 0; while (cond) { __builtin_amdgcn_s_sleep(1); \
    if ((++_sp & 255u) == 0u) { if (xb_ld(&(bar)[XB_TMO])) break; if (_sp > XB_SPIN_CAP) { atomicAdd(&(bar)[XB_TMO], 1u); break; } } } } while (0)

struct XcdBarrier {
    unsigned* bar; unsigned x;
    volatile LAS unsigned* st;
};

__device__ __forceinline__ XcdBarrier xcd_barrier_post(unsigned* bar, volatile LAS unsigned* st) {
    XcdBarrier b; b.bar = bar; b.x = xb_xcc_id(); b.st = st;
    if (threadIdx.x == 0) (void)xb_add(&bar[XB_XCNT(b.x)], 1u);
    return b;
}
__device__ __forceinline__ void xcd_barrier_complete(unsigned* bar, unsigned x, unsigned& nloc, unsigned& nx) {
    const unsigned G = gridDim.x * gridDim.y * gridDim.z;
    unsigned sum, cnt, mine, sp = 0u;
    for (;;) {
        sum = 0u; cnt = 0u; mine = 0u;
#pragma unroll
        for (unsigned j = 0; j < 16; ++j) { const unsigned c = xb_ld(&bar[XB_XCNT(j)]); sum += c; cnt += (c > 0u) ? 1u : 0u; mine = (j == x) ? c : mine; }
        if (sum == G) break;
        __builtin_amdgcn_s_sleep(1);
        if ((++sp & 255u) == 0u) { if (xb_ld(&bar[XB_TMO])) break; if (sp > XB_SPIN_CAP) { atomicAdd(&bar[XB_TMO], 1u); break; } }
    }
    nloc = mine > 0u ? mine : 1u; nx = cnt > 0u ? cnt : 1u;
}

__device__ __forceinline__ void xcd_barrier(const XcdBarrier& b) {
    asm volatile("s_waitcnt vmcnt(0)" ::: "memory");
    __syncthreads();
    int tid0_ = threadIdx.x; asm volatile("" : "+v"(tid0_));
    if (tid0_ == 0) {
        unsigned* bar = b.bar; asm volatile("" : "+s"(bar));
        unsigned bx_ = b.x; asm volatile("" : "+s"(bx_));
        __builtin_amdgcn_s_waitcnt(0);
        unsigned nloc = b.st[0], nx = b.st[1];
        if (nloc == 0u) { xcd_barrier_complete(bar, bx_, nloc, nx); b.st[0] = nloc; b.st[1] = nx; }
        const unsigned old = xb_add(&bar[XB_XSUB(bx_)], 1u);
        const unsigned gen = old / nloc;
        if (old + 1u == (gen + 1u) * nloc) {
            __builtin_amdgcn_fence(__ATOMIC_RELEASE, "agent");
            asm volatile("s_waitcnt vmcnt(0)" ::: "memory");
            const unsigned og = xb_add(&bar[XB_TOP], 1u);
            const unsigned tg = og / nx;
            if (og + 1u == (tg + 1u) * nx) xb_add(&bar[XB_TOPGEN], 1u);
            else XB_SPIN(xb_ld(&bar[XB_TOPGEN]) == tg, bar);
            __builtin_amdgcn_fence(__ATOMIC_ACQUIRE, "agent");
            xb_add(&bar[XB_XGEN(bx_)], 1u);
            asm volatile("s_waitcnt vmcnt(0)" ::: "memory");
        } else {
            XB_SPIN(xb_ld(&bar[XB_XGEN(bx_)]) == gen, bar);
            __builtin_amdgcn_fence(__ATOMIC_ACQUIRE, "agent");
            asm volatile("s_waitcnt vmcnt(0)" ::: "memory");
        }
    }
    __syncthreads();
}

constexpr int LROW = 72;
constexpr int GEMM_LDS = 2 * 128 * LROW * 2;

struct Acc { f32x16 a[4][2]; };

DI void acc_zero(Acc& c) {
#pragma unroll
  for (int i = 0; i < 4; ++i)
#pragma unroll
    for (int j = 0; j < 2; ++j)
#pragma unroll
      for (int k = 0; k < 16; ++k) c.a[i][j][k] = 0.f;
}

DI void gll16(const u16* g, char* l) {
  __builtin_amdgcn_global_load_lds((const __attribute__((address_space(1))) unsigned*)g,
                                   (__attribute__((address_space(3))) unsigned*)l, 16, 0, 0);
}
DI void gemm_kloop(const u16* __restrict__ A, int lda, const u16* __restrict__ B, int ldb, int K, u16* smem, Acc& c) {
  const int t = opaque_tid();
  const int lane = t & 63, w = t >> 6, r = lane & 31, h = lane >> 5;
  const int wm = w >> 1, wn = w & 1;
  char* lds = (char*)smem;
  const int nk = K >> 5;
  const int row0 = t >> 2, c0 = t & 3;
  const int sw0 = (c0 ^ ((row0 >> 2) & 3)) * 8;
  const u16* ga0 = A + (size_t)row0 * lda + sw0;
  const u16* gb0 = B + (size_t)row0 * ldb + sw0;
  const size_t a64 = (size_t)64 * lda, b64 = (size_t)64 * ldb;
  const int loff = t * 16;
#define GEMM_ISSUE(kt_, st_)                                         \
  do {                                                               \
    const int kk_ = ((kt_) < nk ? (kt_) : (nk - 1)) * 32;            \
    char* sp_ = lds + (st_) * 24576 + loff;                          \
    gll16(ga0 + kk_, sp_);                                           \
    gll16(ga0 + a64 + kk_, sp_ + 4096);                              \
    gll16(ga0 + 2 * a64 + kk_, sp_ + 8192);                          \
    gll16(ga0 + 3 * a64 + kk_, sp_ + 12288);                         \
    gll16(gb0 + kk_, sp_ + 16384);                                   \
    gll16(gb0 + b64 + kk_, sp_ + 20480);                             \
  } while (0)
  __syncthreads();
  GEMM_ISSUE(0, 0);
  GEMM_ISSUE(1, 1);
  const int fsw = (r >> 2) & 3;
  const int aoff = (wm * 128 + r) * 64, boff = 16384 + (wn * 64 + r) * 64;
  int scur = 0, snext = 2;
  for (int kt = 0; kt < nk; ++kt) {
    asm volatile("s_waitcnt vmcnt(6)" ::: "memory");
    __builtin_amdgcn_s_barrier();
    asm volatile("" ::: "memory");
    GEMM_ISSUE(kt + 2, snext);
    __builtin_amdgcn_sched_barrier(0);
    const char* st = lds + scur * 24576;
#pragma unroll
    for (int ks = 0; ks < 2; ++ks) {
      const int q = ((ks * 2 + h) ^ fsw) * 16;
      bf16x8 fa[4], fb[2];
#pragma unroll
      for (int i = 0; i < 4; ++i) fa[i] = *(const bf16x8*)(st + aoff + i * 2048 + q);
#pragma unroll
      for (int i = 0; i < 2; ++i) fb[i] = *(const bf16x8*)(st + boff + i * 2048 + q);
#pragma unroll
      for (int i = 0; i < 4; ++i)
#pragma unroll
        for (int j = 0; j < 2; ++j) c.a[i][j] = MFMA(fa[i], fb[j], c.a[i][j]);
    }
    __builtin_amdgcn_sched_barrier(0);
    snext = scur;
    scur = (scur == 2) ? 0 : scur + 1;
  }
  asm volatile("s_waitcnt vmcnt(0)" ::: "memory");
  __builtin_amdgcn_s_barrier();
  asm volatile("" ::: "memory");
#undef GEMM_ISSUE
}

DI void row_scales(const u16* __restrict__ base, int ld, int K, float* sc, int NR) {
  const int t = opaque_tid();
  const int row = (NR == 256) ? t : (t >> 1);
  const int part = (NR == 256) ? 0 : (t & 1);
  const int len = (NR == 256) ? K : (K / 2);
  const u16* p = base + (size_t)row * ld + part * len;
  float ss = 0.f;
  for (int i = 0; i < len / 8; ++i) {
    u32x4 v = *(const u32x4*)(p + i * 8);
#pragma unroll
    for (int j = 0; j < 4; ++j) { float a = bflo(v[j]), b = bfhi(v[j]); ss += a * a + b * b; }
  }
  if (NR != 256) ss += __shfl_xor(ss, 1);
  if (part == 0) sc[row] = rsqrtf(ss / (float)K + EPS);
}


template <int NI, class V, class R>
DI void epi_store(u16* smem, V val, R rowfn) {
  const int t = opaque_tid();
  const int lane = t & 63, w = t >> 6, r = lane & 31, h = lane >> 5;
  char* reg = (char*)smem + w * 18432;
#pragma unroll
  for (int mi = 0; mi < 4; ++mi)
#pragma unroll
    for (int ni = 0; ni < NI; ++ni)
#pragma unroll
      for (int i = 0; i < 16; ++i)
        *(u16*)(reg + (mi * 32 + crow(i, h)) * 144 + (ni * 32 + r) * 2) = f2bf(val(mi, ni, i));
  __builtin_amdgcn_sched_barrier(0);
  constexpr int CPR = NI * 4;
  constexpr int RPI = 64 / CPR;
  const int rr = lane / CPR, ch = lane % CPR;
#pragma unroll
  for (int k = 0; k < 128 / RPI; ++k) {
    const int row = k * RPI + rr;
    u32x4 v = *(const u32x4*)(reg + row * 144 + ch * 16);
    rowfn(row, ch * 8, v);
  }
}

DI void tile_coords(int id, int MT, int NT, int& tm, int& tn) {
  const int per = 32 * NT;
  const int sr = id / per, rem = id - sr * per;
  tn = rem >> 5;
  tm = sr * 32 + (rem & 31);
}

#define EPI_LOOP                                   \
  _Pragma("unroll") for (int mi = 0; mi < 4; ++mi) \
  _Pragma("unroll") for (int ni = 0; ni < 2; ++ni) \
  _Pragma("unroll") for (int i = (__builtin_amdgcn_sched_barrier(0), 0); i < 16; ++i)

constexpr int SMEM_BYTES = 74752;

__global__ void __launch_bounds__(256, 2) fwd_megakernel(Params p) {
  cg::grid_group grid = cg::this_grid();
  __shared__ __attribute__((aligned(16))) char smem_raw[SMEM_BYTES];
  u16* smem = (u16*)smem_raw;
  const int G = gridDim.x, bid = blockIdx.x;
  __shared__ uint4 xb_words;
  if (threadIdx.x == 0) xb_words = make_uint4(0u, 0u, 0u, 0u);
  __syncthreads();
  XcdBarrier xb = xcd_barrier_post((unsigned*)(p.ws + OFF_BAR), (volatile LAS unsigned*)&xb_words);

  char* ws = p.ws;
#define Wb ((u16*)(ws + OFF_WB))
#define ropec ((float*)(ws + OFF_ROPE))
#define ropes (((float*)(ws + OFF_ROPE)) + SEQ * 16)
#define Hb ((u16*)(ws + OFF_H))
#define Yb ((u16*)(ws + OFF_Y))
#define ACT ((u16*)(ws + OFF_ACT))
#define Z ((u16*)(ws + OFF_Z))
#define Qb ((u16*)(ws + OFF_Q))
#define KN ((u16*)(ws + OFF_KN))
#define VT ((u16*)(ws + OFF_VT))
#define KPE ((u16*)(ws + OFF_KPE))
#define OA ((u16*)(ws + OFF_OA))
#define ST ((u16*)(ws + OFF_ST))
#define DEC ((float*)(ws + OFF_DEC))
#define GC ((float*)(ws + OFF_GC))
#define OG ((u16*)(ws + OFF_OG))
#define MG ((u16*)(ws + OFF_MG))
  float* X = p.out;

  auto convert_weights = [&](int l) __attribute__((always_inline)) {
    const int t = opaque_tid();
    const int lane = t & 63, w = t >> 6, r = lane & 31, h = lane >> 5;
    const int wm = w >> 1, wn = w & 1;
    (void)lane; (void)r; (void)h; (void)wm; (void)wn;
    float* tile = (float*)smem_raw;
    for (int mat = 0; mat < 11; ++mat) {
      const float* src; int K, N; size_t dst; int map; const float* ksc = nullptr;
      switch (mat) {
        case 0: src = in_ptr(p, 3) + (size_t)l * DM * NFF2; K = DM; N = NFF2; dst = W_FFN1_IN; map = 1; break;
        case 1: src = in_ptr(p, 4) + (size_t)l * DFF * DM; K = DFF; N = DM; dst = W_FFN1_OUT; map = 0; break;
        case 2: src = in_ptr(p, 7) + (size_t)l * DM * PIN; K = DM; N = PIN; dst = W_IN; map = 0; break;
        case 3: src = in_ptr(p, 9) + (size_t)l * 256 * 768; K = 256; N = 768; dst = W_UQ; map = 0; ksc = in_ptr(p, 8) + l * 256; break;
        case 4: src = in_ptr(p, 11) + (size_t)l * 128 * 1024; K = 128; N = 1024; dst = W_KN; map = 2; ksc = in_ptr(p, 10) + l * 128; break;
        case 5: src = in_ptr(p, 12) + (size_t)l * 512 * DM; K = 512; N = DM; dst = W_OA; map = 0; break;
        case 6: src = in_ptr(p, 18) + (size_t)l * DM * DM; K = DM; N = DM; dst = W_OB; map = 0; break;
        case 7: src = in_ptr(p, 19) + (size_t)l * DM * DM; K = DM; N = DM; dst = W_OUT; map = 0; break;
        case 8: src = in_ptr(p, 22) + (size_t)l * DM * NFF2; K = DM; N = NFF2; dst = W_FFN2_IN; map = 1; break;
        case 9: src = in_ptr(p, 23) + (size_t)l * DFF * DM; K = DFF; N = DM; dst = W_FFN2_OUT; map = 0; break;
        default: src = nullptr; K = DM; N = 64; dst = W_IN + (size_t)PIN * DM; map = 3; break;
      }
      const int kt_n = K / 64, nt_n = N / 64;
      for (int id = bid; id < kt_n * nt_n; id += G) {
        const int kt = id % kt_n, nt = id / kt_n;
        const int k0 = kt * 64, n0 = nt * 64;
        __syncthreads();
        if (map != 3) {
#pragma unroll
          for (int i = 0; i < 4; ++i) {
            const int kk = (t >> 4) + 16 * i, nn = (t & 15) * 4;
            float4 v = *(const float4*)(src + (size_t)(k0 + kk) * N + n0 + nn);
            float sc = ksc ? ksc[k0 + kk] : 1.f;
            tile[kk * 65 + nn + 0] = v.x * sc; tile[kk * 65 + nn + 1] = v.y * sc;
            tile[kk * 65 + nn + 2] = v.z * sc; tile[kk * 65 + nn + 3] = v.w * sc;
          }
        }
        __syncthreads();
        const int nl = t >> 2, kc = (t & 3) * 16;
        const int n = n0 + nl;
        size_t drow;
        if (map == 0) drow = dst + (size_t)n * K;
        else if (map == 1) { const int isb = n >= DFF; const int j = n - isb * DFF; drow = dst + (size_t)((j >> 5) * 64 + isb * 32 + (j & 31)) * K; }
        else if (map == 2) { const int hd = n >> 7, cc = n & 127; drow = (cc < 64) ? (W_KN + (size_t)(hd * 64 + cc) * K) : (W_V + (size_t)(hd * 64 + cc - 64) * K); }
        else drow = dst + (size_t)nl * K;
        unsigned o[8];
#pragma unroll
        for (int j = 0; j < 8; ++j) {
          float a = (map == 3) ? 0.f : tile[(kc + 2 * j) * 65 + nl];
          float b = (map == 3) ? 0.f : tile[(kc + 2 * j + 1) * 65 + nl];
          o[j] = pk2(a, b);
        }
        uint4* dp = (uint4*)(Wb + drow + k0 + kc);
        dp[0] = make_uint4(o[0], o[1], o[2], o[3]);
        dp[1] = make_uint4(o[4], o[5], o[6], o[7]);
      }
    }
  };

  auto rn_pass = [&](int mode, float coef, const float* post_g, const float* pre_g) __attribute__((always_inline)) {
    const int t = opaque_tid();
    const int lane = t & 63, w = t >> 6, r = lane & 31, h = lane >> 5;
    const int wm = w >> 1, wn = w & 1;
    (void)lane; (void)r; (void)h; (void)wm; (void)wn;
    typedef float f4v __attribute__((ext_vector_type(4)));
    typedef unsigned u2v __attribute__((ext_vector_type(2)));
    const int gw = bid * 4 + w, nw = G * 4;
    constexpr int RB = 4;
    f4v pg[4], qg[4];
#pragma unroll
    for (int i = 0; i < 4; ++i) {
      pg[i] = (mode == 1) ? *(const f4v*)(post_g + lane * 4 + 256 * i) : (f4v){0.f, 0.f, 0.f, 0.f};
      qg[i] = pre_g ? *(const f4v*)(pre_g + lane * 4 + 256 * i) : (f4v){0.f, 0.f, 0.f, 0.f};
    }
    for (int row0 = gw; row0 < MALL; row0 += RB * nw) {
      f4v xv[RB][4];
      u2v yu[RB][4];
#pragma unroll
      for (int j = 0; j < RB; ++j) {
        int row = row0 + j * nw;
        if (row >= MALL) row = row0;
        const float* xs;
        if (mode == 0) xs = (row < SEQ) ? (in_ptr(p, 0) + (size_t)row * DM) : (in_ptr(p, 1) + (size_t)(row - SEQ) * DM);
        else xs = X + (size_t)row * DM;
#pragma unroll
        for (int i = 0; i < 4; ++i) xv[j][i] = *(const f4v*)(xs + lane * 4 + 256 * i);
        if (mode == 1) {
#pragma unroll
          for (int i = 0; i < 4; ++i) yu[j][i] = *(const u2v*)(Yb + (size_t)row * DM + lane * 4 + 256 * i);
        }
      }
#pragma unroll
      for (int j = 0; j < RB; ++j) {
        const int row = row0 + j * nw;
        if (row < MALL) {
          if (mode == 1) {
            float yv[16];
            float ss = 0.f;
#pragma unroll
            for (int i = 0; i < 4; ++i) {
              yv[4 * i + 0] = bflo(yu[j][i][0]); yv[4 * i + 1] = bfhi(yu[j][i][0]);
              yv[4 * i + 2] = bflo(yu[j][i][1]); yv[4 * i + 3] = bfhi(yu[j][i][1]);
            }
#pragma unroll
            for (int i = 0; i < 16; ++i) ss += yv[i] * yv[i];
            ss = wave_sum(ss);
            const float ry = rsqrtf(ss * (1.f / DM) + EPS) * coef;
#pragma unroll
            for (int i = 0; i < 4; ++i)
#pragma unroll
              for (int k = 0; k < 4; ++k) xv[j][i][k] += yv[4 * i + k] * ry * pg[i][k];
          }
#pragma unroll
          for (int i = 0; i < 4; ++i) *(f4v*)(X + (size_t)row * DM + lane * 4 + 256 * i) = xv[j][i];
          if (pre_g) {
            float ss = 0.f;
#pragma unroll
            for (int i = 0; i < 4; ++i)
#pragma unroll
              for (int k = 0; k < 4; ++k) ss += xv[j][i][k] * xv[j][i][k];
            ss = wave_sum(ss);
            const float rx = rsqrtf(ss * (1.f / DM) + EPS);
#pragma unroll
            for (int i = 0; i < 4; ++i) {
              u2v o;
              o[0] = pk2(xv[j][i][0] * rx * qg[i][0], xv[j][i][1] * rx * qg[i][1]);
              o[1] = pk2(xv[j][i][2] * rx * qg[i][2], xv[j][i][3] * rx * qg[i][3]);
              *(u2v*)(Hb + (size_t)row * DM + lane * 4 + 256 * i) = o;
            }
          }
        }
      }
    }
  };

  auto ffn_in = [&](size_t woff) __attribute__((always_inline)) {
    const int t = opaque_tid();
    const int lane = t & 63, w = t >> 6, r = lane & 31, h = lane >> 5;
    const int wm = w >> 1, wn = w & 1;
    (void)lane; (void)r; (void)h; (void)wm; (void)wn;
    const int MT = MALL / 256, NT = NFF2 / 128;
    for (int id = bid; id < MT * NT; id += G) {
      int tm, tn; tile_coords(id, MT, NT, tm, tn);
      const int m0 = tm * 256, n0 = tn * 128;
      Acc c; acc_zero(c);
      gemm_kloop(Hb + (size_t)m0 * DM, DM, Wb + woff + (size_t)n0 * DM, DM, DM, smem, c);
#ifdef DUP_KLOOP
      acc_zero(c);
      gemm_kloop(Hb + (size_t)m0 * DM, DM, Wb + woff + (size_t)n0 * DM, DM, DM, smem, c);
#endif
      const int jb0 = ((n0 + wn * 64) >> 6) * 32;
      const unsigned obase = (unsigned)((m0 + wm * 128) * DFF + jb0);
      epi_store<1>(smem,
        [&](int mi, int ni, int i) { return siluf_(c.a[mi][0][i]) * c.a[mi][1][i]; },
        [&](int row, int col, u32x4 v) { *(u32x4*)(ACT + obase + (unsigned)(row * DFF + col)) = v; });
    }
  };
  auto gemm_plain = [&](const u16* A, int lda, int K, const u16* Bt, u16* C, int ldc, int M, int N) __attribute__((always_inline)) {
    const int t = opaque_tid();
    const int lane = t & 63, w = t >> 6, r = lane & 31, h = lane >> 5;
    const int wm = w >> 1, wn = w & 1;
    (void)lane; (void)r; (void)h; (void)wm; (void)wn;
    const int MT = M / 256, NT = N / 128;
    for (int id = bid; id < MT * NT; id += G) {
      int tm, tn; tile_coords(id, MT, NT, tm, tn);
      const int m0 = tm * 256, n0 = tn * 128;
      Acc c; acc_zero(c);
      gemm_kloop(A + (size_t)m0 * lda, lda, Bt + (size_t)n0 * K, K, K, smem, c);
      const unsigned obase = (unsigned)((m0 + wm * 128) * ldc + n0 + wn * 64);
      epi_store<2>(smem,
        [&](int mi, int ni, int i) { return c.a[mi][ni][i]; },
        [&](int row, int col, u32x4 v) { *(u32x4*)(C + obase + (unsigned)(row * ldc + col)) = v; });
    }
  };

  auto prep_phase = [&](int l) __attribute__((always_inline)) {
    const int t = opaque_tid();
    const int lane = t & 63, w = t >> 6, r = lane & 31, h = lane >> 5;
    const int wm = w >> 1, wn = w & 1;
    (void)lane; (void)r; (void)h; (void)wm; (void)wn;
    float* sc = (float*)(smem_raw + 2 * GEMM_LDS);
    const int NQ = 64 * 6, NK = 64 * 4, NV = 2 * 128, NPE = 64, NG1 = NCHUNK * 4;
    const float qscale = 0.10206207261596577f * 1.4426950408889634f;
    {
      for (int id = bid; id < NG1; id += G) {
        const int t = opaque_tid();
        const int lane = t & 63, w = t >> 6, r = lane & 31, h = lane >> 5;
        const int wm = w >> 1, wn = w & 1;
        (void)lane; (void)r; (void)h; (void)wm; (void)wn;
        const int n = id >> 2, hd = id & 3;
        const int t0 = n * 64;
        u16* ksT = smem;
        u16* vT = smem + 2 * 128 * LROW;
        u16* sk = vT;
        float* sga = (float*)(smem_raw + 55296);
        __syncthreads();
        {
          const int cc = t >> 2, part = t & 3;
          const u16* kp = Z + (size_t)(t0 + cc) * ZLD + Z_GK + hd * 128 + part * 32;
#pragma unroll
          for (int j = 0; j < 4; ++j) *(u32x4*)(sk + cc * 128 + part * 32 + j * 8) = *(const u32x4*)(kp + j * 8);
          u32x4 gv = *(const u32x4*)(Z + (size_t)(t0 + cc) * ZLD + Z_GA + part * 8);
#pragma unroll
          for (int k = 0; k < 4; ++k) { sga[cc * 32 + part * 8 + 2 * k] = bflo(gv[k]); sga[cc * 32 + part * 8 + 2 * k + 1] = bfhi(gv[k]); }
        }
        __syncthreads();
        {
          const int dir = t >> 7, d = t & 127;
          const float* wa2 = (dir ? in_ptr(p, 15) : in_ptr(p, 13)) + (size_t)l * 16 * 512 + hd * 128 + d;
          const float ba = ((dir ? in_ptr(p, 16) : in_ptr(p, 14)) + (size_t)l * 512)[hd * 128 + d];
          float wcol[16];
#pragma unroll
          for (int rr = 0; rr < 16; ++rr) wcol[rr] = wa2[rr * 512];
          const float* gar = sga + dir * 16;
          float tot = 0.f;
          for (int cc = 0; cc < 64; ++cc) {
            float pre = ba;
#pragma unroll
            for (int rr = 0; rr < 16; ++rr) pre += gar[cc * 32 + rr] * wcol[rr];
            tot += (fminf(pre, 0.f) - __logf(1.f + __expf(-fabsf(pre)))) * (1.f / 16.f);
          }
          DEC[((size_t)(n * 4 + hd) * 2 + dir) * 128 + d] = __expf(tot);
          float* gc = GC + (size_t)dir * SEQ * 512 + (size_t)t0 * 512 + hd * 128 + d;
          float cb = 0.f;
          u16* krow_out = ksT + (dir * 128 + d) * LROW;
          for (int ci = 0; ci < 64; ++ci) {
            const int cc = dir ? (63 - ci) : ci;
            float pre = ba;
#pragma unroll
            for (int rr = 0; rr < 16; ++rr) pre += gar[cc * 32 + rr] * wcol[rr];
            cb += (fminf(pre, 0.f) - __logf(1.f + __expf(-fabsf(pre)))) * (1.f / 16.f);
            gc[cc * 512] = cb;
            krow_out[cc] = f2bf(bf2f(sk[cc * 128 + d]) * __expf(tot - cb));
          }
        }
        for (int half = 0; half < 2; ++half) {
          __syncthreads();
          {
            const int cc = t & 63, part = t >> 6;
#pragma unroll
            for (int q = 0; q < 4; ++q) {
              const int cg8 = (part * 4 + q) * 8;
              uint4 v = *(const uint4*)(Z + (size_t)(t0 + cc) * ZLD + Z_GV + hd * 256 + half * 128 + cg8);
              unsigned u[4] = {v.x, v.y, v.z, v.w};
#pragma unroll
              for (int j = 0; j < 4; ++j) {
                vT[(cg8 + 2 * j) * LROW + cc] = (u16)(u[j] & 0xffffu);
                vT[(cg8 + 2 * j + 1) * LROW + cc] = (u16)(u[j] >> 16);
              }
            }
          }
          __syncthreads();
#pragma unroll
          for (int dir = 0; dir < 2; ++dir) {
            f32x16 acc[4];
#pragma unroll
            for (int j = 0; j < 4; ++j)
#pragma unroll
              for (int k = 0; k < 16; ++k) acc[j][k] = 0.f;
#pragma unroll
            for (int ks = 0; ks < 4; ++ks) {
              bf16x8 fa = *(const bf16x8*)(vT + (w * 32 + r) * LROW + ks * 16 + h * 8);
#pragma unroll
              for (int nt = 0; nt < 4; ++nt) {
                bf16x8 fb = *(const bf16x8*)(ksT + (dir * 128 + nt * 32 + r) * LROW + ks * 16 + h * 8);
                acc[nt] = MFMA(fb, fa, acc[nt]);
              }
            }
            u16* stp = ST + ((size_t)(n * 4 + hd) * 2 + dir) * 32768;
#pragma unroll
            for (int nt = 0; nt < 4; ++nt)
#pragma unroll
              for (int g4 = 0; g4 < 4; ++g4) {
                uint2 o;
                o.x = pk2(acc[nt][4 * g4 + 0], acc[nt][4 * g4 + 1]);
                o.y = pk2(acc[nt][4 * g4 + 2], acc[nt][4 * g4 + 3]);
                *(uint2*)(stp + (unsigned)((half * 128 + w * 32 + r) * 128 + nt * 32 + 8 * g4 + 4 * h)) = o;
              }
          }
        }
      }
      for (int q = bid; q < NQ; q += G) {
        const int t = opaque_tid();
        const int lane = t & 63, w = t >> 6, r = lane & 31, h = lane >> 5;
        const int wm = w >> 1, wn = w & 1;
        (void)lane; (void)r; (void)h; (void)wm; (void)wn;
        const int tm = q / 6, tn = q % 6;
        const int m0 = tm * 256, n0 = tn * 128;
        __syncthreads();
        row_scales(Z + (size_t)m0 * ZLD + Z_CQ, ZLD, 256, sc, 256);
        Acc c; acc_zero(c);
        gemm_kloop(Z + (size_t)m0 * ZLD + Z_CQ, ZLD, Wb + W_UQ + (size_t)n0 * 256, 256, 256, smem, c);
        {
          const unsigned obase = (unsigned)((m0 + wm * 128) * 768 + n0 + wn * 64);
          epi_store<2>(smem,
            [&](int mi, int ni, int i) {
              const int cb0 = n0 + wn * 64 + ni * 32;
              const bool rope = ((cb0 >> 5) % 3) == 2;
              const int rl = wm * 128 + mi * 32 + crow(i, h);
              float v = c.a[mi][ni][i] * sc[rl];
              const float pv = __shfl_xor(v, 16);
              if (rope) {
                const int row = m0 + rl;
                const float cs = ropec[row * 16 + (r & 15)], sn = ropes[row * 16 + (r & 15)];
                v = (r < 16) ? (v * cs - pv * sn) : (v * cs + pv * sn);
              }
              return v * qscale;
            },
            [&](int row, int col, u32x4 v) { *(u32x4*)(Qb + obase + (unsigned)(row * 768 + col)) = v; });
        }
      }
      for (int q = (bid + G - (NQ % G)) % G; q < NK; q += G) {
        const int t = opaque_tid();
        const int lane = t & 63, w = t >> 6, r = lane & 31, h = lane >> 5;
        const int wm = w >> 1, wn = w & 1;
        (void)lane; (void)r; (void)h; (void)wm; (void)wn;
        const int tm = q >> 2, tn = q & 3;
        const int m0 = tm * 256, n0 = tn * 128;
        __syncthreads();
        row_scales(Z + (size_t)m0 * ZLD + Z_CKV, ZLD, 128, sc, 256);
        Acc c; acc_zero(c);
        gemm_kloop(Z + (size_t)m0 * ZLD + Z_CKV, ZLD, Wb + W_KN + (size_t)n0 * 128, 128, 128, smem, c);
        {
          const unsigned obase = (unsigned)((m0 + wm * 128) * 512 + n0 + wn * 64);
          epi_store<2>(smem,
            [&](int mi, int ni, int i) { return c.a[mi][ni][i] * sc[wm * 128 + mi * 32 + crow(i, h)]; },
            [&](int row, int col, u32x4 v) { *(u32x4*)(KN + obase + (unsigned)(row * 512 + col)) = v; });
        }
      }
      for (int q = (bid + G - ((NQ + NK) % G)) % G; q < NV; q += G) {
        const int t = opaque_tid();
        const int lane = t & 63, w = t >> 6, r = lane & 31, h = lane >> 5;
        const int wm = w >> 1, wn = w & 1;
        (void)lane; (void)r; (void)h; (void)wm; (void)wn;
        const int tm = q & 1, tn = q >> 1;
        const int m0 = tm * 256, n0 = tn * 128;
        __syncthreads();
        row_scales(Z + (size_t)n0 * ZLD + Z_CKV, ZLD, 128, sc, 128);
        Acc c; acc_zero(c);
        gemm_kloop(Wb + W_V + (size_t)m0 * 128, 128, Z + (size_t)n0 * ZLD + Z_CKV, ZLD, 128, smem, c);
        {
          const unsigned obase = (unsigned)((m0 + wm * 128) * SEQ + n0 + wn * 64);
          epi_store<2>(smem,
            [&](int mi, int ni, int i) { return c.a[mi][ni][i] * sc[wn * 64 + ni * 32 + r]; },
            [&](int row, int col, u32x4 v) { *(u32x4*)(VT + obase + (unsigned)(row * SEQ + col)) = v; });
        }
      }
      for (int q = (bid + G - ((NQ + NK + NV) % G)) % G; q < NPE; q += G) {
        const int t = opaque_tid();
        const int lane = t & 63, w = t >> 6, r = lane & 31, h = lane >> 5;
        const int wm = w >> 1, wn = w & 1;
        (void)lane; (void)r; (void)h; (void)wm; (void)wn;
        const int tok = q * 256 + t;
        const u16* src = Z + (size_t)tok * ZLD + Z_KPE;
        float v[32];
#pragma unroll
        for (int j = 0; j < 4; ++j) {
          uint4 u = *(const uint4*)(src + j * 8);
          unsigned uu[4] = {u.x, u.y, u.z, u.w};
#pragma unroll
          for (int k = 0; k < 4; ++k) { v[j * 8 + 2 * k] = bflo(uu[k]); v[j * 8 + 2 * k + 1] = bfhi(uu[k]); }
        }
        float o[32];
#pragma unroll
        for (int i = 0; i < 16; ++i) {
          const float cs = ropec[tok * 16 + i], sn = ropes[tok * 16 + i];
          o[i] = v[i] * cs - v[i + 16] * sn;
          o[i + 16] = v[i + 16] * cs + v[i] * sn;
        }
#pragma unroll
        for (int j = 0; j < 4; ++j) {
          uint4 u;
          u.x = pk2(o[j * 8 + 0], o[j * 8 + 1]); u.y = pk2(o[j * 8 + 2], o[j * 8 + 3]);
          u.z = pk2(o[j * 8 + 4], o[j * 8 + 5]); u.w = pk2(o[j * 8 + 6], o[j * 8 + 7]);
          *(uint4*)(KPE + (size_t)tok * 32 + j * 8) = u;
        }
      }
    }
  };

  auto attn_phase = [&](bool do_scan) __attribute__((always_inline)) {
    const int t = opaque_tid();
    const int lane = t & 63, w = t >> 6, r = lane & 31, h = lane >> 5;
    const int wm = w >> 1, wn = w & 1;
    (void)lane; (void)r; (void)h; (void)wm; (void)wn;
    if (do_scan) for (int id = bid; id < 512; id += G) {
      const int e = id * 256 + t;
      const int d2 = e & 63, v = (e >> 6) & 255, dir = (e >> 14) & 1, hd = e >> 15;
      float s0 = 0.f, s1 = 0.f;
      const size_t eoff = (size_t)v * 128 + 2 * d2;
      for (int i0 = 0; i0 < NCHUNK; i0 += 16) {
        unsigned uu[16];
        float2 dd[16];
#pragma unroll
        for (int j = 0; j < 16; ++j) {
          const int n = dir ? (NCHUNK - 1 - (i0 + j)) : (i0 + j);
          const size_t base = ((size_t)(n * 4 + hd) * 2 + dir);
          uu[j] = *(const unsigned*)(ST + base * 32768 + eoff);
          dd[j] = *(const float2*)(DEC + base * 128 + 2 * d2);
        }
#pragma unroll
        for (int j = 0; j < 16; ++j) {
          const int n = dir ? (NCHUNK - 1 - (i0 + j)) : (i0 + j);
          const size_t base = ((size_t)(n * 4 + hd) * 2 + dir);
          *(unsigned*)(ST + base * 32768 + eoff) = pk2(s0, s1);
          s0 = dd[j].x * s0 + bflo(uu[j]);
          s1 = dd[j].y * s1 + bfhi(uu[j]);
        }
      }
    }
    constexpr int KROW = 104;
    constexpr int ABUF = 64 * KROW + 64 * LROW;
    u16* sK = smem;
    u16* sV = smem + 64 * KROW;
    for (int id = bid; id < 8 * 64; id += G) {
      const int hd = id & 7, qb = id >> 3;
      const int q0 = qb * 256 + w * 64;
      bf16x8 bq[2][6];
#pragma unroll
      for (int qt = 0; qt < 2; ++qt)
#pragma unroll
        for (int ks = 0; ks < 6; ++ks) bq[qt][ks] = *(const bf16x8*)(Qb + (size_t)(q0 + qt * 32 + r) * 768 + hd * 96 + ks * 16 + h * 8);
      f32x16 O[2][2];
#pragma unroll
      for (int j = 0; j < 2; ++j)
#pragma unroll
        for (int qt = 0; qt < 2; ++qt)
#pragma unroll
          for (int k = 0; k < 16; ++k) O[j][qt][k] = 0.f;
      float m[2] = {0.f, 0.f}, lsum[2] = {0.f, 0.f};
      const int kr = t >> 2, kc = t & 3;
      const u16* knp = KN + (size_t)kr * 512 + hd * 64 + kc * 16;
      const u16* kpp = KPE + (size_t)kr * 32 + kc * 8;
      const u16* vpp = VT + (size_t)(hd * 64 + kr) * SEQ + kc * 16;
      u32x4 rk[3], rv[2];
      rk[0] = *(const u32x4*)(knp);
      rk[1] = *(const u32x4*)(knp + 8);
      rk[2] = *(const u32x4*)(kpp);
      rv[0] = *(const u32x4*)(vpp);
      rv[1] = *(const u32x4*)(vpp + 8);
      __syncthreads();
      *(u32x4*)(sK + kr * KROW + kc * 16) = rk[0];
      *(u32x4*)(sK + kr * KROW + kc * 16 + 8) = rk[1];
      *(u32x4*)(sK + kr * KROW + 64 + kc * 8) = rk[2];
      *(u32x4*)(sV + kr * LROW + kc * 16) = rv[0];
      *(u32x4*)(sV + kr * LROW + kc * 16 + 8) = rv[1];
      rk[0] = *(const u32x4*)(knp + (size_t)64 * 512);
      rk[1] = *(const u32x4*)(knp + (size_t)64 * 512 + 8);
      rk[2] = *(const u32x4*)(kpp + (size_t)64 * 32);
      rv[0] = *(const u32x4*)(vpp + 64);
      rv[1] = *(const u32x4*)(vpp + 64 + 8);
      __syncthreads();
      int cur = 0;
      for (int key0 = 0; key0 < SEQ; key0 += 64) {
        const u16* cK = sK + cur * ABUF;
        const u16* cV = sV + cur * ABUF;
        {
          u16* nK = sK + (cur ^ 1) * ABUF;
          u16* nV = sV + (cur ^ 1) * ABUF;
          *(u32x4*)(nK + kr * KROW + kc * 16) = rk[0];
          *(u32x4*)(nK + kr * KROW + kc * 16 + 8) = rk[1];
          *(u32x4*)(nK + kr * KROW + 64 + kc * 8) = rk[2];
          *(u32x4*)(nV + kr * LROW + kc * 16) = rv[0];
          *(u32x4*)(nV + kr * LROW + kc * 16 + 8) = rv[1];
          const int kn = (key0 + 128 < SEQ) ? (key0 + 128) : key0;
          rk[0] = *(const u32x4*)(knp + (size_t)kn * 512);
          rk[1] = *(const u32x4*)(knp + (size_t)kn * 512 + 8);
          rk[2] = *(const u32x4*)(kpp + (size_t)kn * 32);
          rv[0] = *(const u32x4*)(vpp + kn);
          rv[1] = *(const u32x4*)(vpp + kn + 8);
        }
        __builtin_amdgcn_sched_barrier(0);
        f32x16 S[2][2];
#pragma unroll
        for (int kt = 0; kt < 2; ++kt)
#pragma unroll
          for (int qt = 0; qt < 2; ++qt)
#pragma unroll
            for (int k = 0; k < 16; ++k) S[kt][qt][k] = -m[qt];
#pragma unroll
        for (int ks = 0; ks < 6; ++ks)
#pragma unroll
          for (int kt = 0; kt < 2; ++kt) {
            bf16x8 fa = *(const bf16x8*)(cK + (kt * 32 + r) * KROW + ks * 16 + h * 8);
            S[kt][0] = MFMA(fa, bq[0][ks], S[kt][0]);
            S[kt][1] = MFMA(fa, bq[1][ks], S[kt][1]);
          }
        bf16x8 pf[2][4];
#pragma unroll
        for (int qt = 0; qt < 2; ++qt) {
          float mloc = S[0][qt][0];
#pragma unroll
          for (int kt = 0; kt < 2; ++kt)
#pragma unroll
            for (int k = 0; k < 16; ++k) mloc = fmaxf(mloc, S[kt][qt][k]);
          mloc = fmaxf(mloc, __shfl_xor(mloc, 32));
          if (__builtin_amdgcn_ballot_w64(mloc > 0.f) != 0ull) {
            const float delta = fmaxf(mloc, 0.f);
            const float alpha = __builtin_amdgcn_exp2f(-delta);
            m[qt] += delta;
            lsum[qt] *= alpha;
#pragma unroll
            for (int j = 0; j < 2; ++j)
#pragma unroll
              for (int k = 0; k < 16; ++k) O[j][qt][k] *= alpha;
#pragma unroll
            for (int kt = 0; kt < 2; ++kt)
#pragma unroll
              for (int k = 0; k < 16; ++k) S[kt][qt][k] -= delta;
          }
          float ps = 0.f;
#pragma unroll
          for (int kt = 0; kt < 2; ++kt)
#pragma unroll
            for (int k = 0; k < 16; ++k) { S[kt][qt][k] = __builtin_amdgcn_exp2f(S[kt][qt][k]); ps += S[kt][qt][k]; }
          lsum[qt] += ps;
#pragma unroll
          for (int s2 = 0; s2 < 4; ++s2) {
            const int kt = s2 >> 1, sx = s2 & 1;
            unsigned pw[4];
#pragma unroll
            for (int j = 0; j < 4; ++j) pw[j] = pk2(S[kt][qt][8 * sx + 2 * j], S[kt][qt][8 * sx + 2 * j + 1]);
            pf[qt][s2] = __builtin_bit_cast(bf16x8, make_uint4(pw[0], pw[1], pw[2], pw[3]));
          }
        }
#pragma unroll
        for (int s2 = 0; s2 < 4; ++s2) {
          const int kt = s2 >> 1, sx = s2 & 1;
#pragma unroll
          for (int dt = 0; dt < 2; ++dt) {
            const u16* vp = cV + (dt * 32 + r) * LROW + kt * 32 + 16 * sx + 4 * h;
            uint2 lo = *(const uint2*)(vp);
            uint2 hi = *(const uint2*)(vp + 8);
            bf16x8 fv = __builtin_bit_cast(bf16x8, make_uint4(lo.x, lo.y, hi.x, hi.y));
            O[dt][0] = MFMA(fv, pf[0][s2], O[dt][0]);
            O[dt][1] = MFMA(fv, pf[1][s2], O[dt][1]);
          }
        }
        cur ^= 1;
        __syncthreads();
      }
#pragma unroll
      for (int qt = 0; qt < 2; ++qt) {
        const float lt = lsum[qt] + __shfl_xor(lsum[qt], 32);
        const float inv = 1.f / lt;
#pragma unroll
        for (int dt = 0; dt < 2; ++dt)
#pragma unroll
          for (int g4 = 0; g4 < 4; ++g4) {
            uint2 o;
            o.x = pk2(O[dt][qt][4 * g4 + 0] * inv, O[dt][qt][4 * g4 + 1] * inv);
            o.y = pk2(O[dt][qt][4 * g4 + 2] * inv, O[dt][qt][4 * g4 + 3] * inv);
            *(uint2*)(OA + (size_t)(q0 + qt * 32 + r) * 512 + hd * 64 + dt * 32 + 8 * g4 + 4 * h) = o;
          }
      }
    }
  };

  auto gla_out_phase = [&](int l) __attribute__((always_inline)) {
    const int t = opaque_tid();
    const int lane = t & 63, w = t >> 6, r = lane & 31, h = lane >> 5;
    const int wm = w >> 1, wn = w & 1;
    (void)lane; (void)r; (void)h; (void)wm; (void)wn;
    constexpr int QROW = 136;
    u16* sQ = smem;
    u16* sKt = smem + 64 * QROW;
    u16* sVT = smem + 2 * 64 * QROW;
    float* sred = (float*)(smem + 2 * 64 * QROW + 256 * LROW);
    u16* sO = smem;
    constexpr int OROW = 264;
    const float qs = 0.08838834764831845f;
    const int cs = w & 1, vh = w >> 1;
    for (int id = bid; id < NCHUNK * 4; id += G) {
      const int n = id >> 2, hd = id & 3;
      const int t0 = n * 64;
      __syncthreads();
      {
        const int cc = t & 63, part = t >> 6;
#pragma unroll
        for (int q = 0; q < 8; ++q) {
          const int cg8 = (part * 8 + q) * 8;
          uint4 v = *(const uint4*)(Z + (size_t)(t0 + cc) * ZLD + Z_GV + hd * 256 + cg8);
          unsigned u[4] = {v.x, v.y, v.z, v.w};
#pragma unroll
          for (int j = 0; j < 4; ++j) {
            sVT[(cg8 + 2 * j) * LROW + cc] = (u16)(u[j] & 0xffffu);
            sVT[(cg8 + 2 * j + 1) * LROW + cc] = (u16)(u[j] >> 16);
          }
        }
      }
      f32x16 acc[4];
#pragma unroll
      for (int j = 0; j < 4; ++j)
#pragma unroll
        for (int k = 0; k < 16; ++k) acc[j][k] = 0.f;
      for (int dir = 0; dir < 2; ++dir) {
        __syncthreads();
        {
          const int cc = t >> 2, dp = (t & 3) * 32;
          const u16* qp = Z + (size_t)(t0 + cc) * ZLD + Z_GQ + hd * 128 + dp;
          const u16* kp = Z + (size_t)(t0 + cc) * ZLD + Z_GK + hd * 128 + dp;
          const float* gp = GC + (size_t)dir * SEQ * 512 + (size_t)(t0 + cc) * 512 + hd * 128 + dp;
#pragma unroll
          for (int j = 0; j < 4; ++j) {
            uint4 qv = *(const uint4*)(qp + j * 8);
            uint4 kv = *(const uint4*)(kp + j * 8);
            float4 g0 = *(const float4*)(gp + j * 8);
            float4 g1 = *(const float4*)(gp + j * 8 + 4);
            const float gg[8] = {g0.x, g0.y, g0.z, g0.w, g1.x, g1.y, g1.z, g1.w};
            const unsigned qu[4] = {qv.x, qv.y, qv.z, qv.w};
            const unsigned ku[4] = {kv.x, kv.y, kv.z, kv.w};
            unsigned qo[4], ko[4];
#pragma unroll
            for (int k = 0; k < 4; ++k) {
              const float e0 = __expf(gg[2 * k]), e1 = __expf(gg[2 * k + 1]);
              qo[k] = pk2(bflo(qu[k]) * qs * e0, bfhi(qu[k]) * qs * e1);
              ko[k] = pk2(bflo(ku[k]) / e0, bfhi(ku[k]) / e1);
            }
            *(uint4*)(sQ + cc * QROW + dp + j * 8) = make_uint4(qo[0], qo[1], qo[2], qo[3]);
            *(uint4*)(sKt + cc * QROW + dp + j * 8) = make_uint4(ko[0], ko[1], ko[2], ko[3]);
            if (j == 1) __builtin_amdgcn_sched_barrier(0);
          }
        }
        __syncthreads();
        const u16* bqp = sQ + (cs * 32 + r) * QROW + h * 8;
        const u16* stp = ST + ((size_t)(n * 4 + hd) * 2 + dir) * 32768;
        bf16x8 fs[2][4];
#pragma unroll
        for (int ks = 0; ks < 4; ++ks) fs[0][ks] = *(const bf16x8*)(stp + (size_t)(vh * 128 + r) * 128 + ks * 16 + h * 8);
        f32x16 at[2];
#pragma unroll
        for (int et = 0; et < 2; ++et) {
#pragma unroll
          for (int k = 0; k < 16; ++k) at[et][k] = 0.f;
#pragma unroll
          for (int ks = 0; ks < 8; ++ks) {
            bf16x8 fa = *(const bf16x8*)(sKt + (et * 32 + r) * QROW + ks * 16 + h * 8);
            bf16x8 fbq = *(const bf16x8*)(bqp + ks * 16);
            at[et] = MFMA(fa, fbq, at[et]);
          }
          const int cidx = cs * 32 + r;
#pragma unroll
          for (int k = 0; k < 16; ++k) {
            const int e = et * 32 + crow(k, h);
            const bool keep = dir ? (e >= cidx) : (e <= cidx);
            at[et][k] = keep ? at[et][k] : 0.f;
          }
        }
#pragma unroll
        for (int s2 = 0; s2 < 4; ++s2) {
          const int et = s2 >> 1, s = s2 & 1;
          unsigned pw[4];
#pragma unroll
          for (int j = 0; j < 4; ++j) pw[j] = pk2(at[et][8 * s + 2 * j], at[et][8 * s + 2 * j + 1]);
          bf16x8 pf = __builtin_bit_cast(bf16x8, make_uint4(pw[0], pw[1], pw[2], pw[3]));
#pragma unroll
          for (int mt = 0; mt < 4; ++mt) {
            const u16* vp = sVT + (vh * 128 + mt * 32 + r) * LROW + et * 32 + 16 * s + 4 * h;
            uint2 lo = *(const uint2*)(vp);
            uint2 hi = *(const uint2*)(vp + 8);
            bf16x8 fv = __builtin_bit_cast(bf16x8, make_uint4(lo.x, lo.y, hi.x, hi.y));
            acc[mt] = MFMA(fv, pf, acc[mt]);
          }
        }
#pragma unroll
        for (int bb = 0; bb < 8; ++bb) {
          const int mt = bb >> 1, kb = bb & 1;
          if (bb + 1 < 8) {
            const int mt1 = (bb + 1) >> 1, kb1 = (bb + 1) & 1;
#pragma unroll
            for (int ks = 0; ks < 4; ++ks) fs[(bb + 1) & 1][ks] = *(const bf16x8*)(stp + (size_t)(vh * 128 + mt1 * 32 + r) * 128 + (kb1 * 4 + ks) * 16 + h * 8);
          }
          __builtin_amdgcn_sched_barrier(0);
#pragma unroll
          for (int ks = 0; ks < 4; ++ks) { bf16x8 fbq = *(const bf16x8*)(bqp + (kb * 4 + ks) * 16); acc[mt] = MFMA(fs[bb & 1][ks], fbq, acc[mt]); }
          __builtin_amdgcn_sched_barrier(0);
        }
      }
      float ss = 0.f;
#pragma unroll
      for (int mt = 0; mt < 4; ++mt)
#pragma unroll
        for (int k = 0; k < 16; ++k) ss += acc[mt][k] * acc[mt][k];
      ss += __shfl_xor(ss, 32);
      if (h == 0) sred[vh * 64 + cs * 32 + r] = ss;
      __syncthreads();
      const float rs = rsqrtf((sred[cs * 32 + r] + sred[64 + cs * 32 + r]) * (1.f / 256.f) + EPS);
#pragma unroll
      for (int mt = 0; mt < 4; ++mt)
#pragma unroll
        for (int g4 = 0; g4 < 4; ++g4) {
          uint2 o;
          o.x = pk2(acc[mt][4 * g4 + 0] * rs, acc[mt][4 * g4 + 1] * rs);
          o.y = pk2(acc[mt][4 * g4 + 2] * rs, acc[mt][4 * g4 + 3] * rs);
          *(uint2*)(sO + (cs * 32 + r) * OROW + vh * 128 + mt * 32 + 8 * g4 + 4 * h) = o;
        }
      __syncthreads();
      {
        const int t3 = opaque_tid();
        const int cc = t3 >> 2, vp0 = (t3 & 3) * 64;
        const float* ng = in_ptr(p, 17) + (size_t)l * 256;
#pragma unroll
        for (int j = 0; j < 8; ++j) {
          const int v0 = vp0 + j * 8;
          uint4 ov = *(const uint4*)(sO + cc * OROW + v0);
          uint4 gv = *(const uint4*)(Z + (size_t)(t0 + cc) * ZLD + Z_GOG + hd * 256 + v0);
          float4 n0 = *(const float4*)(ng + v0), n1 = *(const float4*)(ng + v0 + 4);
          const float nn[8] = {n0.x, n0.y, n0.z, n0.w, n1.x, n1.y, n1.z, n1.w};
          const unsigned ou[4] = {ov.x, ov.y, ov.z, ov.w};
          const unsigned gu[4] = {gv.x, gv.y, gv.z, gv.w};
          unsigned res[4];
#pragma unroll
          for (int k = 0; k < 4; ++k)
            res[k] = pk2(bflo(ou[k]) * nn[2 * k] * siluf_(bflo(gu[k])), bfhi(ou[k]) * nn[2 * k + 1] * siluf_(bfhi(gu[k])));
          *(uint4*)(OG + (size_t)(t0 + cc) * DM + hd * 256 + v0) = make_uint4(res[0], res[1], res[2], res[3]);
        }
      }
    }
  };

  auto merge_phase = [&]() __attribute__((always_inline)) {
    const int t = opaque_tid();
    const int lane = t & 63, w = t >> 6, r = lane & 31, h = lane >> 5;
    const int wm = w >> 1, wn = w & 1;
    (void)lane; (void)r; (void)h; (void)wm; (void)wn;
    const int MT = SEQ / 256, NT = DM / 128;
    for (int id = bid; id < MT * NT; id += G) {
      int tm, tn; tile_coords(id, MT, NT, tm, tn);
      const int m0 = tm * 256, n0 = tn * 128;
      Acc c; acc_zero(c);
      gemm_kloop(OA + (size_t)m0 * 512, 512, Wb + W_OA + (size_t)n0 * 512, 512, 512, smem, c);
      {
        const unsigned zbase = (unsigned)((m0 + wm * 128) * ZLD + Z_BG + n0 + wn * 64);
        const unsigned obase = (unsigned)((m0 + wm * 128) * DM + n0 + wn * 64);
        epi_store<2>(smem,
          [&](int mi, int ni, int i) { return c.a[mi][ni][i]; },
          [&](int row, int col, u32x4 v) {
            const u32x4 g = *(const u32x4*)(Z + zbase + (unsigned)(row * ZLD + col));
            u32x4 o;
#pragma unroll
            for (int k = 0; k < 4; ++k) o[k] = pk2(bflo(v[k]) * sigmoidf_(bflo(g[k])), bfhi(v[k]) * sigmoidf_(bfhi(g[k])));
            *(u32x4*)(MG + obase + (unsigned)(row * DM + col)) = o;
          });
      }
      acc_zero(c);
      gemm_kloop(OG + (size_t)m0 * DM, DM, Wb + W_OB + (size_t)n0 * DM, DM, DM, smem, c);
      {
        const int t2 = opaque_tid();
        const int wm2 = t2 >> 7, wn2 = (t2 >> 6) & 1;
        const unsigned zbase = (unsigned)((m0 + wm2 * 128) * ZLD + Z_BG + DM + n0 + wn2 * 64);
        const unsigned obase = (unsigned)((m0 + wm2 * 128) * DM + n0 + wn2 * 64);
        epi_store<2>(smem,
          [&](int mi, int ni, int i) { return c.a[mi][ni][i]; },
          [&](int row, int col, u32x4 v) {
            const u32x4 g = *(const u32x4*)(Z + zbase + (unsigned)(row * ZLD + col));
            const u32x4 pm = *(const u32x4*)(MG + obase + (unsigned)(row * DM + col));
            u32x4 o;
#pragma unroll
            for (int k = 0; k < 4; ++k)
              o[k] = pk2(bflo(pm[k]) + bflo(v[k]) * sigmoidf_(bflo(g[k])), bfhi(pm[k]) + bfhi(v[k]) * sigmoidf_(bfhi(g[k])));
            *(u32x4*)(MG + obase + (unsigned)(row * DM + col)) = o;
          });
      }
    }
  };

  for (int i = bid * 256 + opaque_tid(); i < SEQ * 16; i += G * 256) {
    const int pos = i >> 4, j = i & 15;
    const float inv_freq = exp2f(-(float)j * 0.8304820237218406f);
    const float angf = (float)pos * inv_freq;
    double a = (double)angf;
    const double twopi = 6.283185307179586476925286766559;
    a -= twopi * rint(a / twopi);
    const float af = (float)a;
    ropec[i] = __cosf(af);
    ropes[i] = __sinf(af);
  }
  convert_weights(0);
  rn_pass(0, 0.f, nullptr, in_ptr(p, 2));
  grid.sync();

  for (int l = 0; l < 4; ++l) {
    ffn_in(W_FFN1_IN);
#ifdef DUP_FFNIN
    xcd_barrier(xb);
    ffn_in(W_FFN1_IN);
#endif
    xcd_barrier(xb);
    gemm_plain(ACT, DFF, DFF, Wb + W_FFN1_OUT, Yb, DM, MALL, DM);
    xcd_barrier(xb);
    rn_pass(1, 0.5f, in_ptr(p, 5) + l * DM, in_ptr(p, 6) + l * DM);
    xcd_barrier(xb);
    for (int s = 0; s < NSEQ; ++s) {
      gemm_plain(Hb + (size_t)s * SEQ * DM, DM, DM, Wb + W_IN, Z, ZLD, SEQ, ZLD);
      xcd_barrier(xb);
      prep_phase(l);
#ifdef DUP_PREP
      xcd_barrier(xb);
      prep_phase(l);
#endif
      xcd_barrier(xb);
      attn_phase(true);
#ifdef DUP_ATTN
      xcd_barrier(xb);
      attn_phase(false);
#endif
      xcd_barrier(xb);
      gla_out_phase(l);
#ifdef DUP_GLAOUT
      xcd_barrier(xb);
      gla_out_phase(l);
#endif
      xcd_barrier(xb);
      merge_phase();
      xcd_barrier(xb);
      gemm_plain(MG, DM, DM, Wb + W_OUT, Yb + (size_t)s * SEQ * DM, DM, SEQ, DM);
      xcd_barrier(xb);
    }
    rn_pass(1, 1.0f, in_ptr(p, 20) + l * DM, in_ptr(p, 21) + l * DM);
    xcd_barrier(xb);
    ffn_in(W_FFN2_IN);
    xcd_barrier(xb);
    gemm_plain(ACT, DFF, DFF, Wb + W_FFN2_OUT, Yb, DM, MALL, DM);
    xcd_barrier(xb);
    rn_pass(1, 0.5f, in_ptr(p, 24) + l * DM, (l < 3) ? (in_ptr(p, 2) + (l + 1) * DM) : nullptr);
    if (l < 3) convert_weights(l + 1);
    xcd_barrier(xb);
  }
}

extern "C" void kernel_launch(void* const* d_in, const int* in_sizes, int n_in, void* d_out,
                              int out_size, void* d_ws, size_t ws_size, hipStream_t stream) {
  static int grid_blocks = 0;
  if (!grid_blocks) {
    int dev = 0, cus = 0, per_cu = 0;
    (void)hipGetDevice(&dev);
    (void)hipDeviceGetAttribute(&cus, hipDeviceAttributeMultiprocessorCount, dev);
    (void)hipOccupancyMaxActiveBlocksPerMultiprocessor(&per_cu, fwd_megakernel, 256, 0);
    if (per_cu > 2) per_cu = 2;
    if (per_cu < 1) per_cu = 1;
    grid_blocks = cus * per_cu;
  }
  Params p{};
  for (int i = 0; i < 25; ++i) p.in[i] = (const float*)d_in[i];
  p.out = (float*)d_out;
  p.ws = (char*)d_ws;
  (void)hipMemsetAsync((char*)d_ws + OFF_BAR, 0, XCD_BAR_WORDS * 4, stream);
  void* args[] = {&p};
  hipError_t e = hipLaunchCooperativeKernel((void*)fwd_megakernel, dim3(grid_blocks), dim3(256), args, 0, stream);
  if (e != hipSuccess) fprintf(stderr, "cooperative launch failed: %s (grid %d)\n", hipGetErrorString(e), grid_blocks);
}
```

```cpp
#include <hip/hip_runtime.h>
#include <hip/hip_cooperative_groups.h>
#include <cstdio>
namespace cg = cooperative_groups;

typedef unsigned short u16;
typedef short bf16x8 __attribute__((ext_vector_type(8)));
typedef short s16x4 __attribute__((ext_vector_type(4)));
typedef float f32x16 __attribute__((ext_vector_type(16)));
typedef __bf16 bf2_t __attribute__((ext_vector_type(2)));
typedef float f2_t __attribute__((ext_vector_type(2)));
typedef unsigned u32x4 __attribute__((ext_vector_type(4)));
#define DI __device__ __forceinline__
#define MFMA(a, b, c) __builtin_amdgcn_mfma_f32_32x32x16_bf16((a), (b), (c), 0, 0, 0)

constexpr int SEQ = 16384;
constexpr int NSEQ = 3;
constexpr int MALL = SEQ * NSEQ;
constexpr int DM = 1024;
constexpr int DFF = 2816;
constexpr int NFF2 = 5632;
constexpr int PIN = 5568;
constexpr int ZLD = 5632;
constexpr int Z_CQ = 0, Z_CKV = 256, Z_KPE = 384, Z_GQ = 416, Z_GK = 928, Z_GV = 1440, Z_GA = 2464, Z_GOG = 2496, Z_BG = 3520;
constexpr float EPS = 1e-6f;
constexpr int NCHUNK = SEQ / 64;

constexpr size_t W_FFN1_IN = 0;
constexpr size_t W_FFN1_OUT = W_FFN1_IN + (size_t)NFF2 * DM;
constexpr size_t W_IN = W_FFN1_OUT + (size_t)DM * DFF;
constexpr size_t W_UQ = W_IN + (size_t)ZLD * DM;
constexpr size_t W_KN = W_UQ + (size_t)768 * 256;
constexpr size_t W_V = W_KN + (size_t)512 * 128;
constexpr size_t W_OA = W_V + (size_t)512 * 128;
constexpr size_t W_OB = W_OA + (size_t)DM * 512;
constexpr size_t W_OUT = W_OB + (size_t)DM * DM;
constexpr size_t W_FFN2_IN = W_OUT + (size_t)DM * DM;
constexpr size_t W_FFN2_OUT = W_FFN2_IN + (size_t)NFF2 * DM;
constexpr size_t W_END = W_FFN2_OUT + (size_t)DM * DFF;

constexpr size_t al256(size_t x) { return (x + 255) & ~(size_t)255; }
constexpr size_t OFF_WB = 0;
constexpr size_t OFF_ROPE = al256(OFF_WB + W_END * 2);
constexpr size_t OFF_H = al256(OFF_ROPE + (size_t)SEQ * 32 * 4);
constexpr size_t OFF_Y = al256(OFF_H + (size_t)MALL * DM * 2);
constexpr size_t OFF_ACT = al256(OFF_Y + (size_t)MALL * DM * 2);
constexpr size_t OFF_Z = OFF_ACT;
constexpr size_t OFF_Q = al256(OFF_Z + (size_t)SEQ * ZLD * 2);
constexpr size_t OFF_KN = al256(OFF_Q + (size_t)SEQ * 768 * 2);
constexpr size_t OFF_VT = al256(OFF_KN + (size_t)SEQ * 512 * 2);
constexpr size_t OFF_KPE = al256(OFF_VT + (size_t)SEQ * 512 * 2);
constexpr size_t OFF_OA = al256(OFF_KPE + (size_t)SEQ * 32 * 2);
constexpr size_t OFF_MIXEND = al256(OFF_OA + (size_t)SEQ * 512 * 2);
constexpr size_t OFF_ACTEND = al256(OFF_ACT + (size_t)MALL * DFF * 2);
static_assert(OFF_MIXEND <= OFF_ACTEND, "mixer scratch must fit in act");
constexpr size_t OFF_ST = OFF_ACTEND;
constexpr size_t OFF_DEC = al256(OFF_ST + (size_t)NCHUNK * 4 * 2 * 256 * 128 * 2);
constexpr size_t OFF_GC = al256(OFF_DEC + (size_t)NCHUNK * 4 * 2 * 128 * 4);
constexpr size_t OFF_OG = al256(OFF_GC + (size_t)2 * SEQ * 512 * 4);
constexpr size_t OFF_MG = al256(OFF_OG + (size_t)SEQ * DM * 2);
constexpr size_t OFF_END = al256(OFF_MG + (size_t)SEQ * DM * 2);
constexpr size_t OFF_BAR = OFF_END;
static_assert(OFF_BAR + 16384 <= (size_t)768 * 1024 * 1024, "workspace overflow");

struct Params {
  const float* in[25];
  float* out;
  char* ws;
};

DI unsigned pk2(float a, float b) { f2_t v = {a, b}; return __builtin_bit_cast(unsigned, __builtin_convertvector(v, bf2_t)); }
DI u16 f2bf(float a) { return (u16)(pk2(a, 0.f) & 0xffffu); }
DI float bf2f(u16 v) { return __uint_as_float(((unsigned)v) << 16); }
DI float bflo(unsigned v) { return __uint_as_float(v << 16); }
DI float bfhi(unsigned v) { return __uint_as_float(v & 0xffff0000u); }
DI float wave_sum(float v) {
#pragma unroll
  for (int o = 32; o >= 1; o >>= 1) v += __shfl_xor(v, o);
  return v;
}
DI int opaque_tid() { int t = threadIdx.x; asm volatile("" : "+v"(t)); return t; }
DI const float* in_ptr(const Params& p, int k) { asm volatile("" : "+s"(k)); return p.in[k]; }
DI int crow(int i, int h) { return (i & 3) + 8 * (i >> 2) + 4 * h; }
DI float sigmoidf_(float x) { return 1.f / (1.f + __expf(-x)); }
DI float siluf_(float x) { return x / (1.f + __expf(-x)); }


#define XB_TMO      128
#define XB_XCNT(j)  (256  + 64 * (j))
#define XB_XSUB(j)  (1280 + 64 * (j))
#define XB_XGEN(j)  (2304 + 64 * (j))
#define XB_TOP      3328
#define XB_TOPGEN   3392
#define XCD_BAR_WORDS 3456
#define XB_SPIN_CAP (1u << 18)
#define LAS __attribute__((address_space(3)))

__device__ __forceinline__ unsigned xb_ld(unsigned* p)              { return __hip_atomic_load(p, __ATOMIC_RELAXED, __HIP_MEMORY_SCOPE_AGENT); }
__device__ __forceinline__ unsigned xb_add(unsigned* p, unsigned v) { return __hip_atomic_fetch_add(p, v, __ATOMIC_RELAXED, __HIP_MEMORY_SCOPE_AGENT); }
__device__ __forceinline__ unsigned xb_xcc_id() { return (unsigned)__builtin_amdgcn_s_getreg((3 << 11) | 20) & 0xFu; }
#define XB_SPIN(cond, bar) do { unsigned _sp = 0; while (cond) { __builtin_amdgcn_s_sleep(1); \
    if ((++_sp & 255u) == 0u) { if (xb_ld(&(bar)[XB_TMO])) break; if (_sp > XB_SPIN_CAP) { atomicAdd(&(bar)[XB_TMO], 1u); break; } } } } while (0)

struct XcdBarrier {
    unsigned* bar; unsigned x;
    volatile LAS unsigned* st;
};

__device__ __forceinline__ XcdBarrier xcd_barrier_post(unsigned* bar, volatile LAS unsigned* st) {
    XcdBarrier b; b.bar = bar; b.x = xb_xcc_id(); b.st = st;
    if (threadIdx.x == 0) (void)xb_add(&bar[XB_XCNT(b.x)], 1u);
    return b;
}
__device__ __forceinline__ void xcd_barrier_complete(unsigned* bar, unsigned x, unsigned& nloc, unsigned& nx) {
    const unsigned G = gridDim.x * gridDim.y * gridDim.z;
    unsigned sum, cnt, mine, sp = 0u;
    for (;;) {
        sum = 0u; cnt = 0u; mine = 0u;
#pragma unroll
        for (unsigned j = 0; j < 16; ++j) { const unsigned c = xb_ld(&bar[XB_XCNT(j)]); sum += c; cnt += (c > 0u) ? 1u : 0u; mine = (j == x) ? c : mine; }
        if (sum == G) break;
        __builtin_amdgcn_s_sleep(1);
        if ((++sp & 255u) == 0u) { if (xb_ld(&bar[XB_TMO])) break; if (sp > XB_SPIN_CAP) { atomicAdd(&bar[XB_TMO], 1u); break; } }
    }
    nloc = mine > 0u ? mine : 1u; nx = cnt > 0u ? cnt : 1u;
}

__device__ __forceinline__ void xcd_barrier(const XcdBarrier& b) {
    asm volatile("s_waitcnt vmcnt(0)" ::: "memory");
    __syncthreads();
    int tid0_ = threadIdx.x; asm volatile("" : "+v"(tid0_));
    if (tid0_ == 0) {
        unsigned* bar = b.bar; asm volatile("" : "+s"(bar));
        unsigned bx_ = b.x; asm volatile("" : "+s"(bx_));
        __builtin_amdgcn_s_waitcnt(0);
        unsigned nloc = b.st[0], nx = b.st[1];
        if (nloc == 0u) { xcd_barrier_complete(bar, bx_, nloc, nx); b.st[0] = nloc; b.st[1] = nx; }
        const unsigned old = xb_add(&bar[XB_XSUB(bx_)], 1u);
        const unsigned gen = old / nloc;
        if (old + 1u == (gen + 1u) * nloc) {
            __builtin_amdgcn_fence(__ATOMIC_RELEASE, "agent");
            asm volatile("s_waitcnt vmcnt(0)" ::: "memory");
            const unsigned og = xb_add(&bar[XB_TOP], 1u);
            const unsigned tg = og / nx;
            if (og + 1u == (tg + 1u) * nx) xb_add(&bar[XB_TOPGEN], 1u);
            else XB_SPIN(xb_ld(&bar[XB_TOPGEN]) == tg, bar);
            __builtin_amdgcn_fence(__ATOMIC_ACQUIRE, "agent");
            xb_add(&bar[XB_XGEN(bx_)], 1u);
            asm volatile("s_waitcnt vmcnt(0)" ::: "memory");
        } else {
            XB_SPIN(xb_ld(&bar[XB_XGEN(bx_)]) == gen, bar);
            __builtin_amdgcn_fence(__ATOMIC_ACQUIRE, "agent");
            asm volatile("s_waitcnt vmcnt(0)" ::: "memory");
        }
    }
    __syncthreads();
}

constexpr int LROW = 72;
constexpr int GEMM_LDS = 2 * 128 * LROW * 2;

struct Acc { f32x16 a[4][2]; };

DI void acc_zero(Acc& c) {
#pragma unroll
  for (int i = 0; i < 4; ++i)
#pragma unroll
    for (int j = 0; j < 2; ++j)
#pragma unroll
      for (int k = 0; k < 16; ++k) c.a[i][j][k] = 0.f;
}

DI void gll16(const u16* g, char* l) {
  __builtin_amdgcn_global_load_lds((const __attribute__((address_space(1))) unsigned*)g,
                                   (__attribute__((address_space(3))) unsigned*)l, 16, 0, 0);
}
DI void gemm_kloop(const u16* __restrict__ A, int lda, const u16* __restrict__ B, int ldb, int K, u16* smem, Acc& c) {
  const int t = opaque_tid();
  const int lane = t & 63, w = t >> 6, r = lane & 31, h = lane >> 5;
  const int wm = w >> 1, wn = w & 1;
  char* lds = (char*)smem;
  const int nk = K >> 5;
  const int row0 = t >> 2, c0 = t & 3;
  const int sw0 = (c0 ^ ((row0 >> 2) & 3)) * 8;
  const u16* ga0 = A + (size_t)row0 * lda + sw0;
  const u16* gb0 = B + (size_t)row0 * ldb + sw0;
  const size_t a64 = (size_t)64 * lda, b64 = (size_t)64 * ldb;
  const int loff = t * 16;
#define GEMM_ISSUE(kt_, st_)                                         \
  do {                                                               \
    const int kk_ = ((kt_) < nk ? (kt_) : (nk - 1)) * 32;            \
    char* sp_ = lds + (st_) * 24576 + loff;                          \
    gll16(ga0 + kk_, sp_);                                           \
    gll16(ga0 + a64 + kk_, sp_ + 4096);                              \
    gll16(ga0 + 2 * a64 + kk_, sp_ + 8192);                          \
    gll16(ga0 + 3 * a64 + kk_, sp_ + 12288);                         \
    gll16(gb0 + kk_, sp_ + 16384);                                   \
    gll16(gb0 + b64 + kk_, sp_ + 20480);                             \
  } while (0)
  __syncthreads();
  GEMM_ISSUE(0, 0);
  GEMM_ISSUE(1, 1);
  const int fsw = (r >> 2) & 3;
  const int aoff = (wm * 128 + r) * 64, boff = 16384 + (wn * 64 + r) * 64;
  int scur = 0, snext = 2;
  for (int kt = 0; kt < nk; ++kt) {
    asm volatile("s_waitcnt vmcnt(6)" ::: "memory");
    __builtin_amdgcn_s_barrier();
    asm volatile("" ::: "memory");
    GEMM_ISSUE(kt + 2, snext);
    __builtin_amdgcn_sched_barrier(0);
    const char* st = lds + scur * 24576;
#pragma unroll
    for (int ks = 0; ks < 2; ++ks) {
      const int q = ((ks * 2 + h) ^ fsw) * 16;
      bf16x8 fa[4], fb[2];
#pragma unroll
      for (int i = 0; i < 4; ++i) fa[i] = *(const bf16x8*)(st + aoff + i * 2048 + q);
#pragma unroll
      for (int i = 0; i < 2; ++i) fb[i] = *(const bf16x8*)(st + boff + i * 2048 + q);
#pragma unroll
      for (int i = 0; i < 4; ++i)
#pragma unroll
        for (int j = 0; j < 2; ++j) c.a[i][j] = MFMA(fa[i], fb[j], c.a[i][j]);
    }
    __builtin_amdgcn_sched_barrier(0);
    snext = scur;
    scur = (scur == 2) ? 0 : scur + 1;
  }
  asm volatile("s_waitcnt vmcnt(0)" ::: "memory");
  __builtin_amdgcn_s_barrier();
  asm volatile("" ::: "memory");
#undef GEMM_ISSUE
}

DI void row_scales(const u16* __restrict__ base, int ld, int K, float* sc, int NR) {
  const int t = opaque_tid();
  const int row = (NR == 256) ? t : (t >> 1);
  const int part = (NR == 256) ? 0 : (t & 1);
  const int len = (NR == 256) ? K : (K / 2);
  const u16* p = base + (size_t)row * ld + part * len;
  float ss = 0.f;
  for (int i = 0; i < len / 8; ++i) {
    u32x4 v = *(const u32x4*)(p + i * 8);
#pragma unroll
    for (int j = 0; j < 4; ++j) { float a = bflo(v[j]), b = bfhi(v[j]); ss += a * a + b * b; }
  }
  if (NR != 256) ss += __shfl_xor(ss, 1);
  if (part == 0) sc[row] = rsqrtf(ss / (float)K + EPS);
}


template <int NI, class V, class R>
DI void epi_store(u16* smem, V val, R rowfn) {
  const int t = opaque_tid();
  const int lane = t & 63, w = t >> 6, r = lane & 31, h = lane >> 5;
  char* reg = (char*)smem + w * 18432;
#pragma unroll
  for (int mi = 0; mi < 4; ++mi)
#pragma unroll
    for (int ni = 0; ni < NI; ++ni)
#pragma unroll
      for (int i = 0; i < 16; ++i)
        *(u16*)(reg + (mi * 32 + crow(i, h)) * 144 + (ni * 32 + r) * 2) = f2bf(val(mi, ni, i));
  __builtin_amdgcn_sched_barrier(0);
  constexpr int CPR = NI * 4;
  constexpr int RPI = 64 / CPR;
  const int rr = lane / CPR, ch = lane % CPR;
#pragma unroll
  for (int k = 0; k < 128 / RPI; ++k) {
    const int row = k * RPI + rr;
    u32x4 v = *(const u32x4*)(reg + row * 144 + ch * 16);
    rowfn(row, ch * 8, v);
  }
}

DI void tile_coords(int id, int MT, int NT, int& tm, int& tn) {
  const int per = 32 * NT;
  const int sr = id / per, rem = id - sr * per;
  tn = rem >> 5;
  tm = sr * 32 + (rem & 31);
}

#define EPI_LOOP                                   \
  _Pragma("unroll") for (int mi = 0; mi < 4; ++mi) \
  _Pragma("unroll") for (int ni = 0; ni < 2; ++ni) \
  _Pragma("unroll") for (int i = (__builtin_amdgcn_sched_barrier(0), 0); i < 16; ++i)

constexpr int SMEM_BYTES = 74752;

__global__ void __launch_bounds__(256, 2) fwd_megakernel(Params p) {
  cg::grid_group grid = cg::this_grid();
  __shared__ __attribute__((aligned(16))) char smem_raw[SMEM_BYTES];
  u16* smem = (u16*)smem_raw;
  const int G = gridDim.x, bid = blockIdx.x;
  __shared__ uint4 xb_words;
  if (threadIdx.x == 0) xb_words = make_uint4(0u, 0u, 0u, 0u);
  __syncthreads();
  XcdBarrier xb = xcd_barrier_post((unsigned*)(p.ws + OFF_BAR), (volatile LAS unsigned*)&xb_words);

  char* ws = p.ws;
#define Wb ((u16*)(ws + OFF_WB))
#define ropec ((float*)(ws + OFF_ROPE))
#define ropes (((float*)(ws + OFF_ROPE)) + SEQ * 16)
#define Hb ((u16*)(ws + OFF_H))
#define Yb ((u16*)(ws + OFF_Y))
#define ACT ((u16*)(ws + OFF_ACT))
#define Z ((u16*)(ws + OFF_Z))
#define Qb ((u16*)(ws + OFF_Q))
#define KN ((u16*)(ws + OFF_KN))
#define VT ((u16*)(ws + OFF_VT))
#define KPE ((u16*)(ws + OFF_KPE))
#define OA ((u16*)(ws + OFF_OA))
#define ST ((u16*)(ws + OFF_ST))
#define DEC ((float*)(ws + OFF_DEC))
#define GC ((float*)(ws + OFF_GC))
#define OG ((u16*)(ws + OFF_OG))
#define MG ((u16*)(ws + OFF_MG))
  float* X = p.out;

  auto convert_weights = [&](int l) __attribute__((always_inline)) {
    const int t = opaque_tid();
    const int lane = t & 63, w = t >> 6, r = lane & 31, h = lane >> 5;
    const int wm = w >> 1, wn = w & 1;
    (void)lane; (void)r; (void)h; (void)wm; (void)wn;
    float* tile = (float*)smem_raw;
    for (int mat = 0; mat < 11; ++mat) {
      const float* src; int K, N; size_t dst; int map; const float* ksc = nullptr;
      switch (mat) {
        case 0: src = in_ptr(p, 3) + (size_t)l * DM * NFF2; K = DM; N = NFF2; dst = W_FFN1_IN; map = 1; break;
        case 1: src = in_ptr(p, 4) + (size_t)l * DFF * DM; K = DFF; N = DM; dst = W_FFN1_OUT; map = 0; break;
        case 2: src = in_ptr(p, 7) + (size_t)l * DM * PIN; K = DM; N = PIN; dst = W_IN; map = 0; break;
        case 3: src = in_ptr(p, 9) + (size_t)l * 256 * 768; K = 256; N = 768; dst = W_UQ; map = 0; ksc = in_ptr(p, 8) + l * 256; break;
        case 4: src = in_ptr(p, 11) + (size_t)l * 128 * 1024; K = 128; N = 1024; dst = W_KN; map = 2; ksc = in_ptr(p, 10) + l * 128; break;
        case 5: src = in_ptr(p, 12) + (size_t)l * 512 * DM; K = 512; N = DM; dst = W_OA; map = 0; break;
        case 6: src = in_ptr(p, 18) + (size_t)l * DM * DM; K = DM; N = DM; dst = W_OB; map = 0; break;
        case 7: src = in_ptr(p, 19) + (size_t)l * DM * DM; K = DM; N = DM; dst = W_OUT; map = 0; break;
        case 8: src = in_ptr(p, 22) + (size_t)l * DM * NFF2; K = DM; N = NFF2; dst = W_FFN2_IN; map = 1; break;
        case 9: src = in_ptr(p, 23) + (size_t)l * DFF * DM; K = DFF; N = DM; dst = W_FFN2_OUT; map = 0; break;
        default: src = nullptr; K = DM; N = 64; dst = W_IN + (size_t)PIN * DM; map = 3; break;
      }
      const int kt_n = K / 64, nt_n = N / 64;
      for (int id = bid; id < kt_n * nt_n; id += G) {
        const int kt = id % kt_n, nt = id / kt_n;
        const int k0 = kt * 64, n0 = nt * 64;
        __syncthreads();
        if (map != 3) {
#pragma unroll
          for (int i = 0; i < 4; ++i) {
            const int kk = (t >> 4) + 16 * i, nn = (t & 15) * 4;
            float4 v = *(const float4*)(src + (size_t)(k0 + kk) * N + n0 + nn);
            float sc = ksc ? ksc[k0 + kk] : 1.f;
            tile[kk * 65 + nn + 0] = v.x * sc; tile[kk * 65 + nn + 1] = v.y * sc;
            tile[kk * 65 + nn + 2] = v.z * sc; tile[kk * 65 + nn + 3] = v.w * sc;
          }
        }
        __syncthreads();
        const int nl = t >> 2, kc = (t & 3) * 16;
        const int n = n0 + nl;
        size_t drow;
        if (map == 0) drow = dst + (size_t)n * K;
        else if (map == 1) { const int isb = n >= DFF; const int j = n - isb * DFF; drow = dst + (size_t)((j >> 5) * 64 + isb * 32 + (j & 31)) * K; }
        else if (map == 2) { const int hd = n >> 7, cc = n & 127; drow = (cc < 64) ? (W_KN + (size_t)(hd * 64 + cc) * K) : (W_V + (size_t)(hd * 64 + cc - 64) * K); }
        else drow = dst + (size_t)nl * K;
        unsigned o[8];
#pragma unroll
        for (int j = 0; j < 8; ++j) {
          float a = (map == 3) ? 0.f : tile[(kc + 2 * j) * 65 + nl];
          float b = (map == 3) ? 0.f : tile[(kc + 2 * j + 1) * 65 + nl];
          o[j] = pk2(a, b);
        }
        uint4* dp = (uint4*)(Wb + drow + k0 + kc);
        dp[0] = make_uint4(o[0], o[1], o[2], o[3]);
        dp[1] = make_uint4(o[4], o[5], o[6], o[7]);
      }
    }
  };

  auto rn_pass = [&](int mode, float coef, const float* post_g, const float* pre_g) __attribute__((always_inline)) {
    const int t = opaque_tid();
    const int lane = t & 63, w = t >> 6, r = lane & 31, h = lane >> 5;
    const int wm = w >> 1, wn = w & 1;
    (void)lane; (void)r; (void)h; (void)wm; (void)wn;
    typedef float f4v __attribute__((ext_vector_type(4)));
    typedef unsigned u2v __attribute__((ext_vector_type(2)));
    const int gw = bid * 4 + w, nw = G * 4;
    constexpr int RB = 4;
    f4v pg[4], qg[4];
#pragma unroll
    for (int i = 0; i < 4; ++i) {
      pg[i] = (mode == 1) ? *(const f4v*)(post_g + lane * 4 + 256 * i) : (f4v){0.f, 0.f, 0.f, 0.f};
      qg[i] = pre_g ? *(const f4v*)(pre_g + lane * 4 + 256 * i) : (f4v){0.f, 0.f, 0.f, 0.f};
    }
    for (int row0 = gw; row0 < MALL; row0 += RB * nw) {
      f4v xv[RB][4];
      u2v yu[RB][4];
#pragma unroll
      for (int j = 0; j < RB; ++j) {
        int row = row0 + j * nw;
        if (row >= MALL) row = row0;
        const float* xs;
        if (mode == 0) xs = (row < SEQ) ? (in_ptr(p, 0) + (size_t)row * DM) : (in_ptr(p, 1) + (size_t)(row - SEQ) * DM);
        else xs = X + (size_t)row * DM;
#pragma unroll
        for (int i = 0; i < 4; ++i) xv[j][i] = *(const f4v*)(xs + lane * 4 + 256 * i);
        if (mode == 1) {
#pragma unroll
          for (int i = 0; i < 4; ++i) yu[j][i] = *(const u2v*)(Yb + (size_t)row * DM + lane * 4 + 256 * i);
        }
      }
#pragma unroll
      for (int j = 0; j < RB; ++j) {
        const int row = row0 + j * nw;
        if (row < MALL) {
          if (mode == 1) {
            float yv[16];
            float ss = 0.f;
#pragma unroll
            for (int i = 0; i < 4; ++i) {
              yv[4 * i + 0] = bflo(yu[j][i][0]); yv[4 * i + 1] = bfhi(yu[j][i][0]);
              yv[4 * i + 2] = bflo(yu[j][i][1]); yv[4 * i + 3] = bfhi(yu[j][i][1]);
            }
#pragma unroll
            for (int i = 0; i < 16; ++i) ss += yv[i] * yv[i];
            ss = wave_sum(ss);
            const float ry = rsqrtf(ss * (1.f / DM) + EPS) * coef;
#pragma unroll
            for (int i = 0; i < 4; ++i)
#pragma unroll
              for (int k = 0; k < 4; ++k) xv[j][i][k] += yv[4 * i + k] * ry * pg[i][k];
          }
#pragma unroll
          for (int i = 0; i < 4; ++i) *(f4v*)(X + (size_t)row * DM + lane * 4 + 256 * i) = xv[j][i];
          if (pre_g) {
            float ss = 0.f;
#pragma unroll
            for (int i = 0; i < 4; ++i)
#pragma unroll
              for (int k = 0; k < 4; ++k) ss += xv[j][i][k] * xv[j][i][k];
            ss = wave_sum(ss);
            const float rx = rsqrtf(ss * (1.f / DM) + EPS);
#pragma unroll
            for (int i = 0; i < 4; ++i) {
              u2v o;
              o[0] = pk2(xv[j][i][0] * rx * qg[i][0], xv[j][i][1] * rx * qg[i][1]);
              o[1] = pk2(xv[j][i][2] * rx * qg[i][2], xv[j][i][3] * rx * qg[i][3]);
              *(u2v*)(Hb + (size_t)row * DM + lane * 4 + 256 * i) = o;
            }
          }
        }
      }
    }
  };

  auto ffn_in = [&](size_t woff) __attribute__((always_inline)) {
    const int t = opaque_tid();
    const int lane = t & 63, w = t >> 6, r = lane & 31, h = lane >> 5;
    const int wm = w >> 1, wn = w & 1;
    (void)lane; (void)r; (void)h; (void)wm; (void)wn;
    const int MT = MALL / 256, NT = NFF2 / 128;
    for (int id = bid; id < MT * NT; id += G) {
      int tm, tn; tile_coords(id, MT, NT, tm, tn);
      const int m0 = tm * 256, n0 = tn * 128;
      Acc c; acc_zero(c);
      gemm_kloop(Hb + (size_t)m0 * DM, DM, Wb + woff + (size_t)n0 * DM, DM, DM, smem, c);
#ifdef DUP_KLOOP
      acc_zero(c);
      gemm_kloop(Hb + (size_t)m0 * DM, DM, Wb + woff + (size_t)n0 * DM, DM, DM, smem, c);
#endif
      const int jb0 = ((n0 + wn * 64) >> 6) * 32;
      const unsigned obase = (unsigned)((m0 + wm * 128) * DFF + jb0);
      epi_store<1>(smem,
        [&](int mi, int ni, int i) { return siluf_(c.a[mi][0][i]) * c.a[mi][1][i]; },
        [&](int row, int col, u32x4 v) { *(u32x4*)(ACT + obase + (unsigned)(row * DFF + col)) = v; });
    }
  };
  auto gemm_plain = [&](const u16* A, int lda, int K, const u16* Bt, u16* C, int ldc, int M, int N) __attribute__((always_inline)) {
    const int t = opaque_tid();
    const int lane = t & 63, w = t >> 6, r = lane & 31, h = lane >> 5;
    const int wm = w >> 1, wn = w & 1;
    (void)lane; (void)r; (void)h; (void)wm; (void)wn;
    const int MT = M / 256, NT = N / 128;
    for (int id = bid; id < MT * NT; id += G) {
      int tm, tn; tile_coords(id, MT, NT, tm, tn);
      const int m0 = tm * 256, n0 = tn * 128;
      Acc c; acc_zero(c);
      gemm_kloop(A + (size_t)m0 * lda, lda, Bt + (size_t)n0 * K, K, K, smem, c);
      const unsigned obase = (unsigned)((m0 + wm * 128) * ldc + n0 + wn * 64);
      epi_store<2>(smem,
        [&](int mi, int ni, int i) { return c.a[mi][ni][i]; },
        [&](int row, int col, u32x4 v) { *(u32x4*)(C + obase + (unsigned)(row * ldc + col)) = v; });
    }
  };

  auto prep_phase = [&](int l) __attribute__((always_inline)) {
    const int t = opaque_tid();
    const int lane = t & 63, w = t >> 6, r = lane & 31, h = lane >> 5;
    const int wm = w >> 1, wn = w & 1;
    (void)lane; (void)r; (void)h; (void)wm; (void)wn;
    float* sc = (float*)(smem_raw + 2 * GEMM_LDS);
    const int NQ = 64 * 6, NK = 64 * 4, NV = 2 * 128, NPE = 64, NG1 = NCHUNK * 4;
    const float qscale = 0.10206207261596577f * 1.4426950408889634f;
    {
      for (int id = bid; id < NG1; id += G) {
        const int t = opaque_tid();
        const int lane = t & 63, w = t >> 6, r = lane & 31, h = lane >> 5;
        const int wm = w >> 1, wn = w & 1;
        (void)lane; (void)r; (void)h; (void)wm; (void)wn;
        const int n = id >> 2, hd = id & 3;
        const int t0 = n * 64;
        u16* ksT = smem;
        u16* vT = smem + 2 * 128 * LROW;
        u16* sk = vT;
        float* sga = (float*)(smem_raw + 55296);
        __syncthreads();
        {
          const int cc = t >> 2, part = t & 3;
          const u16* kp = Z + (size_t)(t0 + cc) * ZLD + Z_GK + hd * 128 + part * 32;
#pragma unroll
          for (int j = 0; j < 4; ++j) *(u32x4*)(sk + cc * 128 + part * 32 + j * 8) = *(const u32x4*)(kp + j * 8);
          u32x4 gv = *(const u32x4*)(Z + (size_t)(t0 + cc) * ZLD + Z_GA + part * 8);
#pragma unroll
          for (int k = 0; k < 4; ++k) { sga[cc * 32 + part * 8 + 2 * k] = bflo(gv[k]); sga[cc * 32 + part * 8 + 2 * k + 1] = bfhi(gv[k]); }
        }
        __syncthreads();
        {
          const int dir = t >> 7, d = t & 127;
          const float* wa2 = (dir ? in_ptr(p, 15) : in_ptr(p, 13)) + (size_t)l * 16 * 512 + hd * 128 + d;
          const float ba = ((dir ? in_ptr(p, 16) : in_ptr(p, 14)) + (size_t)l * 512)[hd * 128 + d];
          float wcol[16];
#pragma unroll
          for (int rr = 0; rr < 16; ++rr) wcol[rr] = wa2[rr * 512];
          const float* gar = sga + dir * 16;
          float tot = 0.f;
          for (int cc = 0; cc < 64; ++cc) {
            float pre = ba;
#pragma unroll
            for (int rr = 0; rr < 16; ++rr) pre += gar[cc * 32 + rr] * wcol[rr];
            tot += (fminf(pre, 0.f) - __logf(1.f + __expf(-fabsf(pre)))) * (1.f / 16.f);
          }
          DEC[((size_t)(n * 4 + hd) * 2 + dir) * 128 + d] = __expf(tot);
          float* gc = GC + (size_t)dir * SEQ * 512 + (size_t)t0 * 512 + hd * 128 + d;
          float cb = 0.f;
          u16* krow_out = ksT + (dir * 128 + d) * LROW;
          for (int ci = 0; ci < 64; ++ci) {
            const int cc = dir ? (63 - ci) : ci;
            float pre = ba;
#pragma unroll
            for (int rr = 0; rr < 16; ++rr) pre += gar[cc * 32 + rr] * wcol[rr];
            cb += (fminf(pre, 0.f) - __logf(1.f + __expf(-fabsf(pre)))) * (1.f / 16.f);
            gc[cc * 512] = cb;
            krow_out[cc] = f2bf(bf2f(sk[cc * 128 + d]) * __expf(tot - cb));
          }
        }
        for (int half = 0; half < 2; ++half) {
          __syncthreads();
          {
            const int cc = t & 63, part = t >> 6;
#pragma unroll
            for (int q = 0; q < 4; ++q) {
              const int cg8 = (part * 4 + q) * 8;
              uint4 v = *(const uint4*)(Z + (size_t)(t0 + cc) * ZLD + Z_GV + hd * 256 + half * 128 + cg8);
              unsigned u[4] = {v.x, v.y, v.z, v.w};
#pragma unroll
              for (int j = 0; j < 4; ++j) {
                vT[(cg8 + 2 * j) * LROW + cc] = (u16)(u[j] & 0xffffu);
                vT[(cg8 + 2 * j + 1) * LROW + cc] = (u16)(u[j] >> 16);
              }
            }
          }
          __syncthreads();
#pragma unroll
          for (int dir = 0; dir < 2; ++dir) {
            f32x16 acc[4];
#pragma unroll
            for (int j = 0; j < 4; ++j)
#pragma unroll
              for (int k = 0; k < 16; ++k) acc[j][k] = 0.f;
#pragma unroll
            for (int ks = 0; ks < 4; ++ks) {
              bf16x8 fa = *(const bf16x8*)(vT + (w * 32 + r) * LROW + ks * 16 + h * 8);
#pragma unroll
              for (int nt = 0; nt < 4; ++nt) {
                bf16x8 fb = *(const bf16x8*)(ksT + (dir * 128 + nt * 32 + r) * LROW + ks * 16 + h * 8);
                acc[nt] = MFMA(fb, fa, acc[nt]);
              }
            }
            u16* stp = ST + ((size_t)(n * 4 + hd) * 2 + dir) * 32768;
#pragma unroll
            for (int nt = 0; nt < 4; ++nt)
#pragma unroll
              for (int g4 = 0; g4 < 4; ++g4) {
                uint2 o;
                o.x = pk2(acc[nt][4 * g4 + 0], acc[nt][4 * g4 + 1]);
                o.y = pk2(acc[nt][4 * g4 + 2], acc[nt][4 * g4 + 3]);
                *(uint2*)(stp + (unsigned)((half * 128 + w * 32 + r) * 128 + nt * 32 + 8 * g4 + 4 * h)) = o;
              }
          }
        }
      }
      for (int q = bid; q < NQ; q += G) {
        const int t = opaque_tid();
        const int lane = t & 63, w = t >> 6, r = lane & 31, h = lane >> 5;
        const int wm = w >> 1, wn = w & 1;
        (void)lane; (void)r; (void)h; (void)wm; (void)wn;
        const int tm = q / 6, tn = q % 6;
        const int m0 = tm * 256, n0 = tn * 128;
        __syncthreads();
        row_scales(Z + (size_t)m0 * ZLD + Z_CQ, ZLD, 256, sc, 256);
        Acc c; acc_zero(c);
        gemm_kloop(Z + (size_t)m0 * ZLD + Z_CQ, ZLD, Wb + W_UQ + (size_t)n0 * 256, 256, 256, smem, c);
        {
          const unsigned obase = (unsigned)((m0 + wm * 128) * 768 + n0 + wn * 64);
          epi_store<2>(smem,
            [&](int mi, int ni, int i) {
              const int cb0 = n0 + wn * 64 + ni * 32;
              const bool rope = ((cb0 >> 5) % 3) == 2;
              const int rl = wm * 128 + mi * 32 + crow(i, h);
              float v = c.a[mi][ni][i] * sc[rl];
              const float pv = __shfl_xor(v, 16);
              if (rope) {
                const int row = m0 + rl;
                const float cs = ropec[row * 16 + (r & 15)], sn = ropes[row * 16 + (r & 15)];
                v = (r < 16) ? (v * cs - pv * sn) : (v * cs + pv * sn);
              }
              return v * qscale;
            },
            [&](int row, int col, u32x4 v) { *(u32x4*)(Qb + obase + (unsigned)(row * 768 + col)) = v; });
        }
      }
      for (int q = (bid + G - (NQ % G)) % G; q < NK; q += G) {
        const int t = opaque_tid();
        const int lane = t & 63, w = t >> 6, r = lane & 31, h = lane >> 5;
        const int wm = w >> 1, wn = w & 1;
        (void)lane; (void)r; (void)h; (void)wm; (void)wn;
        const int tm = q >> 2, tn = q & 3;
        const int m0 = tm * 256, n0 = tn * 128;
        __syncthreads();
        row_scales(Z + (size_t)m0 * ZLD + Z_CKV, ZLD, 128, sc, 256);
        Acc c; acc_zero(c);
        gemm_kloop(Z + (size_t)m0 * ZLD + Z_CKV, ZLD, Wb + W_KN + (size_t)n0 * 128, 128, 128, smem, c);
        {
          const unsigned obase = (unsigned)((m0 + wm * 128) * 512 + n0 + wn * 64);
          epi_store<2>(smem,
            [&](int mi, int ni, int i) { return c.a[mi][ni][i] * sc[wm * 128 + mi * 32 + crow(i, h)]; },
            [&](int row, int col, u32x4 v) { *(u32x4*)(KN + obase + (unsigned)(row * 512 + col)) = v; });
        }
      }
      for (int q = (bid + G - ((NQ + NK) % G)) % G; q < NV; q += G) {
        const int t = opaque_tid();
        const int lane = t & 63, w = t >> 6, r = lane & 31, h = lane >> 5;
        const int wm = w >> 1, wn = w & 1;
        (void)lane; (void)r; (void)h; (void)wm; (void)wn;
        const int tm = q & 1, tn = q >> 1;
        const int m0 = tm * 256, n0 = tn * 128;
        __syncthreads();
        row_scales(Z + (size_t)n0 * ZLD + Z_CKV, ZLD, 128, sc, 128);
        Acc c; acc_zero(c);
        gemm_kloop(Wb + W_V + (size_t)m0 * 128, 128, Z + (size_t)n0 * ZLD + Z_CKV, ZLD, 128, smem, c);
        {
          const unsigned obase = (unsigned)((m0 + wm * 128) * SEQ + n0 + wn * 64);
          epi_store<2>(smem,
            [&](int mi, int ni, int i) { return c.a[mi][ni][i] * sc[wn * 64 + ni * 32 + r]; },
            [&](int row, int col, u32x4 v) { *(u32x4*)(VT + obase + (unsigned)(row * SEQ + col)) = v; });
        }
      }
      for (int q = (bid + G - ((NQ + NK + NV) % G)) % G; q < NPE; q += G) {
        const int t = opaque_tid();
        const int lane = t & 63, w = t >> 6, r = lane & 31, h = lane >> 5;
        const int wm = w >> 1, wn = w & 1;
        (void)lane; (void)r; (void)h; (void)wm; (void)wn;
        const int tok = q * 256 + t;
        const u16* src = Z + (size_t)tok * ZLD + Z_KPE;
        float v[32];
#pragma unroll
        for (int j = 0; j < 4; ++j) {
          uint4 u = *(const uint4*)(src + j * 8);
          unsigned uu[4] = {u.x, u.y, u.z, u.w};
#pragma unroll
          for (int k = 0; k < 4; ++k) { v[j * 8 + 2 * k] = bflo(uu[k]); v[j * 8 + 2 * k + 1] = bfhi(uu[k]); }
        }
        float o[32];
#pragma unroll
        for (int i = 0; i < 16; ++i) {
          const float cs = ropec[tok * 16 + i], sn = ropes[tok * 16 + i];
          o[i] = v[i] * cs - v[i + 16] * sn;
          o[i + 16] = v[i + 16] * cs + v[i] * sn;
        }
#pragma unroll
        for (int j = 0; j < 4; ++j) {
          uint4 u;
          u.x = pk2(o[j * 8 + 0], o[j * 8 + 1]); u.y = pk2(o[j * 8 + 2], o[j * 8 + 3]);
          u.z = pk2(o[j * 8 + 4], o[j * 8 + 5]); u.w = pk2(o[j * 8 + 6], o[j * 8 + 7]);
          *(uint4*)(KPE + (size_t)tok * 32 + j * 8) = u;
        }
      }
    }
  };

  auto attn_phase = [&](bool do_scan) __attribute__((always_inline)) {
    const int t = opaque_tid();
    const int lane = t & 63, w = t >> 6, r = lane & 31, h = lane >> 5;
    const int wm = w >> 1, wn = w & 1;
    (void)lane; (void)r; (void)h; (void)wm; (void)wn;
    if (do_scan) for (int id = bid; id < 512; id += G) {
      const int e = id * 256 + t;
      const int d2 = e & 63, v = (e >> 6) & 255, dir = (e >> 14) & 1, hd = e >> 15;
      float s0 = 0.f, s1 = 0.f;
      const size_t eoff = (size_t)v * 128 + 2 * d2;
      for (int i0 = 0; i0 < NCHUNK; i0 += 16) {
        unsigned uu[16];
        float2 dd[16];
#pragma unroll
        for (int j = 0; j < 16; ++j) {
          const int n = dir ? (NCHUNK - 1 - (i0 + j)) : (i0 + j);
          const size_t base = ((size_t)(n * 4 + hd) * 2 + dir);
          uu[j] = *(const unsigned*)(ST + base * 32768 + eoff);
          dd[j] = *(const float2*)(DEC + base * 128 + 2 * d2);
        }
#pragma unroll
        for (int j = 0; j < 16; ++j) {
          const int n = dir ? (NCHUNK - 1 - (i0 + j)) : (i0 + j);
          const size_t base = ((size_t)(n * 4 + hd) * 2 + dir);
          *(unsigned*)(ST + base * 32768 + eoff) = pk2(s0, s1);
          s0 = dd[j].x * s0 + bflo(uu[j]);
          s1 = dd[j].y * s1 + bfhi(uu[j]);
        }
      }
    }
    constexpr int KROW = 104;
    constexpr int VR = 68;
    constexpr int ABUF = 64 * KROW + 64 * VR;
    u16* sK = smem;
    u16* sV = smem + 64 * KROW;
    for (int id = bid; id < 8 * 64; id += G) {
      const int hd = id & 7, qb = id >> 3;
      const int q0 = qb * 256 + w * 64;
      bf16x8 bq[2][6];
#pragma unroll
      for (int qt = 0; qt < 2; ++qt)
#pragma unroll
        for (int ks = 0; ks < 6; ++ks) bq[qt][ks] = *(const bf16x8*)(Qb + (size_t)(q0 + qt * 32 + r) * 768 + hd * 96 + ks * 16 + h * 8);
      f32x16 O[2][2];
#pragma unroll
      for (int j = 0; j < 2; ++j)
#pragma unroll
        for (int qt = 0; qt < 2; ++qt)
#pragma unroll
          for (int k = 0; k < 16; ++k) O[j][qt][k] = 0.f;
      float m[2] = {0.f, 0.f}, lsum[2] = {0.f, 0.f};
      const int kr = t >> 2, kc = t & 3;
      const u16* knp = KN + (size_t)kr * 512 + hd * 64 + kc * 16;
      const u16* kpp = KPE + (size_t)kr * 32 + kc * 8;
      const u16* vpp = VT + (size_t)(hd * 64 + kr) * SEQ + kc * 16;
      u32x4 rk[3], rv[2];
      rk[0] = *(const u32x4*)(knp);
      rk[1] = *(const u32x4*)(knp + 8);
      rk[2] = *(const u32x4*)(kpp);
      rv[0] = *(const u32x4*)(vpp);
      rv[1] = *(const u32x4*)(vpp + 8);
      __syncthreads();
      *(u32x4*)(sK + kr * KROW + kc * 16) = rk[0];
      *(u32x4*)(sK + kr * KROW + kc * 16 + 8) = rk[1];
      *(u32x4*)(sK + kr * KROW + 64 + kc * 8) = rk[2];
      *(uint2*)(sV + kr * VR + kc * 16) = make_uint2(rv[0][0], rv[0][1]);
      *(uint2*)(sV + kr * VR + kc * 16 + 4) = make_uint2(rv[0][2], rv[0][3]);
      *(uint2*)(sV + kr * VR + kc * 16 + 8) = make_uint2(rv[1][0], rv[1][1]);
      *(uint2*)(sV + kr * VR + kc * 16 + 12) = make_uint2(rv[1][2], rv[1][3]);
      rk[0] = *(const u32x4*)(knp + (size_t)64 * 512);
      rk[1] = *(const u32x4*)(knp + (size_t)64 * 512 + 8);
      rk[2] = *(const u32x4*)(kpp + (size_t)64 * 32);
      rv[0] = *(const u32x4*)(vpp + 64);
      rv[1] = *(const u32x4*)(vpp + 64 + 8);
      __syncthreads();
      int cur = 0;
      for (int key0 = 0; key0 < SEQ; key0 += 64) {
        const u16* cK = sK + cur * ABUF;
        const u16* cV = sV + cur * ABUF;
        {
          u16* nK = sK + (cur ^ 1) * ABUF;
          u16* nV = sV + (cur ^ 1) * ABUF;
          *(u32x4*)(nK + kr * KROW + kc * 16) = rk[0];
          *(u32x4*)(nK + kr * KROW + kc * 16 + 8) = rk[1];
          *(u32x4*)(nK + kr * KROW + 64 + kc * 8) = rk[2];
          *(uint2*)(nV + kr * VR + kc * 16) = make_uint2(rv[0][0], rv[0][1]);
          *(uint2*)(nV + kr * VR + kc * 16 + 4) = make_uint2(rv[0][2], rv[0][3]);
          *(uint2*)(nV + kr * VR + kc * 16 + 8) = make_uint2(rv[1][0], rv[1][1]);
          *(uint2*)(nV + kr * VR + kc * 16 + 12) = make_uint2(rv[1][2], rv[1][3]);
          const int kn = (key0 + 128 < SEQ) ? (key0 + 128) : key0;
          rk[0] = *(const u32x4*)(knp + (size_t)kn * 512);
          rk[1] = *(const u32x4*)(knp + (size_t)kn * 512 + 8);
          rk[2] = *(const u32x4*)(kpp + (size_t)kn * 32);
          rv[0] = *(const u32x4*)(vpp + kn);
          rv[1] = *(const u32x4*)(vpp + kn + 8);
        }
        __builtin_amdgcn_sched_barrier(0);
        f32x16 S[2][2];
#pragma unroll
        for (int kt = 0; kt < 2; ++kt)
#pragma unroll
          for (int qt = 0; qt < 2; ++qt)
#pragma unroll
            for (int k = 0; k < 16; ++k) S[kt][qt][k] = -m[qt];
#pragma unroll
        for (int ks = 0; ks < 6; ++ks)
#pragma unroll
          for (int kt = 0; kt < 2; ++kt) {
            bf16x8 fa = *(const bf16x8*)(cK + (kt * 32 + r) * KROW + ks * 16 + h * 8);
            S[kt][0] = MFMA(fa, bq[0][ks], S[kt][0]);
            S[kt][1] = MFMA(fa, bq[1][ks], S[kt][1]);
          }
        bf16x8 pf[2][4];
#pragma unroll
        for (int qt = 0; qt < 2; ++qt) {
          float mloc = S[0][qt][0];
#pragma unroll
          for (int kt = 0; kt < 2; ++kt)
#pragma unroll
            for (int k = 0; k < 16; ++k) mloc = fmaxf(mloc, S[kt][qt][k]);
          mloc = fmaxf(mloc, __shfl_xor(mloc, 32));
          if (__builtin_amdgcn_ballot_w64(mloc > 0.f) != 0ull) {
            const float delta = fmaxf(mloc, 0.f);
            const float alpha = __builtin_amdgcn_exp2f(-delta);
            m[qt] += delta;
            lsum[qt] *= alpha;
#pragma unroll
            for (int j = 0; j < 2; ++j)
#pragma unroll
              for (int k = 0; k < 16; ++k) O[j][qt][k] *= alpha;
#pragma unroll
            for (int kt = 0; kt < 2; ++kt)
#pragma unroll
              for (int k = 0; k < 16; ++k) S[kt][qt][k] -= delta;
          }
          float ps = 0.f;
#pragma unroll
          for (int kt = 0; kt < 2; ++kt)
#pragma unroll
            for (int k = 0; k < 16; ++k) { S[kt][qt][k] = __builtin_amdgcn_exp2f(S[kt][qt][k]); ps += S[kt][qt][k]; }
          lsum[qt] += ps;
#pragma unroll
          for (int s2 = 0; s2 < 4; ++s2) {
            const int kt = s2 >> 1, sx = s2 & 1;
            unsigned pw[4];
#pragma unroll
            for (int j = 0; j < 4; ++j) pw[j] = pk2(S[kt][qt][8 * sx + 2 * j], S[kt][qt][8 * sx + 2 * j + 1]);
            pf[qt][s2] = __builtin_bit_cast(bf16x8, make_uint4(pw[0], pw[1], pw[2], pw[3]));
          }
        }
#pragma unroll
        for (int s2 = 0; s2 < 4; ++s2) {
          const int kt = s2 >> 1, sx = s2 & 1;
#pragma unroll
          for (int dt = 0; dt < 2; ++dt) {
            const u16* vp = cV + (dt * 32 + r) * VR + kt * 32 + 16 * sx + 4 * h;
            uint2 lo = *(const uint2*)(vp);
            uint2 hi = *(const uint2*)(vp + 8);
            bf16x8 fv = __builtin_bit_cast(bf16x8, make_uint4(lo.x, lo.y, hi.x, hi.y));
            O[dt][0] = MFMA(fv, pf[0][s2], O[dt][0]);
            O[dt][1] = MFMA(fv, pf[1][s2], O[dt][1]);
          }
        }
        cur ^= 1;
        __syncthreads();
      }
#pragma unroll
      for (int qt = 0; qt < 2; ++qt) {
        const float lt = lsum[qt] + __shfl_xor(lsum[qt], 32);
        const float inv = 1.f / lt;
#pragma unroll
        for (int dt = 0; dt < 2; ++dt)
#pragma unroll
          for (int g4 = 0; g4 < 4; ++g4) {
            uint2 o;
            o.x = pk2(O[dt][qt][4 * g4 + 0] * inv, O[dt][qt][4 * g4 + 1] * inv);
            o.y = pk2(O[dt][qt][4 * g4 + 2] * inv, O[dt][qt][4 * g4 + 3] * inv);
            *(uint2*)(OA + (size_t)(q0 + qt * 32 + r) * 512 + hd * 64 + dt * 32 + 8 * g4 + 4 * h) = o;
          }
      }
    }
  };

  auto gla_out_phase = [&](int l) __attribute__((always_inline)) {
    const int t = opaque_tid();
    const int lane = t & 63, w = t >> 6, r = lane & 31, h = lane >> 5;
    const int wm = w >> 1, wn = w & 1;
    (void)lane; (void)r; (void)h; (void)wm; (void)wn;
    constexpr int QROW = 136;
    u16* sQ = smem;
    u16* sKt = smem + 64 * QROW;
    u16* sVT = smem + 2 * 64 * QROW;
    float* sred = (float*)(smem + 2 * 64 * QROW + 256 * LROW);
    u16* sO = smem;
    constexpr int OROW = 264;
    const float qs = 0.08838834764831845f;
    const int cs = w & 1, vh = w >> 1;
    for (int id = bid; id < NCHUNK * 4; id += G) {
      const int n = id >> 2, hd = id & 3;
      const int t0 = n * 64;
      __syncthreads();
      {
        const int cc = t & 63, part = t >> 6;
#pragma unroll
        for (int q = 0; q < 8; ++q) {
          const int cg8 = (part * 8 + q) * 8;
          uint4 v = *(const uint4*)(Z + (size_t)(t0 + cc) * ZLD + Z_GV + hd * 256 + cg8);
          unsigned u[4] = {v.x, v.y, v.z, v.w};
#pragma unroll
          for (int j = 0; j < 4; ++j) {
            sVT[(cg8 + 2 * j) * LROW + cc] = (u16)(u[j] & 0xffffu);
            sVT[(cg8 + 2 * j + 1) * LROW + cc] = (u16)(u[j] >> 16);
          }
        }
      }
      f32x16 acc[4];
#pragma unroll
      for (int j = 0; j < 4; ++j)
#pragma unroll
        for (int k = 0; k < 16; ++k) acc[j][k] = 0.f;
      for (int dir = 0; dir < 2; ++dir) {
        __syncthreads();
        {
          const int cc = t >> 2, dp = (t & 3) * 32;
          const u16* qp = Z + (size_t)(t0 + cc) * ZLD + Z_GQ + hd * 128 + dp;
          const u16* kp = Z + (size_t)(t0 + cc) * ZLD + Z_GK + hd * 128 + dp;
          const float* gp = GC + (size_t)dir * SEQ * 512 + (size_t)(t0 + cc) * 512 + hd * 128 + dp;
#pragma unroll
          for (int j = 0; j < 4; ++j) {
            uint4 qv = *(const uint4*)(qp + j * 8);
            uint4 kv = *(const uint4*)(kp + j * 8);
            float4 g0 = *(const float4*)(gp + j * 8);
            float4 g1 = *(const float4*)(gp + j * 8 + 4);
            const float gg[8] = {g0.x, g0.y, g0.z, g0.w, g1.x, g1.y, g1.z, g1.w};
            const unsigned qu[4] = {qv.x, qv.y, qv.z, qv.w};
            const unsigned ku[4] = {kv.x, kv.y, kv.z, kv.w};
            unsigned qo[4], ko[4];
#pragma unroll
            for (int k = 0; k < 4; ++k) {
              const float e0 = __expf(gg[2 * k]), e1 = __expf(gg[2 * k + 1]);
              qo[k] = pk2(bflo(qu[k]) * qs * e0, bfhi(qu[k]) * qs * e1);
              ko[k] = pk2(bflo(ku[k]) / e0, bfhi(ku[k]) / e1);
            }
            *(uint4*)(sQ + cc * QROW + dp + j * 8) = make_uint4(qo[0], qo[1], qo[2], qo[3]);
            *(uint4*)(sKt + cc * QROW + dp + j * 8) = make_uint4(ko[0], ko[1], ko[2], ko[3]);
            if (j == 1) __builtin_amdgcn_sched_barrier(0);
          }
        }
        __syncthreads();
        const u16* bqp = sQ + (cs * 32 + r) * QROW + h * 8;
        const u16* stp = ST + ((size_t)(n * 4 + hd) * 2 + dir) * 32768;
        bf16x8 fs[2][4];
#pragma unroll
        for (int ks = 0; ks < 4; ++ks) fs[0][ks] = *(const bf16x8*)(stp + (size_t)(vh * 128 + r) * 128 + ks * 16 + h * 8);
        f32x16 at[2];
#pragma unroll
        for (int et = 0; et < 2; ++et) {
#pragma unroll
          for (int k = 0; k < 16; ++k) at[et][k] = 0.f;
#pragma unroll
          for (int ks = 0; ks < 8; ++ks) {
            bf16x8 fa = *(const bf16x8*)(sKt + (et * 32 + r) * QROW + ks * 16 + h * 8);
            bf16x8 fbq = *(const bf16x8*)(bqp + ks * 16);
            at[et] = MFMA(fa, fbq, at[et]);
          }
          const int cidx = cs * 32 + r;
#pragma unroll
          for (int k = 0; k < 16; ++k) {
            const int e = et * 32 + crow(k, h);
            const bool keep = dir ? (e >= cidx) : (e <= cidx);
            at[et][k] = keep ? at[et][k] : 0.f;
          }
        }
#pragma unroll
        for (int s2 = 0; s2 < 4; ++s2) {
          const int et = s2 >> 1, s = s2 & 1;
          unsigned pw[4];
#pragma unroll
          for (int j = 0; j < 4; ++j) pw[j] = pk2(at[et][8 * s + 2 * j], at[et][8 * s + 2 * j + 1]);
          bf16x8 pf = __builtin_bit_cast(bf16x8, make_uint4(pw[0], pw[1], pw[2], pw[3]));
#pragma unroll
          for (int mt = 0; mt < 4; ++mt) {
            const u16* vp = sVT + (vh * 128 + mt * 32 + r) * LROW + et * 32 + 16 * s + 4 * h;
            uint2 lo = *(const uint2*)(vp);
            uint2 hi = *(const uint2*)(vp + 8);
            bf16x8 fv = __builtin_bit_cast(bf16x8, make_uint4(lo.x, lo.y, hi.x, hi.y));
            acc[mt] = MFMA(fv, pf, acc[mt]);
          }
        }
#pragma unroll
        for (int bb = 0; bb < 8; ++bb) {
          const int mt = bb >> 1, kb = bb & 1;
          if (bb + 1 < 8) {
            const int mt1 = (bb + 1) >> 1, kb1 = (bb + 1) & 1;
#pragma unroll
            for (int ks = 0; ks < 4; ++ks) fs[(bb + 1) & 1][ks] = *(const bf16x8*)(stp + (size_t)(vh * 128 + mt1 * 32 + r) * 128 + (kb1 * 4 + ks) * 16 + h * 8);
          }
          __builtin_amdgcn_sched_barrier(0);
#pragma unroll
          for (int ks = 0; ks < 4; ++ks) { bf16x8 fbq = *(const bf16x8*)(bqp + (kb * 4 + ks) * 16); acc[mt] = MFMA(fs[bb & 1][ks], fbq, acc[mt]); }
          __builtin_amdgcn_sched_barrier(0);
        }
      }
      float ss = 0.f;
#pragma unroll
      for (int mt = 0; mt < 4; ++mt)
#pragma unroll
        for (int k = 0; k < 16; ++k) ss += acc[mt][k] * acc[mt][k];
      ss += __shfl_xor(ss, 32);
      if (h == 0) sred[vh * 64 + cs * 32 + r] = ss;
      __syncthreads();
      const float rs = rsqrtf((sred[cs * 32 + r] + sred[64 + cs * 32 + r]) * (1.f / 256.f) + EPS);
#pragma unroll
      for (int mt = 0; mt < 4; ++mt)
#pragma unroll
        for (int g4 = 0; g4 < 4; ++g4) {
          uint2 o;
          o.x = pk2(acc[mt][4 * g4 + 0] * rs, acc[mt][4 * g4 + 1] * rs);
          o.y = pk2(acc[mt][4 * g4 + 2] * rs, acc[mt][4 * g4 + 3] * rs);
          *(uint2*)(sO + (cs * 32 + r) * OROW + vh * 128 + mt * 32 + 8 * g4 + 4 * h) = o;
        }
      __syncthreads();
      {
        const int t3 = opaque_tid();
        const int cc = t3 >> 2, vp0 = (t3 & 3) * 64;
        const float* ng = in_ptr(p, 17) + (size_t)l * 256;
#pragma unroll
        for (int j = 0; j < 8; ++j) {
          const int v0 = vp0 + j * 8;
          uint4 ov = *(const uint4*)(sO + cc * OROW + v0);
          uint4 gv = *(const uint4*)(Z + (size_t)(t0 + cc) * ZLD + Z_GOG + hd * 256 + v0);
          float4 n0 = *(const float4*)(ng + v0), n1 = *(const float4*)(ng + v0 + 4);
          const float nn[8] = {n0.x, n0.y, n0.z, n0.w, n1.x, n1.y, n1.z, n1.w};
          const unsigned ou[4] = {ov.x, ov.y, ov.z, ov.w};
          const unsigned gu[4] = {gv.x, gv.y, gv.z, gv.w};
          unsigned res[4];
#pragma unroll
          for (int k = 0; k < 4; ++k)
            res[k] = pk2(bflo(ou[k]) * nn[2 * k] * siluf_(bflo(gu[k])), bfhi(ou[k]) * nn[2 * k + 1] * siluf_(bfhi(gu[k])));
          *(uint4*)(OG + (size_t)(t0 + cc) * DM + hd * 256 + v0) = make_uint4(res[0], res[1], res[2], res[3]);
        }
      }
    }
  };

  auto merge_phase = [&]() __attribute__((always_inline)) {
    const int t = opaque_tid();
    const int lane = t & 63, w = t >> 6, r = lane & 31, h = lane >> 5;
    const int wm = w >> 1, wn = w & 1;
    (void)lane; (void)r; (void)h; (void)wm; (void)wn;
    const int MT = SEQ / 256, NT = DM / 128;
    for (int id = bid; id < MT * NT; id += G) {
      int tm, tn; tile_coords(id, MT, NT, tm, tn);
      const int m0 = tm * 256, n0 = tn * 128;
      Acc c; acc_zero(c);
      gemm_kloop(OA + (size_t)m0 * 512, 512, Wb + W_OA + (size_t)n0 * 512, 512, 512, smem, c);
      {
        const unsigned zbase = (unsigned)((m0 + wm * 128) * ZLD + Z_BG + n0 + wn * 64);
        const unsigned obase = (unsigned)((m0 + wm * 128) * DM + n0 + wn * 64);
        epi_store<2>(smem,
          [&](int mi, int ni, int i) { return c.a[mi][ni][i]; },
          [&](int row, int col, u32x4 v) {
            const u32x4 g = *(const u32x4*)(Z + zbase + (unsigned)(row * ZLD + col));
            u32x4 o;
#pragma unroll
            for (int k = 0; k < 4; ++k) o[k] = pk2(bflo(v[k]) * sigmoidf_(bflo(g[k])), bfhi(v[k]) * sigmoidf_(bfhi(g[k])));
            *(u32x4*)(MG + obase + (unsigned)(row * DM + col)) = o;
          });
      }
      acc_zero(c);
      gemm_kloop(OG + (size_t)m0 * DM, DM, Wb + W_OB + (size_t)n0 * DM, DM, DM, smem, c);
      {
        const int t2 = opaque_tid();
        const int wm2 = t2 >> 7, wn2 = (t2 >> 6) & 1;
        const unsigned zbase = (unsigned)((m0 + wm2 * 128) * ZLD + Z_BG + DM + n0 + wn2 * 64);
        const unsigned obase = (unsigned)((m0 + wm2 * 128) * DM + n0 + wn2 * 64);
        epi_store<2>(smem,
          [&](int mi, int ni, int i) { return c.a[mi][ni][i]; },
          [&](int row, int col, u32x4 v) {
            const u32x4 g = *(const u32x4*)(Z + zbase + (unsigned)(row * ZLD + col));
            const u32x4 pm = *(const u32x4*)(MG + obase + (unsigned)(row * DM + col));
            u32x4 o;
#pragma unroll
            for (int k = 0; k < 4; ++k)
              o[k] = pk2(bflo(pm[k]) + bflo(v[k]) * sigmoidf_(bflo(g[k])), bfhi(pm[k]) + bfhi(v[k]) * sigmoidf_(bfhi(g[k])));
            *(u32x4*)(MG + obase + (unsigned)(row * DM + col)) = o;
          });
      }
    }
  };

  for (int i = bid * 256 + opaque_tid(); i < SEQ * 16; i += G * 256) {
    const int pos = i >> 4, j = i & 15;
    const float inv_freq = exp2f(-(float)j * 0.8304820237218406f);
    const float angf = (float)pos * inv_freq;
    double a = (double)angf;
    const double twopi = 6.283185307179586476925286766559;
    a -= twopi * rint(a / twopi);
    const float af = (float)a;
    ropec[i] = __cosf(af);
    ropes[i] = __sinf(af);
  }
  convert_weights(0);
  rn_pass(0, 0.f, nullptr, in_ptr(p, 2));
  grid.sync();

  for (int l = 0; l < 4; ++l) {
    ffn_in(W_FFN1_IN);
#ifdef DUP_FFNIN
    xcd_barrier(xb);
    ffn_in(W_FFN1_IN);
#endif
    xcd_barrier(xb);
    gemm_plain(ACT, DFF, DFF, Wb + W_FFN1_OUT, Yb, DM, MALL, DM);
    xcd_barrier(xb);
    rn_pass(1, 0.5f, in_ptr(p, 5) + l * DM, in_ptr(p, 6) + l * DM);
    xcd_barrier(xb);
    for (int s = 0; s < NSEQ; ++s) {
      gemm_plain(Hb + (size_t)s * SEQ * DM, DM, DM, Wb + W_IN, Z, ZLD, SEQ, ZLD);
      xcd_barrier(xb);
      prep_phase(l);
#ifdef DUP_PREP
      xcd_barrier(xb);
      prep_phase(l);
#endif
      xcd_barrier(xb);
      attn_phase(true);
#ifdef DUP_ATTN
      xcd_barrier(xb);
      attn_phase(false);
#endif
      xcd_barrier(xb);
      gla_out_phase(l);
#ifdef DUP_GLAOUT
      xcd_barrier(xb);
      gla_out_phase(l);
#endif
      xcd_barrier(xb);
      merge_phase();
      xcd_barrier(xb);
      gemm_plain(MG, DM, DM, Wb + W_OUT, Yb + (size_t)s * SEQ * DM, DM, SEQ, DM);
      xcd_barrier(xb);
    }
    rn_pass(1, 1.0f, in_ptr(p, 20) + l * DM, in_ptr(p, 21) + l * DM);
    xcd_barrier(xb);
    ffn_in(W_FFN2_IN);
    xcd_barrier(xb);
    gemm_plain(ACT, DFF, DFF, Wb + W_FFN2_OUT, Yb, DM, MALL, DM);
    xcd_barrier(xb);
    rn_pass(1, 0.5f, in_ptr(p, 24) + l * DM, (l < 3) ? (in_ptr(p, 2) + (l + 1) * DM) : nullptr);
    if (l < 3) convert_weights(l + 1);
    xcd_barrier(xb);
  }
}

extern "C" void kernel_launch(void* const* d_in, const int* in_sizes, int n_in, void* d_out,
                              int out_size, void* d_ws, size_t ws_size, hipStream_t stream) {
  static int grid_blocks = 0;
  if (!grid_blocks) {
    int dev = 0, cus = 0, per_cu = 0;
    (void)hipGetDevice(&dev);
    (void)hipDeviceGetAttribute(&cus, hipDeviceAttributeMultiprocessorCount, dev);
    (void)hipOccupancyMaxActiveBlocksPerMultiprocessor(&per_cu, fwd_megakernel, 256, 0);
    if (per_cu > 2) per_cu = 2;
    if (per_cu < 1) per_cu = 1;
    grid_blocks = cus * per_cu;
  }
  Params p{};
  for (int i = 0; i < 25; ++i) p.in[i] = (const float*)d_in[i];
  p.out = (float*)d_out;
  p.ws = (char*)d_ws;
  (void)hipMemsetAsync((char*)d_ws + OFF_BAR, 0, XCD_BAR_WORDS * 4, stream);
  void* args[] = {&p};
  hipError_t e = hipLaunchCooperativeKernel((void*)fwd_megakernel, dim3(grid_blocks), dim3(256), args, 0, stream);
  if (e != hipSuccess) fprintf(stderr, "cooperative launch failed: %s (grid %d)\n", hipGetErrorString(e), grid_blocks);
}
```

```cpp
#include <hip/hip_runtime.h>
#include <hip/hip_cooperative_groups.h>
#include <cstdio>
namespace cg = cooperative_groups;

typedef unsigned short u16;
typedef short bf16x8 __attribute__((ext_vector_type(8)));
typedef short s16x4 __attribute__((ext_vector_type(4)));
typedef float f32x16 __attribute__((ext_vector_type(16)));
typedef __bf16 bf2_t __attribute__((ext_vector_type(2)));
typedef float f2_t __attribute__((ext_vector_type(2)));
typedef unsigned u32x4 __attribute__((ext_vector_type(4)));
#define DI __device__ __forceinline__
#define MFMA(a, b, c) __builtin_amdgcn_mfma_f32_32x32x16_bf16((a), (b), (c), 0, 0, 0)

constexpr int SEQ = 16384;
constexpr int NSEQ = 3;
constexpr int MALL = SEQ * NSEQ;
constexpr int DM = 1024;
constexpr int DFF = 2816;
constexpr int NFF2 = 5632;
constexpr int PIN = 5568;
constexpr int ZLD = 5632;
constexpr int Z_CQ = 0, Z_CKV = 256, Z_KPE = 384, Z_GQ = 416, Z_GK = 928, Z_GV = 1440, Z_GA = 2464, Z_GOG = 2496, Z_BG = 3520;
constexpr float EPS = 1e-6f;
constexpr int NCHUNK = SEQ / 64;

constexpr size_t W_FFN1_IN = 0;
constexpr size_t W_FFN1_OUT = W_FFN1_IN + (size_t)NFF2 * DM;
constexpr size_t W_IN = W_FFN1_OUT + (size_t)DM * DFF;
constexpr size_t W_UQ = W_IN + (size_t)ZLD * DM;
constexpr size_t W_KN = W_UQ + (size_t)768 * 256;
constexpr size_t W_V = W_KN + (size_t)512 * 128;
constexpr size_t W_OA = W_V + (size_t)512 * 128;
constexpr size_t W_OB = W_OA + (size_t)DM * 512;
constexpr size_t W_OUT = W_OB + (size_t)DM * DM;
constexpr size_t W_FFN2_IN = W_OUT + (size_t)DM * DM;
constexpr size_t W_FFN2_OUT = W_FFN2_IN + (size_t)NFF2 * DM;
constexpr size_t W_END = W_FFN2_OUT + (size_t)DM * DFF;

constexpr size_t al256(size_t x) { return (x + 255) & ~(size_t)255; }
constexpr size_t OFF_WB = 0;
constexpr size_t OFF_ROPE = al256(OFF_WB + W_END * 2);
constexpr size_t OFF_H = al256(OFF_ROPE + (size_t)SEQ * 32 * 4);
constexpr size_t OFF_Y = al256(OFF_H + (size_t)MALL * DM * 2);
constexpr size_t OFF_ACT = al256(OFF_Y + (size_t)MALL * DM * 2);
constexpr size_t OFF_Z = OFF_ACT;
constexpr size_t OFF_Q = al256(OFF_Z + (size_t)SEQ * ZLD * 2);
constexpr size_t OFF_KN = al256(OFF_Q + (size_t)SEQ * 768 * 2);
constexpr size_t OFF_VT = al256(OFF_KN + (size_t)SEQ * 512 * 2);
constexpr size_t OFF_KPE = al256(OFF_VT + (size_t)SEQ * 512 * 2);
constexpr size_t OFF_OA = al256(OFF_KPE + (size_t)SEQ * 32 * 2);
constexpr size_t OFF_MIXEND = al256(OFF_OA + (size_t)SEQ * 512 * 2);
constexpr size_t OFF_ACTEND = al256(OFF_ACT + (size_t)MALL * DFF * 2);
static_assert(OFF_MIXEND <= OFF_ACTEND, "mixer scratch must fit in act");
constexpr size_t OFF_ST = OFF_ACTEND;
constexpr size_t OFF_DEC = al256(OFF_ST + (size_t)NCHUNK * 4 * 2 * 256 * 128 * 2);
constexpr size_t OFF_GC = al256(OFF_DEC + (size_t)NCHUNK * 4 * 2 * 128 * 4);
constexpr size_t OFF_OG = al256(OFF_GC + (size_t)2 * SEQ * 512 * 4);
constexpr size_t OFF_MG = al256(OFF_OG + (size_t)SEQ * DM * 2);
constexpr size_t OFF_END = al256(OFF_MG + (size_t)SEQ * DM * 2);
constexpr size_t OFF_BAR = OFF_END;
static_assert(OFF_BAR + 16384 <= (size_t)768 * 1024 * 1024, "workspace overflow");

struct Params {
  const float* in[25];
  float* out;
  char* ws;
};

DI unsigned pk2(float a, float b) { f2_t v = {a, b}; return __builtin_bit_cast(unsigned, __builtin_convertvector(v, bf2_t)); }
DI u16 f2bf(float a) { return (u16)(pk2(a, 0.f) & 0xffffu); }
DI float bf2f(u16 v) { return __uint_as_float(((unsigned)v) << 16); }
DI float bflo(unsigned v) { return __uint_as_float(v << 16); }
DI float bfhi(unsigned v) { return __uint_as_float(v & 0xffff0000u); }
DI float wave_sum(float v) {
#pragma unroll
  for (int o = 32; o >= 1; o >>= 1) v += __shfl_xor(v, o);
  return v;
}
DI int opaque_tid() { int t = threadIdx.x; asm volatile("" : "+v"(t)); return t; }
DI const float* in_ptr(const Params& p, int k) { asm volatile("" : "+s"(k)); return p.in[k]; }
DI int crow(int i, int h) { return (i & 3) + 8 * (i >> 2) + 4 * h; }
DI float sigmoidf_(float x) { return 1.f / (1.f + __expf(-x)); }
DI float siluf_(float x) { return x / (1.f + __expf(-x)); }


#define XB_TMO      128
#define XB_XCNT(j)  (256  + 64 * (j))
#define XB_XSUB(j)  (1280 + 64 * (j))
#define XB_XGEN(j)  (2304 + 64 * (j))
#define XB_TOP      3328
#define XB_TOPGEN   3392
#define XCD_BAR_WORDS 3456
#define XB_SPIN_CAP (1u << 18)
#define LAS __attribute__((address_space(3)))

__device__ __forceinline__ unsigned xb_ld(unsigned* p)              { return __hip_atomic_load(p, __ATOMIC_RELAXED, __HIP_MEMORY_SCOPE_AGENT); }
__device__ __forceinline__ unsigned xb_add(unsigned* p, unsigned v) { return __hip_atomic_fetch_add(p, v, __ATOMIC_RELAXED, __HIP_MEMORY_SCOPE_AGENT); }
__device__ __forceinline__ unsigned xb_xcc_id() { return (unsigned)__builtin_amdgcn_s_getreg((3 << 11) | 20) & 0xFu; }
#define XB_SPIN(cond, bar) do { unsigned _sp = 0; while (cond) { __builtin_amdgcn_s_sleep(1); \
    if ((++_sp & 255u) == 0u) { if (xb_ld(&(bar)[XB_TMO])) break; if (_sp > XB_SPIN_CAP) { atomicAdd(&(bar)[XB_TMO], 1u); break; } } } } while (0)

struct XcdBarrier {
    unsigned* bar; unsigned x;
    volatile LAS unsigned* st;
};

__device__ __forceinline__ XcdBarrier xcd_barrier_post(unsigned* bar, volatile LAS unsigned* st) {
    XcdBarrier b; b.bar = bar; b.x = xb_xcc_id(); b.st = st;
    if (threadIdx.x == 0) (void)xb_add(&bar[XB_XCNT(b.x)], 1u);
    return b;
}
__device__ __forceinline__ void xcd_barrier_complete(unsigned* bar, unsigned x, unsigned& nloc, unsigned& nx) {
    const unsigned G = gridDim.x * gridDim.y * gridDim.z;
    unsigned sum, cnt, mine, sp = 0u;
    for (;;) {
        sum = 0u; cnt = 0u; mine = 0u;
#pragma unroll
        for (unsigned j = 0; j < 16; ++j) { const unsigned c = xb_ld(&bar[XB_XCNT(j)]); sum += c; cnt += (c > 0u) ? 1u : 0u; mine = (j == x) ? c : mine; }
        if (sum == G) break;
        __builtin_amdgcn_s_sleep(1);
        if ((++sp & 255u) == 0u) { if (xb_ld(&bar[XB_TMO])) break; if (sp > XB_SPIN_CAP) { atomicAdd(&bar[XB_TMO], 1u); break; } }
    }
    nloc = mine > 0u ? mine : 1u; nx = cnt > 0u ? cnt : 1u;
}

__device__ __forceinline__ void xcd_barrier(const XcdBarrier& b) {
    asm volatile("s_waitcnt vmcnt(0)" ::: "memory");
    __syncthreads();
    int tid0_ = threadIdx.x; asm volatile("" : "+v"(tid0_));
    if (tid0_ == 0) {
        unsigned* bar = b.bar; asm volatile("" : "+s"(bar));
        unsigned bx_ = b.x; asm volatile("" : "+s"(bx_));
        __builtin_amdgcn_s_waitcnt(0);
        unsigned nloc = b.st[0], nx = b.st[1];
        if (nloc == 0u) { xcd_barrier_complete(bar, bx_, nloc, nx); b.st[0] = nloc; b.st[1] = nx; }
        const unsigned old = xb_add(&bar[XB_XSUB(bx_)], 1u);
        const unsigned gen = old / nloc;
        if (old + 1u == (gen + 1u) * nloc) {
            __builtin_amdgcn_fence(__ATOMIC_RELEASE, "agent");
            asm volatile("s_waitcnt vmcnt(0)" ::: "memory");
            const unsigned og = xb_add(&bar[XB_TOP], 1u);
            const unsigned tg = og / nx;
            if (og + 1u == (tg + 1u) * nx) xb_add(&bar[XB_TOPGEN], 1u);
            else XB_SPIN(xb_ld(&bar[XB_TOPGEN]) == tg, bar);
            __builtin_amdgcn_fence(__ATOMIC_ACQUIRE, "agent");
            xb_add(&bar[XB_XGEN(bx_)], 1u);
            asm volatile("s_waitcnt vmcnt(0)" ::: "memory");
        } else {
            XB_SPIN(xb_ld(&bar[XB_XGEN(bx_)]) == gen, bar);
            __builtin_amdgcn_fence(__ATOMIC_ACQUIRE, "agent");
            asm volatile("s_waitcnt vmcnt(0)" ::: "memory");
        }
    }
    __syncthreads();
}

constexpr int LROW = 72;
constexpr int GEMM_LDS = 2 * 128 * LROW * 2;

struct Acc { f32x16 a[4][2]; };

DI void acc_zero(Acc& c) {
#pragma unroll
  for (int i = 0; i < 4; ++i)
#pragma unroll
    for (int j = 0; j < 2; ++j)
#pragma unroll
      for (int k = 0; k < 16; ++k) c.a[i][j][k] = 0.f;
}

DI void gll16(const u16* g, char* l) {
  __builtin_amdgcn_global_load_lds((const __attribute__((address_space(1))) unsigned*)g,
                                   (__attribute__((address_space(3))) unsigned*)l, 16, 0, 0);
}
DI void gemm_kloop(const u16* __restrict__ A, int lda, const u16* __restrict__ B, int ldb, int K, u16* smem, Acc& c) {
  const int t = opaque_tid();
  const int lane = t & 63, w = t >> 6, r = lane & 31, h = lane >> 5;
  const int wm = w >> 1, wn = w & 1;
  char* lds = (char*)smem;
  const int nk = K >> 5;
  const int row0 = t >> 2, c0 = t & 3;
  const int sw0 = (c0 ^ ((row0 >> 2) & 3)) * 8;
  const u16* ga0 = A + (size_t)row0 * lda + sw0;
  const u16* gb0 = B + (size_t)row0 * ldb + sw0;
  const size_t a64 = (size_t)64 * lda, b64 = (size_t)64 * ldb;
  const int loff = t * 16;
#define GEMM_ISSUE(kt_, st_)                                         \
  do {                                                               \
    const int kk_ = ((kt_) < nk ? (kt_) : (nk - 1)) * 32;            \
    char* sp_ = lds + (st_) * 24576 + loff;                          \
    gll16(ga0 + kk_, sp_);                                           \
    gll16(ga0 + a64 + kk_, sp_ + 4096);                              \
    gll16(ga0 + 2 * a64 + kk_, sp_ + 8192);                          \
    gll16(ga0 + 3 * a64 + kk_, sp_ + 12288);                         \
    gll16(gb0 + kk_, sp_ + 16384);                                   \
    gll16(gb0 + b64 + kk_, sp_ + 20480);                             \
  } while (0)
  __syncthreads();
  GEMM_ISSUE(0, 0);
  GEMM_ISSUE(1, 1);
  const int fsw = (r >> 2) & 3;
  const int aoff = (wm * 128 + r) * 64, boff = 16384 + (wn * 64 + r) * 64;
  int scur = 0, snext = 2;
  for (int kt = 0; kt < nk; ++kt) {
    asm volatile("s_waitcnt vmcnt(6)" ::: "memory");
    __builtin_amdgcn_s_barrier();
    asm volatile("" ::: "memory");
    GEMM_ISSUE(kt + 2, snext);
    __builtin_amdgcn_sched_barrier(0);
    const char* st = lds + scur * 24576;
#pragma unroll
    for (int ks = 0; ks < 2; ++ks) {
      const int q = ((ks * 2 + h) ^ fsw) * 16;
      bf16x8 fa[4], fb[2];
#pragma unroll
      for (int i = 0; i < 4; ++i) fa[i] = *(const bf16x8*)(st + aoff + i * 2048 + q);
#pragma unroll
      for (int i = 0; i < 2; ++i) fb[i] = *(const bf16x8*)(st + boff + i * 2048 + q);
#pragma unroll
      for (int i = 0; i < 4; ++i)
#pragma unroll
        for (int j = 0; j < 2; ++j) c.a[i][j] = MFMA(fa[i], fb[j], c.a[i][j]);
    }
    __builtin_amdgcn_sched_barrier(0);
    snext = scur;
    scur = (scur == 2) ? 0 : scur + 1;
  }
  asm volatile("s_waitcnt vmcnt(0)" ::: "memory");
  __builtin_amdgcn_s_barrier();
  asm volatile("" ::: "memory");
#undef GEMM_ISSUE
}

DI void row_scales(const u16* __restrict__ base, int ld, int K, float* sc, int NR) {
  const int t = opaque_tid();
  const int row = (NR == 256) ? t : (t >> 1);
  const int part = (NR == 256) ? 0 : (t & 1);
  const int len = (NR == 256) ? K : (K / 2);
  const u16* p = base + (size_t)row * ld + part * len;
  float ss = 0.f;
  for (int i = 0; i < len / 8; ++i) {
    u32x4 v = *(const u32x4*)(p + i * 8);
#pragma unroll
    for (int j = 0; j < 4; ++j) { float a = bflo(v[j]), b = bfhi(v[j]); ss += a * a + b * b; }
  }
  if (NR != 256) ss += __shfl_xor(ss, 1);
  if (part == 0) sc[row] = rsqrtf(ss / (float)K + EPS);
}


template <int NI, class V, class R>
DI void epi_store(u16* smem, V val, R rowfn) {
  const int t = opaque_tid();
  const int lane = t & 63, w = t >> 6, r = lane & 31, h = lane >> 5;
  char* reg = (char*)smem + w * 18432;
#pragma unroll
  for (int mi = 0; mi < 4; ++mi)
#pragma unroll
    for (int ni = 0; ni < NI; ++ni)
#pragma unroll
      for (int i = 0; i < 16; ++i)
        *(u16*)(reg + (mi * 32 + crow(i, h)) * 144 + (ni * 32 + r) * 2) = f2bf(val(mi, ni, i));
  __builtin_amdgcn_sched_barrier(0);
  constexpr int CPR = NI * 4;
  constexpr int RPI = 64 / CPR;
  const int rr = lane / CPR, ch = lane % CPR;
#pragma unroll
  for (int k = 0; k < 128 / RPI; ++k) {
    const int row = k * RPI + rr;
    u32x4 v = *(const u32x4*)(reg + row * 144 + ch * 16);
    rowfn(row, ch * 8, v);
  }
}

DI void tile_coords(int id, int MT, int NT, int& tm, int& tn) {
  const int per = 32 * NT;
  const int sr = id / per, rem = id - sr * per;
  tn = rem >> 5;
  tm = sr * 32 + (rem & 31);
}

#define EPI_LOOP                                   \
  _Pragma("unroll") for (int mi = 0; mi < 4; ++mi) \
  _Pragma("unroll") for (int ni = 0; ni < 2; ++ni) \
  _Pragma("unroll") for (int i = (__builtin_amdgcn_sched_barrier(0), 0); i < 16; ++i)

constexpr int SMEM_BYTES = 74752;

__global__ void __launch_bounds__(256, 2) fwd_megakernel(Params p) {
  cg::grid_group grid = cg::this_grid();
  __shared__ __attribute__((aligned(16))) char smem_raw[SMEM_BYTES];
  u16* smem = (u16*)smem_raw;
  const int G = gridDim.x;
  int bid = blockIdx.x;
  __shared__ uint4 xb_words;
  if (threadIdx.x == 0) xb_words = make_uint4(0u, 0u, 0u, 0u);
  __syncthreads();
  XcdBarrier xb = xcd_barrier_post((unsigned*)(p.ws + OFF_BAR), (volatile LAS unsigned*)&xb_words);

  char* ws = p.ws;
#define Wb ((u16*)(ws + OFF_WB))
#define ropec ((float*)(ws + OFF_ROPE))
#define ropes (((float*)(ws + OFF_ROPE)) + SEQ * 16)
#define Hb ((u16*)(ws + OFF_H))
#define Yb ((u16*)(ws + OFF_Y))
#define ACT ((u16*)(ws + OFF_ACT))
#define Z ((u16*)(ws + OFF_Z))
#define Qb ((u16*)(ws + OFF_Q))
#define KN ((u16*)(ws + OFF_KN))
#define VT ((u16*)(ws + OFF_VT))
#define KPE ((u16*)(ws + OFF_KPE))
#define OA ((u16*)(ws + OFF_OA))
#define ST ((u16*)(ws + OFF_ST))
#define DEC ((float*)(ws + OFF_DEC))
#define GC ((float*)(ws + OFF_GC))
#define OG ((u16*)(ws + OFF_OG))
#define MG ((u16*)(ws + OFF_MG))
  float* X = p.out;

  auto convert_weights = [&](int l) __attribute__((always_inline)) {
    const int t = opaque_tid();
    const int lane = t & 63, w = t >> 6, r = lane & 31, h = lane >> 5;
    const int wm = w >> 1, wn = w & 1;
    (void)lane; (void)r; (void)h; (void)wm; (void)wn;
    float* tile = (float*)smem_raw;
    for (int mat = 0; mat < 11; ++mat) {
      const float* src; int K, N; size_t dst; int map; const float* ksc = nullptr;
      switch (mat) {
        case 0: src = in_ptr(p, 3) + (size_t)l * DM * NFF2; K = DM; N = NFF2; dst = W_FFN1_IN; map = 1; break;
        case 1: src = in_ptr(p, 4) + (size_t)l * DFF * DM; K = DFF; N = DM; dst = W_FFN1_OUT; map = 0; break;
        case 2: src = in_ptr(p, 7) + (size_t)l * DM * PIN; K = DM; N = PIN; dst = W_IN; map = 0; break;
        case 3: src = in_ptr(p, 9) + (size_t)l * 256 * 768; K = 256; N = 768; dst = W_UQ; map = 0; ksc = in_ptr(p, 8) + l * 256; break;
        case 4: src = in_ptr(p, 11) + (size_t)l * 128 * 1024; K = 128; N = 1024; dst = W_KN; map = 2; ksc = in_ptr(p, 10) + l * 128; break;
        case 5: src = in_ptr(p, 12) + (size_t)l * 512 * DM; K = 512; N = DM; dst = W_OA; map = 0; break;
        case 6: src = in_ptr(p, 18) + (size_t)l * DM * DM; K = DM; N = DM; dst = W_OB; map = 0; break;
        case 7: src = in_ptr(p, 19) + (size_t)l * DM * DM; K = DM; N = DM; dst = W_OUT; map = 0; break;
        case 8: src = in_ptr(p, 22) + (size_t)l * DM * NFF2; K = DM; N = NFF2; dst = W_FFN2_IN; map = 1; break;
        case 9: src = in_ptr(p, 23) + (size_t)l * DFF * DM; K = DFF; N = DM; dst = W_FFN2_OUT; map = 0; break;
        default: src = nullptr; K = DM; N = 64; dst = W_IN + (size_t)PIN * DM; map = 3; break;
      }
      const int kt_n = K / 64, nt_n = N / 64;
      for (int id = bid; id < kt_n * nt_n; id += G) {
        const int kt = id % kt_n, nt = id / kt_n;
        const int k0 = kt * 64, n0 = nt * 64;
        __syncthreads();
        if (map != 3) {
#pragma unroll
          for (int i = 0; i < 4; ++i) {
            const int kk = (t >> 4) + 16 * i, nn = (t & 15) * 4;
            float4 v = *(const float4*)(src + (size_t)(k0 + kk) * N + n0 + nn);
            float sc = ksc ? ksc[k0 + kk] : 1.f;
            tile[kk * 65 + nn + 0] = v.x * sc; tile[kk * 65 + nn + 1] = v.y * sc;
            tile[kk * 65 + nn + 2] = v.z * sc; tile[kk * 65 + nn + 3] = v.w * sc;
          }
        }
        __syncthreads();
        const int nl = t >> 2, kc = (t & 3) * 16;
        const int n = n0 + nl;
        size_t drow;
        if (map == 0) drow = dst + (size_t)n * K;
        else if (map == 1) { const int isb = n >= DFF; const int j = n - isb * DFF; drow = dst + (size_t)((j >> 5) * 64 + isb * 32 + (j & 31)) * K; }
        else if (map == 2) { const int hd = n >> 7, cc = n & 127; drow = (cc < 64) ? (W_KN + (size_t)(hd * 64 + cc) * K) : (W_V + (size_t)(hd * 64 + cc - 64) * K); }
        else drow = dst + (size_t)nl * K;
        unsigned o[8];
#pragma unroll
        for (int j = 0; j < 8; ++j) {
          float a = (map == 3) ? 0.f : tile[(kc + 2 * j) * 65 + nl];
          float b = (map == 3) ? 0.f : tile[(kc + 2 * j + 1) * 65 + nl];
          o[j] = pk2(a, b);
        }
        uint4* dp = (uint4*)(Wb + drow + k0 + kc);
        dp[0] = make_uint4(o[0], o[1], o[2], o[3]);
        dp[1] = make_uint4(o[4], o[5], o[6], o[7]);
      }
    }
  };

  auto rn_pass = [&](int mode, float coef, const float* post_g, const float* pre_g) __attribute__((always_inline)) {
    const int t = opaque_tid();
    const int lane = t & 63, w = t >> 6, r = lane & 31, h = lane >> 5;
    const int wm = w >> 1, wn = w & 1;
    (void)lane; (void)r; (void)h; (void)wm; (void)wn;
    typedef float f4v __attribute__((ext_vector_type(4)));
    typedef unsigned u2v __attribute__((ext_vector_type(2)));
    const int gw = bid * 4 + w, nw = G * 4;
    constexpr int RB = 4;
    f4v pg[4], qg[4];
#pragma unroll
    for (int i = 0; i < 4; ++i) {
      pg[i] = (mode == 1) ? *(const f4v*)(post_g + lane * 4 + 256 * i) : (f4v){0.f, 0.f, 0.f, 0.f};
      qg[i] = pre_g ? *(const f4v*)(pre_g + lane * 4 + 256 * i) : (f4v){0.f, 0.f, 0.f, 0.f};
    }
    for (int row0 = gw; row0 < MALL; row0 += RB * nw) {
      f4v xv[RB][4];
      u2v yu[RB][4];
#pragma unroll
      for (int j = 0; j < RB; ++j) {
        int row = row0 + j * nw;
        if (row >= MALL) row = row0;
        const float* xs;
        if (mode == 0) xs = (row < SEQ) ? (in_ptr(p, 0) + (size_t)row * DM) : (in_ptr(p, 1) + (size_t)(row - SEQ) * DM);
        else xs = X + (size_t)row * DM;
#pragma unroll
        for (int i = 0; i < 4; ++i) xv[j][i] = *(const f4v*)(xs + lane * 4 + 256 * i);
        if (mode == 1) {
#pragma unroll
          for (int i = 0; i < 4; ++i) yu[j][i] = *(const u2v*)(Yb + (size_t)row * DM + lane * 4 + 256 * i);
        }
      }
#pragma unroll
      for (int j = 0; j < RB; ++j) {
        const int row = row0 + j * nw;
        if (row < MALL) {
          if (mode == 1) {
            float yv[16];
            float ss = 0.f;
#pragma unroll
            for (int i = 0; i < 4; ++i) {
              yv[4 * i + 0] = bflo(yu[j][i][0]); yv[4 * i + 1] = bfhi(yu[j][i][0]);
              yv[4 * i + 2] = bflo(yu[j][i][1]); yv[4 * i + 3] = bfhi(yu[j][i][1]);
            }
#pragma unroll
            for (int i = 0; i < 16; ++i) ss += yv[i] * yv[i];
            ss = wave_sum(ss);
            const float ry = rsqrtf(ss * (1.f / DM) + EPS) * coef;
#pragma unroll
            for (int i = 0; i < 4; ++i)
#pragma unroll
              for (int k = 0; k < 4; ++k) xv[j][i][k] += yv[4 * i + k] * ry * pg[i][k];
          }
#pragma unroll
          for (int i = 0; i < 4; ++i) *(f4v*)(X + (size_t)row * DM + lane * 4 + 256 * i) = xv[j][i];
          if (pre_g) {
            float ss = 0.f;
#pragma unroll
            for (int i = 0; i < 4; ++i)
#pragma unroll
              for (int k = 0; k < 4; ++k) ss += xv[j][i][k] * xv[j][i][k];
            ss = wave_sum(ss);
            const float rx = rsqrtf(ss * (1.f / DM) + EPS);
#pragma unroll
            for (int i = 0; i < 4; ++i) {
              u2v o;
              o[0] = pk2(xv[j][i][0] * rx * qg[i][0], xv[j][i][1] * rx * qg[i][1]);
              o[1] = pk2(xv[j][i][2] * rx * qg[i][2], xv[j][i][3] * rx * qg[i][3]);
              *(u2v*)(Hb + (size_t)row * DM + lane * 4 + 256 * i) = o;
            }
          }
        }
      }
    }
  };

  auto ffn_in = [&](size_t woff) __attribute__((always_inline)) {
    const int t = opaque_tid();
    const int lane = t & 63, w = t >> 6, r = lane & 31, h = lane >> 5;
    const int wm = w >> 1, wn = w & 1;
    (void)lane; (void)r; (void)h; (void)wm; (void)wn;
    const int MT = MALL / 256, NT = NFF2 / 128;
    for (int id = bid; id < MT * NT; id += G) {
      int tm, tn; tile_coords(id, MT, NT, tm, tn);
      const int m0 = tm * 256, n0 = tn * 128;
      Acc c; acc_zero(c);
      gemm_kloop(Hb + (size_t)m0 * DM, DM, Wb + woff + (size_t)n0 * DM, DM, DM, smem, c);
#ifdef DUP_KLOOP
      acc_zero(c);
      gemm_kloop(Hb + (size_t)m0 * DM, DM, Wb + woff + (size_t)n0 * DM, DM, DM, smem, c);
#endif
      const int jb0 = ((n0 + wn * 64) >> 6) * 32;
      const unsigned obase = (unsigned)((m0 + wm * 128) * DFF + jb0);
      epi_store<1>(smem,
        [&](int mi, int ni, int i) { return siluf_(c.a[mi][0][i]) * c.a[mi][1][i]; },
        [&](int row, int col, u32x4 v) { *(u32x4*)(ACT + obase + (unsigned)(row * DFF + col)) = v; });
    }
  };
  auto gemm_plain = [&](const u16* A, int lda, int K, const u16* Bt, u16* C, int ldc, int M, int N) __attribute__((always_inline)) {
    const int t = opaque_tid();
    const int lane = t & 63, w = t >> 6, r = lane & 31, h = lane >> 5;
    const int wm = w >> 1, wn = w & 1;
    (void)lane; (void)r; (void)h; (void)wm; (void)wn;
    const int MT = M / 256, NT = N / 128;
    for (int id = bid; id < MT * NT; id += G) {
      int tm, tn; tile_coords(id, MT, NT, tm, tn);
      const int m0 = tm * 256, n0 = tn * 128;
      Acc c; acc_zero(c);
      gemm_kloop(A + (size_t)m0 * lda, lda, Bt + (size_t)n0 * K, K, K, smem, c);
      const unsigned obase = (unsigned)((m0 + wm * 128) * ldc + n0 + wn * 64);
      epi_store<2>(smem,
        [&](int mi, int ni, int i) { return c.a[mi][ni][i]; },
        [&](int row, int col, u32x4 v) { *(u32x4*)(C + obase + (unsigned)(row * ldc + col)) = v; });
    }
  };

  auto prep_phase = [&](int l) __attribute__((always_inline)) {
    int pb_ = bid; asm volatile("" : "+s"(pb_));
    const int t = opaque_tid();
    const int lane = t & 63, w = t >> 6, r = lane & 31, h = lane >> 5;
    const int wm = w >> 1, wn = w & 1;
    (void)lane; (void)r; (void)h; (void)wm; (void)wn;
    float* sc = (float*)(smem_raw + 2 * GEMM_LDS);
    const int NQ = 64 * 6, NK = 64 * 4, NV = 2 * 128, NPE = 64, NG1 = NCHUNK * 4;
    const float qscale = 0.10206207261596577f * 1.4426950408889634f;
    {
      for (int id = pb_; id < NG1; id += G) {
        const int t = opaque_tid();
        const int lane = t & 63, w = t >> 6, r = lane & 31, h = lane >> 5;
        const int wm = w >> 1, wn = w & 1;
        (void)lane; (void)r; (void)h; (void)wm; (void)wn;
        const int n = id >> 2, hd = id & 3;
        const int t0 = n * 64;
        u16* ksT = smem;
        u16* vT = smem + 2 * 128 * LROW;
        u16* sk = vT;
        float* sga = (float*)(smem_raw + 55296);
        __syncthreads();
        {
          const int cc = t >> 2, part = t & 3;
          const u16* kp = Z + (size_t)(t0 + cc) * ZLD + Z_GK + hd * 128 + part * 32;
#pragma unroll
          for (int j = 0; j < 4; ++j) *(u32x4*)(sk + cc * 128 + part * 32 + j * 8) = *(const u32x4*)(kp + j * 8);
          u32x4 gv = *(const u32x4*)(Z + (size_t)(t0 + cc) * ZLD + Z_GA + part * 8);
#pragma unroll
          for (int k = 0; k < 4; ++k) { sga[cc * 32 + part * 8 + 2 * k] = bflo(gv[k]); sga[cc * 32 + part * 8 + 2 * k + 1] = bfhi(gv[k]); }
        }
        __syncthreads();
        {
          const int dir = t >> 7, d = t & 127;
          const float* wa2 = (dir ? in_ptr(p, 15) : in_ptr(p, 13)) + (size_t)l * 16 * 512 + hd * 128 + d;
          const float ba = ((dir ? in_ptr(p, 16) : in_ptr(p, 14)) + (size_t)l * 512)[hd * 128 + d];
          float wcol[16];
#pragma unroll
          for (int rr = 0; rr < 16; ++rr) wcol[rr] = wa2[rr * 512];
          const float* gar = sga + dir * 16;
          float tot = 0.f;
          for (int cc = 0; cc < 64; ++cc) {
            float pre = ba;
#pragma unroll
            for (int rr = 0; rr < 16; ++rr) pre += gar[cc * 32 + rr] * wcol[rr];
            tot += (fminf(pre, 0.f) - __logf(1.f + __expf(-fabsf(pre)))) * (1.f / 16.f);
          }
          DEC[((size_t)(n * 4 + hd) * 2 + dir) * 128 + d] = __expf(tot);
          float* gc = GC + (size_t)dir * SEQ * 512 + (size_t)t0 * 512 + hd * 128 + d;
          float cb = 0.f;
          u16* krow_out = ksT + (dir * 128 + d) * LROW;
          for (int ci = 0; ci < 64; ++ci) {
            const int cc = dir ? (63 - ci) : ci;
            float pre = ba;
#pragma unroll
            for (int rr = 0; rr < 16; ++rr) pre += gar[cc * 32 + rr] * wcol[rr];
            cb += (fminf(pre, 0.f) - __logf(1.f + __expf(-fabsf(pre)))) * (1.f / 16.f);
            gc[cc * 512] = cb;
            krow_out[cc] = f2bf(bf2f(sk[cc * 128 + d]) * __expf(tot - cb));
          }
        }
        for (int half = 0; half < 2; ++half) {
          __syncthreads();
          {
            const int cc = t & 63, part = t >> 6;
#pragma unroll
            for (int q = 0; q < 4; ++q) {
              const int cg8 = (part * 4 + q) * 8;
              uint4 v = *(const uint4*)(Z + (size_t)(t0 + cc) * ZLD + Z_GV + hd * 256 + half * 128 + cg8);
              unsigned u[4] = {v.x, v.y, v.z, v.w};
#pragma unroll
              for (int j = 0; j < 4; ++j) {
                vT[(cg8 + 2 * j) * LROW + cc] = (u16)(u[j] & 0xffffu);
                vT[(cg8 + 2 * j + 1) * LROW + cc] = (u16)(u[j] >> 16);
              }
            }
          }
          __syncthreads();
#pragma unroll
          for (int dir = 0; dir < 2; ++dir) {
            f32x16 acc[4];
#pragma unroll
            for (int j = 0; j < 4; ++j)
#pragma unroll
              for (int k = 0; k < 16; ++k) acc[j][k] = 0.f;
#pragma unroll
            for (int ks = 0; ks < 4; ++ks) {
              bf16x8 fa = *(const bf16x8*)(vT + (w * 32 + r) * LROW + ks * 16 + h * 8);
#pragma unroll
              for (int nt = 0; nt < 4; ++nt) {
                bf16x8 fb = *(const bf16x8*)(ksT + (dir * 128 + nt * 32 + r) * LROW + ks * 16 + h * 8);
                acc[nt] = MFMA(fb, fa, acc[nt]);
              }
            }
            u16* stp = ST + ((size_t)(n * 4 + hd) * 2 + dir) * 32768;
#pragma unroll
            for (int nt = 0; nt < 4; ++nt)
#pragma unroll
              for (int g4 = 0; g4 < 4; ++g4) {
                uint2 o;
                o.x = pk2(acc[nt][4 * g4 + 0], acc[nt][4 * g4 + 1]);
                o.y = pk2(acc[nt][4 * g4 + 2], acc[nt][4 * g4 + 3]);
                *(uint2*)(stp + (unsigned)((half * 128 + w * 32 + r) * 128 + nt * 32 + 8 * g4 + 4 * h)) = o;
              }
          }
        }
      }
      for (int q = pb_; q < NQ; q += G) {
        const int t = opaque_tid();
        const int lane = t & 63, w = t >> 6, r = lane & 31, h = lane >> 5;
        const int wm = w >> 1, wn = w & 1;
        (void)lane; (void)r; (void)h; (void)wm; (void)wn;
        const int tm = q / 6, tn = q % 6;
        const int m0 = tm * 256, n0 = tn * 128;
        __syncthreads();
        row_scales(Z + (size_t)m0 * ZLD + Z_CQ, ZLD, 256, sc, 256);
        Acc c; acc_zero(c);
        gemm_kloop(Z + (size_t)m0 * ZLD + Z_CQ, ZLD, Wb + W_UQ + (size_t)n0 * 256, 256, 256, smem, c);
        {
          const unsigned obase = (unsigned)((m0 + wm * 128) * 768 + n0 + wn * 64);
          epi_store<2>(smem,
            [&](int mi, int ni, int i) {
              const int cb0 = n0 + wn * 64 + ni * 32;
              const bool rope = ((cb0 >> 5) % 3) == 2;
              const int rl = wm * 128 + mi * 32 + crow(i, h);
              float v = c.a[mi][ni][i] * sc[rl];
              const float pv = __shfl_xor(v, 16);
              if (rope) {
                const int row = m0 + rl;
                const float cs = ropec[row * 16 + (r & 15)], sn = ropes[row * 16 + (r & 15)];
                v = (r < 16) ? (v * cs - pv * sn) : (v * cs + pv * sn);
              }
              return v * qscale;
            },
            [&](int row, int col, u32x4 v) { *(u32x4*)(Qb + obase + (unsigned)(row * 768 + col)) = v; });
        }
      }
      for (int q = (pb_ + G - (NQ % G)) % G; q < NK; q += G) {
        const int t = opaque_tid();
        const int lane = t & 63, w = t >> 6, r = lane & 31, h = lane >> 5;
        const int wm = w >> 1, wn = w & 1;
        (void)lane; (void)r; (void)h; (void)wm; (void)wn;
        const int tm = q >> 2, tn = q & 3;
        const int m0 = tm * 256, n0 = tn * 128;
        __syncthreads();
        row_scales(Z + (size_t)m0 * ZLD + Z_CKV, ZLD, 128, sc, 256);
        Acc c; acc_zero(c);
        gemm_kloop(Z + (size_t)m0 * ZLD + Z_CKV, ZLD, Wb + W_KN + (size_t)n0 * 128, 128, 128, smem, c);
        {
          const unsigned obase = (unsigned)((m0 + wm * 128) * 512 + n0 + wn * 64);
          epi_store<2>(smem,
            [&](int mi, int ni, int i) { return c.a[mi][ni][i] * sc[wm * 128 + mi * 32 + crow(i, h)]; },
            [&](int row, int col, u32x4 v) { *(u32x4*)(KN + obase + (unsigned)(row * 512 + col)) = v; });
        }
      }
      for (int q = (pb_ + G - ((NQ + NK) % G)) % G; q < NV; q += G) {
        const int t = opaque_tid();
        const int lane = t & 63, w = t >> 6, r = lane & 31, h = lane >> 5;
        const int wm = w >> 1, wn = w & 1;
        (void)lane; (void)r; (void)h; (void)wm; (void)wn;
        const int tm = q & 1, tn = q >> 1;
        const int m0 = tm * 256, n0 = tn * 128;
        __syncthreads();
        row_scales(Z + (size_t)n0 * ZLD + Z_CKV, ZLD, 128, sc, 128);
        Acc c; acc_zero(c);
        gemm_kloop(Wb + W_V + (size_t)m0 * 128, 128, Z + (size_t)n0 * ZLD + Z_CKV, ZLD, 128, smem, c);
        {
          const unsigned obase = (unsigned)((m0 + wm * 128) * SEQ + n0 + wn * 64);
          epi_store<2>(smem,
            [&](int mi, int ni, int i) { return c.a[mi][ni][i] * sc[wn * 64 + ni * 32 + r]; },
            [&](int row, int col, u32x4 v) { *(u32x4*)(VT + obase + (unsigned)(row * SEQ + col)) = v; });
        }
      }
      for (int q = (pb_ + G - ((NQ + NK + NV) % G)) % G; q < NPE; q += G) {
        const int t = opaque_tid();
        const int lane = t & 63, w = t >> 6, r = lane & 31, h = lane >> 5;
        const int wm = w >> 1, wn = w & 1;
        (void)lane; (void)r; (void)h; (void)wm; (void)wn;
        const int tok = q * 256 + t;
        const u16* src = Z + (size_t)tok * ZLD + Z_KPE;
        float v[32];
#pragma unroll
        for (int j = 0; j < 4; ++j) {
          uint4 u = *(const uint4*)(src + j * 8);
          unsigned uu[4] = {u.x, u.y, u.z, u.w};
#pragma unroll
          for (int k = 0; k < 4; ++k) { v[j * 8 + 2 * k] = bflo(uu[k]); v[j * 8 + 2 * k + 1] = bfhi(uu[k]); }
        }
        float o[32];
#pragma unroll
        for (int i = 0; i < 16; ++i) {
          const float cs = ropec[tok * 16 + i], sn = ropes[tok * 16 + i];
          o[i] = v[i] * cs - v[i + 16] * sn;
          o[i + 16] = v[i + 16] * cs + v[i] * sn;
        }
#pragma unroll
        for (int j = 0; j < 4; ++j) {
          uint4 u;
          u.x = pk2(o[j * 8 + 0], o[j * 8 + 1]); u.y = pk2(o[j * 8 + 2], o[j * 8 + 3]);
          u.z = pk2(o[j * 8 + 4], o[j * 8 + 5]); u.w = pk2(o[j * 8 + 6], o[j * 8 + 7]);
          *(uint4*)(KPE + (size_t)tok * 32 + j * 8) = u;
        }
      }
    }
  };

  auto attn_phase = [&](int mode) __attribute__((always_inline)) {
    const int t = opaque_tid();
    const int lane = t & 63, w = t >> 6, r = lane & 31, h = lane >> 5;
    const int wm = w >> 1, wn = w & 1;
    (void)lane; (void)r; (void)h; (void)wm; (void)wn;
    if (mode & 1) for (int id = bid; id < 512; id += G) {
      const int e = id * 256 + t;
      const int d2 = e & 63, v = (e >> 6) & 255, dir = (e >> 14) & 1, hd = e >> 15;
      float s0 = 0.f, s1 = 0.f;
      const size_t eoff = (size_t)v * 128 + 2 * d2;
      for (int i0 = 0; i0 < NCHUNK; i0 += 16) {
        unsigned uu[16];
        float2 dd[16];
#pragma unroll
        for (int j = 0; j < 16; ++j) {
          const int n = dir ? (NCHUNK - 1 - (i0 + j)) : (i0 + j);
          const size_t base = ((size_t)(n * 4 + hd) * 2 + dir);
          uu[j] = *(const unsigned*)(ST + base * 32768 + eoff);
          dd[j] = *(const float2*)(DEC + base * 128 + 2 * d2);
        }
#pragma unroll
        for (int j = 0; j < 16; ++j) {
          const int n = dir ? (NCHUNK - 1 - (i0 + j)) : (i0 + j);
          const size_t base = ((size_t)(n * 4 + hd) * 2 + dir);
          *(unsigned*)(ST + base * 32768 + eoff) = pk2(s0, s1);
          s0 = dd[j].x * s0 + bflo(uu[j]);
          s1 = dd[j].y * s1 + bfhi(uu[j]);
        }
      }
    }
    constexpr int KROW = 104;
    constexpr int VR = 68;
    constexpr int ABUF = 64 * KROW + 64 * VR;
    u16* sK = smem;
    u16* sV = smem + 64 * KROW;
    if (mode & 2) for (int id = bid; id < 8 * 64; id += G) {
      const int hd = id & 7, qb = id >> 3;
      const int q0 = qb * 256 + w * 64;
      bf16x8 bq[2][6];
#pragma unroll
      for (int qt = 0; qt < 2; ++qt)
#pragma unroll
        for (int ks = 0; ks < 6; ++ks) bq[qt][ks] = *(const bf16x8*)(Qb + (size_t)(q0 + qt * 32 + r) * 768 + hd * 96 + ks * 16 + h * 8);
      f32x16 O[2][2];
#pragma unroll
      for (int j = 0; j < 2; ++j)
#pragma unroll
        for (int qt = 0; qt < 2; ++qt)
#pragma unroll
          for (int k = 0; k < 16; ++k) O[j][qt][k] = 0.f;
      float m[2] = {0.f, 0.f}, lsum[2] = {0.f, 0.f};
      const int kr = t >> 2, kc = t & 3;
      const u16* knp = KN + (size_t)kr * 512 + hd * 64 + kc * 16;
      const u16* kpp = KPE + (size_t)kr * 32 + kc * 8;
      const u16* vpp = VT + (size_t)(hd * 64 + kr) * SEQ + kc * 16;
      u32x4 rk[3], rv[2];
      rk[0] = *(const u32x4*)(knp);
      rk[1] = *(const u32x4*)(knp + 8);
      rk[2] = *(const u32x4*)(kpp);
      rv[0] = *(const u32x4*)(vpp);
      rv[1] = *(const u32x4*)(vpp + 8);
      __syncthreads();
      *(u32x4*)(sK + kr * KROW + kc * 16) = rk[0];
      *(u32x4*)(sK + kr * KROW + kc * 16 + 8) = rk[1];
      *(u32x4*)(sK + kr * KROW + 64 + kc * 8) = rk[2];
      *(uint2*)(sV + kr * VR + kc * 16) = make_uint2(rv[0][0], rv[0][1]);
      *(uint2*)(sV + kr * VR + kc * 16 + 4) = make_uint2(rv[0][2], rv[0][3]);
      *(uint2*)(sV + kr * VR + kc * 16 + 8) = make_uint2(rv[1][0], rv[1][1]);
      *(uint2*)(sV + kr * VR + kc * 16 + 12) = make_uint2(rv[1][2], rv[1][3]);
      rk[0] = *(const u32x4*)(knp + (size_t)64 * 512);
      rk[1] = *(const u32x4*)(knp + (size_t)64 * 512 + 8);
      rk[2] = *(const u32x4*)(kpp + (size_t)64 * 32);
      rv[0] = *(const u32x4*)(vpp + 64);
      rv[1] = *(const u32x4*)(vpp + 64 + 8);
      __syncthreads();
      int cur = 0;
      for (int key0 = 0; key0 < SEQ; key0 += 64) {
        const u16* cK = sK + cur * ABUF;
        const u16* cV = sV + cur * ABUF;
        {
          u16* nK = sK + (cur ^ 1) * ABUF;
          u16* nV = sV + (cur ^ 1) * ABUF;
          *(u32x4*)(nK + kr * KROW + kc * 16) = rk[0];
          *(u32x4*)(nK + kr * KROW + kc * 16 + 8) = rk[1];
          *(u32x4*)(nK + kr * KROW + 64 + kc * 8) = rk[2];
          *(uint2*)(nV + kr * VR + kc * 16) = make_uint2(rv[0][0], rv[0][1]);
          *(uint2*)(nV + kr * VR + kc * 16 + 4) = make_uint2(rv[0][2], rv[0][3]);
          *(uint2*)(nV + kr * VR + kc * 16 + 8) = make_uint2(rv[1][0], rv[1][1]);
          *(uint2*)(nV + kr * VR + kc * 16 + 12) = make_uint2(rv[1][2], rv[1][3]);
          const int kn = (key0 + 128 < SEQ) ? (key0 + 128) : key0;
          rk[0] = *(const u32x4*)(knp + (size_t)kn * 512);
          rk[1] = *(const u32x4*)(knp + (size_t)kn * 512 + 8);
          rk[2] = *(const u32x4*)(kpp + (size_t)kn * 32);
          rv[0] = *(const u32x4*)(vpp + kn);
          rv[1] = *(const u32x4*)(vpp + kn + 8);
        }
        __builtin_amdgcn_sched_barrier(0);
        f32x16 S[2][2];
#pragma unroll
        for (int kt = 0; kt < 2; ++kt)
#pragma unroll
          for (int qt = 0; qt < 2; ++qt)
#pragma unroll
            for (int k = 0; k < 16; ++k) S[kt][qt][k] = -m[qt];
#pragma unroll
        for (int ks = 0; ks < 6; ++ks)
#pragma unroll
          for (int kt = 0; kt < 2; ++kt) {
            bf16x8 fa = *(const bf16x8*)(cK + (kt * 32 + r) * KROW + ks * 16 + h * 8);
            S[kt][0] = MFMA(fa, bq[0][ks], S[kt][0]);
            S[kt][1] = MFMA(fa, bq[1][ks], S[kt][1]);
          }
        bf16x8 pf[2][4];
#pragma unroll
        for (int qt = 0; qt < 2; ++qt) {
          float mloc = S[0][qt][0];
#pragma unroll
          for (int kt = 0; kt < 2; ++kt)
#pragma unroll
            for (int k = 0; k < 16; ++k) mloc = fmaxf(mloc, S[kt][qt][k]);
          mloc = fmaxf(mloc, __shfl_xor(mloc, 32));
          if (__builtin_amdgcn_ballot_w64(mloc > 0.f) != 0ull) {
            const float delta = fmaxf(mloc, 0.f);
            const float alpha = __builtin_amdgcn_exp2f(-delta);
            m[qt] += delta;
            lsum[qt] *= alpha;
#pragma unroll
            for (int j = 0; j < 2; ++j)
#pragma unroll
              for (int k = 0; k < 16; ++k) O[j][qt][k] *= alpha;
#pragma unroll
            for (int kt = 0; kt < 2; ++kt)
#pragma unroll
              for (int k = 0; k < 16; ++k) S[kt][qt][k] -= delta;
          }
          float ps = 0.f;
#pragma unroll
          for (int kt = 0; kt < 2; ++kt)
#pragma unroll
            for (int k = 0; k < 16; ++k) { S[kt][qt][k] = __builtin_amdgcn_exp2f(S[kt][qt][k]); ps += S[kt][qt][k]; }
          lsum[qt] += ps;
#pragma unroll
          for (int s2 = 0; s2 < 4; ++s2) {
            const int kt = s2 >> 1, sx = s2 & 1;
            unsigned pw[4];
#pragma unroll
            for (int j = 0; j < 4; ++j) pw[j] = pk2(S[kt][qt][8 * sx + 2 * j], S[kt][qt][8 * sx + 2 * j + 1]);
            pf[qt][s2] = __builtin_bit_cast(bf16x8, make_uint4(pw[0], pw[1], pw[2], pw[3]));
          }
        }
#pragma unroll
        for (int s2 = 0; s2 < 4; ++s2) {
          const int kt = s2 >> 1, sx = s2 & 1;
#pragma unroll
          for (int dt = 0; dt < 2; ++dt) {
            const u16* vp = cV + (dt * 32 + r) * VR + kt * 32 + 16 * sx + 4 * h;
            uint2 lo = *(const uint2*)(vp);
            uint2 hi = *(const uint2*)(vp + 8);
            bf16x8 fv = __builtin_bit_cast(bf16x8, make_uint4(lo.x, lo.y, hi.x, hi.y));
            O[dt][0] = MFMA(fv, pf[0][s2], O[dt][0]);
            O[dt][1] = MFMA(fv, pf[1][s2], O[dt][1]);
          }
        }
        cur ^= 1;
        __syncthreads();
      }
#pragma unroll
      for (int qt = 0; qt < 2; ++qt) {
        const float lt = lsum[qt] + __shfl_xor(lsum[qt], 32);
        const float inv = 1.f / lt;
#pragma unroll
        for (int dt = 0; dt < 2; ++dt)
#pragma unroll
          for (int g4 = 0; g4 < 4; ++g4) {
            uint2 o;
            o.x = pk2(O[dt][qt][4 * g4 + 0] * inv, O[dt][qt][4 * g4 + 1] * inv);
            o.y = pk2(O[dt][qt][4 * g4 + 2] * inv, O[dt][qt][4 * g4 + 3] * inv);
            *(uint2*)(OA + (size_t)(q0 + qt * 32 + r) * 512 + hd * 64 + dt * 32 + 8 * g4 + 4 * h) = o;
          }
      }
    }
  };

  auto gla_out_phase = [&](int l) __attribute__((always_inline)) {
    const int t = opaque_tid();
    const int lane = t & 63, w = t >> 6, r = lane & 31, h = lane >> 5;
    const int wm = w >> 1, wn = w & 1;
    (void)lane; (void)r; (void)h; (void)wm; (void)wn;
    constexpr int QROW = 136;
    u16* sQ = smem;
    u16* sKt = smem + 64 * QROW;
    u16* sVT = smem + 2 * 64 * QROW;
    float* sred = (float*)(smem + 2 * 64 * QROW + 256 * LROW);
    u16* sO = smem;
    constexpr int OROW = 264;
    const float qs = 0.08838834764831845f;
    const int cs = w & 1, vh = w >> 1;
    for (int id = bid; id < NCHUNK * 4; id += G) {
      const int n = id >> 2, hd = id & 3;
      const int t0 = n * 64;
      __syncthreads();
      {
        const int cc = t & 63, part = t >> 6;
#pragma unroll
        for (int q = 0; q < 8; ++q) {
          const int cg8 = (part * 8 + q) * 8;
          uint4 v = *(const uint4*)(Z + (size_t)(t0 + cc) * ZLD + Z_GV + hd * 256 + cg8);
          unsigned u[4] = {v.x, v.y, v.z, v.w};
#pragma unroll
          for (int j = 0; j < 4; ++j) {
            sVT[(cg8 + 2 * j) * LROW + cc] = (u16)(u[j] & 0xffffu);
            sVT[(cg8 + 2 * j + 1) * LROW + cc] = (u16)(u[j] >> 16);
          }
        }
      }
      f32x16 acc[4];
#pragma unroll
      for (int j = 0; j < 4; ++j)
#pragma unroll
        for (int k = 0; k < 16; ++k) acc[j][k] = 0.f;
      for (int dir = 0; dir < 2; ++dir) {
        __syncthreads();
        {
          const int cc = t >> 2, dp = (t & 3) * 32;
          const u16* qp = Z + (size_t)(t0 + cc) * ZLD + Z_GQ + hd * 128 + dp;
          const u16* kp = Z + (size_t)(t0 + cc) * ZLD + Z_GK + hd * 128 + dp;
          const float* gp = GC + (size_t)dir * SEQ * 512 + (size_t)(t0 + cc) * 512 + hd * 128 + dp;
#pragma unroll
          for (int j = 0; j < 4; ++j) {
            uint4 qv = *(const uint4*)(qp + j * 8);
            uint4 kv = *(const uint4*)(kp + j * 8);
            float4 g0 = *(const float4*)(gp + j * 8);
            float4 g1 = *(const float4*)(gp + j * 8 + 4);
            const float gg[8] = {g0.x, g0.y, g0.z, g0.w, g1.x, g1.y, g1.z, g1.w};
            const unsigned qu[4] = {qv.x, qv.y, qv.z, qv.w};
            const unsigned ku[4] = {kv.x, kv.y, kv.z, kv.w};
            unsigned qo[4], ko[4];
#pragma unroll
            for (int k = 0; k < 4; ++k) {
              const float e0 = __expf(gg[2 * k]), e1 = __expf(gg[2 * k + 1]);
              qo[k] = pk2(bflo(qu[k]) * qs * e0, bfhi(qu[k]) * qs * e1);
              ko[k] = pk2(bflo(ku[k]) / e0, bfhi(ku[k]) / e1);
            }
            *(uint4*)(sQ + cc * QROW + dp + j * 8) = make_uint4(qo[0], qo[1], qo[2], qo[3]);
            *(uint4*)(sKt + cc * QROW + dp + j * 8) = make_uint4(ko[0], ko[1], ko[2], ko[3]);
            if (j == 1) __builtin_amdgcn_sched_barrier(0);
          }
        }
        __syncthreads();
        const u16* bqp = sQ + (cs * 32 + r) * QROW + h * 8;
        const u16* stp = ST + ((size_t)(n * 4 + hd) * 2 + dir) * 32768;
        bf16x8 fs[2][4];
#pragma unroll
        for (int ks = 0; ks < 4; ++ks) fs[0][ks] = *(const bf16x8*)(stp + (size_t)(vh * 128 + r) * 128 + ks * 16 + h * 8);
        f32x16 at[2];
#pragma unroll
        for (int et = 0; et < 2; ++et) {
#pragma unroll
          for (int k = 0; k < 16; ++k) at[et][k] = 0.f;
#pragma unroll
          for (int ks = 0; ks < 8; ++ks) {
            bf16x8 fa = *(const bf16x8*)(sKt + (et * 32 + r) * QROW + ks * 16 + h * 8);
            bf16x8 fbq = *(const bf16x8*)(bqp + ks * 16);
            at[et] = MFMA(fa, fbq, at[et]);
          }
          const int cidx = cs * 32 + r;
#pragma unroll
          for (int k = 0; k < 16; ++k) {
            const int e = et * 32 + crow(k, h);
            const bool keep = dir ? (e >= cidx) : (e <= cidx);
            at[et][k] = keep ? at[et][k] : 0.f;
          }
        }
#pragma unroll
        for (int s2 = 0; s2 < 4; ++s2) {
          const int et = s2 >> 1, s = s2 & 1;
          unsigned pw[4];
#pragma unroll
          for (int j = 0; j < 4; ++j) pw[j] = pk2(at[et][8 * s + 2 * j], at[et][8 * s + 2 * j + 1]);
          bf16x8 pf = __builtin_bit_cast(bf16x8, make_uint4(pw[0], pw[1], pw[2], pw[3]));
#pragma unroll
          for (int mt = 0; mt < 4; ++mt) {
            const u16* vp = sVT + (vh * 128 + mt * 32 + r) * LROW + et * 32 + 16 * s + 4 * h;
            uint2 lo = *(const uint2*)(vp);
            uint2 hi = *(const uint2*)(vp + 8);
            bf16x8 fv = __builtin_bit_cast(bf16x8, make_uint4(lo.x, lo.y, hi.x, hi.y));
            acc[mt] = MFMA(fv, pf, acc[mt]);
          }
        }
#pragma unroll
        for (int bb = 0; bb < 8; ++bb) {
          const int mt = bb >> 1, kb = bb & 1;
          if (bb + 1 < 8) {
            const int mt1 = (bb + 1) >> 1, kb1 = (bb + 1) & 1;
#pragma unroll
            for (int ks = 0; ks < 4; ++ks) fs[(bb + 1) & 1][ks] = *(const bf16x8*)(stp + (size_t)(vh * 128 + mt1 * 32 + r) * 128 + (kb1 * 4 + ks) * 16 + h * 8);
          }
          __builtin_amdgcn_sched_barrier(0);
#pragma unroll
          for (int ks = 0; ks < 4; ++ks) { bf16x8 fbq = *(const bf16x8*)(bqp + (kb * 4 + ks) * 16); acc[mt] = MFMA(fs[bb & 1][ks], fbq, acc[mt]); }
          __builtin_amdgcn_sched_barrier(0);
        }
      }
      float ss = 0.f;
#pragma unroll
      for (int mt = 0; mt < 4; ++mt)
#pragma unroll
        for (int k = 0; k < 16; ++k) ss += acc[mt][k] * acc[mt][k];
      ss += __shfl_xor(ss, 32);
      if (h == 0) sred[vh * 64 + cs * 32 + r] = ss;
      __syncthreads();
      const float rs = rsqrtf((sred[cs * 32 + r] + sred[64 + cs * 32 + r]) * (1.f / 256.f) + EPS);
#pragma unroll
      for (int mt = 0; mt < 4; ++mt)
#pragma unroll
        for (int g4 = 0; g4 < 4; ++g4) {
          uint2 o;
          o.x = pk2(acc[mt][4 * g4 + 0] * rs, acc[mt][4 * g4 + 1] * rs);
          o.y = pk2(acc[mt][4 * g4 + 2] * rs, acc[mt][4 * g4 + 3] * rs);
          *(uint2*)(sO + (cs * 32 + r) * OROW + vh * 128 + mt * 32 + 8 * g4 + 4 * h) = o;
        }
      __syncthreads();
      {
        const int t3 = opaque_tid();
        const int cc = t3 >> 2, vp0 = (t3 & 3) * 64;
        const float* ng = in_ptr(p, 17) + (size_t)l * 256;
#pragma unroll
        for (int j = 0; j < 8; ++j) {
          const int v0 = vp0 + j * 8;
          uint4 ov = *(const uint4*)(sO + cc * OROW + v0);
          uint4 gv = *(const uint4*)(Z + (size_t)(t0 + cc) * ZLD + Z_GOG + hd * 256 + v0);
          float4 n0 = *(const float4*)(ng + v0), n1 = *(const float4*)(ng + v0 + 4);
          const float nn[8] = {n0.x, n0.y, n0.z, n0.w, n1.x, n1.y, n1.z, n1.w};
          const unsigned ou[4] = {ov.x, ov.y, ov.z, ov.w};
          const unsigned gu[4] = {gv.x, gv.y, gv.z, gv.w};
          unsigned res[4];
#pragma unroll
          for (int k = 0; k < 4; ++k)
            res[k] = pk2(bflo(ou[k]) * nn[2 * k] * siluf_(bflo(gu[k])), bfhi(ou[k]) * nn[2 * k + 1] * siluf_(bfhi(gu[k])));
          *(uint4*)(OG + (size_t)(t0 + cc) * DM + hd * 256 + v0) = make_uint4(res[0], res[1], res[2], res[3]);
        }
      }
    }
  };

  auto merge_phase = [&]() __attribute__((always_inline)) {
    const int t = opaque_tid();
    const int lane = t & 63, w = t >> 6, r = lane & 31, h = lane >> 5;
    const int wm = w >> 1, wn = w & 1;
    (void)lane; (void)r; (void)h; (void)wm; (void)wn;
    const int MT = SEQ / 256, NT = DM / 128;
    for (int id = bid; id < MT * NT; id += G) {
      int tm, tn; tile_coords(id, MT, NT, tm, tn);
      const int m0 = tm * 256, n0 = tn * 128;
      Acc c; acc_zero(c);
      gemm_kloop(OA + (size_t)m0 * 512, 512, Wb + W_OA + (size_t)n0 * 512, 512, 512, smem, c);
      {
        const unsigned zbase = (unsigned)((m0 + wm * 128) * ZLD + Z_BG + n0 + wn * 64);
        const unsigned obase = (unsigned)((m0 + wm * 128) * DM + n0 + wn * 64);
        epi_store<2>(smem,
          [&](int mi, int ni, int i) { return c.a[mi][ni][i]; },
          [&](int row, int col, u32x4 v) {
            const u32x4 g = *(const u32x4*)(Z + zbase + (unsigned)(row * ZLD + col));
            u32x4 o;
#pragma unroll
            for (int k = 0; k < 4; ++k) o[k] = pk2(bflo(v[k]) * sigmoidf_(bflo(g[k])), bfhi(v[k]) * sigmoidf_(bfhi(g[k])));
            *(u32x4*)(MG + obase + (unsigned)(row * DM + col)) = o;
          });
      }
      acc_zero(c);
      gemm_kloop(OG + (size_t)m0 * DM, DM, Wb + W_OB + (size_t)n0 * DM, DM, DM, smem, c);
      {
        const int t2 = opaque_tid();
        const int wm2 = t2 >> 7, wn2 = (t2 >> 6) & 1;
        const unsigned zbase = (unsigned)((m0 + wm2 * 128) * ZLD + Z_BG + DM + n0 + wn2 * 64);
        const unsigned obase = (unsigned)((m0 + wm2 * 128) * DM + n0 + wn2 * 64);
        epi_store<2>(smem,
          [&](int mi, int ni, int i) { return c.a[mi][ni][i]; },
          [&](int row, int col, u32x4 v) {
            const u32x4 g = *(const u32x4*)(Z + zbase + (unsigned)(row * ZLD + col));
            const u32x4 pm = *(const u32x4*)(MG + obase + (unsigned)(row * DM + col));
            u32x4 o;
#pragma unroll
            for (int k = 0; k < 4; ++k)
              o[k] = pk2(bflo(pm[k]) + bflo(v[k]) * sigmoidf_(bflo(g[k])), bfhi(pm[k]) + bfhi(v[k]) * sigmoidf_(bfhi(g[k])));
            *(u32x4*)(MG + obase + (unsigned)(row * DM + col)) = o;
          });
      }
    }
  };

  for (int i = bid * 256 + opaque_tid(); i < SEQ * 16; i += G * 256) {
    const int pos = i >> 4, j = i & 15;
    const float inv_freq = exp2f(-(float)j * 0.8304820237218406f);
    const float angf = (float)pos * inv_freq;
    double a = (double)angf;
    const double twopi = 6.283185307179586476925286766559;
    a -= twopi * rint(a / twopi);
    const float af = (float)a;
    ropec[i] = __cosf(af);
    ropes[i] = __sinf(af);
  }
  convert_weights(0);
  rn_pass(0, 0.f, nullptr, in_ptr(p, 2));
  grid.sync();

  for (int l = 0; l < 4; ++l) {
    asm volatile("" : "+s"(bid));
    ffn_in(W_FFN1_IN);
#ifdef DUP_FFNIN
    xcd_barrier(xb);
    ffn_in(W_FFN1_IN);
#endif
    xcd_barrier(xb);
    gemm_plain(ACT, DFF, DFF, Wb + W_FFN1_OUT, Yb, DM, MALL, DM);
    xcd_barrier(xb);
    rn_pass(1, 0.5f, in_ptr(p, 5) + l * DM, in_ptr(p, 6) + l * DM);
    xcd_barrier(xb);
    for (int s = 0; s < NSEQ; ++s) {
      asm volatile("" : "+s"(bid));
      gemm_plain(Hb + (size_t)s * SEQ * DM, DM, DM, Wb + W_IN, Z, ZLD, SEQ, ZLD);
      xcd_barrier(xb);
      prep_phase(l);
#ifdef DUP_PREP
      xcd_barrier(xb);
      prep_phase(l);
#endif
      xcd_barrier(xb);
      attn_phase(1);
      xcd_barrier(xb);
      int bpar_ = bid; asm volatile("" : "+s"(bpar_));
      if (bpar_ & 1) { attn_phase(2); gla_out_phase(l); }
      else { gla_out_phase(l); attn_phase(2); }
      xcd_barrier(xb);
      merge_phase();
      xcd_barrier(xb);
      gemm_plain(MG, DM, DM, Wb + W_OUT, Yb + (size_t)s * SEQ * DM, DM, SEQ, DM);
      xcd_barrier(xb);
    }
    rn_pass(1, 1.0f, in_ptr(p, 20) + l * DM, in_ptr(p, 21) + l * DM);
    xcd_barrier(xb);
    ffn_in(W_FFN2_IN);
    xcd_barrier(xb);
    gemm_plain(ACT, DFF, DFF, Wb + W_FFN2_OUT, Yb, DM, MALL, DM);
    xcd_barrier(xb);
    rn_pass(1, 0.5f, in_ptr(p, 24) + l * DM, (l < 3) ? (in_ptr(p, 2) + (l + 1) * DM) : nullptr);
    if (l < 3) convert_weights(l + 1);
    xcd_barrier(xb);
  }
}

extern "C" void kernel_launch(void* const* d_in, const int* in_sizes, int n_in, void* d_out,
                              int out_size, void* d_ws, size_t ws_size, hipStream_t stream) {
  static int grid_blocks = 0;
  if (!grid_blocks) {
    int dev = 0, cus = 0, per_cu = 0;
    (void)hipGetDevice(&dev);
    (void)hipDeviceGetAttribute(&cus, hipDeviceAttributeMultiprocessorCount, dev);
    (void)hipOccupancyMaxActiveBlocksPerMultiprocessor(&per_cu, fwd_megakernel, 256, 0);
    if (per_cu > 2) per_cu = 2;
    if (per_cu < 1) per_cu = 1;
    grid_blocks = cus * per_cu;
  }
  Params p{};
  for (int i = 0; i < 25; ++i) p.in[i] = (const float*)d_in[i];
  p.out = (float*)d_out;
  p.ws = (char*)d_ws;
  (void)hipMemsetAsync((char*)d_ws + OFF_BAR, 0, XCD_BAR_WORDS * 4, stream);
  void* args[] = {&p};
  hipError_t e = hipLaunchCooperativeKernel((void*)fwd_megakernel, dim3(grid_blocks), dim3(256), args, 0, stream);
  if (e != hipSuccess) fprintf(stderr, "cooperative launch failed: %s (grid %d)\n", hipGetErrorString(e), grid_blocks);
}
```

```cpp
#include <hip/hip_runtime.h>
#include <hip/hip_cooperative_groups.h>
#include <cstdio>
namespace cg = cooperative_groups;

typedef unsigned short u16;
typedef short bf16x8 __attribute__((ext_vector_type(8)));
typedef short s16x4 __attribute__((ext_vector_type(4)));
typedef float f32x16 __attribute__((ext_vector_type(16)));
typedef __bf16 bf2_t __attribute__((ext_vector_type(2)));
typedef float f2_t __attribute__((ext_vector_type(2)));
typedef unsigned u32x4 __attribute__((ext_vector_type(4)));
#define DI __device__ __forceinline__
#define MFMA(a, b, c) __builtin_amdgcn_mfma_f32_32x32x16_bf16((a), (b), (c), 0, 0, 0)

constexpr int SEQ = 16384;
constexpr int NSEQ = 3;
constexpr int MALL = SEQ * NSEQ;
constexpr int DM = 1024;
constexpr int DFF = 2816;
constexpr int NFF2 = 5632;
constexpr int PIN = 5568;
constexpr int ZLD = 5632;
constexpr int Z_CQ = 0, Z_CKV = 256, Z_KPE = 384, Z_GQ = 416, Z_GK = 928, Z_GV = 1440, Z_GA = 2464, Z_GOG = 2496, Z_BG = 3520;
constexpr float EPS = 1e-6f;
constexpr int NCHUNK = SEQ / 64;

constexpr size_t W_FFN1_IN = 0;
constexpr size_t W_FFN1_OUT = W_FFN1_IN + (size_t)NFF2 * DM;
constexpr size_t W_IN = W_FFN1_OUT + (size_t)DM * DFF;
constexpr size_t W_UQ = W_IN + (size_t)ZLD * DM;
constexpr size_t W_KN = W_UQ + (size_t)768 * 256;
constexpr size_t W_V = W_KN + (size_t)512 * 128;
constexpr size_t W_OA = W_V + (size_t)512 * 128;
constexpr size_t W_OB = W_OA + (size_t)DM * 512;
constexpr size_t W_OUT = W_OB + (size_t)DM * DM;
constexpr size_t W_FFN2_IN = W_OUT + (size_t)DM * DM;
constexpr size_t W_FFN2_OUT = W_FFN2_IN + (size_t)NFF2 * DM;
constexpr size_t W_END = W_FFN2_OUT + (size_t)DM * DFF;

constexpr size_t al256(size_t x) { return (x + 255) & ~(size_t)255; }
constexpr size_t OFF_WB = 0;
constexpr size_t OFF_ROPE = al256(OFF_WB + W_END * 2);
constexpr size_t OFF_H = al256(OFF_ROPE + (size_t)SEQ * 32 * 4);
constexpr size_t OFF_Y = al256(OFF_H + (size_t)MALL * DM * 2);
constexpr size_t OFF_ACT = al256(OFF_Y + (size_t)MALL * DM * 2);
constexpr size_t OFF_Z = OFF_ACT;
constexpr size_t OFF_Q = al256(OFF_Z + (size_t)SEQ * ZLD * 2);
constexpr size_t OFF_KN = al256(OFF_Q + (size_t)SEQ * 768 * 2);
constexpr size_t OFF_VT = al256(OFF_KN + (size_t)SEQ * 512 * 2);
constexpr size_t OFF_KPE = al256(OFF_VT + (size_t)SEQ * 512 * 2);
constexpr size_t OFF_OA = al256(OFF_KPE + (size_t)SEQ * 32 * 2);
constexpr size_t OFF_MIXEND = al256(OFF_OA + (size_t)SEQ * 512 * 2);
constexpr size_t OFF_ACTEND = al256(OFF_ACT + (size_t)MALL * DFF * 2);
static_assert(OFF_MIXEND <= OFF_ACTEND, "mixer scratch must fit in act");
constexpr size_t OFF_ST = OFF_ACTEND;
constexpr size_t OFF_DEC = al256(OFF_ST + (size_t)NCHUNK * 4 * 2 * 256 * 128 * 2);
constexpr size_t OFF_GC = al256(OFF_DEC + (size_t)NCHUNK * 4 * 2 * 128 * 4);
constexpr size_t OFF_OG = al256(OFF_GC + (size_t)2 * SEQ * 512 * 4);
constexpr size_t OFF_MG = al256(OFF_OG + (size_t)SEQ * DM * 2);
constexpr size_t OFF_END = al256(OFF_MG + (size_t)SEQ * DM * 2);
constexpr size_t OFF_BAR = OFF_END;
static_assert(OFF_BAR + 16384 <= (size_t)768 * 1024 * 1024, "workspace overflow");

struct Params {
  const float* in[25];
  float* out;
  char* ws;
};

DI unsigned pk2(float a, float b) { f2_t v = {a, b}; return __builtin_bit_cast(unsigned, __builtin_convertvector(v, bf2_t)); }
DI u16 f2bf(float a) { return (u16)(pk2(a, 0.f) & 0xffffu); }
DI float bf2f(u16 v) { return __uint_as_float(((unsigned)v) << 16); }
DI float bflo(unsigned v) { return __uint_as_float(v << 16); }
DI float bfhi(unsigned v) { return __uint_as_float(v & 0xffff0000u); }
DI float wave_sum(float v) {
#pragma unroll
  for (int o = 32; o >= 1; o >>= 1) v += __shfl_xor(v, o);
  return v;
}
DI int opaque_tid() { int t = threadIdx.x; asm volatile("" : "+v"(t)); return t; }
DI const float* in_ptr(const Params& p, int k) { asm volatile("" : "+s"(k)); return p.in[k]; }
DI int crow(int i, int h) { return (i & 3) + 8 * (i >> 2) + 4 * h; }
DI float sigmoidf_(float x) { return 1.f / (1.f + __expf(-x)); }
DI float siluf_(float x) { return x / (1.f + __expf(-x)); }


#define XB_TMO      128
#define XB_XCNT(j)  (256  + 64 * (j))
#define XB_XSUB(j)  (1280 + 64 * (j))
#define XB_XGEN(j)  (2304 + 64 * (j))
#define XB_TOP      3328
#define XB_TOPGEN   3392
#define XCD_BAR_WORDS 3456
#define XB_SPIN_CAP (1u << 18)
#define LAS __attribute__((address_space(3)))

__device__ __forceinline__ unsigned xb_ld(unsigned* p)              { return __hip_atomic_load(p, __ATOMIC_RELAXED, __HIP_MEMORY_SCOPE_AGENT); }
__device__ __forceinline__ unsigned xb_add(unsigned* p, unsigned v) { return __hip_atomic_fetch_add(p, v, __ATOMIC_RELAXED, __HIP_MEMORY_SCOPE_AGENT); }
__device__ __forceinline__ unsigned xb_xcc_id() { return (unsigned)__builtin_amdgcn_s_getreg((3 << 11) | 20) & 0xFu; }
#define XB_SPIN(cond, bar) do { unsigned _sp = 0; while (cond) { __builtin_amdgcn_s_sleep(1); \
    if ((++_sp & 255u) == 0u) { if (xb_ld(&(bar)[XB_TMO])) break; if (_sp > XB_SPIN_CAP) { atomicAdd(&(bar)[XB_TMO], 1u); break; } } } } while (0)

struct XcdBarrier {
    unsigned* bar; unsigned x;
    volatile LAS unsigned* st;
};

__device__ __forceinline__ XcdBarrier xcd_barrier_post(unsigned* bar, volatile LAS unsigned* st) {
    XcdBarrier b; b.bar = bar; b.x = xb_xcc_id(); b.st = st;
    if (threadIdx.x == 0) (void)xb_add(&bar[XB_XCNT(b.x)], 1u);
    return b;
}
__device__ __forceinline__ void xcd_barrier_complete(unsigned* bar, unsigned x, unsigned& nloc, unsigned& nx) {
    const unsigned G = gridDim.x * gridDim.y * gridDim.z;
    unsigned sum, cnt, mine, sp = 0u;
    for (;;) {
        sum = 0u; cnt = 0u; mine = 0u;
#pragma unroll
        for (unsigned j = 0; j < 16; ++j) { const unsigned c = xb_ld(&bar[XB_XCNT(j)]); sum += c; cnt += (c > 0u) ? 1u : 0u; mine = (j == x) ? c : mine; }
        if (sum == G) break;
        __builtin_amdgcn_s_sleep(1);
        if ((++sp & 255u) == 0u) { if (xb_ld(&bar[XB_TMO])) break; if (sp > XB_SPIN_CAP) { atomicAdd(&bar[XB_TMO], 1u); break; } }
    }
    nloc = mine > 0u ? mine : 1u; nx = cnt > 0u ? cnt : 1u;
}

__device__ __forceinline__ void xcd_barrier(const XcdBarrier& b) {
    asm volatile("s_waitcnt vmcnt(0)" ::: "memory");
    __syncthreads();
    int tid0_ = threadIdx.x; asm volatile("" : "+v"(tid0_));
    if (tid0_ == 0) {
        unsigned* bar = b.bar; asm volatile("" : "+s"(bar));
        unsigned bx_ = b.x; asm volatile("" : "+s"(bx_));
        __builtin_amdgcn_s_waitcnt(0);
        unsigned nloc = b.st[0], nx = b.st[1];
        if (nloc == 0u) { xcd_barrier_complete(bar, bx_, nloc, nx); b.st[0] = nloc; b.st[1] = nx; }
        const unsigned old = xb_add(&bar[XB_XSUB(bx_)], 1u);
        const unsigned gen = old / nloc;
        if (old + 1u == (gen + 1u) * nloc) {
            __builtin_amdgcn_fence(__ATOMIC_RELEASE, "agent");
            asm volatile("s_waitcnt vmcnt(0)" ::: "memory");
            const unsigned og = xb_add(&bar[XB_TOP], 1u);
            const unsigned tg = og / nx;
            if (og + 1u == (tg + 1u) * nx) xb_add(&bar[XB_TOPGEN], 1u);
            else XB_SPIN(xb_ld(&bar[XB_TOPGEN]) == tg, bar);
            __builtin_amdgcn_fence(__ATOMIC_ACQUIRE, "agent");
            xb_add(&bar[XB_XGEN(bx_)], 1u);
            asm volatile("s_waitcnt vmcnt(0)" ::: "memory");
        } else {
            XB_SPIN(xb_ld(&bar[XB_XGEN(bx_)]) == gen, bar);
            __builtin_amdgcn_fence(__ATOMIC_ACQUIRE, "agent");
            asm volatile("s_waitcnt vmcnt(0)" ::: "memory");
        }
    }
    __syncthreads();
}

constexpr int LROW = 72;
constexpr int GEMM_LDS = 2 * 128 * LROW * 2;

struct Acc { f32x16 a[4][2]; };

DI void acc_zero(Acc& c) {
#pragma unroll
  for (int i = 0; i < 4; ++i)
#pragma unroll
    for (int j = 0; j < 2; ++j)
#pragma unroll
      for (int k = 0; k < 16; ++k) c.a[i][j][k] = 0.f;
}

DI void gll16(const u16* g, char* l) {
  __builtin_amdgcn_global_load_lds((const __attribute__((address_space(1))) unsigned*)g,
                                   (__attribute__((address_space(3))) unsigned*)l, 16, 0, 0);
}
DI void gemm_kloop(const u16* __restrict__ A, int lda, const u16* __restrict__ B, int ldb, int K, u16* smem, Acc& c) {
  const int t = opaque_tid();
  const int lane = t & 63, w = t >> 6, r = lane & 31, h = lane >> 5;
  const int wm = w >> 1, wn = w & 1;
  char* lds = (char*)smem;
  const int nk = K >> 5;
  const int row0 = t >> 2, c0 = t & 3;
  const int sw0 = (c0 ^ ((row0 >> 2) & 3)) * 8;
  const u16* ga0 = A + (size_t)row0 * lda + sw0;
  const u16* gb0 = B + (size_t)row0 * ldb + sw0;
  const size_t a64 = (size_t)64 * lda, b64 = (size_t)64 * ldb;
  const int loff = t * 16;
#define GEMM_ISSUE(kt_, st_)                                         \
  do {                                                               \
    const int kk_ = ((kt_) < nk ? (kt_) : (nk - 1)) * 32;            \
    char* sp_ = lds + (st_) * 24576 + loff;                          \
    gll16(ga0 + kk_, sp_);                                           \
    gll16(ga0 + a64 + kk_, sp_ + 4096);                              \
    gll16(ga0 + 2 * a64 + kk_, sp_ + 8192);                          \
    gll16(ga0 + 3 * a64 + kk_, sp_ + 12288);                         \
    gll16(gb0 + kk_, sp_ + 16384);                                   \
    gll16(gb0 + b64 + kk_, sp_ + 20480);                             \
  } while (0)
  __syncthreads();
  GEMM_ISSUE(0, 0);
  GEMM_ISSUE(1, 1);
  const int fsw = (r >> 2) & 3;
  const int aoff = (wm * 128 + r) * 64, boff = 16384 + (wn * 64 + r) * 64;
  int scur = 0, snext = 2;
  for (int kt = 0; kt < nk; ++kt) {
    asm volatile("s_waitcnt vmcnt(6)" ::: "memory");
    __builtin_amdgcn_s_barrier();
    asm volatile("" ::: "memory");
    GEMM_ISSUE(kt + 2, snext);
    __builtin_amdgcn_sched_barrier(0);
    const char* st = lds + scur * 24576;
#pragma unroll
    for (int ks = 0; ks < 2; ++ks) {
      const int q = ((ks * 2 + h) ^ fsw) * 16;
      bf16x8 fa[4], fb[2];
#pragma unroll
      for (int i = 0; i < 4; ++i) fa[i] = *(const bf16x8*)(st + aoff + i * 2048 + q);
#pragma unroll
      for (int i = 0; i < 2; ++i) fb[i] = *(const bf16x8*)(st + boff + i * 2048 + q);
#pragma unroll
      for (int i = 0; i < 4; ++i)
#pragma unroll
        for (int j = 0; j < 2; ++j) c.a[i][j] = MFMA(fa[i], fb[j], c.a[i][j]);
    }
    __builtin_amdgcn_sched_barrier(0);
    snext = scur;
    scur = (scur == 2) ? 0 : scur + 1;
  }
  asm volatile("s_waitcnt vmcnt(0)" ::: "memory");
  __builtin_amdgcn_s_barrier();
  asm volatile("" ::: "memory");
#undef GEMM_ISSUE
}

DI void row_scales(const u16* __restrict__ base, int ld, int K, float* sc, int NR) {
  const int t = opaque_tid();
  const int row = (NR == 256) ? t : (t >> 1);
  const int part = (NR == 256) ? 0 : (t & 1);
  const int len = (NR == 256) ? K : (K / 2);
  const u16* p = base + (size_t)row * ld + part * len;
  float ss = 0.f;
  for (int i = 0; i < len / 8; ++i) {
    u32x4 v = *(const u32x4*)(p + i * 8);
#pragma unroll
    for (int j = 0; j < 4; ++j) { float a = bflo(v[j]), b = bfhi(v[j]); ss += a * a + b * b; }
  }
  if (NR != 256) ss += __shfl_xor(ss, 1);
  if (part == 0) sc[row] = rsqrtf(ss / (float)K + EPS);
}


template <int NI, class V, class R>
DI void epi_store(u16* smem, V val, R rowfn) {
  const int t = opaque_tid();
  const int lane = t & 63, w = t >> 6, r = lane & 31, h = lane >> 5;
  char* reg = (char*)smem + w * 18432;
#pragma unroll
  for (int mi = 0; mi < 4; ++mi)
#pragma unroll
    for (int ni = 0; ni < NI; ++ni)
#pragma unroll
      for (int i = 0; i < 16; ++i)
        *(u16*)(reg + (mi * 32 + crow(i, h)) * 144 + (ni * 32 + r) * 2) = f2bf(val(mi, ni, i));
  __builtin_amdgcn_sched_barrier(0);
  constexpr int CPR = NI * 4;
  constexpr int RPI = 64 / CPR;
  const int rr = lane / CPR, ch = lane % CPR;
#pragma unroll
  for (int k = 0; k < 128 / RPI; ++k) {
    const int row = k * RPI + rr;
    u32x4 v = *(const u32x4*)(reg + row * 144 + ch * 16);
    rowfn(row, ch * 8, v);
  }
}

DI void tile_coords(int id, int MT, int NT, int& tm, int& tn) {
  const int per = 32 * NT;
  const int sr = id / per, rem = id - sr * per;
  tn = rem >> 5;
  tm = sr * 32 + (rem & 31);
}

#define EPI_LOOP                                   \
  _Pragma("unroll") for (int mi = 0; mi < 4; ++mi) \
  _Pragma("unroll") for (int ni = 0; ni < 2; ++ni) \
  _Pragma("unroll") for (int i = (__builtin_amdgcn_sched_barrier(0), 0); i < 16; ++i)

constexpr int SMEM_BYTES = 74752;

__global__ void __launch_bounds__(256, 2) fwd_megakernel(Params p) {
  cg::grid_group grid = cg::this_grid();
  __shared__ __attribute__((aligned(16))) char smem_raw[SMEM_BYTES];
  u16* smem = (u16*)smem_raw;
  const int G = gridDim.x;
  int bid = blockIdx.x;
  __shared__ uint4 xb_words;
  if (threadIdx.x == 0) xb_words = make_uint4(0u, 0u, 0u, 0u);
  __syncthreads();
  XcdBarrier xb = xcd_barrier_post((unsigned*)(p.ws + OFF_BAR), (volatile LAS unsigned*)&xb_words);

  char* ws = p.ws;
#define Wb ((u16*)(ws + OFF_WB))
#define ropec ((float*)(ws + OFF_ROPE))
#define ropes (((float*)(ws + OFF_ROPE)) + SEQ * 16)
#define Hb ((u16*)(ws + OFF_H))
#define Yb ((u16*)(ws + OFF_Y))
#define ACT ((u16*)(ws + OFF_ACT))
#define Z ((u16*)(ws + OFF_Z))
#define Qb ((u16*)(ws + OFF_Q))
#define KN ((u16*)(ws + OFF_KN))
#define VT ((u16*)(ws + OFF_VT))
#define KPE ((u16*)(ws + OFF_KPE))
#define OA ((u16*)(ws + OFF_OA))
#define ST ((u16*)(ws + OFF_ST))
#define DEC ((float*)(ws + OFF_DEC))
#define GC ((float*)(ws + OFF_GC))
#define OG ((u16*)(ws + OFF_OG))
#define MG ((u16*)(ws + OFF_MG))
  float* X = p.out;

  auto convert_weights = [&](int l) __attribute__((always_inline)) {
    const int t = opaque_tid();
    const int lane = t & 63, w = t >> 6, r = lane & 31, h = lane >> 5;
    const int wm = w >> 1, wn = w & 1;
    (void)lane; (void)r; (void)h; (void)wm; (void)wn;
    float* tile = (float*)smem_raw;
    for (int mat = 0; mat < 11; ++mat) {
      const float* src; int K, N; size_t dst; int map; const float* ksc = nullptr;
      switch (mat) {
        case 0: src = in_ptr(p, 3) + (size_t)l * DM * NFF2; K = DM; N = NFF2; dst = W_FFN1_IN; map = 1; break;
        case 1: src = in_ptr(p, 4) + (size_t)l * DFF * DM; K = DFF; N = DM; dst = W_FFN1_OUT; map = 0; break;
        case 2: src = in_ptr(p, 7) + (size_t)l * DM * PIN; K = DM; N = PIN; dst = W_IN; map = 0; break;
        case 3: src = in_ptr(p, 9) + (size_t)l * 256 * 768; K = 256; N = 768; dst = W_UQ; map = 0; ksc = in_ptr(p, 8) + l * 256; break;
        case 4: src = in_ptr(p, 11) + (size_t)l * 128 * 1024; K = 128; N = 1024; dst = W_KN; map = 2; ksc = in_ptr(p, 10) + l * 128; break;
        case 5: src = in_ptr(p, 12) + (size_t)l * 512 * DM; K = 512; N = DM; dst = W_OA; map = 0; break;
        case 6: src = in_ptr(p, 18) + (size_t)l * DM * DM; K = DM; N = DM; dst = W_OB; map = 0; break;
        case 7: src = in_ptr(p, 19) + (size_t)l * DM * DM; K = DM; N = DM; dst = W_OUT; map = 0; break;
        case 8: src = in_ptr(p, 22) + (size_t)l * DM * NFF2; K = DM; N = NFF2; dst = W_FFN2_IN; map = 1; break;
        case 9: src = in_ptr(p, 23) + (size_t)l * DFF * DM; K = DFF; N = DM; dst = W_FFN2_OUT; map = 0; break;
        default: src = nullptr; K = DM; N = 64; dst = W_IN + (size_t)PIN * DM; map = 3; break;
      }
      const int kt_n = K / 64, nt_n = N / 64;
      for (int id = bid; id < kt_n * nt_n; id += G) {
        const int kt = id % kt_n, nt = id / kt_n;
        const int k0 = kt * 64, n0 = nt * 64;
        __syncthreads();
        if (map != 3) {
#pragma unroll
          for (int i = 0; i < 4; ++i) {
            const int kk = (t >> 4) + 16 * i, nn = (t & 15) * 4;
            float4 v = *(const float4*)(src + (size_t)(k0 + kk) * N + n0 + nn);
            float sc = ksc ? ksc[k0 + kk] : 1.f;
            tile[kk * 65 + nn + 0] = v.x * sc; tile[kk * 65 + nn + 1] = v.y * sc;
            tile[kk * 65 + nn + 2] = v.z * sc; tile[kk * 65 + nn + 3] = v.w * sc;
          }
        }
        __syncthreads();
        const int nl = t >> 2, kc = (t & 3) * 16;
        const int n = n0 + nl;
        size_t drow;
        if (map == 0) drow = dst + (size_t)n * K;
        else if (map == 1) { const int isb = n >= DFF; const int j = n - isb * DFF; drow = dst + (size_t)((j >> 5) * 64 + isb * 32 + (j & 31)) * K; }
        else if (map == 2) { const int hd = n >> 7, cc = n & 127; drow = (cc < 64) ? (W_KN + (size_t)(hd * 64 + cc) * K) : (W_V + (size_t)(hd * 64 + cc - 64) * K); }
        else drow = dst + (size_t)nl * K;
        unsigned o[8];
#pragma unroll
        for (int j = 0; j < 8; ++j) {
          float a = (map == 3) ? 0.f : tile[(kc + 2 * j) * 65 + nl];
          float b = (map == 3) ? 0.f : tile[(kc + 2 * j + 1) * 65 + nl];
          o[j] = pk2(a, b);
        }
        uint4* dp = (uint4*)(Wb + drow + k0 + kc);
        dp[0] = make_uint4(o[0], o[1], o[2], o[3]);
        dp[1] = make_uint4(o[4], o[5], o[6], o[7]);
      }
    }
  };

  auto rn_pass = [&](int mode, float coef, const float* post_g, const float* pre_g) __attribute__((always_inline)) {
    const int t = opaque_tid();
    const int lane = t & 63, w = t >> 6, r = lane & 31, h = lane >> 5;
    const int wm = w >> 1, wn = w & 1;
    (void)lane; (void)r; (void)h; (void)wm; (void)wn;
    typedef float f4v __attribute__((ext_vector_type(4)));
    typedef unsigned u2v __attribute__((ext_vector_type(2)));
    const int gw = bid * 4 + w, nw = G * 4;
    constexpr int RB = 4;
    f4v pg[4], qg[4];
#pragma unroll
    for (int i = 0; i < 4; ++i) {
      pg[i] = (mode == 1) ? *(const f4v*)(post_g + lane * 4 + 256 * i) : (f4v){0.f, 0.f, 0.f, 0.f};
      qg[i] = pre_g ? *(const f4v*)(pre_g + lane * 4 + 256 * i) : (f4v){0.f, 0.f, 0.f, 0.f};
    }
    for (int row0 = gw; row0 < MALL; row0 += RB * nw) {
      f4v xv[RB][4];
      u2v yu[RB][4];
#pragma unroll
      for (int j = 0; j < RB; ++j) {
        int row = row0 + j * nw;
        if (row >= MALL) row = row0;
        const float* xs;
        if (mode == 0) xs = (row < SEQ) ? (in_ptr(p, 0) + (size_t)row * DM) : (in_ptr(p, 1) + (size_t)(row - SEQ) * DM);
        else xs = X + (size_t)row * DM;
#pragma unroll
        for (int i = 0; i < 4; ++i) xv[j][i] = *(const f4v*)(xs + lane * 4 + 256 * i);
        if (mode == 1) {
#pragma unroll
          for (int i = 0; i < 4; ++i) yu[j][i] = *(const u2v*)(Yb + (size_t)row * DM + lane * 4 + 256 * i);
        }
      }
#pragma unroll
      for (int j = 0; j < RB; ++j) {
        const int row = row0 + j * nw;
        if (row < MALL) {
          if (mode == 1) {
            float yv[16];
            float ss = 0.f;
#pragma unroll
            for (int i = 0; i < 4; ++i) {
              yv[4 * i + 0] = bflo(yu[j][i][0]); yv[4 * i + 1] = bfhi(yu[j][i][0]);
              yv[4 * i + 2] = bflo(yu[j][i][1]); yv[4 * i + 3] = bfhi(yu[j][i][1]);
            }
#pragma unroll
            for (int i = 0; i < 16; ++i) ss += yv[i] * yv[i];
            ss = wave_sum(ss);
            const float ry = rsqrtf(ss * (1.f / DM) + EPS) * coef;
#pragma unroll
            for (int i = 0; i < 4; ++i)
#pragma unroll
              for (int k = 0; k < 4; ++k) xv[j][i][k] += yv[4 * i + k] * ry * pg[i][k];
          }
#pragma unroll
          for (int i = 0; i < 4; ++i) *(f4v*)(X + (size_t)row * DM + lane * 4 + 256 * i) = xv[j][i];
          if (pre_g) {
            float ss = 0.f;
#pragma unroll
            for (int i = 0; i < 4; ++i)
#pragma unroll
              for (int k = 0; k < 4; ++k) ss += xv[j][i][k] * xv[j][i][k];
            ss = wave_sum(ss);
            const float rx = rsqrtf(ss * (1.f / DM) + EPS);
#pragma unroll
            for (int i = 0; i < 4; ++i) {
              u2v o;
              o[0] = pk2(xv[j][i][0] * rx * qg[i][0], xv[j][i][1] * rx * qg[i][1]);
              o[1] = pk2(xv[j][i][2] * rx * qg[i][2], xv[j][i][3] * rx * qg[i][3]);
              *(u2v*)(Hb + (size_t)row * DM + lane * 4 + 256 * i) = o;
            }
          }
        }
      }
    }
  };

  auto ffn_in = [&](size_t woff) __attribute__((always_inline)) {
    const int t = opaque_tid();
    const int lane = t & 63, w = t >> 6, r = lane & 31, h = lane >> 5;
    const int wm = w >> 1, wn = w & 1;
    (void)lane; (void)r; (void)h; (void)wm; (void)wn;
    const int MT = MALL / 256, NT = NFF2 / 128;
    for (int id = bid; id < MT * NT; id += G) {
      int tm, tn; tile_coords(id, MT, NT, tm, tn);
      const int m0 = tm * 256, n0 = tn * 128;
      Acc c; acc_zero(c);
      gemm_kloop(Hb + (size_t)m0 * DM, DM, Wb + woff + (size_t)n0 * DM, DM, DM, smem, c);
#ifdef DUP_KLOOP
      acc_zero(c);
      gemm_kloop(Hb + (size_t)m0 * DM, DM, Wb + woff + (size_t)n0 * DM, DM, DM, smem, c);
#endif
      const int jb0 = ((n0 + wn * 64) >> 6) * 32;
      const unsigned obase = (unsigned)((m0 + wm * 128) * DFF + jb0);
      epi_store<1>(smem,
        [&](int mi, int ni, int i) { return siluf_(c.a[mi][0][i]) * c.a[mi][1][i]; },
        [&](int row, int col, u32x4 v) { *(u32x4*)(ACT + obase + (unsigned)(row * DFF + col)) = v; });
    }
  };
  auto gemm_plain = [&](const u16* A, int lda, int K, const u16* Bt, u16* C, int ldc, int M, int N) __attribute__((always_inline)) {
    const int t = opaque_tid();
    const int lane = t & 63, w = t >> 6, r = lane & 31, h = lane >> 5;
    const int wm = w >> 1, wn = w & 1;
    (void)lane; (void)r; (void)h; (void)wm; (void)wn;
    const int MT = M / 256, NT = N / 128;
    for (int id = bid; id < MT * NT; id += G) {
      int tm, tn; tile_coords(id, MT, NT, tm, tn);
      const int m0 = tm * 256, n0 = tn * 128;
      Acc c; acc_zero(c);
      gemm_kloop(A + (size_t)m0 * lda, lda, Bt + (size_t)n0 * K, K, K, smem, c);
      const unsigned obase = (unsigned)((m0 + wm * 128) * ldc + n0 + wn * 64);
      epi_store<2>(smem,
        [&](int mi, int ni, int i) { return c.a[mi][ni][i]; },
        [&](int row, int col, u32x4 v) { *(u32x4*)(C + obase + (unsigned)(row * ldc + col)) = v; });
    }
  };

  auto prep_phase = [&](int l) __attribute__((always_inline)) {
    int pb_ = bid; asm volatile("" : "+s"(pb_));
    const int t = opaque_tid();
    const int lane = t & 63, w = t >> 6, r = lane & 31, h = lane >> 5;
    const int wm = w >> 1, wn = w & 1;
    (void)lane; (void)r; (void)h; (void)wm; (void)wn;
    float* sc = (float*)(smem_raw + 2 * GEMM_LDS);
    const int NQ = 64 * 6, NK = 64 * 4, NV = 2 * 128, NPE = 64, NG1 = NCHUNK * 4;
    const float qscale = 0.10206207261596577f * 1.4426950408889634f;
    {
      for (int id = pb_; id < NG1; id += G) {
        const int t = opaque_tid();
        const int lane = t & 63, w = t >> 6, r = lane & 31, h = lane >> 5;
        const int wm = w >> 1, wn = w & 1;
        (void)lane; (void)r; (void)h; (void)wm; (void)wn;
        const int n = id >> 2, hd = id & 3;
        const int t0 = n * 64;
        u16* ksT = smem;
        u16* vT = smem + 2 * 128 * LROW;
        u16* sk = vT;
        float* sga = (float*)(smem_raw + 55296);
        __syncthreads();
        {
          const int cc = t >> 2, part = t & 3;
          const u16* kp = Z + (size_t)(t0 + cc) * ZLD + Z_GK + hd * 128 + part * 32;
#pragma unroll
          for (int j = 0; j < 4; ++j) *(u32x4*)(sk + cc * 128 + part * 32 + j * 8) = *(const u32x4*)(kp + j * 8);
          u32x4 gv = *(const u32x4*)(Z + (size_t)(t0 + cc) * ZLD + Z_GA + part * 8);
#pragma unroll
          for (int k = 0; k < 4; ++k) { sga[cc * 32 + part * 8 + 2 * k] = bflo(gv[k]); sga[cc * 32 + part * 8 + 2 * k + 1] = bfhi(gv[k]); }
        }
        __syncthreads();
        {
          const int dir = t >> 7, d = t & 127;
          const float* wa2 = (dir ? in_ptr(p, 15) : in_ptr(p, 13)) + (size_t)l * 16 * 512 + hd * 128 + d;
          const float ba = ((dir ? in_ptr(p, 16) : in_ptr(p, 14)) + (size_t)l * 512)[hd * 128 + d];
          float wcol[16];
#pragma unroll
          for (int rr = 0; rr < 16; ++rr) wcol[rr] = wa2[rr * 512];
          const float* gar = sga + dir * 16;
          float tot = 0.f;
          for (int cc = 0; cc < 64; ++cc) {
            float pre = ba;
#pragma unroll
            for (int rr = 0; rr < 16; ++rr) pre += gar[cc * 32 + rr] * wcol[rr];
            tot += (fminf(pre, 0.f) - __logf(1.f + __expf(-fabsf(pre)))) * (1.f / 16.f);
          }
          DEC[((size_t)(n * 4 + hd) * 2 + dir) * 128 + d] = __expf(tot);
          float* gc = GC + (size_t)dir * SEQ * 512 + (size_t)t0 * 512 + hd * 128 + d;
          float cb = 0.f;
          u16* krow_out = ksT + (dir * 128 + d) * LROW;
          for (int ci = 0; ci < 64; ++ci) {
            const int cc = dir ? (63 - ci) : ci;
            float pre = ba;
#pragma unroll
            for (int rr = 0; rr < 16; ++rr) pre += gar[cc * 32 + rr] * wcol[rr];
            cb += (fminf(pre, 0.f) - __logf(1.f + __expf(-fabsf(pre)))) * (1.f / 16.f);
            gc[cc * 512] = cb;
            krow_out[cc] = f2bf(bf2f(sk[cc * 128 + d]) * __expf(tot - cb));
          }
        }
        for (int half = 0; half < 2; ++half) {
          __syncthreads();
          {
            const int cc = t & 63, part = t >> 6;
#pragma unroll
            for (int q = 0; q < 4; ++q) {
              const int cg8 = (part * 4 + q) * 8;
              uint4 v = *(const uint4*)(Z + (size_t)(t0 + cc) * ZLD + Z_GV + hd * 256 + half * 128 + cg8);
              unsigned u[4] = {v.x, v.y, v.z, v.w};
#pragma unroll
              for (int j = 0; j < 4; ++j) {
                vT[(cg8 + 2 * j) * LROW + cc] = (u16)(u[j] & 0xffffu);
                vT[(cg8 + 2 * j + 1) * LROW + cc] = (u16)(u[j] >> 16);
              }
            }
          }
          __syncthreads();
#pragma unroll
          for (int dir = 0; dir < 2; ++dir) {
            f32x16 acc[4];
#pragma unroll
            for (int j = 0; j < 4; ++j)
#pragma unroll
              for (int k = 0; k < 16; ++k) acc[j][k] = 0.f;
#pragma unroll
            for (int ks = 0; ks < 4; ++ks) {
              bf16x8 fa = *(const bf16x8*)(vT + (w * 32 + r) * LROW + ks * 16 + h * 8);
#pragma unroll
              for (int nt = 0; nt < 4; ++nt) {
                bf16x8 fb = *(const bf16x8*)(ksT + (dir * 128 + nt * 32 + r) * LROW + ks * 16 + h * 8);
                acc[nt] = MFMA(fb, fa, acc[nt]);
              }
            }
            u16* stp = ST + ((size_t)(n * 4 + hd) * 2 + dir) * 32768;
#pragma unroll
            for (int nt = 0; nt < 4; ++nt)
#pragma unroll
              for (int g4 = 0; g4 < 4; ++g4) {
                uint2 o;
                o.x = pk2(acc[nt][4 * g4 + 0], acc[nt][4 * g4 + 1]);
                o.y = pk2(acc[nt][4 * g4 + 2], acc[nt][4 * g4 + 3]);
                *(uint2*)(stp + (unsigned)((half * 128 + w * 32 + r) * 128 + nt * 32 + 8 * g4 + 4 * h)) = o;
              }
          }
        }
      }
      for (int q = pb_; q < NQ; q += G) {
        const int t = opaque_tid();
        const int lane = t & 63, w = t >> 6, r = lane & 31, h = lane >> 5;
        const int wm = w >> 1, wn = w & 1;
        (void)lane; (void)r; (void)h; (void)wm; (void)wn;
        const int tm = q / 6, tn = q % 6;
        const int m0 = tm * 256, n0 = tn * 128;
        __syncthreads();
        row_scales(Z + (size_t)m0 * ZLD + Z_CQ, ZLD, 256, sc, 256);
        Acc c; acc_zero(c);
        gemm_kloop(Z + (size_t)m0 * ZLD + Z_CQ, ZLD, Wb + W_UQ + (size_t)n0 * 256, 256, 256, smem, c);
        {
          const unsigned obase = (unsigned)((m0 + wm * 128) * 768 + n0 + wn * 64);
          epi_store<2>(smem,
            [&](int mi, int ni, int i) {
              const int cb0 = n0 + wn * 64 + ni * 32;
              const bool rope = ((cb0 >> 5) % 3) == 2;
              const int rl = wm * 128 + mi * 32 + crow(i, h);
              float v = c.a[mi][ni][i] * sc[rl];
              const float pv = __shfl_xor(v, 16);
              if (rope) {
                const int row = m0 + rl;
                const float cs = ropec[row * 16 + (r & 15)], sn = ropes[row * 16 + (r & 15)];
                v = (r < 16) ? (v * cs - pv * sn) : (v * cs + pv * sn);
              }
              return v * qscale;
            },
            [&](int row, int col, u32x4 v) { *(u32x4*)(Qb + obase + (unsigned)(row * 768 + col)) = v; });
        }
      }
      for (int q = (pb_ + G - (NQ % G)) % G; q < NK; q += G) {
        const int t = opaque_tid();
        const int lane = t & 63, w = t >> 6, r = lane & 31, h = lane >> 5;
        const int wm = w >> 1, wn = w & 1;
        (void)lane; (void)r; (void)h; (void)wm; (void)wn;
        const int tm = q >> 2, tn = q & 3;
        const int m0 = tm * 256, n0 = tn * 128;
        __syncthreads();
        row_scales(Z + (size_t)m0 * ZLD + Z_CKV, ZLD, 128, sc, 256);
        Acc c; acc_zero(c);
        gemm_kloop(Z + (size_t)m0 * ZLD + Z_CKV, ZLD, Wb + W_KN + (size_t)n0 * 128, 128, 128, smem, c);
        {
          const unsigned obase = (unsigned)((m0 + wm * 128) * 512 + n0 + wn * 64);
          epi_store<2>(smem,
            [&](int mi, int ni, int i) { return c.a[mi][ni][i] * sc[wm * 128 + mi * 32 + crow(i, h)]; },
            [&](int row, int col, u32x4 v) { *(u32x4*)(KN + obase + (unsigned)(row * 512 + col)) = v; });
        }
      }
      for (int q = (pb_ + G - ((NQ + NK) % G)) % G; q < NV; q += G) {
        const int t = opaque_tid();
        const int lane = t & 63, w = t >> 6, r = lane & 31, h = lane >> 5;
        const int wm = w >> 1, wn = w & 1;
        (void)lane; (void)r; (void)h; (void)wm; (void)wn;
        const int tm = q & 1, tn = q >> 1;
        const int m0 = tm * 256, n0 = tn * 128;
        __syncthreads();
        row_scales(Z + (size_t)n0 * ZLD + Z_CKV, ZLD, 128, sc, 128);
        Acc c; acc_zero(c);
        gemm_kloop(Wb + W_V + (size_t)m0 * 128, 128, Z + (size_t)n0 * ZLD + Z_CKV, ZLD, 128, smem, c);
        {
          const unsigned obase = (unsigned)((m0 + wm * 128) * SEQ + n0 + wn * 64);
          epi_store<2>(smem,
            [&](int mi, int ni, int i) { return c.a[mi][ni][i] * sc[wn * 64 + ni * 32 + r]; },
            [&](int row, int col, u32x4 v) { *(u32x4*)(VT + obase + (unsigned)(row * SEQ + col)) = v; });
        }
      }
      for (int q = (pb_ + G - ((NQ + NK + NV) % G)) % G; q < NPE; q += G) {
        const int t = opaque_tid();
        const int lane = t & 63, w = t >> 6, r = lane & 31, h = lane >> 5;
        const int wm = w >> 1, wn = w & 1;
        (void)lane; (void)r; (void)h; (void)wm; (void)wn;
        const int tok = q * 256 + t;
        const u16* src = Z + (size_t)tok * ZLD + Z_KPE;
        float v[32];
#pragma unroll
        for (int j = 0; j < 4; ++j) {
          uint4 u = *(const uint4*)(src + j * 8);
          unsigned uu[4] = {u.x, u.y, u.z, u.w};
#pragma unroll
          for (int k = 0; k < 4; ++k) { v[j * 8 + 2 * k] = bflo(uu[k]); v[j * 8 + 2 * k + 1] = bfhi(uu[k]); }
        }
        float o[32];
#pragma unroll
        for (int i = 0; i < 16; ++i) {
          const float cs = ropec[tok * 16 + i], sn = ropes[tok * 16 + i];
          o[i] = v[i] * cs - v[i + 16] * sn;
          o[i + 16] = v[i + 16] * cs + v[i] * sn;
        }
#pragma unroll
        for (int j = 0; j < 4; ++j) {
          uint4 u;
          u.x = pk2(o[j * 8 + 0], o[j * 8 + 1]); u.y = pk2(o[j * 8 + 2], o[j * 8 + 3]);
          u.z = pk2(o[j * 8 + 4], o[j * 8 + 5]); u.w = pk2(o[j * 8 + 6], o[j * 8 + 7]);
          *(uint4*)(KPE + (size_t)tok * 32 + j * 8) = u;
        }
      }
    }
  };

  auto attn_phase = [&](int mode) __attribute__((always_inline)) {
    const int t = opaque_tid();
    const int lane = t & 63, w = t >> 6, r = lane & 31, h = lane >> 5;
    const int wm = w >> 1, wn = w & 1;
    (void)lane; (void)r; (void)h; (void)wm; (void)wn;
    if (mode & 1) for (int id = bid; id < 512; id += G) {
      const int e = id * 256 + t;
      const int d2 = e & 63, v = (e >> 6) & 255, dir = (e >> 14) & 1, hd = e >> 15;
      float s0 = 0.f, s1 = 0.f;
      const size_t eoff = (size_t)v * 128 + 2 * d2;
      for (int i0 = 0; i0 < NCHUNK; i0 += 16) {
        unsigned uu[16];
        float2 dd[16];
#pragma unroll
        for (int j = 0; j < 16; ++j) {
          const int n = dir ? (NCHUNK - 1 - (i0 + j)) : (i0 + j);
          const size_t base = ((size_t)(n * 4 + hd) * 2 + dir);
          uu[j] = *(const unsigned*)(ST + base * 32768 + eoff);
          dd[j] = *(const float2*)(DEC + base * 128 + 2 * d2);
        }
#pragma unroll
        for (int j = 0; j < 16; ++j) {
          const int n = dir ? (NCHUNK - 1 - (i0 + j)) : (i0 + j);
          const size_t base = ((size_t)(n * 4 + hd) * 2 + dir);
          *(unsigned*)(ST + base * 32768 + eoff) = pk2(s0, s1);
          s0 = dd[j].x * s0 + bflo(uu[j]);
          s1 = dd[j].y * s1 + bfhi(uu[j]);
        }
      }
    }
    constexpr int KROW = 104;
    constexpr int VR = 68;
    constexpr int ABUF = 64 * KROW + 64 * VR;
    u16* sK = smem;
    u16* sV = smem + 64 * KROW;
    if (mode & 2) for (int id = bid; id < 8 * 64; id += G) {
      const int hd = id & 7, qb = id >> 3;
      const int q0 = qb * 256 + w * 64;
      bf16x8 bq[2][6];
#pragma unroll
      for (int qt = 0; qt < 2; ++qt)
#pragma unroll
        for (int ks = 0; ks < 6; ++ks) bq[qt][ks] = *(const bf16x8*)(Qb + (size_t)(q0 + qt * 32 + r) * 768 + hd * 96 + ks * 16 + h * 8);
      f32x16 O[2][2];
#pragma unroll
      for (int j = 0; j < 2; ++j)
#pragma unroll
        for (int qt = 0; qt < 2; ++qt)
#pragma unroll
          for (int k = 0; k < 16; ++k) O[j][qt][k] = 0.f;
      float m[2] = {0.f, 0.f}, lsum[2] = {0.f, 0.f};
      const int kr = t >> 2, kc = t & 3;
      const u16* knp = KN + (size_t)kr * 512 + hd * 64 + kc * 16;
      const u16* kpp = KPE + (size_t)kr * 32 + kc * 8;
      const u16* vpp = VT + (size_t)(hd * 64 + kr) * SEQ + kc * 16;
      u32x4 rk[3], rv[2];
      rk[0] = *(const u32x4*)(knp);
      rk[1] = *(const u32x4*)(knp + 8);
      rk[2] = *(const u32x4*)(kpp);
      rv[0] = *(const u32x4*)(vpp);
      rv[1] = *(const u32x4*)(vpp + 8);
      __syncthreads();
      *(u32x4*)(sK + kr * KROW + kc * 16) = rk[0];
      *(u32x4*)(sK + kr * KROW + kc * 16 + 8) = rk[1];
      *(u32x4*)(sK + kr * KROW + 64 + kc * 8) = rk[2];
      *(uint2*)(sV + kr * VR + kc * 16) = make_uint2(rv[0][0], rv[0][1]);
      *(uint2*)(sV + kr * VR + kc * 16 + 4) = make_uint2(rv[0][2], rv[0][3]);
      *(uint2*)(sV + kr * VR + kc * 16 + 8) = make_uint2(rv[1][0], rv[1][1]);
      *(uint2*)(sV + kr * VR + kc * 16 + 12) = make_uint2(rv[1][2], rv[1][3]);
      rk[0] = *(const u32x4*)(knp + (size_t)64 * 512);
      rk[1] = *(const u32x4*)(knp + (size_t)64 * 512 + 8);
      rk[2] = *(const u32x4*)(kpp + (size_t)64 * 32);
      rv[0] = *(const u32x4*)(vpp + 64);
      rv[1] = *(const u32x4*)(vpp + 64 + 8);
      __syncthreads();
      int cur = 0;
      for (int key0 = 0; key0 < SEQ; key0 += 64) {
        const u16* cK = sK + cur * ABUF;
        const u16* cV = sV + cur * ABUF;
        {
          u16* nK = sK + (cur ^ 1) * ABUF;
          u16* nV = sV + (cur ^ 1) * ABUF;
          *(u32x4*)(nK + kr * KROW + kc * 16) = rk[0];
          *(u32x4*)(nK + kr * KROW + kc * 16 + 8) = rk[1];
          *(u32x4*)(nK + kr * KROW + 64 + kc * 8) = rk[2];
          *(uint2*)(nV + kr * VR + kc * 16) = make_uint2(rv[0][0], rv[0][1]);
          *(uint2*)(nV + kr * VR + kc * 16 + 4) = make_uint2(rv[0][2], rv[0][3]);
          *(uint2*)(nV + kr * VR + kc * 16 + 8) = make_uint2(rv[1][0], rv[1][1]);
          *(uint2*)(nV + kr * VR + kc * 16 + 12) = make_uint2(rv[1][2], rv[1][3]);
          const int kn = (key0 + 128 < SEQ) ? (key0 + 128) : key0;
          rk[0] = *(const u32x4*)(knp + (size_t)kn * 512);
          rk[1] = *(const u32x4*)(knp + (size_t)kn * 512 + 8);
          rk[2] = *(const u32x4*)(kpp + (size_t)kn * 32);
          rv[0] = *(const u32x4*)(vpp + kn);
          rv[1] = *(const u32x4*)(vpp + kn + 8);
        }
        __builtin_amdgcn_sched_barrier(0);
        f32x16 S[2][2];
#pragma unroll
        for (int kt = 0; kt < 2; ++kt)
#pragma unroll
          for (int qt = 0; qt < 2; ++qt)
#pragma unroll
            for (int k = 0; k < 16; ++k) S[kt][qt][k] = -m[qt];
#pragma unroll
        for (int ks = 0; ks < 6; ++ks)
#pragma unroll
          for (int kt = 0; kt < 2; ++kt) {
            bf16x8 fa = *(const bf16x8*)(cK + (kt * 32 + r) * KROW + ks * 16 + h * 8);
            S[kt][0] = MFMA(fa, bq[0][ks], S[kt][0]);
            S[kt][1] = MFMA(fa, bq[1][ks], S[kt][1]);
          }
        bf16x8 pf[2][4];
#pragma unroll
        for (int qt = 0; qt < 2; ++qt) {
          float mloc = S[0][qt][0];
#pragma unroll
          for (int kt = 0; kt < 2; ++kt)
#pragma unroll
            for (int k = 0; k < 16; ++k) mloc = fmaxf(mloc, S[kt][qt][k]);
          {
            auto sw_ = __builtin_amdgcn_permlane32_swap(__float_as_uint(mloc), __float_as_uint(mloc), false, false);
            mloc = fmaxf(__uint_as_float(sw_[0]), __uint_as_float(sw_[1]));
          }
          if (__builtin_amdgcn_ballot_w64(mloc > 6.f) != 0ull) {
            const float delta = fmaxf(mloc, 0.f);
            const float alpha = __builtin_amdgcn_exp2f(-delta);
            m[qt] += delta;
            lsum[qt] *= alpha;
#pragma unroll
            for (int j = 0; j < 2; ++j)
#pragma unroll
              for (int k = 0; k < 16; ++k) O[j][qt][k] *= alpha;
#pragma unroll
            for (int kt = 0; kt < 2; ++kt)
#pragma unroll
              for (int k = 0; k < 16; ++k) S[kt][qt][k] -= delta;
          }
          float ps = 0.f;
#pragma unroll
          for (int kt = 0; kt < 2; ++kt)
#pragma unroll
            for (int k = 0; k < 16; ++k) { S[kt][qt][k] = __builtin_amdgcn_exp2f(S[kt][qt][k]); ps += S[kt][qt][k]; }
          lsum[qt] += ps;
#pragma unroll
          for (int s2 = 0; s2 < 4; ++s2) {
            const int kt = s2 >> 1, sx = s2 & 1;
            unsigned pw[4];
#pragma unroll
            for (int j = 0; j < 4; ++j) pw[j] = pk2(S[kt][qt][8 * sx + 2 * j], S[kt][qt][8 * sx + 2 * j + 1]);
            pf[qt][s2] = __builtin_bit_cast(bf16x8, make_uint4(pw[0], pw[1], pw[2], pw[3]));
          }
        }
#pragma unroll
        for (int s2 = 0; s2 < 4; ++s2) {
          const int kt = s2 >> 1, sx = s2 & 1;
#pragma unroll
          for (int dt = 0; dt < 2; ++dt) {
            const u16* vp = cV + (dt * 32 + r) * VR + kt * 32 + 16 * sx + 4 * h;
            uint2 lo = *(const uint2*)(vp);
            uint2 hi = *(const uint2*)(vp + 8);
            bf16x8 fv = __builtin_bit_cast(bf16x8, make_uint4(lo.x, lo.y, hi.x, hi.y));
            O[dt][0] = MFMA(fv, pf[0][s2], O[dt][0]);
            O[dt][1] = MFMA(fv, pf[1][s2], O[dt][1]);
          }
        }
        cur ^= 1;
        __syncthreads();
      }
#pragma unroll
      for (int qt = 0; qt < 2; ++qt) {
        const float lt = lsum[qt] + __shfl_xor(lsum[qt], 32);
        const float inv = 1.f / lt;
#pragma unroll
        for (int dt = 0; dt < 2; ++dt)
#pragma unroll
          for (int g4 = 0; g4 < 4; ++g4) {
            uint2 o;
            o.x = pk2(O[dt][qt][4 * g4 + 0] * inv, O[dt][qt][4 * g4 + 1] * inv);
            o.y = pk2(O[dt][qt][4 * g4 + 2] * inv, O[dt][qt][4 * g4 + 3] * inv);
            *(uint2*)(OA + (size_t)(q0 + qt * 32 + r) * 512 + hd * 64 + dt * 32 + 8 * g4 + 4 * h) = o;
          }
      }
    }
  };

  auto gla_out_phase = [&](int l) __attribute__((always_inline)) {
    const int t = opaque_tid();
    const int lane = t & 63, w = t >> 6, r = lane & 31, h = lane >> 5;
    const int wm = w >> 1, wn = w & 1;
    (void)lane; (void)r; (void)h; (void)wm; (void)wn;
    constexpr int QROW = 136;
    u16* sQ = smem;
    u16* sKt = smem + 64 * QROW;
    u16* sVT = smem + 2 * 64 * QROW;
    float* sred = (float*)(smem + 2 * 64 * QROW + 256 * LROW);
    u16* sO = smem;
    constexpr int OROW = 264;
    const float qs = 0.08838834764831845f;
    const int cs = w & 1, vh = w >> 1;
    for (int id = bid; id < NCHUNK * 4; id += G) {
      const int n = id >> 2, hd = id & 3;
      const int t0 = n * 64;
      __syncthreads();
      {
        const int cc = t & 63, part = t >> 6;
#pragma unroll
        for (int q = 0; q < 8; ++q) {
          const int cg8 = (part * 8 + q) * 8;
          uint4 v = *(const uint4*)(Z + (size_t)(t0 + cc) * ZLD + Z_GV + hd * 256 + cg8);
          unsigned u[4] = {v.x, v.y, v.z, v.w};
#pragma unroll
          for (int j = 0; j < 4; ++j) {
            sVT[(cg8 + 2 * j) * LROW + cc] = (u16)(u[j] & 0xffffu);
            sVT[(cg8 + 2 * j + 1) * LROW + cc] = (u16)(u[j] >> 16);
          }
        }
      }
      f32x16 acc[4];
#pragma unroll
      for (int j = 0; j < 4; ++j)
#pragma unroll
        for (int k = 0; k < 16; ++k) acc[j][k] = 0.f;
      for (int dir = 0; dir < 2; ++dir) {
        __syncthreads();
        {
          const int cc = t >> 2, dp = (t & 3) * 32;
          const u16* qp = Z + (size_t)(t0 + cc) * ZLD + Z_GQ + hd * 128 + dp;
          const u16* kp = Z + (size_t)(t0 + cc) * ZLD + Z_GK + hd * 128 + dp;
          const float* gp = GC + (size_t)dir * SEQ * 512 + (size_t)(t0 + cc) * 512 + hd * 128 + dp;
#pragma unroll
          for (int j = 0; j < 4; ++j) {
            uint4 qv = *(const uint4*)(qp + j * 8);
            uint4 kv = *(const uint4*)(kp + j * 8);
            float4 g0 = *(const float4*)(gp + j * 8);
            float4 g1 = *(const float4*)(gp + j * 8 + 4);
            const float gg[8] = {g0.x, g0.y, g0.z, g0.w, g1.x, g1.y, g1.z, g1.w};
            const unsigned qu[4] = {qv.x, qv.y, qv.z, qv.w};
            const unsigned ku[4] = {kv.x, kv.y, kv.z, kv.w};
            unsigned qo[4], ko[4];
#pragma unroll
            for (int k = 0; k < 4; ++k) {
              const float e0 = __expf(gg[2 * k]), e1 = __expf(gg[2 * k + 1]);
              qo[k] = pk2(bflo(qu[k]) * qs * e0, bfhi(qu[k]) * qs * e1);
              ko[k] = pk2(bflo(ku[k]) / e0, bfhi(ku[k]) / e1);
            }
            *(uint4*)(sQ + cc * QROW + dp + j * 8) = make_uint4(qo[0], qo[1], qo[2], qo[3]);
            *(uint4*)(sKt + cc * QROW + dp + j * 8) = make_uint4(ko[0], ko[1], ko[2], ko[3]);
            if (j == 1) __builtin_amdgcn_sched_barrier(0);
          }
        }
        __syncthreads();
        const u16* bqp = sQ + (cs * 32 + r) * QROW + h * 8;
        const u16* stp = ST + ((size_t)(n * 4 + hd) * 2 + dir) * 32768;
        bf16x8 fs[2][4];
#pragma unroll
        for (int ks = 0; ks < 4; ++ks) fs[0][ks] = *(const bf16x8*)(stp + (size_t)(vh * 128 + r) * 128 + ks * 16 + h * 8);
        f32x16 at[2];
#pragma unroll
        for (int et = 0; et < 2; ++et) {
#pragma unroll
          for (int k = 0; k < 16; ++k) at[et][k] = 0.f;
#pragma unroll
          for (int ks = 0; ks < 8; ++ks) {
            bf16x8 fa = *(const bf16x8*)(sKt + (et * 32 + r) * QROW + ks * 16 + h * 8);
            bf16x8 fbq = *(const bf16x8*)(bqp + ks * 16);
            at[et] = MFMA(fa, fbq, at[et]);
          }
          const int cidx = cs * 32 + r;
#pragma unroll
          for (int k = 0; k < 16; ++k) {
            const int e = et * 32 + crow(k, h);
            const bool keep = dir ? (e >= cidx) : (e <= cidx);
            at[et][k] = keep ? at[et][k] : 0.f;
          }
        }
#pragma unroll
        for (int s2 = 0; s2 < 4; ++s2) {
          const int et = s2 >> 1, s = s2 & 1;
          unsigned pw[4];
#pragma unroll
          for (int j = 0; j < 4; ++j) pw[j] = pk2(at[et][8 * s + 2 * j], at[et][8 * s + 2 * j + 1]);
          bf16x8 pf = __builtin_bit_cast(bf16x8, make_uint4(pw[0], pw[1], pw[2], pw[3]));
#pragma unroll
          for (int mt = 0; mt < 4; ++mt) {
            const u16* vp = sVT + (vh * 128 + mt * 32 + r) * LROW + et * 32 + 16 * s + 4 * h;
            uint2 lo = *(const uint2*)(vp);
            uint2 hi = *(const uint2*)(vp + 8);
            bf16x8 fv = __builtin_bit_cast(bf16x8, make_uint4(lo.x, lo.y, hi.x, hi.y));
            acc[mt] = MFMA(fv, pf, acc[mt]);
          }
        }
#pragma unroll
        for (int bb = 0; bb < 8; ++bb) {
          const int mt = bb >> 1, kb = bb & 1;
          if (bb + 1 < 8) {
            const int mt1 = (bb + 1) >> 1, kb1 = (bb + 1) & 1;
#pragma unroll
            for (int ks = 0; ks < 4; ++ks) fs[(bb + 1) & 1][ks] = *(const bf16x8*)(stp + (size_t)(vh * 128 + mt1 * 32 + r) * 128 + (kb1 * 4 + ks) * 16 + h * 8);
          }
          __builtin_amdgcn_sched_barrier(0);
#pragma unroll
          for (int ks = 0; ks < 4; ++ks) { bf16x8 fbq = *(const bf16x8*)(bqp + (kb * 4 + ks) * 16); acc[mt] = MFMA(fs[bb & 1][ks], fbq, acc[mt]); }
          __builtin_amdgcn_sched_barrier(0);
        }
      }
      float ss = 0.f;
#pragma unroll
      for (int mt = 0; mt < 4; ++mt)
#pragma unroll
        for (int k = 0; k < 16; ++k) ss += acc[mt][k] * acc[mt][k];
      ss += __shfl_xor(ss, 32);
      if (h == 0) sred[vh * 64 + cs * 32 + r] = ss;
      __syncthreads();
      const float rs = rsqrtf((sred[cs * 32 + r] + sred[64 + cs * 32 + r]) * (1.f / 256.f) + EPS);
#pragma unroll
      for (int mt = 0; mt < 4; ++mt)
#pragma unroll
        for (int g4 = 0; g4 < 4; ++g4) {
          uint2 o;
          o.x = pk2(acc[mt][4 * g4 + 0] * rs, acc[mt][4 * g4 + 1] * rs);
          o.y = pk2(acc[mt][4 * g4 + 2] * rs, acc[mt][4 * g4 + 3] * rs);
          *(uint2*)(sO + (cs * 32 + r) * OROW + vh * 128 + mt * 32 + 8 * g4 + 4 * h) = o;
        }
      __syncthreads();
      {
        const int t3 = opaque_tid();
        const int cc = t3 >> 2, vp0 = (t3 & 3) * 64;
        const float* ng = in_ptr(p, 17) + (size_t)l * 256;
#pragma unroll
        for (int j = 0; j < 8; ++j) {
          const int v0 = vp0 + j * 8;
          uint4 ov = *(const uint4*)(sO + cc * OROW + v0);
          uint4 gv = *(const uint4*)(Z + (size_t)(t0 + cc) * ZLD + Z_GOG + hd * 256 + v0);
          float4 n0 = *(const float4*)(ng + v0), n1 = *(const float4*)(ng + v0 + 4);
          const float nn[8] = {n0.x, n0.y, n0.z, n0.w, n1.x, n1.y, n1.z, n1.w};
          const unsigned ou[4] = {ov.x, ov.y, ov.z, ov.w};
          const unsigned gu[4] = {gv.x, gv.y, gv.z, gv.w};
          unsigned res[4];
#pragma unroll
          for (int k = 0; k < 4; ++k)
            res[k] = pk2(bflo(ou[k]) * nn[2 * k] * siluf_(bflo(gu[k])), bfhi(ou[k]) * nn[2 * k + 1] * siluf_(bfhi(gu[k])));
          *(uint4*)(OG + (size_t)(t0 + cc) * DM + hd * 256 + v0) = make_uint4(res[0], res[1], res[2], res[3]);
        }
      }
    }
  };

  auto merge_phase = [&]() __attribute__((always_inline)) {
    const int t = opaque_tid();
    const int lane = t & 63, w = t >> 6, r = lane & 31, h = lane >> 5;
    const int wm = w >> 1, wn = w & 1;
    (void)lane; (void)r; (void)h; (void)wm; (void)wn;
    const int MT = SEQ / 256, NT = DM / 128;
    for (int id = bid; id < MT * NT; id += G) {
      int tm, tn; tile_coords(id, MT, NT, tm, tn);
      const int m0 = tm * 256, n0 = tn * 128;
      Acc c; acc_zero(c);
      gemm_kloop(OA + (size_t)m0 * 512, 512, Wb + W_OA + (size_t)n0 * 512, 512, 512, smem, c);
      {
        const unsigned zbase = (unsigned)((m0 + wm * 128) * ZLD + Z_BG + n0 + wn * 64);
        const unsigned obase = (unsigned)((m0 + wm * 128) * DM + n0 + wn * 64);
        epi_store<2>(smem,
          [&](int mi, int ni, int i) { return c.a[mi][ni][i]; },
          [&](int row, int col, u32x4 v) {
            const u32x4 g = *(const u32x4*)(Z + zbase + (unsigned)(row * ZLD + col));
            u32x4 o;
#pragma unroll
            for (int k = 0; k < 4; ++k) o[k] = pk2(bflo(v[k]) * sigmoidf_(bflo(g[k])), bfhi(v[k]) * sigmoidf_(bfhi(g[k])));
            *(u32x4*)(MG + obase + (unsigned)(row * DM + col)) = o;
          });
      }
      acc_zero(c);
      gemm_kloop(OG + (size_t)m0 * DM, DM, Wb + W_OB + (size_t)n0 * DM, DM, DM, smem, c);
      {
        const int t2 = opaque_tid();
        const int wm2 = t2 >> 7, wn2 = (t2 >> 6) & 1;
        const unsigned zbase = (unsigned)((m0 + wm2 * 128) * ZLD + Z_BG + DM + n0 + wn2 * 64);
        const unsigned obase = (unsigned)((m0 + wm2 * 128) * DM + n0 + wn2 * 64);
        epi_store<2>(smem,
          [&](int mi, int ni, int i) { return c.a[mi][ni][i]; },
          [&](int row, int col, u32x4 v) {
            const u32x4 g = *(const u32x4*)(Z + zbase + (unsigned)(row * ZLD + col));
            const u32x4 pm = *(const u32x4*)(MG + obase + (unsigned)(row * DM + col));
            u32x4 o;
#pragma unroll
            for (int k = 0; k < 4; ++k)
              o[k] = pk2(bflo(pm[k]) + bflo(v[k]) * sigmoidf_(bflo(g[k])), bfhi(pm[k]) + bfhi(v[k]) * sigmoidf_(bfhi(g[k])));
            *(u32x4*)(MG + obase + (unsigned)(row * DM + col)) = o;
          });
      }
    }
  };

  for (int i = bid * 256 + opaque_tid(); i < SEQ * 16; i += G * 256) {
    const int pos = i >> 4, j = i & 15;
    const float inv_freq = exp2f(-(float)j * 0.8304820237218406f);
    const float angf = (float)pos * inv_freq;
    double a = (double)angf;
    const double twopi = 6.283185307179586476925286766559;
    a -= twopi * rint(a / twopi);
    const float af = (float)a;
    ropec[i] = __cosf(af);
    ropes[i] = __sinf(af);
  }
  convert_weights(0);
  rn_pass(0, 0.f, nullptr, in_ptr(p, 2));
  grid.sync();

  for (int l = 0; l < 4; ++l) {
    asm volatile("" : "+s"(bid));
    ffn_in(W_FFN1_IN);
#ifdef DUP_FFNIN
    xcd_barrier(xb);
    ffn_in(W_FFN1_IN);
#endif
    xcd_barrier(xb);
    gemm_plain(ACT, DFF, DFF, Wb + W_FFN1_OUT, Yb, DM, MALL, DM);
    xcd_barrier(xb);
    rn_pass(1, 0.5f, in_ptr(p, 5) + l * DM, in_ptr(p, 6) + l * DM);
    xcd_barrier(xb);
    for (int s = 0; s < NSEQ; ++s) {
      asm volatile("" : "+s"(bid));
      gemm_plain(Hb + (size_t)s * SEQ * DM, DM, DM, Wb + W_IN, Z, ZLD, SEQ, ZLD);
      xcd_barrier(xb);
      prep_phase(l);
#ifdef DUP_PREP
      xcd_barrier(xb);
      prep_phase(l);
#endif
      xcd_barrier(xb);
      attn_phase(1);
      xcd_barrier(xb);
      int bpar_ = bid; asm volatile("" : "+s"(bpar_));
      if (bpar_ & 1) { attn_phase(2); gla_out_phase(l); }
      else { gla_out_phase(l); attn_phase(2); }
      xcd_barrier(xb);
      merge_phase();
      xcd_barrier(xb);
      gemm_plain(MG, DM, DM, Wb + W_OUT, Yb + (size_t)s * SEQ * DM, DM, SEQ, DM);
      xcd_barrier(xb);
    }
    rn_pass(1, 1.0f, in_ptr(p, 20) + l * DM, in_ptr(p, 21) + l * DM);
    xcd_barrier(xb);
    ffn_in(W_FFN2_IN);
    xcd_barrier(xb);
    gemm_plain(ACT, DFF, DFF, Wb + W_FFN2_OUT, Yb, DM, MALL, DM);
    xcd_barrier(xb);
    rn_pass(1, 0.5f, in_ptr(p, 24) + l * DM, (l < 3) ? (in_ptr(p, 2) + (l + 1) * DM) : nullptr);
    if (l < 3) convert_weights(l + 1);
    xcd_barrier(xb);
  }
}

extern "C" void kernel_launch(void* const* d_in, const int* in_sizes, int n_in, void* d_out,
                              int out_size, void* d_ws, size_t ws_size, hipStream_t stream) {
  static int grid_blocks = 0;
  if (!grid_blocks) {
    int dev = 0, cus = 0, per_cu = 0;
    (void)hipGetDevice(&dev);
    (void)hipDeviceGetAttribute(&cus, hipDeviceAttributeMultiprocessorCount, dev);
    (void)hipOccupancyMaxActiveBlocksPerMultiprocessor(&per_cu, fwd_megakernel, 256, 0);
    if (per_cu > 2) per_cu = 2;
    if (per_cu < 1) per_cu = 1;
    grid_blocks = cus * per_cu;
  }
  Params p{};
  for (int i = 0; i < 25; ++i) p.in[i] = (const float*)d_in[i];
  p.out = (float*)d_out;
  p.ws = (char*)d_ws;
  (void)hipMemsetAsync((char*)d_ws + OFF_BAR, 0, XCD_BAR_WORDS * 4, stream);
  void* args[] = {&p};
  hipError_t e = hipLaunchCooperativeKernel((void*)fwd_megakernel, dim3(grid_blocks), dim3(256), args, 0, stream);
  if (e != hipSuccess) fprintf(stderr, "cooperative launch failed: %s (grid %d)\n", hipGetErrorString(e), grid_blocks);
}
```

```cpp
#include <hip/hip_runtime.h>
#include <hip/hip_cooperative_groups.h>
#include <cstdio>
namespace cg = cooperative_groups;

typedef unsigned short u16;
typedef short bf16x8 __attribute__((ext_vector_type(8)));
typedef short s16x4 __attribute__((ext_vector_type(4)));
typedef float f32x16 __attribute__((ext_vector_type(16)));
typedef __bf16 bf2_t __attribute__((ext_vector_type(2)));
typedef float f2_t __attribute__((ext_vector_type(2)));
typedef unsigned u32x4 __attribute__((ext_vector_type(4)));
#define DI __device__ __forceinline__
#define MFMA(a, b, c) __builtin_amdgcn_mfma_f32_32x32x16_bf16((a), (b), (c), 0, 0, 0)

constexpr int SEQ = 16384;
constexpr int NSEQ = 3;
constexpr int MALL = SEQ * NSEQ;
constexpr int DM = 1024;
constexpr int DFF = 2816;
constexpr int NFF2 = 5632;
constexpr int PIN = 5568;
constexpr int ZLD = 5632;
constexpr int Z_CQ = 0, Z_CKV = 256, Z_KPE = 384, Z_GQ = 416, Z_GK = 928, Z_GV = 1440, Z_GA = 2464, Z_GOG = 2496, Z_BG = 3520;
constexpr float EPS = 1e-6f;
constexpr int NCHUNK = SEQ / 64;

constexpr size_t W_FFN1_IN = 0;
constexpr size_t W_FFN1_OUT = W_FFN1_IN + (size_t)NFF2 * DM;
constexpr size_t W_IN = W_FFN1_OUT + (size_t)DM * DFF;
constexpr size_t W_UQ = W_IN + (size_t)ZLD * DM;
constexpr size_t W_KN = W_UQ + (size_t)768 * 256;
constexpr size_t W_V = W_KN + (size_t)512 * 128;
constexpr size_t W_OA = W_V + (size_t)512 * 128;
constexpr size_t W_OB = W_OA + (size_t)DM * 512;
constexpr size_t W_OUT = W_OB + (size_t)DM * DM;
constexpr size_t W_FFN2_IN = W_OUT + (size_t)DM * DM;
constexpr size_t W_FFN2_OUT = W_FFN2_IN + (size_t)NFF2 * DM;
constexpr size_t W_END = W_FFN2_OUT + (size_t)DM * DFF;

constexpr size_t al256(size_t x) { return (x + 255) & ~(size_t)255; }
constexpr size_t OFF_WB = 0;
constexpr size_t OFF_ROPE = al256(OFF_WB + W_END * 2);
constexpr size_t OFF_H = al256(OFF_ROPE + (size_t)SEQ * 32 * 4);
constexpr size_t OFF_Y = al256(OFF_H + (size_t)MALL * DM * 2);
constexpr size_t OFF_ACT = al256(OFF_Y + (size_t)MALL * DM * 2);
constexpr size_t OFF_Z = OFF_ACT;
constexpr size_t OFF_Q = al256(OFF_Z + (size_t)SEQ * ZLD * 2);
constexpr size_t OFF_KN = al256(OFF_Q + (size_t)SEQ * 768 * 2);
constexpr size_t OFF_VT = al256(OFF_KN + (size_t)SEQ * 512 * 2);
constexpr size_t OFF_KPE = al256(OFF_VT + (size_t)SEQ * 512 * 2);
constexpr size_t OFF_OA = al256(OFF_KPE + (size_t)SEQ * 32 * 2);
constexpr size_t OFF_MIXEND = al256(OFF_OA + (size_t)SEQ * 512 * 2);
constexpr size_t OFF_ACTEND = al256(OFF_ACT + (size_t)MALL * DFF * 2);
static_assert(OFF_MIXEND <= OFF_ACTEND, "mixer scratch must fit in act");
constexpr size_t OFF_ST = OFF_ACTEND;
constexpr size_t OFF_DEC = al256(OFF_ST + (size_t)NCHUNK * 4 * 2 * 256 * 128 * 2);
constexpr size_t OFF_GC = al256(OFF_DEC + (size_t)NCHUNK * 4 * 2 * 128 * 4);
constexpr size_t OFF_OG = al256(OFF_GC + (size_t)2 * SEQ * 512 * 4);
constexpr size_t OFF_MG = al256(OFF_OG + (size_t)SEQ * DM * 2);
constexpr size_t OFF_END = al256(OFF_MG + (size_t)SEQ * DM * 2);
constexpr size_t OFF_BAR = OFF_END;
static_assert(OFF_BAR + 16384 <= (size_t)768 * 1024 * 1024, "workspace overflow");

struct Params {
  const float* in[25];
  float* out;
  char* ws;
};

DI unsigned pk2(float a, float b) { f2_t v = {a, b}; return __builtin_bit_cast(unsigned, __builtin_convertvector(v, bf2_t)); }
DI u16 f2bf(float a) { return (u16)(pk2(a, 0.f) & 0xffffu); }
DI float bf2f(u16 v) { return __uint_as_float(((unsigned)v) << 16); }
DI float bflo(unsigned v) { return __uint_as_float(v << 16); }
DI float bfhi(unsigned v) { return __uint_as_float(v & 0xffff0000u); }
DI float wave_sum(float v) {
#pragma unroll
  for (int o = 32; o >= 1; o >>= 1) v += __shfl_xor(v, o);
  return v;
}
DI int opaque_tid() { int t = threadIdx.x; asm volatile("" : "+v"(t)); return t; }
DI const float* in_ptr(const Params& p, int k) { asm volatile("" : "+s"(k)); return p.in[k]; }
DI int crow(int i, int h) { return (i & 3) + 8 * (i >> 2) + 4 * h; }
DI float sigmoidf_(float x) { return 1.f / (1.f + __expf(-x)); }
DI float siluf_(float x) { return x / (1.f + __expf(-x)); }


#define XB_TMO      128
#define XB_XCNT(j)  (256  + 64 * (j))
#define XB_XSUB(j)  (1280 + 64 * (j))
#define XB_XGEN(j)  (2304 + 64 * (j))
#define XB_TOP      3328
#define XB_TOPGEN   3392
#define XCD_BAR_WORDS 3456
#define XB_SPIN_CAP (1u << 18)
#define LAS __attribute__((address_space(3)))

__device__ __forceinline__ unsigned xb_ld(unsigned* p)              { return __hip_atomic_load(p, __ATOMIC_RELAXED, __HIP_MEMORY_SCOPE_AGENT); }
__device__ __forceinline__ unsigned xb_add(unsigned* p, unsigned v) { return __hip_atomic_fetch_add(p, v, __ATOMIC_RELAXED, __HIP_MEMORY_SCOPE_AGENT); }
__device__ __forceinline__ unsigned xb_xcc_id() { return (unsigned)__builtin_amdgcn_s_getreg((3 << 11) | 20) & 0xFu; }
#define XB_SPIN(cond, bar) do { unsigned _sp = 0; while (cond) { __builtin_amdgcn_s_sleep(1); \
    if ((++_sp & 255u) == 0u) { if (xb_ld(&(bar)[XB_TMO])) break; if (_sp > XB_SPIN_CAP) { atomicAdd(&(bar)[XB_TMO], 1u); break; } } } } while (0)

struct XcdBarrier {
    unsigned* bar; unsigned x;
    volatile LAS unsigned* st;
};

__device__ __forceinline__ XcdBarrier xcd_barrier_post(unsigned* bar, volatile LAS unsigned* st) {
    XcdBarrier b; b.bar = bar; b.x = xb_xcc_id(); b.st = st;
    if (threadIdx.x == 0) (void)xb_add(&bar[XB_XCNT(b.x)], 1u);
    return b;
}
__device__ __forceinline__ void xcd_barrier_complete(unsigned* bar, unsigned x, unsigned& nloc, unsigned& nx) {
    const unsigned G = gridDim.x * gridDim.y * gridDim.z;
    unsigned sum, cnt, mine, sp = 0u;
    for (;;) {
        sum = 0u; cnt = 0u; mine = 0u;
#pragma unroll
        for (unsigned j = 0; j < 16; ++j) { const unsigned c = xb_ld(&bar[XB_XCNT(j)]); sum += c; cnt += (c > 0u) ? 1u : 0u; mine = (j == x) ? c : mine; }
        if (sum == G) break;
        __builtin_amdgcn_s_sleep(1);
        if ((++sp & 255u) == 0u) { if (xb_ld(&bar[XB_TMO])) break; if (sp > XB_SPIN_CAP) { atomicAdd(&bar[XB_TMO], 1u); break; } }
    }
    nloc = mine > 0u ? mine : 1u; nx = cnt > 0u ? cnt : 1u;
}

__device__ __forceinline__ void xcd_barrier(const XcdBarrier& b) {
    asm volatile("s_waitcnt vmcnt(0)" ::: "memory");
    __syncthreads();
    int tid0_ = threadIdx.x; asm volatile("" : "+v"(tid0_));
    if (tid0_ == 0) {
        unsigned* bar = b.bar; asm volatile("" : "+s"(bar));
        unsigned bx_ = b.x; asm volatile("" : "+s"(bx_));
        __builtin_amdgcn_s_waitcnt(0);
        unsigned nloc = b.st[0], nx = b.st[1];
        if (nloc == 0u) { xcd_barrier_complete(bar, bx_, nloc, nx); b.st[0] = nloc; b.st[1] = nx; }
        const unsigned old = xb_add(&bar[XB_XSUB(bx_)], 1u);
        const unsigned gen = old / nloc;
        if (old + 1u == (gen + 1u) * nloc) {
            __builtin_amdgcn_fence(__ATOMIC_RELEASE, "agent");
            asm volatile("s_waitcnt vmcnt(0)" ::: "memory");
            const unsigned og = xb_add(&bar[XB_TOP], 1u);
            const unsigned tg = og / nx;
            if (og + 1u == (tg + 1u) * nx) xb_add(&bar[XB_TOPGEN], 1u);
            else XB_SPIN(xb_ld(&bar[XB_TOPGEN]) == tg, bar);
            __builtin_amdgcn_fence(__ATOMIC_ACQUIRE, "agent");
            xb_add(&bar[XB_XGEN(bx_)], 1u);
            asm volatile("s_waitcnt vmcnt(0)" ::: "memory");
        } else {
            XB_SPIN(xb_ld(&bar[XB_XGEN(bx_)]) == gen, bar);
            __builtin_amdgcn_fence(__ATOMIC_ACQUIRE, "agent");
            asm volatile("s_waitcnt vmcnt(0)" ::: "memory");
        }
    }
    __syncthreads();
}

constexpr int LROW = 72;
constexpr int GEMM_LDS = 2 * 128 * LROW * 2;

struct Acc { f32x16 a[4][2]; };

DI void acc_zero(Acc& c) {
#pragma unroll
  for (int i = 0; i < 4; ++i)
#pragma unroll
    for (int j = 0; j < 2; ++j)
#pragma unroll
      for (int k = 0; k < 16; ++k) c.a[i][j][k] = 0.f;
}

DI void gll16(const u16* g, char* l) {
  __builtin_amdgcn_global_load_lds((const __attribute__((address_space(1))) unsigned*)g,
                                   (__attribute__((address_space(3))) unsigned*)l, 16, 0, 0);
}
DI void gemm_kloop(const u16* __restrict__ A, int lda, const u16* __restrict__ B, int ldb, int K, u16* smem, Acc& c) {
  const int t = opaque_tid();
  const int lane = t & 63, w = t >> 6, r = lane & 31, h = lane >> 5;
  const int wm = w >> 1, wn = w & 1;
  char* lds = (char*)smem;
  const int nk = K >> 5;
  const int row0 = t >> 2, c0 = t & 3;
  const int sw0 = (c0 ^ ((row0 >> 2) & 3)) * 8;
  const u16* ga0 = A + (size_t)row0 * lda + sw0;
  const u16* gb0 = B + (size_t)row0 * ldb + sw0;
  const size_t a64 = (size_t)64 * lda, b64 = (size_t)64 * ldb;
  const int loff = t * 16;
#define GEMM_ISSUE(kt_, st_)                                         \
  do {                                                               \
    const int kk_ = ((kt_) < nk ? (kt_) : (nk - 1)) * 32;            \
    char* sp_ = lds + (st_) * 24576 + loff;                          \
    gll16(ga0 + kk_, sp_);                                           \
    gll16(ga0 + a64 + kk_, sp_ + 4096);                              \
    gll16(ga0 + 2 * a64 + kk_, sp_ + 8192);                          \
    gll16(ga0 + 3 * a64 + kk_, sp_ + 12288);                         \
    gll16(gb0 + kk_, sp_ + 16384);                                   \
    gll16(gb0 + b64 + kk_, sp_ + 20480);                             \
  } while (0)
  __syncthreads();
  GEMM_ISSUE(0, 0);
  GEMM_ISSUE(1, 1);
  const int fsw = (r >> 2) & 3;
  const int aoff = (wm * 128 + r) * 64, boff = 16384 + (wn * 64 + r) * 64;
  int scur = 0, snext = 2;
  for (int kt = 0; kt < nk; ++kt) {
    asm volatile("s_waitcnt vmcnt(6)" ::: "memory");
    __builtin_amdgcn_s_barrier();
    asm volatile("" ::: "memory");
    GEMM_ISSUE(kt + 2, snext);
    __builtin_amdgcn_sched_barrier(0);
    const char* st = lds + scur * 24576;
#pragma unroll
    for (int ks = 0; ks < 2; ++ks) {
      const int q = ((ks * 2 + h) ^ fsw) * 16;
      bf16x8 fa[4], fb[2];
#pragma unroll
      for (int i = 0; i < 4; ++i) fa[i] = *(const bf16x8*)(st + aoff + i * 2048 + q);
#pragma unroll
      for (int i = 0; i < 2; ++i) fb[i] = *(const bf16x8*)(st + boff + i * 2048 + q);
#pragma unroll
      for (int i = 0; i < 4; ++i)
#pragma unroll
        for (int j = 0; j < 2; ++j) c.a[i][j] = MFMA(fa[i], fb[j], c.a[i][j]);
    }
    __builtin_amdgcn_sched_barrier(0);
    snext = scur;
    scur = (scur == 2) ? 0 : scur + 1;
  }
  asm volatile("s_waitcnt vmcnt(0)" ::: "memory");
  __builtin_amdgcn_s_barrier();
  asm volatile("" ::: "memory");
#undef GEMM_ISSUE
}

DI void row_scales(const u16* __restrict__ base, int ld, int K, float* sc, int NR) {
  const int t = opaque_tid();
  const int row = (NR == 256) ? t : (t >> 1);
  const int part = (NR == 256) ? 0 : (t & 1);
  const int len = (NR == 256) ? K : (K / 2);
  const u16* p = base + (size_t)row * ld + part * len;
  float ss = 0.f;
  for (int i = 0; i < len / 8; ++i) {
    u32x4 v = *(const u32x4*)(p + i * 8);
#pragma unroll
    for (int j = 0; j < 4; ++j) { float a = bflo(v[j]), b = bfhi(v[j]); ss += a * a + b * b; }
  }
  if (NR != 256) ss += __shfl_xor(ss, 1);
  if (part == 0) sc[row] = rsqrtf(ss / (float)K + EPS);
}


template <int NI, class V, class R>
DI void epi_store(u16* smem, V val, R rowfn) {
  const int t = opaque_tid();
  const int lane = t & 63, w = t >> 6, r = lane & 31, h = lane >> 5;
  char* reg = (char*)smem + w * 18432;
#pragma unroll
  for (int mi = 0; mi < 4; ++mi)
#pragma unroll
    for (int ni = 0; ni < NI; ++ni)
#pragma unroll
      for (int i = 0; i < 16; ++i)
        *(u16*)(reg + (mi * 32 + crow(i, h)) * 144 + (ni * 32 + r) * 2) = f2bf(val(mi, ni, i));
  __builtin_amdgcn_sched_barrier(0);
  constexpr int CPR = NI * 4;
  constexpr int RPI = 64 / CPR;
  const int rr = lane / CPR, ch = lane % CPR;
#pragma unroll
  for (int k = 0; k < 128 / RPI; ++k) {
    const int row = k * RPI + rr;
    u32x4 v = *(const u32x4*)(reg + row * 144 + ch * 16);
    rowfn(row, ch * 8, v);
  }
}

DI void tile_coords(int id, int MT, int NT, int& tm, int& tn) {
  const int per = 32 * NT;
  const int sr = id / per, rem = id - sr * per;
  tn = rem >> 5;
  tm = sr * 32 + (rem & 31);
}

#define EPI_LOOP                                   \
  _Pragma("unroll") for (int mi = 0; mi < 4; ++mi) \
  _Pragma("unroll") for (int ni = 0; ni < 2; ++ni) \
  _Pragma("unroll") for (int i = (__builtin_amdgcn_sched_barrier(0), 0); i < 16; ++i)

constexpr int SMEM_BYTES = 74752;

__global__ void __launch_bounds__(256, 2) fwd_megakernel(Params p) {
  cg::grid_group grid = cg::this_grid();
  __shared__ __attribute__((aligned(16))) char smem_raw[SMEM_BYTES];
  u16* smem = (u16*)smem_raw;
  const int G = gridDim.x;
  int bid = blockIdx.x;
  __shared__ uint4 xb_words;
  if (threadIdx.x == 0) xb_words = make_uint4(0u, 0u, 0u, 0u);
  __syncthreads();
  XcdBarrier xb = xcd_barrier_post((unsigned*)(p.ws + OFF_BAR), (volatile LAS unsigned*)&xb_words);

  char* ws = p.ws;
#define Wb ((u16*)(ws + OFF_WB))
#define ropec ((float*)(ws + OFF_ROPE))
#define ropes (((float*)(ws + OFF_ROPE)) + SEQ * 16)
#define Hb ((u16*)(ws + OFF_H))
#define Yb ((u16*)(ws + OFF_Y))
#define ACT ((u16*)(ws + OFF_ACT))
#define Z ((u16*)(ws + OFF_Z))
#define Qb ((u16*)(ws + OFF_Q))
#define KN ((u16*)(ws + OFF_KN))
#define VT ((u16*)(ws + OFF_VT))
#define KPE ((u16*)(ws + OFF_KPE))
#define OA ((u16*)(ws + OFF_OA))
#define ST ((u16*)(ws + OFF_ST))
#define DEC ((float*)(ws + OFF_DEC))
#define GC ((float*)(ws + OFF_GC))
#define OG ((u16*)(ws + OFF_OG))
#define MG ((u16*)(ws + OFF_MG))
  float* X = p.out;

  auto convert_weights = [&](int l) __attribute__((always_inline)) {
    const int t = opaque_tid();
    const int lane = t & 63, w = t >> 6, r = lane & 31, h = lane >> 5;
    const int wm = w >> 1, wn = w & 1;
    (void)lane; (void)r; (void)h; (void)wm; (void)wn;
    float* tile = (float*)smem_raw;
    for (int mat = 0; mat < 11; ++mat) {
      const float* src; int K, N; size_t dst; int map; const float* ksc = nullptr;
      switch (mat) {
        case 0: src = in_ptr(p, 3) + (size_t)l * DM * NFF2; K = DM; N = NFF2; dst = W_FFN1_IN; map = 1; break;
        case 1: src = in_ptr(p, 4) + (size_t)l * DFF * DM; K = DFF; N = DM; dst = W_FFN1_OUT; map = 0; break;
        case 2: src = in_ptr(p, 7) + (size_t)l * DM * PIN; K = DM; N = PIN; dst = W_IN; map = 0; break;
        case 3: src = in_ptr(p, 9) + (size_t)l * 256 * 768; K = 256; N = 768; dst = W_UQ; map = 0; ksc = in_ptr(p, 8) + l * 256; break;
        case 4: src = in_ptr(p, 11) + (size_t)l * 128 * 1024; K = 128; N = 1024; dst = W_KN; map = 2; ksc = in_ptr(p, 10) + l * 128; break;
        case 5: src = in_ptr(p, 12) + (size_t)l * 512 * DM; K = 512; N = DM; dst = W_OA; map = 0; break;
        case 6: src = in_ptr(p, 18) + (size_t)l * DM * DM; K = DM; N = DM; dst = W_OB; map = 0; break;
        case 7: src = in_ptr(p, 19) + (size_t)l * DM * DM; K = DM; N = DM; dst = W_OUT; map = 0; break;
        case 8: src = in_ptr(p, 22) + (size_t)l * DM * NFF2; K = DM; N = NFF2; dst = W_FFN2_IN; map = 1; break;
        case 9: src = in_ptr(p, 23) + (size_t)l * DFF * DM; K = DFF; N = DM; dst = W_FFN2_OUT; map = 0; break;
        default: src = nullptr; K = DM; N = 64; dst = W_IN + (size_t)PIN * DM; map = 3; break;
      }
      const int kt_n = K / 64, nt_n = N / 64;
      for (int id = bid; id < kt_n * nt_n; id += G) {
        const int kt = id % kt_n, nt = id / kt_n;
        const int k0 = kt * 64, n0 = nt * 64;
        __syncthreads();
        if (map != 3) {
#pragma unroll
          for (int i = 0; i < 4; ++i) {
            const int kk = (t >> 4) + 16 * i, nn = (t & 15) * 4;
            float4 v = *(const float4*)(src + (size_t)(k0 + kk) * N + n0 + nn);
            float sc = ksc ? ksc[k0 + kk] : 1.f;
            tile[kk * 65 + nn + 0] = v.x * sc; tile[kk * 65 + nn + 1] = v.y * sc;
            tile[kk * 65 + nn + 2] = v.z * sc; tile[kk * 65 + nn + 3] = v.w * sc;
          }
        }
        __syncthreads();
        const int nl = t >> 2, kc = (t & 3) * 16;
        const int n = n0 + nl;
        size_t drow;
        if (map == 0) drow = dst + (size_t)n * K;
        else if (map == 1) { const int isb = n >= DFF; const int j = n - isb * DFF; drow = dst + (size_t)((j >> 5) * 64 + isb * 32 + (j & 31)) * K; }
        else if (map == 2) { const int hd = n >> 7, cc = n & 127; drow = (cc < 64) ? (W_KN + (size_t)(hd * 64 + cc) * K) : (W_V + (size_t)(hd * 64 + cc - 64) * K); }
        else drow = dst + (size_t)nl * K;
        unsigned o[8];
#pragma unroll
        for (int j = 0; j < 8; ++j) {
          float a = (map == 3) ? 0.f : tile[(kc + 2 * j) * 65 + nl];
          float b = (map == 3) ? 0.f : tile[(kc + 2 * j + 1) * 65 + nl];
          o[j] = pk2(a, b);
        }
        uint4* dp = (uint4*)(Wb + drow + k0 + kc);
        dp[0] = make_uint4(o[0], o[1], o[2], o[3]);
        dp[1] = make_uint4(o[4], o[5], o[6], o[7]);
      }
    }
  };

  auto rn_pass = [&](int mode, float coef, const float* post_g, const float* pre_g) __attribute__((always_inline)) {
    const int t = opaque_tid();
    const int lane = t & 63, w = t >> 6, r = lane & 31, h = lane >> 5;
    const int wm = w >> 1, wn = w & 1;
    (void)lane; (void)r; (void)h; (void)wm; (void)wn;
    typedef float f4v __attribute__((ext_vector_type(4)));
    typedef unsigned u2v __attribute__((ext_vector_type(2)));
    const int gw = bid * 4 + w, nw = G * 4;
    constexpr int RB = 4;
    f4v pg[4], qg[4];
#pragma unroll
    for (int i = 0; i < 4; ++i) {
      pg[i] = (mode == 1) ? *(const f4v*)(post_g + lane * 4 + 256 * i) : (f4v){0.f, 0.f, 0.f, 0.f};
      qg[i] = pre_g ? *(const f4v*)(pre_g + lane * 4 + 256 * i) : (f4v){0.f, 0.f, 0.f, 0.f};
    }
    for (int row0 = gw; row0 < MALL; row0 += RB * nw) {
      f4v xv[RB][4];
      u2v yu[RB][4];
#pragma unroll
      for (int j = 0; j < RB; ++j) {
        int row = row0 + j * nw;
        if (row >= MALL) row = row0;
        const float* xs;
        if (mode == 0) xs = (row < SEQ) ? (in_ptr(p, 0) + (size_t)row * DM) : (in_ptr(p, 1) + (size_t)(row - SEQ) * DM);
        else xs = X + (size_t)row * DM;
#pragma unroll
        for (int i = 0; i < 4; ++i) xv[j][i] = *(const f4v*)(xs + lane * 4 + 256 * i);
        if (mode == 1) {
#pragma unroll
          for (int i = 0; i < 4; ++i) yu[j][i] = *(const u2v*)(Yb + (size_t)row * DM + lane * 4 + 256 * i);
        }
      }
#pragma unroll
      for (int j = 0; j < RB; ++j) {
        const int row = row0 + j * nw;
        if (row < MALL) {
          if (mode == 1) {
            float yv[16];
            float ss = 0.f;
#pragma unroll
            for (int i = 0; i < 4; ++i) {
              yv[4 * i + 0] = bflo(yu[j][i][0]); yv[4 * i + 1] = bfhi(yu[j][i][0]);
              yv[4 * i + 2] = bflo(yu[j][i][1]); yv[4 * i + 3] = bfhi(yu[j][i][1]);
            }
#pragma unroll
            for (int i = 0; i < 16; ++i) ss += yv[i] * yv[i];
            ss = wave_sum(ss);
            const float ry = rsqrtf(ss * (1.f / DM) + EPS) * coef;
#pragma unroll
            for (int i = 0; i < 4; ++i)
#pragma unroll
              for (int k = 0; k < 4; ++k) xv[j][i][k] += yv[4 * i + k] * ry * pg[i][k];
          }
#pragma unroll
          for (int i = 0; i < 4; ++i) *(f4v*)(X + (size_t)row * DM + lane * 4 + 256 * i) = xv[j][i];
          if (pre_g) {
            float ss = 0.f;
#pragma unroll
            for (int i = 0; i < 4; ++i)
#pragma unroll
              for (int k = 0; k < 4; ++k) ss += xv[j][i][k] * xv[j][i][k];
            ss = wave_sum(ss);
            const float rx = rsqrtf(ss * (1.f / DM) + EPS);
#pragma unroll
            for (int i = 0; i < 4; ++i) {
              u2v o;
              o[0] = pk2(xv[j][i][0] * rx * qg[i][0], xv[j][i][1] * rx * qg[i][1]);
              o[1] = pk2(xv[j][i][2] * rx * qg[i][2], xv[j][i][3] * rx * qg[i][3]);
              *(u2v*)(Hb + (size_t)row * DM + lane * 4 + 256 * i) = o;
            }
          }
        }
      }
    }
  };

  auto ffn_in = [&](size_t woff) __attribute__((always_inline)) {
    const int t = opaque_tid();
    const int lane = t & 63, w = t >> 6, r = lane & 31, h = lane >> 5;
    const int wm = w >> 1, wn = w & 1;
    (void)lane; (void)r; (void)h; (void)wm; (void)wn;
    const int MT = MALL / 256, NT = NFF2 / 128;
    for (int id = bid; id < MT * NT; id += G) {
      int tm, tn; tile_coords(id, MT, NT, tm, tn);
      const int m0 = tm * 256, n0 = tn * 128;
      Acc c; acc_zero(c);
      gemm_kloop(Hb + (size_t)m0 * DM, DM, Wb + woff + (size_t)n0 * DM, DM, DM, smem, c);
#ifdef DUP_KLOOP
      acc_zero(c);
      gemm_kloop(Hb + (size_t)m0 * DM, DM, Wb + woff + (size_t)n0 * DM, DM, DM, smem, c);
#endif
      const int jb0 = ((n0 + wn * 64) >> 6) * 32;
      const unsigned obase = (unsigned)((m0 + wm * 128) * DFF + jb0);
      epi_store<1>(smem,
        [&](int mi, int ni, int i) { return siluf_(c.a[mi][0][i]) * c.a[mi][1][i]; },
        [&](int row, int col, u32x4 v) { *(u32x4*)(ACT + obase + (unsigned)(row * DFF + col)) = v; });
    }
  };
  auto gemm_plain = [&](const u16* A, int lda, int K, const u16* Bt, u16* C, int ldc, int M, int N) __attribute__((always_inline)) {
    const int t = opaque_tid();
    const int lane = t & 63, w = t >> 6, r = lane & 31, h = lane >> 5;
    const int wm = w >> 1, wn = w & 1;
    (void)lane; (void)r; (void)h; (void)wm; (void)wn;
    const int MT = M / 256, NT = N / 128;
    for (int id = bid; id < MT * NT; id += G) {
      int tm, tn; tile_coords(id, MT, NT, tm, tn);
      const int m0 = tm * 256, n0 = tn * 128;
      Acc c; acc_zero(c);
      gemm_kloop(A + (size_t)m0 * lda, lda, Bt + (size_t)n0 * K, K, K, smem, c);
      const unsigned obase = (unsigned)((m0 + wm * 128) * ldc + n0 + wn * 64);
      epi_store<2>(smem,
        [&](int mi, int ni, int i) { return c.a[mi][ni][i]; },
        [&](int row, int col, u32x4 v) { *(u32x4*)(C + obase + (unsigned)(row * ldc + col)) = v; });
    }
  };

  auto prep_phase = [&](int l) __attribute__((always_inline)) {
    int pb_ = bid; asm volatile("" : "+s"(pb_));
    const int t = opaque_tid();
    const int lane = t & 63, w = t >> 6, r = lane & 31, h = lane >> 5;
    const int wm = w >> 1, wn = w & 1;
    (void)lane; (void)r; (void)h; (void)wm; (void)wn;
    float* sc = (float*)(smem_raw + 2 * GEMM_LDS);
    const int NQ = 64 * 6, NK = 64 * 4, NV = 2 * 128, NPE = 64, NG1 = NCHUNK * 4;
    const float qscale = 0.10206207261596577f * 1.4426950408889634f;
    {
      for (int id = pb_; id < NG1; id += G) {
        const int t = opaque_tid();
        const int lane = t & 63, w = t >> 6, r = lane & 31, h = lane >> 5;
        const int wm = w >> 1, wn = w & 1;
        (void)lane; (void)r; (void)h; (void)wm; (void)wn;
        const int n = id >> 2, hd = id & 3;
        const int t0 = n * 64;
        u16* ksT = smem;
        u16* vT = smem + 2 * 128 * LROW;
        u16* sk = vT;
        float* sga = (float*)(smem_raw + 55296);
        __syncthreads();
        {
          const int cc = t >> 2, part = t & 3;
          const u16* kp = Z + (size_t)(t0 + cc) * ZLD + Z_GK + hd * 128 + part * 32;
#pragma unroll
          for (int j = 0; j < 4; ++j) *(u32x4*)(sk + cc * 128 + part * 32 + j * 8) = *(const u32x4*)(kp + j * 8);
          u32x4 gv = *(const u32x4*)(Z + (size_t)(t0 + cc) * ZLD + Z_GA + part * 8);
#pragma unroll
          for (int k = 0; k < 4; ++k) { sga[cc * 32 + part * 8 + 2 * k] = bflo(gv[k]); sga[cc * 32 + part * 8 + 2 * k + 1] = bfhi(gv[k]); }
        }
        __syncthreads();
        {
          const int dir = t >> 7, d = t & 127;
          const float* wa2 = (dir ? in_ptr(p, 15) : in_ptr(p, 13)) + (size_t)l * 16 * 512 + hd * 128 + d;
          const float ba = ((dir ? in_ptr(p, 16) : in_ptr(p, 14)) + (size_t)l * 512)[hd * 128 + d];
          float wcol[16];
#pragma unroll
          for (int rr = 0; rr < 16; ++rr) wcol[rr] = wa2[rr * 512];
          const float* gar = sga + dir * 16;
          float tot = 0.f;
          for (int cc = 0; cc < 64; ++cc) {
            float pre = ba;
#pragma unroll
            for (int rr = 0; rr < 16; ++rr) pre += gar[cc * 32 + rr] * wcol[rr];
            tot += (fminf(pre, 0.f) - __logf(1.f + __expf(-fabsf(pre)))) * (1.f / 16.f);
          }
          DEC[((size_t)(n * 4 + hd) * 2 + dir) * 128 + d] = __expf(tot);
          float* gc = GC + (size_t)dir * SEQ * 512 + (size_t)t0 * 512 + hd * 128 + d;
          float cb = 0.f;
          u16* krow_out = ksT + (dir * 128 + d) * LROW;
          for (int ci = 0; ci < 64; ++ci) {
            const int cc = dir ? (63 - ci) : ci;
            float pre = ba;
#pragma unroll
            for (int rr = 0; rr < 16; ++rr) pre += gar[cc * 32 + rr] * wcol[rr];
            cb += (fminf(pre, 0.f) - __logf(1.f + __expf(-fabsf(pre)))) * (1.f / 16.f);
            gc[cc * 512] = cb;
            krow_out[cc] = f2bf(bf2f(sk[cc * 128 + d]) * __expf(tot - cb));
          }
        }
        for (int half = 0; half < 2; ++half) {
          __syncthreads();
          {
            const int cc = t & 63, part = t >> 6;
#pragma unroll
            for (int q = 0; q < 4; ++q) {
              const int cg8 = (part * 4 + q) * 8;
              uint4 v = *(const uint4*)(Z + (size_t)(t0 + cc) * ZLD + Z_GV + hd * 256 + half * 128 + cg8);
              unsigned u[4] = {v.x, v.y, v.z, v.w};
#pragma unroll
              for (int j = 0; j < 4; ++j) {
                vT[(cg8 + 2 * j) * LROW + cc] = (u16)(u[j] & 0xffffu);
                vT[(cg8 + 2 * j + 1) * LROW + cc] = (u16)(u[j] >> 16);
              }
            }
          }
          __syncthreads();
#pragma unroll
          for (int dir = 0; dir < 2; ++dir) {
            f32x16 acc[4];
#pragma unroll
            for (int j = 0; j < 4; ++j)
#pragma unroll
              for (int k = 0; k < 16; ++k) acc[j][k] = 0.f;
#pragma unroll
            for (int ks = 0; ks < 4; ++ks) {
              bf16x8 fa = *(const bf16x8*)(vT + (w * 32 + r) * LROW + ks * 16 + h * 8);
#pragma unroll
              for (int nt = 0; nt < 4; ++nt) {
                bf16x8 fb = *(const bf16x8*)(ksT + (dir * 128 + nt * 32 + r) * LROW + ks * 16 + h * 8);
                acc[nt] = MFMA(fb, fa, acc[nt]);
              }
            }
            u16* stp = ST + ((size_t)(n * 4 + hd) * 2 + dir) * 32768;
#pragma unroll
            for (int nt = 0; nt < 4; ++nt)
#pragma unroll
              for (int g4 = 0; g4 < 4; ++g4) {
                uint2 o;
                o.x = pk2(acc[nt][4 * g4 + 0], acc[nt][4 * g4 + 1]);
                o.y = pk2(acc[nt][4 * g4 + 2], acc[nt][4 * g4 + 3]);
                *(uint2*)(stp + (unsigned)((half * 128 + w * 32 + r) * 128 + nt * 32 + 8 * g4 + 4 * h)) = o;
              }
          }
        }
      }
      for (int q = pb_; q < NQ; q += G) {
        const int t = opaque_tid();
        const int lane = t & 63, w = t >> 6, r = lane & 31, h = lane >> 5;
        const int wm = w >> 1, wn = w & 1;
        (void)lane; (void)r; (void)h; (void)wm; (void)wn;
        const int tm = q / 6, tn = q % 6;
        const int m0 = tm * 256, n0 = tn * 128;
        __syncthreads();
        row_scales(Z + (size_t)m0 * ZLD + Z_CQ, ZLD, 256, sc, 256);
        Acc c; acc_zero(c);
        gemm_kloop(Z + (size_t)m0 * ZLD + Z_CQ, ZLD, Wb + W_UQ + (size_t)n0 * 256, 256, 256, smem, c);
        {
          const unsigned obase = (unsigned)((m0 + wm * 128) * 768 + n0 + wn * 64);
          epi_store<2>(smem,
            [&](int mi, int ni, int i) {
              const int cb0 = n0 + wn * 64 + ni * 32;
              const bool rope = ((cb0 >> 5) % 3) == 2;
              const int rl = wm * 128 + mi * 32 + crow(i, h);
              float v = c.a[mi][ni][i] * sc[rl];
              const float pv = __shfl_xor(v, 16);
              if (rope) {
                const int row = m0 + rl;
                const float cs = ropec[row * 16 + (r & 15)], sn = ropes[row * 16 + (r & 15)];
                v = (r < 16) ? (v * cs - pv * sn) : (v * cs + pv * sn);
              }
              return v * qscale;
            },
            [&](int row, int col, u32x4 v) { *(u32x4*)(Qb + obase + (unsigned)(row * 768 + col)) = v; });
        }
      }
      for (int q = (pb_ + G - (NQ % G)) % G; q < NK; q += G) {
        const int t = opaque_tid();
        const int lane = t & 63, w = t >> 6, r = lane & 31, h = lane >> 5;
        const int wm = w >> 1, wn = w & 1;
        (void)lane; (void)r; (void)h; (void)wm; (void)wn;
        const int tm = q >> 2, tn = q & 3;
        const int m0 = tm * 256, n0 = tn * 128;
        __syncthreads();
        row_scales(Z + (size_t)m0 * ZLD + Z_CKV, ZLD, 128, sc, 256);
        Acc c; acc_zero(c);
        gemm_kloop(Z + (size_t)m0 * ZLD + Z_CKV, ZLD, Wb + W_KN + (size_t)n0 * 128, 128, 128, smem, c);
        {
          const unsigned obase = (unsigned)((m0 + wm * 128) * 512 + n0 + wn * 64);
          epi_store<2>(smem,
            [&](int mi, int ni, int i) { return c.a[mi][ni][i] * sc[wm * 128 + mi * 32 + crow(i, h)]; },
            [&](int row, int col, u32x4 v) { *(u32x4*)(KN + obase + (unsigned)(row * 512 + col)) = v; });
        }
      }
      for (int q = (pb_ + G - ((NQ + NK) % G)) % G; q < NV; q += G) {
        const int t = opaque_tid();
        const int lane = t & 63, w = t >> 6, r = lane & 31, h = lane >> 5;
        const int wm = w >> 1, wn = w & 1;
        (void)lane; (void)r; (void)h; (void)wm; (void)wn;
        const int tm = q & 1, tn = q >> 1;
        const int m0 = tm * 256, n0 = tn * 128;
        __syncthreads();
        row_scales(Z + (size_t)n0 * ZLD + Z_CKV, ZLD, 128, sc, 128);
        Acc c; acc_zero(c);
        gemm_kloop(Wb + W_V + (size_t)m0 * 128, 128, Z + (size_t)n0 * ZLD + Z_CKV, ZLD, 128, smem, c);
        {
          const unsigned obase = (unsigned)((m0 + wm * 128) * SEQ + n0 + wn * 64);
          epi_store<2>(smem,
            [&](int mi, int ni, int i) { return c.a[mi][ni][i] * sc[wn * 64 + ni * 32 + r]; },
            [&](int row, int col, u32x4 v) { *(u32x4*)(VT + obase + (unsigned)(row * SEQ + col)) = v; });
        }
      }
      for (int q = (pb_ + G - ((NQ + NK + NV) % G)) % G; q < NPE; q += G) {
        const int t = opaque_tid();
        const int lane = t & 63, w = t >> 6, r = lane & 31, h = lane >> 5;
        const int wm = w >> 1, wn = w & 1;
        (void)lane; (void)r; (void)h; (void)wm; (void)wn;
        const int tok = q * 256 + t;
        const u16* src = Z + (size_t)tok * ZLD + Z_KPE;
        float v[32];
#pragma unroll
        for (int j = 0; j < 4; ++j) {
          uint4 u = *(const uint4*)(src + j * 8);
          unsigned uu[4] = {u.x, u.y, u.z, u.w};
#pragma unroll
          for (int k = 0; k < 4; ++k) { v[j * 8 + 2 * k] = bflo(uu[k]); v[j * 8 + 2 * k + 1] = bfhi(uu[k]); }
        }
        float o[32];
#pragma unroll
        for (int i = 0; i < 16; ++i) {
          const float cs = ropec[tok * 16 + i], sn = ropes[tok * 16 + i];
          o[i] = v[i] * cs - v[i + 16] * sn;
          o[i + 16] = v[i + 16] * cs + v[i] * sn;
        }
#pragma unroll
        for (int j = 0; j < 4; ++j) {
          uint4 u;
          u.x = pk2(o[j * 8 + 0], o[j * 8 + 1]); u.y = pk2(o[j * 8 + 2], o[j * 8 + 3]);
          u.z = pk2(o[j * 8 + 4], o[j * 8 + 5]); u.w = pk2(o[j * 8 + 6], o[j * 8 + 7]);
          *(uint4*)(KPE + (size_t)tok * 32 + j * 8) = u;
        }
      }
    }
  };

  auto attn_phase = [&](int mode) __attribute__((always_inline)) {
    const int t = opaque_tid();
    const int lane = t & 63, w = t >> 6, r = lane & 31, h = lane >> 5;
    const int wm = w >> 1, wn = w & 1;
    (void)lane; (void)r; (void)h; (void)wm; (void)wn;
    if (mode & 1) for (int id = bid; id < 512; id += G) {
      const int e = id * 256 + t;
      const int d2 = e & 63, v = (e >> 6) & 255, dir = (e >> 14) & 1, hd = e >> 15;
      float s0 = 0.f, s1 = 0.f;
      const size_t eoff = (size_t)v * 128 + 2 * d2;
      for (int i0 = 0; i0 < NCHUNK; i0 += 16) {
        unsigned uu[16];
        float2 dd[16];
#pragma unroll
        for (int j = 0; j < 16; ++j) {
          const int n = dir ? (NCHUNK - 1 - (i0 + j)) : (i0 + j);
          const size_t base = ((size_t)(n * 4 + hd) * 2 + dir);
          uu[j] = *(const unsigned*)(ST + base * 32768 + eoff);
          dd[j] = *(const float2*)(DEC + base * 128 + 2 * d2);
        }
#pragma unroll
        for (int j = 0; j < 16; ++j) {
          const int n = dir ? (NCHUNK - 1 - (i0 + j)) : (i0 + j);
          const size_t base = ((size_t)(n * 4 + hd) * 2 + dir);
          *(unsigned*)(ST + base * 32768 + eoff) = pk2(s0, s1);
          s0 = dd[j].x * s0 + bflo(uu[j]);
          s1 = dd[j].y * s1 + bfhi(uu[j]);
        }
      }
    }
    constexpr int KROW = 104;
    constexpr int VR = 68;
    constexpr int ABUF = 64 * KROW + 64 * VR;
    u16* sK = smem;
    u16* sV = smem + 64 * KROW;
    if (mode & 2) for (int id = bid; id < 8 * 64; id += G) {
      const int hd = id & 7, qb = id >> 3;
      const int q0 = qb * 256 + w * 64;
      bf16x8 bq[2][6];
#pragma unroll
      for (int qt = 0; qt < 2; ++qt)
#pragma unroll
        for (int ks = 0; ks < 6; ++ks) bq[qt][ks] = *(const bf16x8*)(Qb + (size_t)(q0 + qt * 32 + r) * 768 + hd * 96 + ks * 16 + h * 8);
      f32x16 O[2][2];
#pragma unroll
      for (int j = 0; j < 2; ++j)
#pragma unroll
        for (int qt = 0; qt < 2; ++qt)
#pragma unroll
          for (int k = 0; k < 16; ++k) O[j][qt][k] = 0.f;
      float m[2] = {0.f, 0.f}, lsum[2] = {0.f, 0.f};
      const int kr = t >> 2, kc = t & 3;
      const u16* knp = KN + (size_t)kr * 512 + hd * 64 + kc * 16;
      const u16* kpp = KPE + (size_t)kr * 32 + kc * 8;
      const u16* vpp = VT + (size_t)(hd * 64 + kr) * SEQ + kc * 16;
      u32x4 rk[3], rv[2];
      rk[0] = *(const u32x4*)(knp);
      rk[1] = *(const u32x4*)(knp + 8);
      rk[2] = *(const u32x4*)(kpp);
      rv[0] = *(const u32x4*)(vpp);
      rv[1] = *(const u32x4*)(vpp + 8);
      __syncthreads();
      *(u32x4*)(sK + kr * KROW + kc * 16) = rk[0];
      *(u32x4*)(sK + kr * KROW + kc * 16 + 8) = rk[1];
      *(u32x4*)(sK + kr * KROW + 64 + kc * 8) = rk[2];
      *(uint2*)(sV + kr * VR + kc * 16) = make_uint2(rv[0][0], rv[0][1]);
      *(uint2*)(sV + kr * VR + kc * 16 + 4) = make_uint2(rv[0][2], rv[0][3]);
      *(uint2*)(sV + kr * VR + kc * 16 + 8) = make_uint2(rv[1][0], rv[1][1]);
      *(uint2*)(sV + kr * VR + kc * 16 + 12) = make_uint2(rv[1][2], rv[1][3]);
      rk[0] = *(const u32x4*)(knp + (size_t)64 * 512);
      rk[1] = *(const u32x4*)(knp + (size_t)64 * 512 + 8);
      rk[2] = *(const u32x4*)(kpp + (size_t)64 * 32);
      rv[0] = *(const u32x4*)(vpp + 64);
      rv[1] = *(const u32x4*)(vpp + 64 + 8);
      __syncthreads();
      int cur = 0;
      for (int key0 = 0; key0 < SEQ; key0 += 64) {
        const u16* cK = sK + cur * ABUF;
        const u16* cV = sV + cur * ABUF;
        {
          u16* nK = sK + (cur ^ 1) * ABUF;
          u16* nV = sV + (cur ^ 1) * ABUF;
          *(u32x4*)(nK + kr * KROW + kc * 16) = rk[0];
          *(u32x4*)(nK + kr * KROW + kc * 16 + 8) = rk[1];
          *(u32x4*)(nK + kr * KROW + 64 + kc * 8) = rk[2];
          *(uint2*)(nV + kr * VR + kc * 16) = make_uint2(rv[0][0], rv[0][1]);
          *(uint2*)(nV + kr * VR + kc * 16 + 4) = make_uint2(rv[0][2], rv[0][3]);
          *(uint2*)(nV + kr * VR + kc * 16 + 8) = make_uint2(rv[1][0], rv[1][1]);
          *(uint2*)(nV + kr * VR + kc * 16 + 12) = make_uint2(rv[1][2], rv[1][3]);
          const int kn = (key0 + 128 < SEQ) ? (key0 + 128) : key0;
          rk[0] = *(const u32x4*)(knp + (size_t)kn * 512);
          rk[1] = *(const u32x4*)(knp + (size_t)kn * 512 + 8);
          rk[2] = *(const u32x4*)(kpp + (size_t)kn * 32);
          rv[0] = *(const u32x4*)(vpp + kn);
          rv[1] = *(const u32x4*)(vpp + kn + 8);
        }
        __builtin_amdgcn_sched_barrier(0);
        f32x16 S[2][2];
#pragma unroll
        for (int kt = 0; kt < 2; ++kt)
#pragma unroll
          for (int qt = 0; qt < 2; ++qt)
#pragma unroll
            for (int k = 0; k < 16; ++k) S[kt][qt][k] = -m[qt];
        __builtin_amdgcn_s_setprio(1);
#pragma unroll
        for (int ks = 0; ks < 6; ++ks)
#pragma unroll
          for (int kt = 0; kt < 2; ++kt) {
            bf16x8 fa = *(const bf16x8*)(cK + (kt * 32 + r) * KROW + ks * 16 + h * 8);
            S[kt][0] = MFMA(fa, bq[0][ks], S[kt][0]);
            S[kt][1] = MFMA(fa, bq[1][ks], S[kt][1]);
          }
        __builtin_amdgcn_s_setprio(0);
        bf16x8 pf[2][4];
#pragma unroll
        for (int qt = 0; qt < 2; ++qt) {
          float mloc = S[0][qt][0];
#pragma unroll
          for (int kt = 0; kt < 2; ++kt)
#pragma unroll
            for (int k = 0; k < 16; ++k) mloc = fmaxf(mloc, S[kt][qt][k]);
          {
            auto sw_ = __builtin_amdgcn_permlane32_swap(__float_as_uint(mloc), __float_as_uint(mloc), false, false);
            mloc = fmaxf(__uint_as_float(sw_[0]), __uint_as_float(sw_[1]));
          }
          if (__builtin_amdgcn_ballot_w64(mloc > 6.f) != 0ull) {
            const float delta = fmaxf(mloc, 0.f);
            const float alpha = __builtin_amdgcn_exp2f(-delta);
            m[qt] += delta;
            lsum[qt] *= alpha;
#pragma unroll
            for (int j = 0; j < 2; ++j)
#pragma unroll
              for (int k = 0; k < 16; ++k) O[j][qt][k] *= alpha;
#pragma unroll
            for (int kt = 0; kt < 2; ++kt)
#pragma unroll
              for (int k = 0; k < 16; ++k) S[kt][qt][k] -= delta;
          }
          float ps = 0.f;
#pragma unroll
          for (int kt = 0; kt < 2; ++kt)
#pragma unroll
            for (int k = 0; k < 16; ++k) { S[kt][qt][k] = __builtin_amdgcn_exp2f(S[kt][qt][k]); ps += S[kt][qt][k]; }
          lsum[qt] += ps;
#pragma unroll
          for (int s2 = 0; s2 < 4; ++s2) {
            const int kt = s2 >> 1, sx = s2 & 1;
            unsigned pw[4];
#pragma unroll
            for (int j = 0; j < 4; ++j) pw[j] = pk2(S[kt][qt][8 * sx + 2 * j], S[kt][qt][8 * sx + 2 * j + 1]);
            pf[qt][s2] = __builtin_bit_cast(bf16x8, make_uint4(pw[0], pw[1], pw[2], pw[3]));
          }
        }
#pragma unroll
        for (int s2 = 0; s2 < 4; ++s2) {
          const int kt = s2 >> 1, sx = s2 & 1;
#pragma unroll
          for (int dt = 0; dt < 2; ++dt) {
            const u16* vp = cV + (dt * 32 + r) * VR + kt * 32 + 16 * sx + 4 * h;
            uint2 lo = *(const uint2*)(vp);
            uint2 hi = *(const uint2*)(vp + 8);
            bf16x8 fv = __builtin_bit_cast(bf16x8, make_uint4(lo.x, lo.y, hi.x, hi.y));
            O[dt][0] = MFMA(fv, pf[0][s2], O[dt][0]);
            O[dt][1] = MFMA(fv, pf[1][s2], O[dt][1]);
          }
        }
        cur ^= 1;
        __syncthreads();
      }
#pragma unroll
      for (int qt = 0; qt < 2; ++qt) {
        const float lt = lsum[qt] + __shfl_xor(lsum[qt], 32);
        const float inv = 1.f / lt;
#pragma unroll
        for (int dt = 0; dt < 2; ++dt)
#pragma unroll
          for (int g4 = 0; g4 < 4; ++g4) {
            uint2 o;
            o.x = pk2(O[dt][qt][4 * g4 + 0] * inv, O[dt][qt][4 * g4 + 1] * inv);
            o.y = pk2(O[dt][qt][4 * g4 + 2] * inv, O[dt][qt][4 * g4 + 3] * inv);
            *(uint2*)(OA + (size_t)(q0 + qt * 32 + r) * 512 + hd * 64 + dt * 32 + 8 * g4 + 4 * h) = o;
          }
      }
    }
  };

  auto gla_out_phase = [&](int l) __attribute__((always_inline)) {
    const int t = opaque_tid();
    const int lane = t & 63, w = t >> 6, r = lane & 31, h = lane >> 5;
    const int wm = w >> 1, wn = w & 1;
    (void)lane; (void)r; (void)h; (void)wm; (void)wn;
    constexpr int QROW = 136;
    u16* sQ = smem;
    u16* sKt = smem + 64 * QROW;
    u16* sVT = smem + 2 * 64 * QROW;
    float* sred = (float*)(smem + 2 * 64 * QROW + 256 * LROW);
    u16* sO = smem;
    constexpr int OROW = 264;
    const float qs = 0.08838834764831845f;
    const int cs = w & 1, vh = w >> 1;
    for (int id = bid; id < NCHUNK * 4; id += G) {
      const int n = id >> 2, hd = id & 3;
      const int t0 = n * 64;
      __syncthreads();
      {
        const int cc = t & 63, part = t >> 6;
#pragma unroll
        for (int q = 0; q < 8; ++q) {
          const int cg8 = (part * 8 + q) * 8;
          uint4 v = *(const uint4*)(Z + (size_t)(t0 + cc) * ZLD + Z_GV + hd * 256 + cg8);
          unsigned u[4] = {v.x, v.y, v.z, v.w};
#pragma unroll
          for (int j = 0; j < 4; ++j) {
            sVT[(cg8 + 2 * j) * LROW + cc] = (u16)(u[j] & 0xffffu);
            sVT[(cg8 + 2 * j + 1) * LROW + cc] = (u16)(u[j] >> 16);
          }
        }
      }
      f32x16 acc[4];
#pragma unroll
      for (int j = 0; j < 4; ++j)
#pragma unroll
        for (int k = 0; k < 16; ++k) acc[j][k] = 0.f;
      for (int dir = 0; dir < 2; ++dir) {
        __syncthreads();
        {
          const int cc = t >> 2, dp = (t & 3) * 32;
          const u16* qp = Z + (size_t)(t0 + cc) * ZLD + Z_GQ + hd * 128 + dp;
          const u16* kp = Z + (size_t)(t0 + cc) * ZLD + Z_GK + hd * 128 + dp;
          const float* gp = GC + (size_t)dir * SEQ * 512 + (size_t)(t0 + cc) * 512 + hd * 128 + dp;
#pragma unroll
          for (int j = 0; j < 4; ++j) {
            uint4 qv = *(const uint4*)(qp + j * 8);
            uint4 kv = *(const uint4*)(kp + j * 8);
            float4 g0 = *(const float4*)(gp + j * 8);
            float4 g1 = *(const float4*)(gp + j * 8 + 4);
            const float gg[8] = {g0.x, g0.y, g0.z, g0.w, g1.x, g1.y, g1.z, g1.w};
            const unsigned qu[4] = {qv.x, qv.y, qv.z, qv.w};
            const unsigned ku[4] = {kv.x, kv.y, kv.z, kv.w};
            unsigned qo[4], ko[4];
#pragma unroll
            for (int k = 0; k < 4; ++k) {
              const float e0 = __expf(gg[2 * k]), e1 = __expf(gg[2 * k + 1]);
              qo[k] = pk2(bflo(qu[k]) * qs * e0, bfhi(qu[k]) * qs * e1);
              ko[k] = pk2(bflo(ku[k]) / e0, bfhi(ku[k]) / e1);
            }
            *(uint4*)(sQ + cc * QROW + dp + j * 8) = make_uint4(qo[0], qo[1], qo[2], qo[3]);
            *(uint4*)(sKt + cc * QROW + dp + j * 8) = make_uint4(ko[0], ko[1], ko[2], ko[3]);
            if (j == 1) __builtin_amdgcn_sched_barrier(0);
          }
        }
        __syncthreads();
        const u16* bqp = sQ + (cs * 32 + r) * QROW + h * 8;
        const u16* stp = ST + ((size_t)(n * 4 + hd) * 2 + dir) * 32768;
        bf16x8 fs[2][4];
#pragma unroll
        for (int ks = 0; ks < 4; ++ks) fs[0][ks] = *(const bf16x8*)(stp + (size_t)(vh * 128 + r) * 128 + ks * 16 + h * 8);
        f32x16 at[2];
#pragma unroll
        for (int et = 0; et < 2; ++et) {
#pragma unroll
          for (int k = 0; k < 16; ++k) at[et][k] = 0.f;
#pragma unroll
          for (int ks = 0; ks < 8; ++ks) {
            bf16x8 fa = *(const bf16x8*)(sKt + (et * 32 + r) * QROW + ks * 16 + h * 8);
            bf16x8 fbq = *(const bf16x8*)(bqp + ks * 16);
            at[et] = MFMA(fa, fbq, at[et]);
          }
          const int cidx = cs * 32 + r;
#pragma unroll
          for (int k = 0; k < 16; ++k) {
            const int e = et * 32 + crow(k, h);
            const bool keep = dir ? (e >= cidx) : (e <= cidx);
            at[et][k] = keep ? at[et][k] : 0.f;
          }
        }
#pragma unroll
        for (int s2 = 0; s2 < 4; ++s2) {
          const int et = s2 >> 1, s = s2 & 1;
          unsigned pw[4];
#pragma unroll
          for (int j = 0; j < 4; ++j) pw[j] = pk2(at[et][8 * s + 2 * j], at[et][8 * s + 2 * j + 1]);
          bf16x8 pf = __builtin_bit_cast(bf16x8, make_uint4(pw[0], pw[1], pw[2], pw[3]));
#pragma unroll
          for (int mt = 0; mt < 4; ++mt) {
            const u16* vp = sVT + (vh * 128 + mt * 32 + r) * LROW + et * 32 + 16 * s + 4 * h;
            uint2 lo = *(const uint2*)(vp);
            uint2 hi = *(const uint2*)(vp + 8);
            bf16x8 fv = __builtin_bit_cast(bf16x8, make_uint4(lo.x, lo.y, hi.x, hi.y));
            acc[mt] = MFMA(fv, pf, acc[mt]);
          }
        }
#pragma unroll
        for (int bb = 0; bb < 8; ++bb) {
          const int mt = bb >> 1, kb = bb & 1;
          if (bb + 1 < 8) {
            const int mt1 = (bb + 1) >> 1, kb1 = (bb + 1) & 1;
#pragma unroll
            for (int ks = 0; ks < 4; ++ks) fs[(bb + 1) & 1][ks] = *(const bf16x8*)(stp + (size_t)(vh * 128 + mt1 * 32 + r) * 128 + (kb1 * 4 + ks) * 16 + h * 8);
          }
          __builtin_amdgcn_sched_barrier(0);
#pragma unroll
          for (int ks = 0; ks < 4; ++ks) { bf16x8 fbq = *(const bf16x8*)(bqp + (kb * 4 + ks) * 16); acc[mt] = MFMA(fs[bb & 1][ks], fbq, acc[mt]); }
          __builtin_amdgcn_sched_barrier(0);
        }
      }
      float ss = 0.f;
#pragma unroll
      for (int mt = 0; mt < 4; ++mt)
#pragma unroll
        for (int k = 0; k < 16; ++k) ss += acc[mt][k] * acc[mt][k];
      ss += __shfl_xor(ss, 32);
      if (h == 0) sred[vh * 64 + cs * 32 + r] = ss;
      __syncthreads();
      const float rs = rsqrtf((sred[cs * 32 + r] + sred[64 + cs * 32 + r]) * (1.f / 256.f) + EPS);
#pragma unroll
      for (int mt = 0; mt < 4; ++mt)
#pragma unroll
        for (int g4 = 0; g4 < 4; ++g4) {
          uint2 o;
          o.x = pk2(acc[mt][4 * g4 + 0] * rs, acc[mt][4 * g4 + 1] * rs);
          o.y = pk2(acc[mt][4 * g4 + 2] * rs, acc[mt][4 * g4 + 3] * rs);
          *(uint2*)(sO + (cs * 32 + r) * OROW + vh * 128 + mt * 32 + 8 * g4 + 4 * h) = o;
        }
      __syncthreads();
      {
        const int t3 = opaque_tid();
        const int cc = t3 >> 2, vp0 = (t3 & 3) * 64;
        const float* ng = in_ptr(p, 17) + (size_t)l * 256;
#pragma unroll
        for (int j = 0; j < 8; ++j) {
          const int v0 = vp0 + j * 8;
          uint4 ov = *(const uint4*)(sO + cc * OROW + v0);
          uint4 gv = *(const uint4*)(Z + (size_t)(t0 + cc) * ZLD + Z_GOG + hd * 256 + v0);
          float4 n0 = *(const float4*)(ng + v0), n1 = *(const float4*)(ng + v0 + 4);
          const float nn[8] = {n0.x, n0.y, n0.z, n0.w, n1.x, n1.y, n1.z, n1.w};
          const unsigned ou[4] = {ov.x, ov.y, ov.z, ov.w};
          const unsigned gu[4] = {gv.x, gv.y, gv.z, gv.w};
          unsigned res[4];
#pragma unroll
          for (int k = 0; k < 4; ++k)
            res[k] = pk2(bflo(ou[k]) * nn[2 * k] * siluf_(bflo(gu[k])), bfhi(ou[k]) * nn[2 * k + 1] * siluf_(bfhi(gu[k])));
          *(uint4*)(OG + (size_t)(t0 + cc) * DM + hd * 256 + v0) = make_uint4(res[0], res[1], res[2], res[3]);
        }
      }
    }
  };

  auto merge_phase = [&]() __attribute__((always_inline)) {
    const int t = opaque_tid();
    const int lane = t & 63, w = t >> 6, r = lane & 31, h = lane >> 5;
    const int wm = w >> 1, wn = w & 1;
    (void)lane; (void)r; (void)h; (void)wm; (void)wn;
    const int MT = SEQ / 256, NT = DM / 128;
    for (int id = bid; id < MT * NT; id += G) {
      int tm, tn; tile_coords(id, MT, NT, tm, tn);
      const int m0 = tm * 256, n0 = tn * 128;
      Acc c; acc_zero(c);
      gemm_kloop(OA + (size_t)m0 * 512, 512, Wb + W_OA + (size_t)n0 * 512, 512, 512, smem, c);
      {
        const unsigned zbase = (unsigned)((m0 + wm * 128) * ZLD + Z_BG + n0 + wn * 64);
        const unsigned obase = (unsigned)((m0 + wm * 128) * DM + n0 + wn * 64);
        epi_store<2>(smem,
          [&](int mi, int ni, int i) { return c.a[mi][ni][i]; },
          [&](int row, int col, u32x4 v) {
            const u32x4 g = *(const u32x4*)(Z + zbase + (unsigned)(row * ZLD + col));
            u32x4 o;
#pragma unroll
            for (int k = 0; k < 4; ++k) o[k] = pk2(bflo(v[k]) * sigmoidf_(bflo(g[k])), bfhi(v[k]) * sigmoidf_(bfhi(g[k])));
            *(u32x4*)(MG + obase + (unsigned)(row * DM + col)) = o;
          });
      }
      acc_zero(c);
      gemm_kloop(OG + (size_t)m0 * DM, DM, Wb + W_OB + (size_t)n0 * DM, DM, DM, smem, c);
      {
        const int t2 = opaque_tid();
        const int wm2 = t2 >> 7, wn2 = (t2 >> 6) & 1;
        const unsigned zbase = (unsigned)((m0 + wm2 * 128) * ZLD + Z_BG + DM + n0 + wn2 * 64);
        const unsigned obase = (unsigned)((m0 + wm2 * 128) * DM + n0 + wn2 * 64);
        epi_store<2>(smem,
          [&](int mi, int ni, int i) { return c.a[mi][ni][i]; },
          [&](int row, int col, u32x4 v) {
            const u32x4 g = *(const u32x4*)(Z + zbase + (unsigned)(row * ZLD + col));
            const u32x4 pm = *(const u32x4*)(MG + obase + (unsigned)(row * DM + col));
            u32x4 o;
#pragma unroll
            for (int k = 0; k < 4; ++k)
              o[k] = pk2(bflo(pm[k]) + bflo(v[k]) * sigmoidf_(bflo(g[k])), bfhi(pm[k]) + bfhi(v[k]) * sigmoidf_(bfhi(g[k])));
            *(u32x4*)(MG + obase + (unsigned)(row * DM + col)) = o;
          });
      }
    }
  };

  for (int i = bid * 256 + opaque_tid(); i < SEQ * 16; i += G * 256) {
    const int pos = i >> 4, j = i & 15;
    const float inv_freq = exp2f(-(float)j * 0.8304820237218406f);
    const float angf = (float)pos * inv_freq;
    double a = (double)angf;
    const double twopi = 6.283185307179586476925286766559;
    a -= twopi * rint(a / twopi);
    const float af = (float)a;
    ropec[i] = __cosf(af);
    ropes[i] = __sinf(af);
  }
  convert_weights(0);
  rn_pass(0, 0.f, nullptr, in_ptr(p, 2));
  grid.sync();

  for (int l = 0; l < 4; ++l) {
    asm volatile("" : "+s"(bid));
    ffn_in(W_FFN1_IN);
#ifdef DUP_FFNIN
    xcd_barrier(xb);
    ffn_in(W_FFN1_IN);
#endif
    xcd_barrier(xb);
    gemm_plain(ACT, DFF, DFF, Wb + W_FFN1_OUT, Yb, DM, MALL, DM);
    xcd_barrier(xb);
    rn_pass(1, 0.5f, in_ptr(p, 5) + l * DM, in_ptr(p, 6) + l * DM);
    xcd_barrier(xb);
    for (int s = 0; s < NSEQ; ++s) {
      asm volatile("" : "+s"(bid));
      gemm_plain(Hb + (size_t)s * SEQ * DM, DM, DM, Wb + W_IN, Z, ZLD, SEQ, ZLD);
      xcd_barrier(xb);
      prep_phase(l);
#ifdef DUP_PREP
      xcd_barrier(xb);
      prep_phase(l);
#endif
      xcd_barrier(xb);
      attn_phase(1);
      xcd_barrier(xb);
      int bpar_ = bid; asm volatile("" : "+s"(bpar_));
      if (bpar_ & 1) { attn_phase(2); gla_out_phase(l); }
      else { gla_out_phase(l); attn_phase(2); }
      xcd_barrier(xb);
      merge_phase();
      xcd_barrier(xb);
      gemm_plain(MG, DM, DM, Wb + W_OUT, Yb + (size_t)s * SEQ * DM, DM, SEQ, DM);
      xcd_barrier(xb);
    }
    rn_pass(1, 1.0f, in_ptr(p, 20) + l * DM, in_ptr(p, 21) + l * DM);
    xcd_barrier(xb);
    ffn_in(W_FFN2_IN);
    xcd_barrier(xb);
    gemm_plain(ACT, DFF, DFF, Wb + W_FFN2_OUT, Yb, DM, MALL, DM);
    xcd_barrier(xb);
    rn_pass(1, 0.5f, in_ptr(p, 24) + l * DM, (l < 3) ? (in_ptr(p, 2) + (l + 1) * DM) : nullptr);
    if (l < 3) convert_weights(l + 1);
    xcd_barrier(xb);
  }
}

extern "C" void kernel_launch(void* const* d_in, const int* in_sizes, int n_in, void* d_out,
                              int out_size, void* d_ws, size_t ws_size, hipStream_t stream) {
  static int grid_blocks = 0;
  if (!grid_blocks) {
    int dev = 0, cus = 0, per_cu = 0;
    (void)hipGetDevice(&dev);
    (void)hipDeviceGetAttribute(&cus, hipDeviceAttributeMultiprocessorCount, dev);
    (void)hipOccupancyMaxActiveBlocksPerMultiprocessor(&per_cu, fwd_megakernel, 256, 0);
    if (per_cu > 2) per_cu = 2;
    if (per_cu < 1) per_cu = 1;
    grid_blocks = cus * per_cu;
  }
  Params p{};
  for (int i = 0; i < 25; ++i) p.in[i] = (const float*)d_in[i];
  p.out = (float*)d_out;
  p.ws = (char*)d_ws;
  (void)hipMemsetAsync((char*)d_ws + OFF_BAR, 0, XCD_BAR_WORDS * 4, stream);
  void* args[] = {&p};
  hipError_t e = hipLaunchCooperativeKernel((void*)fwd_megakernel, dim3(grid_blocks), dim3(256), args, 0, stream);
  if (e != hipSuccess) fprintf(stderr, "cooperative launch failed: %s (grid %d)\n", hipGetErrorString(e), grid_blocks);
}
```

```cpp
#include <hip/hip_runtime.h>
#include <hip/hip_cooperative_groups.h>
#include <cstdio>
namespace cg = cooperative_groups;

typedef unsigned short u16;
typedef short bf16x8 __attribute__((ext_vector_type(8)));
typedef short s16x4 __attribute__((ext_vector_type(4)));
typedef float f32x16 __attribute__((ext_vector_type(16)));
typedef __bf16 bf2_t __attribute__((ext_vector_type(2)));
typedef float f2_t __attribute__((ext_vector_type(2)));
typedef unsigned u32x4 __attribute__((ext_vector_type(4)));
#define DI __device__ __forceinline__
#define MFMA(a, b, c) __builtin_amdgcn_mfma_f32_32x32x16_bf16((a), (b), (c), 0, 0, 0)

constexpr int SEQ = 16384;
constexpr int NSEQ = 3;
constexpr int MALL = SEQ * NSEQ;
constexpr int DM = 1024;
constexpr int DFF = 2816;
constexpr int NFF2 = 5632;
constexpr int PIN = 5568;
constexpr int ZLD = 5632;
constexpr int Z_CQ = 0, Z_CKV = 256, Z_KPE = 384, Z_GQ = 416, Z_GK = 928, Z_GV = 1440, Z_GA = 2464, Z_GOG = 2496, Z_BG = 3520;
constexpr float EPS = 1e-6f;
constexpr int NCHUNK = SEQ / 64;

constexpr size_t W_FFN1_IN = 0;
constexpr size_t W_FFN1_OUT = W_FFN1_IN + (size_t)NFF2 * DM;
constexpr size_t W_IN = W_FFN1_OUT + (size_t)DM * DFF;
constexpr size_t W_UQ = W_IN + (size_t)ZLD * DM;
constexpr size_t W_KN = W_UQ + (size_t)768 * 256;
constexpr size_t W_V = W_KN + (size_t)512 * 128;
constexpr size_t W_OA = W_V + (size_t)512 * 128;
constexpr size_t W_OB = W_OA + (size_t)DM * 512;
constexpr size_t W_OUT = W_OB + (size_t)DM * DM;
constexpr size_t W_FFN2_IN = W_OUT + (size_t)DM * DM;
constexpr size_t W_FFN2_OUT = W_FFN2_IN + (size_t)NFF2 * DM;
constexpr size_t W_END = W_FFN2_OUT + (size_t)DM * DFF;

constexpr size_t al256(size_t x) { return (x + 255) & ~(size_t)255; }
constexpr size_t OFF_WB = 0;
constexpr size_t OFF_ROPE = al256(OFF_WB + W_END * 2);
constexpr size_t OFF_H = al256(OFF_ROPE + (size_t)SEQ * 32 * 4);
constexpr size_t OFF_Y = al256(OFF_H + (size_t)MALL * DM * 2);
constexpr size_t OFF_ACT = al256(OFF_Y + (size_t)MALL * DM * 2);
constexpr size_t OFF_Z = OFF_ACT;
constexpr size_t OFF_Q = al256(OFF_Z + (size_t)SEQ * ZLD * 2);
constexpr size_t OFF_KN = al256(OFF_Q + (size_t)SEQ * 768 * 2);
constexpr size_t OFF_VT = al256(OFF_KN + (size_t)SEQ * 512 * 2);
constexpr size_t OFF_KPE = al256(OFF_VT + (size_t)SEQ * 512 * 2);
constexpr size_t OFF_OA = al256(OFF_KPE + (size_t)SEQ * 32 * 2);
constexpr size_t OFF_MIXEND = al256(OFF_OA + (size_t)SEQ * 512 * 2);
constexpr size_t OFF_ACTEND = al256(OFF_ACT + (size_t)MALL * DFF * 2);
static_assert(OFF_MIXEND <= OFF_ACTEND, "mixer scratch must fit in act");
constexpr size_t OFF_ST = OFF_ACTEND;
constexpr size_t OFF_DEC = al256(OFF_ST + (size_t)NCHUNK * 4 * 2 * 256 * 128 * 2);
constexpr size_t OFF_GC = al256(OFF_DEC + (size_t)NCHUNK * 4 * 2 * 128 * 4);
constexpr size_t OFF_OG = al256(OFF_GC + (size_t)2 * SEQ * 512 * 4);
constexpr size_t OFF_MG = al256(OFF_OG + (size_t)SEQ * DM * 2);
constexpr size_t OFF_END = al256(OFF_MG + (size_t)SEQ * DM * 2);
constexpr size_t OFF_BAR = OFF_END;
static_assert(OFF_BAR + 16384 <= (size_t)768 * 1024 * 1024, "workspace overflow");

struct Params {
  const float* in[25];
  float* out;
  char* ws;
};

DI unsigned pk2(float a, float b) { f2_t v = {a, b}; return __builtin_bit_cast(unsigned, __builtin_convertvector(v, bf2_t)); }
DI u16 f2bf(float a) { return (u16)(pk2(a, 0.f) & 0xffffu); }
DI float bf2f(u16 v) { return __uint_as_float(((unsigned)v) << 16); }
DI float bflo(unsigned v) { return __uint_as_float(v << 16); }
DI float bfhi(unsigned v) { return __uint_as_float(v & 0xffff0000u); }
DI float wave_sum(float v) {
#pragma unroll
  for (int o = 32; o >= 1; o >>= 1) v += __shfl_xor(v, o);
  return v;
}
DI int opaque_tid() { int t = threadIdx.x; asm volatile("" : "+v"(t)); return t; }
DI const float* in_ptr(const Params& p, int k) { asm volatile("" : "+s"(k)); return p.in[k]; }
DI int crow(int i, int h) { return (i & 3) + 8 * (i >> 2) + 4 * h; }
DI float sigmoidf_(float x) { return 1.f / (1.f + __expf(-x)); }
DI float siluf_(float x) { return x / (1.f + __expf(-x)); }


#define XB_TMO      128
#define XB_XCNT(j)  (256  + 64 * (j))
#define XB_XSUB(j)  (1280 + 64 * (j))
#define XB_XGEN(j)  (2304 + 64 * (j))
#define XB_TOP      3328
#define XB_TOPGEN   3392
#define XCD_BAR_WORDS 3456
#define XB_SPIN_CAP (1u << 18)
#define LAS __attribute__((address_space(3)))

__device__ __forceinline__ unsigned xb_ld(unsigned* p)              { return __hip_atomic_load(p, __ATOMIC_RELAXED, __HIP_MEMORY_SCOPE_AGENT); }
__device__ __forceinline__ unsigned xb_add(unsigned* p, unsigned v) { return __hip_atomic_fetch_add(p, v, __ATOMIC_RELAXED, __HIP_MEMORY_SCOPE_AGENT); }
__device__ __forceinline__ unsigned xb_xcc_id() { return (unsigned)__builtin_amdgcn_s_getreg((3 << 11) | 20) & 0xFu; }
#define XB_SPIN(cond, bar) do { unsigned _sp = 0; while (cond) { __builtin_amdgcn_s_sleep(1); \
    if ((++_sp & 255u) == 0u) { if (xb_ld(&(bar)[XB_TMO])) break; if (_sp > XB_SPIN_CAP) { atomicAdd(&(bar)[XB_TMO], 1u); break; } } } } while (0)

struct XcdBarrier {
    unsigned* bar; unsigned x;
    volatile LAS unsigned* st;
};

__device__ __forceinline__ XcdBarrier xcd_barrier_post(unsigned* bar, volatile LAS unsigned* st) {
    XcdBarrier b; b.bar = bar; b.x = xb_xcc_id(); b.st = st;
    if (threadIdx.x == 0) (void)xb_add(&bar[XB_XCNT(b.x)], 1u);
    return b;
}
__device__ __forceinline__ void xcd_barrier_complete(unsigned* bar, unsigned x, unsigned& nloc, unsigned& nx) {
    const unsigned G = gridDim.x * gridDim.y * gridDim.z;
    unsigned sum, cnt, mine, sp = 0u;
    for (;;) {
        sum = 0u; cnt = 0u; mine = 0u;
#pragma unroll
        for (unsigned j = 0; j < 16; ++j) { const unsigned c = xb_ld(&bar[XB_XCNT(j)]); sum += c; cnt += (c > 0u) ? 1u : 0u; mine = (j == x) ? c : mine; }
        if (sum == G) break;
        __builtin_amdgcn_s_sleep(1);
        if ((++sp & 255u) == 0u) { if (xb_ld(&bar[XB_TMO])) break; if (sp > XB_SPIN_CAP) { atomicAdd(&bar[XB_TMO], 1u); break; } }
    }
    nloc = mine > 0u ? mine : 1u; nx = cnt > 0u ? cnt : 1u;
}

__device__ __forceinline__ void xcd_barrier(const XcdBarrier& b) {
    asm volatile("s_waitcnt vmcnt(0)" ::: "memory");
    __syncthreads();
    int tid0_ = threadIdx.x; asm volatile("" : "+v"(tid0_));
    if (tid0_ == 0) {
        unsigned* bar = b.bar; asm volatile("" : "+s"(bar));
        unsigned bx_ = b.x; asm volatile("" : "+s"(bx_));
        __builtin_amdgcn_s_waitcnt(0);
        unsigned nloc = b.st[0], nx = b.st[1];
        if (nloc == 0u) { xcd_barrier_complete(bar, bx_, nloc, nx); b.st[0] = nloc; b.st[1] = nx; }
        const unsigned old = xb_add(&bar[XB_XSUB(bx_)], 1u);
        const unsigned gen = old / nloc;
        if (old + 1u == (gen + 1u) * nloc) {
            __builtin_amdgcn_fence(__ATOMIC_RELEASE, "agent");
            asm volatile("s_waitcnt vmcnt(0)" ::: "memory");
            const unsigned og = xb_add(&bar[XB_TOP], 1u);
            const unsigned tg = og / nx;
            if (og + 1u == (tg + 1u) * nx) xb_add(&bar[XB_TOPGEN], 1u);
            else XB_SPIN(xb_ld(&bar[XB_TOPGEN]) == tg, bar);
            __builtin_amdgcn_fence(__ATOMIC_ACQUIRE, "agent");
            xb_add(&bar[XB_XGEN(bx_)], 1u);
            asm volatile("s_waitcnt vmcnt(0)" ::: "memory");
        } else {
            XB_SPIN(xb_ld(&bar[XB_XGEN(bx_)]) == gen, bar);
            __builtin_amdgcn_fence(__ATOMIC_ACQUIRE, "agent");
            asm volatile("s_waitcnt vmcnt(0)" ::: "memory");
        }
    }
    __syncthreads();
}

constexpr int LROW = 72;
constexpr int GEMM_LDS = 2 * 128 * LROW * 2;

struct Acc { f32x16 a[4][2]; };

DI void acc_zero(Acc& c) {
#pragma unroll
  for (int i = 0; i < 4; ++i)
#pragma unroll
    for (int j = 0; j < 2; ++j)
#pragma unroll
      for (int k = 0; k < 16; ++k) c.a[i][j][k] = 0.f;
}

DI void gll16(const u16* g, char* l) {
  __builtin_amdgcn_global_load_lds((const __attribute__((address_space(1))) unsigned*)g,
                                   (__attribute__((address_space(3))) unsigned*)l, 16, 0, 0);
}
DI void gemm_kloop(const u16* __restrict__ A, int lda, const u16* __restrict__ B, int ldb, int K, u16* smem, Acc& c) {
  const int t = opaque_tid();
  const int lane = t & 63, w = t >> 6, r = lane & 31, h = lane >> 5;
  const int wm = w >> 1, wn = w & 1;
  char* lds = (char*)smem;
  const int nk = K >> 5;
  const int row0 = t >> 2, c0 = t & 3;
  const int sw0 = (c0 ^ ((row0 >> 2) & 3)) * 8;
  const u16* ga0 = A + (size_t)row0 * lda + sw0;
  const u16* gb0 = B + (size_t)row0 * ldb + sw0;
  const size_t a64 = (size_t)64 * lda, b64 = (size_t)64 * ldb;
  const int loff = t * 16;
#define GEMM_ISSUE(kt_, st_)                                         \
  do {                                                               \
    const int kk_ = ((kt_) < nk ? (kt_) : (nk - 1)) * 32;            \
    char* sp_ = lds + (st_) * 24576 + loff;                          \
    gll16(ga0 + kk_, sp_);                                           \
    gll16(ga0 + a64 + kk_, sp_ + 4096);                              \
    gll16(ga0 + 2 * a64 + kk_, sp_ + 8192);                          \
    gll16(ga0 + 3 * a64 + kk_, sp_ + 12288);                         \
    gll16(gb0 + kk_, sp_ + 16384);                                   \
    gll16(gb0 + b64 + kk_, sp_ + 20480);                             \
  } while (0)
  __syncthreads();
  GEMM_ISSUE(0, 0);
  GEMM_ISSUE(1, 1);
  const int fsw = (r >> 2) & 3;
  const int aoff = (wm * 128 + r) * 64, boff = 16384 + (wn * 64 + r) * 64;
  int scur = 0, snext = 2;
  for (int kt = 0; kt < nk; ++kt) {
    asm volatile("s_waitcnt vmcnt(6)" ::: "memory");
    __builtin_amdgcn_s_barrier();
    asm volatile("" ::: "memory");
    GEMM_ISSUE(kt + 2, snext);
    __builtin_amdgcn_sched_barrier(0);
    const char* st = lds + scur * 24576;
#pragma unroll
    for (int ks = 0; ks < 2; ++ks) {
      const int q = ((ks * 2 + h) ^ fsw) * 16;
      bf16x8 fa[4], fb[2];
#pragma unroll
      for (int i = 0; i < 4; ++i) fa[i] = *(const bf16x8*)(st + aoff + i * 2048 + q);
#pragma unroll
      for (int i = 0; i < 2; ++i) fb[i] = *(const bf16x8*)(st + boff + i * 2048 + q);
#pragma unroll
      for (int i = 0; i < 4; ++i)
#pragma unroll
        for (int j = 0; j < 2; ++j) c.a[i][j] = MFMA(fa[i], fb[j], c.a[i][j]);
    }
    __builtin_amdgcn_sched_barrier(0);
    snext = scur;
    scur = (scur == 2) ? 0 : scur + 1;
  }
  asm volatile("s_waitcnt vmcnt(0)" ::: "memory");
  __builtin_amdgcn_s_barrier();
  asm volatile("" ::: "memory");
#undef GEMM_ISSUE
}

DI void row_scales(const u16* __restrict__ base, int ld, int K, float* sc, int NR) {
  const int t = opaque_tid();
  const int row = (NR == 256) ? t : (t >> 1);
  const int part = (NR == 256) ? 0 : (t & 1);
  const int len = (NR == 256) ? K : (K / 2);
  const u16* p = base + (size_t)row * ld + part * len;
  float ss = 0.f;
  for (int i = 0; i < len / 8; ++i) {
    u32x4 v = *(const u32x4*)(p + i * 8);
#pragma unroll
    for (int j = 0; j < 4; ++j) { float a = bflo(v[j]), b = bfhi(v[j]); ss += a * a + b * b; }
  }
  if (NR != 256) ss += __shfl_xor(ss, 1);
  if (part == 0) sc[row] = rsqrtf(ss / (float)K + EPS);
}


template <int NI, class V, class R>
DI void epi_store(u16* smem, V val, R rowfn) {
  const int t = opaque_tid();
  const int lane = t & 63, w = t >> 6, r = lane & 31, h = lane >> 5;
  char* reg = (char*)smem + w * 18432;
#pragma unroll
  for (int mi = 0; mi < 4; ++mi)
#pragma unroll
    for (int ni = 0; ni < NI; ++ni)
#pragma unroll
      for (int i = 0; i < 16; ++i)
        *(u16*)(reg + (mi * 32 + crow(i, h)) * 144 + (ni * 32 + r) * 2) = f2bf(val(mi, ni, i));
  __builtin_amdgcn_sched_barrier(0);
  constexpr int CPR = NI * 4;
  constexpr int RPI = 64 / CPR;
  const int rr = lane / CPR, ch = lane % CPR;
#pragma unroll
  for (int k = 0; k < 128 / RPI; ++k) {
    const int row = k * RPI + rr;
    u32x4 v = *(const u32x4*)(reg + row * 144 + ch * 16);
    rowfn(row, ch * 8, v);
  }
}


template <int NI, int NPRE, class V, class L, class R>
DI void epi_store_pre(u16* smem, V val, L loadfn, R rowfn) {
  const int t = opaque_tid();
  const int lane = t & 63, w = t >> 6, r = lane & 31, h = lane >> 5;
  char* reg = (char*)smem + w * 18432;
#pragma unroll
  for (int mi = 0; mi < 4; ++mi)
#pragma unroll
    for (int ni = 0; ni < NI; ++ni)
#pragma unroll
      for (int i = 0; i < 16; ++i)
        *(u16*)(reg + (mi * 32 + crow(i, h)) * 144 + (ni * 32 + r) * 2) = f2bf(val(mi, ni, i));
  __builtin_amdgcn_sched_barrier(0);
  constexpr int CPR = NI * 4;
  constexpr int RPI = 64 / CPR;
  constexpr int NK = 128 / RPI;
  const int rr = lane / CPR, ch = lane % CPR;
  u32x4 pre[NK][NPRE];
#pragma unroll
  for (int k = 0; k < NK; ++k)
#pragma unroll
    for (int q = 0; q < NPRE; ++q) pre[k][q] = loadfn(k * RPI + rr, ch * 8, q);
  __builtin_amdgcn_sched_barrier(0);
#pragma unroll
  for (int k = 0; k < NK; ++k) {
    const int row = k * RPI + rr;
    u32x4 v = *(const u32x4*)(reg + row * 144 + ch * 16);
    rowfn(row, ch * 8, v, pre[k]);
  }
}

DI void tile_coords(int id, int MT, int NT, int& tm, int& tn) {
  const int per = 32 * NT;
  const int sr = id / per, rem = id - sr * per;
  tn = rem >> 5;
  tm = sr * 32 + (rem & 31);
}

#define EPI_LOOP                                   \
  _Pragma("unroll") for (int mi = 0; mi < 4; ++mi) \
  _Pragma("unroll") for (int ni = 0; ni < 2; ++ni) \
  _Pragma("unroll") for (int i = (__builtin_amdgcn_sched_barrier(0), 0); i < 16; ++i)

constexpr int SMEM_BYTES = 74752;

__global__ void __launch_bounds__(256, 2) fwd_megakernel(Params p) {
  cg::grid_group grid = cg::this_grid();
  __shared__ __attribute__((aligned(16))) char smem_raw[SMEM_BYTES];
  u16* smem = (u16*)smem_raw;
  const int G = gridDim.x;
  int bid = blockIdx.x;
  __shared__ uint4 xb_words;
  if (threadIdx.x == 0) xb_words = make_uint4(0u, 0u, 0u, 0u);
  __syncthreads();
  XcdBarrier xb = xcd_barrier_post((unsigned*)(p.ws + OFF_BAR), (volatile LAS unsigned*)&xb_words);

  char* ws = p.ws;
#define Wb ((u16*)(ws + OFF_WB))
#define ropec ((float*)(ws + OFF_ROPE))
#define ropes (((float*)(ws + OFF_ROPE)) + SEQ * 16)
#define Hb ((u16*)(ws + OFF_H))
#define Yb ((u16*)(ws + OFF_Y))
#define ACT ((u16*)(ws + OFF_ACT))
#define Z ((u16*)(ws + OFF_Z))
#define Qb ((u16*)(ws + OFF_Q))
#define KN ((u16*)(ws + OFF_KN))
#define VT ((u16*)(ws + OFF_VT))
#define KPE ((u16*)(ws + OFF_KPE))
#define OA ((u16*)(ws + OFF_OA))
#define ST ((u16*)(ws + OFF_ST))
#define DEC ((float*)(ws + OFF_DEC))
#define GC ((float*)(ws + OFF_GC))
#define OG ((u16*)(ws + OFF_OG))
#define MG ((u16*)(ws + OFF_MG))
  float* X = p.out;

  auto convert_weights = [&](int l) __attribute__((always_inline)) {
    const int t = opaque_tid();
    const int lane = t & 63, w = t >> 6, r = lane & 31, h = lane >> 5;
    const int wm = w >> 1, wn = w & 1;
    (void)lane; (void)r; (void)h; (void)wm; (void)wn;
    float* tile = (float*)smem_raw;
    for (int mat = 0; mat < 11; ++mat) {
      const float* src; int K, N; size_t dst; int map; const float* ksc = nullptr;
      switch (mat) {
        case 0: src = in_ptr(p, 3) + (size_t)l * DM * NFF2; K = DM; N = NFF2; dst = W_FFN1_IN; map = 1; break;
        case 1: src = in_ptr(p, 4) + (size_t)l * DFF * DM; K = DFF; N = DM; dst = W_FFN1_OUT; map = 0; break;
        case 2: src = in_ptr(p, 7) + (size_t)l * DM * PIN; K = DM; N = PIN; dst = W_IN; map = 0; break;
        case 3: src = in_ptr(p, 9) + (size_t)l * 256 * 768; K = 256; N = 768; dst = W_UQ; map = 0; ksc = in_ptr(p, 8) + l * 256; break;
        case 4: src = in_ptr(p, 11) + (size_t)l * 128 * 1024; K = 128; N = 1024; dst = W_KN; map = 2; ksc = in_ptr(p, 10) + l * 128; break;
        case 5: src = in_ptr(p, 12) + (size_t)l * 512 * DM; K = 512; N = DM; dst = W_OA; map = 0; break;
        case 6: src = in_ptr(p, 18) + (size_t)l * DM * DM; K = DM; N = DM; dst = W_OB; map = 0; break;
        case 7: src = in_ptr(p, 19) + (size_t)l * DM * DM; K = DM; N = DM; dst = W_OUT; map = 0; break;
        case 8: src = in_ptr(p, 22) + (size_t)l * DM * NFF2; K = DM; N = NFF2; dst = W_FFN2_IN; map = 1; break;
        case 9: src = in_ptr(p, 23) + (size_t)l * DFF * DM; K = DFF; N = DM; dst = W_FFN2_OUT; map = 0; break;
        default: src = nullptr; K = DM; N = 64; dst = W_IN + (size_t)PIN * DM; map = 3; break;
      }
      const int kt_n = K / 64, nt_n = N / 64;
      for (int id = bid; id < kt_n * nt_n; id += G) {
        const int kt = id % kt_n, nt = id / kt_n;
        const int k0 = kt * 64, n0 = nt * 64;
        __syncthreads();
        if (map != 3) {
#pragma unroll
          for (int i = 0; i < 4; ++i) {
            const int kk = (t >> 4) + 16 * i, nn = (t & 15) * 4;
            float4 v = *(const float4*)(src + (size_t)(k0 + kk) * N + n0 + nn);
            float sc = ksc ? ksc[k0 + kk] : 1.f;
            tile[kk * 65 + nn + 0] = v.x * sc; tile[kk * 65 + nn + 1] = v.y * sc;
            tile[kk * 65 + nn + 2] = v.z * sc; tile[kk * 65 + nn + 3] = v.w * sc;
          }
        }
        __syncthreads();
        const int nl = t >> 2, kc = (t & 3) * 16;
        const int n = n0 + nl;
        size_t drow;
        if (map == 0) drow = dst + (size_t)n * K;
        else if (map == 1) { const int isb = n >= DFF; const int j = n - isb * DFF; drow = dst + (size_t)((j >> 5) * 64 + isb * 32 + (j & 31)) * K; }
        else if (map == 2) { const int hd = n >> 7, cc = n & 127; drow = (cc < 64) ? (W_KN + (size_t)(hd * 64 + cc) * K) : (W_V + (size_t)(hd * 64 + cc - 64) * K); }
        else drow = dst + (size_t)nl * K;
        unsigned o[8];
#pragma unroll
        for (int j = 0; j < 8; ++j) {
          float a = (map == 3) ? 0.f : tile[(kc + 2 * j) * 65 + nl];
          float b = (map == 3) ? 0.f : tile[(kc + 2 * j + 1) * 65 + nl];
          o[j] = pk2(a, b);
        }
        uint4* dp = (uint4*)(Wb + drow + k0 + kc);
        dp[0] = make_uint4(o[0], o[1], o[2], o[3]);
        dp[1] = make_uint4(o[4], o[5], o[6], o[7]);
      }
    }
  };

  auto rn_pass = [&](int mode, float coef, const float* post_g, const float* pre_g) __attribute__((always_inline)) {
    const int t = opaque_tid();
    const int lane = t & 63, w = t >> 6, r = lane & 31, h = lane >> 5;
    const int wm = w >> 1, wn = w & 1;
    (void)lane; (void)r; (void)h; (void)wm; (void)wn;
    typedef float f4v __attribute__((ext_vector_type(4)));
    typedef unsigned u2v __attribute__((ext_vector_type(2)));
    const int gw = bid * 4 + w, nw = G * 4;
    constexpr int RB = 4;
    f4v pg[4], qg[4];
#pragma unroll
    for (int i = 0; i < 4; ++i) {
      pg[i] = (mode == 1) ? *(const f4v*)(post_g + lane * 4 + 256 * i) : (f4v){0.f, 0.f, 0.f, 0.f};
      qg[i] = pre_g ? *(const f4v*)(pre_g + lane * 4 + 256 * i) : (f4v){0.f, 0.f, 0.f, 0.f};
    }
    for (int row0 = gw; row0 < MALL; row0 += RB * nw) {
      f4v xv[RB][4];
      u2v yu[RB][4];
#pragma unroll
      for (int j = 0; j < RB; ++j) {
        int row = row0 + j * nw;
        if (row >= MALL) row = row0;
        const float* xs;
        if (mode == 0) xs = (row < SEQ) ? (in_ptr(p, 0) + (size_t)row * DM) : (in_ptr(p, 1) + (size_t)(row - SEQ) * DM);
        else xs = X + (size_t)row * DM;
#pragma unroll
        for (int i = 0; i < 4; ++i) xv[j][i] = *(const f4v*)(xs + lane * 4 + 256 * i);
        if (mode == 1) {
#pragma unroll
          for (int i = 0; i < 4; ++i) yu[j][i] = *(const u2v*)(Yb + (size_t)row * DM + lane * 4 + 256 * i);
        }
      }
#pragma unroll
      for (int j = 0; j < RB; ++j) {
        const int row = row0 + j * nw;
        if (row < MALL) {
          if (mode == 1) {
            float yv[16];
            float ss = 0.f;
#pragma unroll
            for (int i = 0; i < 4; ++i) {
              yv[4 * i + 0] = bflo(yu[j][i][0]); yv[4 * i + 1] = bfhi(yu[j][i][0]);
              yv[4 * i + 2] = bflo(yu[j][i][1]); yv[4 * i + 3] = bfhi(yu[j][i][1]);
            }
#pragma unroll
            for (int i = 0; i < 16; ++i) ss += yv[i] * yv[i];
            ss = wave_sum(ss);
            const float ry = rsqrtf(ss * (1.f / DM) + EPS) * coef;
#pragma unroll
            for (int i = 0; i < 4; ++i)
#pragma unroll
              for (int k = 0; k < 4; ++k) xv[j][i][k] += yv[4 * i + k] * ry * pg[i][k];
          }
#pragma unroll
          for (int i = 0; i < 4; ++i) *(f4v*)(X + (size_t)row * DM + lane * 4 + 256 * i) = xv[j][i];
          if (pre_g) {
            float ss = 0.f;
#pragma unroll
            for (int i = 0; i < 4; ++i)
#pragma unroll
              for (int k = 0; k < 4; ++k) ss += xv[j][i][k] * xv[j][i][k];
            ss = wave_sum(ss);
            const float rx = rsqrtf(ss * (1.f / DM) + EPS);
#pragma unroll
            for (int i = 0; i < 4; ++i) {
              u2v o;
              o[0] = pk2(xv[j][i][0] * rx * qg[i][0], xv[j][i][1] * rx * qg[i][1]);
              o[1] = pk2(xv[j][i][2] * rx * qg[i][2], xv[j][i][3] * rx * qg[i][3]);
              *(u2v*)(Hb + (size_t)row * DM + lane * 4 + 256 * i) = o;
            }
          }
        }
      }
    }
  };

  auto ffn_in = [&](size_t woff) __attribute__((always_inline)) {
    const int t = opaque_tid();
    const int lane = t & 63, w = t >> 6, r = lane & 31, h = lane >> 5;
    const int wm = w >> 1, wn = w & 1;
    (void)lane; (void)r; (void)h; (void)wm; (void)wn;
    const int MT = MALL / 256, NT = NFF2 / 128;
    for (int id = bid; id < MT * NT; id += G) {
      int tm, tn; tile_coords(id, MT, NT, tm, tn);
      const int m0 = tm * 256, n0 = tn * 128;
      Acc c; acc_zero(c);
      gemm_kloop(Hb + (size_t)m0 * DM, DM, Wb + woff + (size_t)n0 * DM, DM, DM, smem, c);
#ifdef DUP_KLOOP
      acc_zero(c);
      gemm_kloop(Hb + (size_t)m0 * DM, DM, Wb + woff + (size_t)n0 * DM, DM, DM, smem, c);
#endif
      const int jb0 = ((n0 + wn * 64) >> 6) * 32;
      const unsigned obase = (unsigned)((m0 + wm * 128) * DFF + jb0);
      epi_store<1>(smem,
        [&](int mi, int ni, int i) { return siluf_(c.a[mi][0][i]) * c.a[mi][1][i]; },
        [&](int row, int col, u32x4 v) { *(u32x4*)(ACT + obase + (unsigned)(row * DFF + col)) = v; });
    }
  };
  auto gemm_plain = [&](const u16* A, int lda, int K, const u16* Bt, u16* C, int ldc, int M, int N) __attribute__((always_inline)) {
    const int t = opaque_tid();
    const int lane = t & 63, w = t >> 6, r = lane & 31, h = lane >> 5;
    const int wm = w >> 1, wn = w & 1;
    (void)lane; (void)r; (void)h; (void)wm; (void)wn;
    const int MT = M / 256, NT = N / 128;
    for (int id = bid; id < MT * NT; id += G) {
      int tm, tn; tile_coords(id, MT, NT, tm, tn);
      const int m0 = tm * 256, n0 = tn * 128;
      Acc c; acc_zero(c);
      gemm_kloop(A + (size_t)m0 * lda, lda, Bt + (size_t)n0 * K, K, K, smem, c);
      const unsigned obase = (unsigned)((m0 + wm * 128) * ldc + n0 + wn * 64);
      epi_store<2>(smem,
        [&](int mi, int ni, int i) { return c.a[mi][ni][i]; },
        [&](int row, int col, u32x4 v) { *(u32x4*)(C + obase + (unsigned)(row * ldc + col)) = v; });
    }
  };

  auto prep_phase = [&](int l) __attribute__((always_inline)) {
    int pb_ = bid; asm volatile("" : "+s"(pb_));
    const int t = opaque_tid();
    const int lane = t & 63, w = t >> 6, r = lane & 31, h = lane >> 5;
    const int wm = w >> 1, wn = w & 1;
    (void)lane; (void)r; (void)h; (void)wm; (void)wn;
    float* sc = (float*)(smem_raw + 2 * GEMM_LDS);
    const int NQ = 64 * 6, NK = 64 * 4, NV = 2 * 128, NPE = 64, NG1 = NCHUNK * 4;
    const float qscale = 0.10206207261596577f * 1.4426950408889634f;
    {
      for (int id = pb_; id < NG1; id += G) {
        const int t = opaque_tid();
        const int lane = t & 63, w = t >> 6, r = lane & 31, h = lane >> 5;
        const int wm = w >> 1, wn = w & 1;
        (void)lane; (void)r; (void)h; (void)wm; (void)wn;
        const int n = id >> 2, hd = id & 3;
        const int t0 = n * 64;
        u16* ksT = smem;
        u16* vT = smem + 2 * 128 * LROW;
        u16* sk = vT;
        float* sga = (float*)(smem_raw + 55296);
        __syncthreads();
        {
          const int cc = t >> 2, part = t & 3;
          const u16* kp = Z + (size_t)(t0 + cc) * ZLD + Z_GK + hd * 128 + part * 32;
#pragma unroll
          for (int j = 0; j < 4; ++j) *(u32x4*)(sk + cc * 128 + part * 32 + j * 8) = *(const u32x4*)(kp + j * 8);
          u32x4 gv = *(const u32x4*)(Z + (size_t)(t0 + cc) * ZLD + Z_GA + part * 8);
#pragma unroll
          for (int k = 0; k < 4; ++k) { sga[cc * 32 + part * 8 + 2 * k] = bflo(gv[k]); sga[cc * 32 + part * 8 + 2 * k + 1] = bfhi(gv[k]); }
        }
        __syncthreads();
        {
          const int dir = t >> 7, d = t & 127;
          const float* wa2 = (dir ? in_ptr(p, 15) : in_ptr(p, 13)) + (size_t)l * 16 * 512 + hd * 128 + d;
          const float ba = ((dir ? in_ptr(p, 16) : in_ptr(p, 14)) + (size_t)l * 512)[hd * 128 + d];
          float wcol[16];
#pragma unroll
          for (int rr = 0; rr < 16; ++rr) wcol[rr] = wa2[rr * 512];
          const float* gar = sga + dir * 16;
          float tot = 0.f;
          for (int cc = 0; cc < 64; ++cc) {
            float pre = ba;
#pragma unroll
            for (int rr = 0; rr < 16; ++rr) pre += gar[cc * 32 + rr] * wcol[rr];
            tot += (fminf(pre, 0.f) - __logf(1.f + __expf(-fabsf(pre)))) * (1.f / 16.f);
          }
          DEC[((size_t)(n * 4 + hd) * 2 + dir) * 128 + d] = __expf(tot);
          float* gc = GC + (size_t)dir * SEQ * 512 + (size_t)t0 * 512 + hd * 128 + d;
          float cb = 0.f;
          u16* krow_out = ksT + (dir * 128 + d) * LROW;
          for (int ci = 0; ci < 64; ++ci) {
            const int cc = dir ? (63 - ci) : ci;
            float pre = ba;
#pragma unroll
            for (int rr = 0; rr < 16; ++rr) pre += gar[cc * 32 + rr] * wcol[rr];
            cb += (fminf(pre, 0.f) - __logf(1.f + __expf(-fabsf(pre)))) * (1.f / 16.f);
            gc[cc * 512] = cb;
            krow_out[cc] = f2bf(bf2f(sk[cc * 128 + d]) * __expf(tot - cb));
          }
        }
        for (int half = 0; half < 2; ++half) {
          __syncthreads();
          {
            const int cc = t & 63, part = t >> 6;
#pragma unroll
            for (int q = 0; q < 4; ++q) {
              const int cg8 = (part * 4 + q) * 8;
              uint4 v = *(const uint4*)(Z + (size_t)(t0 + cc) * ZLD + Z_GV + hd * 256 + half * 128 + cg8);
              unsigned u[4] = {v.x, v.y, v.z, v.w};
#pragma unroll
              for (int j = 0; j < 4; ++j) {
                vT[(cg8 + 2 * j) * LROW + cc] = (u16)(u[j] & 0xffffu);
                vT[(cg8 + 2 * j + 1) * LROW + cc] = (u16)(u[j] >> 16);
              }
            }
          }
          __syncthreads();
#pragma unroll
          for (int dir = 0; dir < 2; ++dir) {
            f32x16 acc[4];
#pragma unroll
            for (int j = 0; j < 4; ++j)
#pragma unroll
              for (int k = 0; k < 16; ++k) acc[j][k] = 0.f;
#pragma unroll
            for (int ks = 0; ks < 4; ++ks) {
              bf16x8 fa = *(const bf16x8*)(vT + (w * 32 + r) * LROW + ks * 16 + h * 8);
#pragma unroll
              for (int nt = 0; nt < 4; ++nt) {
                bf16x8 fb = *(const bf16x8*)(ksT + (dir * 128 + nt * 32 + r) * LROW + ks * 16 + h * 8);
                acc[nt] = MFMA(fb, fa, acc[nt]);
              }
            }
            u16* stp = ST + ((size_t)(n * 4 + hd) * 2 + dir) * 32768;
#pragma unroll
            for (int nt = 0; nt < 4; ++nt)
#pragma unroll
              for (int g4 = 0; g4 < 4; ++g4) {
                uint2 o;
                o.x = pk2(acc[nt][4 * g4 + 0], acc[nt][4 * g4 + 1]);
                o.y = pk2(acc[nt][4 * g4 + 2], acc[nt][4 * g4 + 3]);
                *(uint2*)(stp + (unsigned)((half * 128 + w * 32 + r) * 128 + nt * 32 + 8 * g4 + 4 * h)) = o;
              }
          }
        }
      }
      for (int q = pb_; q < NQ; q += G) {
        const int t = opaque_tid();
        const int lane = t & 63, w = t >> 6, r = lane & 31, h = lane >> 5;
        const int wm = w >> 1, wn = w & 1;
        (void)lane; (void)r; (void)h; (void)wm; (void)wn;
        const int tm = q / 6, tn = q % 6;
        const int m0 = tm * 256, n0 = tn * 128;
        __syncthreads();
        row_scales(Z + (size_t)m0 * ZLD + Z_CQ, ZLD, 256, sc, 256);
        Acc c; acc_zero(c);
        gemm_kloop(Z + (size_t)m0 * ZLD + Z_CQ, ZLD, Wb + W_UQ + (size_t)n0 * 256, 256, 256, smem, c);
        {
          const unsigned obase = (unsigned)((m0 + wm * 128) * 768 + n0 + wn * 64);
          epi_store<2>(smem,
            [&](int mi, int ni, int i) {
              const int cb0 = n0 + wn * 64 + ni * 32;
              const bool rope = ((cb0 >> 5) % 3) == 2;
              const int rl = wm * 128 + mi * 32 + crow(i, h);
              float v = c.a[mi][ni][i] * sc[rl];
              const float pv = __shfl_xor(v, 16);
              if (rope) {
                const int row = m0 + rl;
                const float cs = ropec[row * 16 + (r & 15)], sn = ropes[row * 16 + (r & 15)];
                v = (r < 16) ? (v * cs - pv * sn) : (v * cs + pv * sn);
              }
              return v * qscale;
            },
            [&](int row, int col, u32x4 v) { *(u32x4*)(Qb + obase + (unsigned)(row * 768 + col)) = v; });
        }
      }
      for (int q = (pb_ + G - (NQ % G)) % G; q < NK; q += G) {
        const int t = opaque_tid();
        const int lane = t & 63, w = t >> 6, r = lane & 31, h = lane >> 5;
        const int wm = w >> 1, wn = w & 1;
        (void)lane; (void)r; (void)h; (void)wm; (void)wn;
        const int tm = q >> 2, tn = q & 3;
        const int m0 = tm * 256, n0 = tn * 128;
        __syncthreads();
        row_scales(Z + (size_t)m0 * ZLD + Z_CKV, ZLD, 128, sc, 256);
        Acc c; acc_zero(c);
        gemm_kloop(Z + (size_t)m0 * ZLD + Z_CKV, ZLD, Wb + W_KN + (size_t)n0 * 128, 128, 128, smem, c);
        {
          const unsigned obase = (unsigned)((m0 + wm * 128) * 512 + n0 + wn * 64);
          epi_store<2>(smem,
            [&](int mi, int ni, int i) { return c.a[mi][ni][i] * sc[wm * 128 + mi * 32 + crow(i, h)]; },
            [&](int row, int col, u32x4 v) { *(u32x4*)(KN + obase + (unsigned)(row * 512 + col)) = v; });
        }
      }
      for (int q = (pb_ + G - ((NQ + NK) % G)) % G; q < NV; q += G) {
        const int t = opaque_tid();
        const int lane = t & 63, w = t >> 6, r = lane & 31, h = lane >> 5;
        const int wm = w >> 1, wn = w & 1;
        (void)lane; (void)r; (void)h; (void)wm; (void)wn;
        const int tm = q & 1, tn = q >> 1;
        const int m0 = tm * 256, n0 = tn * 128;
        __syncthreads();
        row_scales(Z + (size_t)n0 * ZLD + Z_CKV, ZLD, 128, sc, 128);
        Acc c; acc_zero(c);
        gemm_kloop(Wb + W_V + (size_t)m0 * 128, 128, Z + (size_t)n0 * ZLD + Z_CKV, ZLD, 128, smem, c);
        {
          const unsigned obase = (unsigned)((m0 + wm * 128) * SEQ + n0 + wn * 64);
          epi_store<2>(smem,
            [&](int mi, int ni, int i) { return c.a[mi][ni][i] * sc[wn * 64 + ni * 32 + r]; },
            [&](int row, int col, u32x4 v) { *(u32x4*)(VT + obase + (unsigned)(row * SEQ + col)) = v; });
        }
      }
      for (int q = (pb_ + G - ((NQ + NK + NV) % G)) % G; q < NPE; q += G) {
        const int t = opaque_tid();
        const int lane = t & 63, w = t >> 6, r = lane & 31, h = lane >> 5;
        const int wm = w >> 1, wn = w & 1;
        (void)lane; (void)r; (void)h; (void)wm; (void)wn;
        const int tok = q * 256 + t;
        const u16* src = Z + (size_t)tok * ZLD + Z_KPE;
        float v[32];
#pragma unroll
        for (int j = 0; j < 4; ++j) {
          uint4 u = *(const uint4*)(src + j * 8);
          unsigned uu[4] = {u.x, u.y, u.z, u.w};
#pragma unroll
          for (int k = 0; k < 4; ++k) { v[j * 8 + 2 * k] = bflo(uu[k]); v[j * 8 + 2 * k + 1] = bfhi(uu[k]); }
        }
        float o[32];
#pragma unroll
        for (int i = 0; i < 16; ++i) {
          const float cs = ropec[tok * 16 + i], sn = ropes[tok * 16 + i];
          o[i] = v[i] * cs - v[i + 16] * sn;
          o[i + 16] = v[i + 16] * cs + v[i] * sn;
        }
#pragma unroll
        for (int j = 0; j < 4; ++j) {
          uint4 u;
          u.x = pk2(o[j * 8 + 0], o[j * 8 + 1]); u.y = pk2(o[j * 8 + 2], o[j * 8 + 3]);
          u.z = pk2(o[j * 8 + 4], o[j * 8 + 5]); u.w = pk2(o[j * 8 + 6], o[j * 8 + 7]);
          *(uint4*)(KPE + (size_t)tok * 32 + j * 8) = u;
        }
      }
    }
  };

  auto attn_phase = [&](int mode) __attribute__((always_inline)) {
    const int t = opaque_tid();
    const int lane = t & 63, w = t >> 6, r = lane & 31, h = lane >> 5;
    const int wm = w >> 1, wn = w & 1;
    (void)lane; (void)r; (void)h; (void)wm; (void)wn;
    if (mode & 1) for (int id = bid; id < 512; id += G) {
      const int e = id * 256 + t;
      const int d2 = e & 63, v = (e >> 6) & 255, dir = (e >> 14) & 1, hd = e >> 15;
      float s0 = 0.f, s1 = 0.f;
      const size_t eoff = (size_t)v * 128 + 2 * d2;
      for (int i0 = 0; i0 < NCHUNK; i0 += 16) {
        unsigned uu[16];
        float2 dd[16];
#pragma unroll
        for (int j = 0; j < 16; ++j) {
          const int n = dir ? (NCHUNK - 1 - (i0 + j)) : (i0 + j);
          const size_t base = ((size_t)(n * 4 + hd) * 2 + dir);
          uu[j] = *(const unsigned*)(ST + base * 32768 + eoff);
          dd[j] = *(const float2*)(DEC + base * 128 + 2 * d2);
        }
#pragma unroll
        for (int j = 0; j < 16; ++j) {
          const int n = dir ? (NCHUNK - 1 - (i0 + j)) : (i0 + j);
          const size_t base = ((size_t)(n * 4 + hd) * 2 + dir);
          *(unsigned*)(ST + base * 32768 + eoff) = pk2(s0, s1);
          s0 = dd[j].x * s0 + bflo(uu[j]);
          s1 = dd[j].y * s1 + bfhi(uu[j]);
        }
      }
    }
    constexpr int KROW = 104;
    constexpr int VR = 68;
    constexpr int ABUF = 64 * KROW + 64 * VR;
    u16* sK = smem;
    u16* sV = smem + 64 * KROW;
    if (mode & 2) for (int id = bid; id < 8 * 64; id += G) {
      const int hd = id & 7, qb = id >> 3;
      const int q0 = qb * 256 + w * 64;
      bf16x8 bq[2][6];
#pragma unroll
      for (int qt = 0; qt < 2; ++qt)
#pragma unroll
        for (int ks = 0; ks < 6; ++ks) bq[qt][ks] = *(const bf16x8*)(Qb + (size_t)(q0 + qt * 32 + r) * 768 + hd * 96 + ks * 16 + h * 8);
      f32x16 O[2][2];
#pragma unroll
      for (int j = 0; j < 2; ++j)
#pragma unroll
        for (int qt = 0; qt < 2; ++qt)
#pragma unroll
          for (int k = 0; k < 16; ++k) O[j][qt][k] = 0.f;
      float m[2] = {0.f, 0.f}, lsum[2] = {0.f, 0.f};
      const int kr = t >> 2, kc = t & 3;
      const u16* knp = KN + (size_t)kr * 512 + hd * 64 + kc * 16;
      const u16* kpp = KPE + (size_t)kr * 32 + kc * 8;
      const u16* vpp = VT + (size_t)(hd * 64 + kr) * SEQ + kc * 16;
      u32x4 rk[3], rv[2];
      rk[0] = *(const u32x4*)(knp);
      rk[1] = *(const u32x4*)(knp + 8);
      rk[2] = *(const u32x4*)(kpp);
      rv[0] = *(const u32x4*)(vpp);
      rv[1] = *(const u32x4*)(vpp + 8);
      __syncthreads();
      *(u32x4*)(sK + kr * KROW + kc * 16) = rk[0];
      *(u32x4*)(sK + kr * KROW + kc * 16 + 8) = rk[1];
      *(u32x4*)(sK + kr * KROW + 64 + kc * 8) = rk[2];
      *(uint2*)(sV + kr * VR + kc * 16) = make_uint2(rv[0][0], rv[0][1]);
      *(uint2*)(sV + kr * VR + kc * 16 + 4) = make_uint2(rv[0][2], rv[0][3]);
      *(uint2*)(sV + kr * VR + kc * 16 + 8) = make_uint2(rv[1][0], rv[1][1]);
      *(uint2*)(sV + kr * VR + kc * 16 + 12) = make_uint2(rv[1][2], rv[1][3]);
      rk[0] = *(const u32x4*)(knp + (size_t)64 * 512);
      rk[1] = *(const u32x4*)(knp + (size_t)64 * 512 + 8);
      rk[2] = *(const u32x4*)(kpp + (size_t)64 * 32);
      rv[0] = *(const u32x4*)(vpp + 64);
      rv[1] = *(const u32x4*)(vpp + 64 + 8);
      __syncthreads();
      int cur = 0;
      for (int key0 = 0; key0 < SEQ; key0 += 64) {
        const u16* cK = sK + cur * ABUF;
        const u16* cV = sV + cur * ABUF;
        {
          u16* nK = sK + (cur ^ 1) * ABUF;
          u16* nV = sV + (cur ^ 1) * ABUF;
          *(u32x4*)(nK + kr * KROW + kc * 16) = rk[0];
          *(u32x4*)(nK + kr * KROW + kc * 16 + 8) = rk[1];
          *(u32x4*)(nK + kr * KROW + 64 + kc * 8) = rk[2];
          *(uint2*)(nV + kr * VR + kc * 16) = make_uint2(rv[0][0], rv[0][1]);
          *(uint2*)(nV + kr * VR + kc * 16 + 4) = make_uint2(rv[0][2], rv[0][3]);
          *(uint2*)(nV + kr * VR + kc * 16 + 8) = make_uint2(rv[1][0], rv[1][1]);
          *(uint2*)(nV + kr * VR + kc * 16 + 12) = make_uint2(rv[1][2], rv[1][3]);
          const int kn = (key0 + 128 < SEQ) ? (key0 + 128) : key0;
          rk[0] = *(const u32x4*)(knp + (size_t)kn * 512);
          rk[1] = *(const u32x4*)(knp + (size_t)kn * 512 + 8);
          rk[2] = *(const u32x4*)(kpp + (size_t)kn * 32);
          rv[0] = *(const u32x4*)(vpp + kn);
          rv[1] = *(const u32x4*)(vpp + kn + 8);
        }
        __builtin_amdgcn_sched_barrier(0);
        f32x16 S[2][2];
#pragma unroll
        for (int kt = 0; kt < 2; ++kt)
#pragma unroll
          for (int qt = 0; qt < 2; ++qt)
#pragma unroll
            for (int k = 0; k < 16; ++k) S[kt][qt][k] = -m[qt];
        __builtin_amdgcn_s_setprio(1);
#pragma unroll
        for (int ks = 0; ks < 6; ++ks)
#pragma unroll
          for (int kt = 0; kt < 2; ++kt) {
            bf16x8 fa = *(const bf16x8*)(cK + (kt * 32 + r) * KROW + ks * 16 + h * 8);
            S[kt][0] = MFMA(fa, bq[0][ks], S[kt][0]);
            S[kt][1] = MFMA(fa, bq[1][ks], S[kt][1]);
          }
        __builtin_amdgcn_s_setprio(0);
        bf16x8 pf[2][4];
#pragma unroll
        for (int qt = 0; qt < 2; ++qt) {
          float mloc = S[0][qt][0];
#pragma unroll
          for (int kt = 0; kt < 2; ++kt)
#pragma unroll
            for (int k = 0; k < 16; ++k) mloc = fmaxf(mloc, S[kt][qt][k]);
          {
            auto sw_ = __builtin_amdgcn_permlane32_swap(__float_as_uint(mloc), __float_as_uint(mloc), false, false);
            mloc = fmaxf(__uint_as_float(sw_[0]), __uint_as_float(sw_[1]));
          }
          if (__builtin_amdgcn_ballot_w64(mloc > 6.f) != 0ull) {
            const float delta = fmaxf(mloc, 0.f);
            const float alpha = __builtin_amdgcn_exp2f(-delta);
            m[qt] += delta;
            lsum[qt] *= alpha;
#pragma unroll
            for (int j = 0; j < 2; ++j)
#pragma unroll
              for (int k = 0; k < 16; ++k) O[j][qt][k] *= alpha;
#pragma unroll
            for (int kt = 0; kt < 2; ++kt)
#pragma unroll
              for (int k = 0; k < 16; ++k) S[kt][qt][k] -= delta;
          }
          float ps = 0.f;
#pragma unroll
          for (int kt = 0; kt < 2; ++kt)
#pragma unroll
            for (int k = 0; k < 16; ++k) { S[kt][qt][k] = __builtin_amdgcn_exp2f(S[kt][qt][k]); ps += S[kt][qt][k]; }
          lsum[qt] += ps;
#pragma unroll
          for (int s2 = 0; s2 < 4; ++s2) {
            const int kt = s2 >> 1, sx = s2 & 1;
            unsigned pw[4];
#pragma unroll
            for (int j = 0; j < 4; ++j) pw[j] = pk2(S[kt][qt][8 * sx + 2 * j], S[kt][qt][8 * sx + 2 * j + 1]);
            pf[qt][s2] = __builtin_bit_cast(bf16x8, make_uint4(pw[0], pw[1], pw[2], pw[3]));
          }
        }
#pragma unroll
        for (int s2 = 0; s2 < 4; ++s2) {
          const int kt = s2 >> 1, sx = s2 & 1;
#pragma unroll
          for (int dt = 0; dt < 2; ++dt) {
            const u16* vp = cV + (dt * 32 + r) * VR + kt * 32 + 16 * sx + 4 * h;
            uint2 lo = *(const uint2*)(vp);
            uint2 hi = *(const uint2*)(vp + 8);
            bf16x8 fv = __builtin_bit_cast(bf16x8, make_uint4(lo.x, lo.y, hi.x, hi.y));
            O[dt][0] = MFMA(fv, pf[0][s2], O[dt][0]);
            O[dt][1] = MFMA(fv, pf[1][s2], O[dt][1]);
          }
        }
        cur ^= 1;
        __syncthreads();
      }
#pragma unroll
      for (int qt = 0; qt < 2; ++qt) {
        const float lt = lsum[qt] + __shfl_xor(lsum[qt], 32);
        const float inv = 1.f / lt;
#pragma unroll
        for (int dt = 0; dt < 2; ++dt)
#pragma unroll
          for (int g4 = 0; g4 < 4; ++g4) {
            uint2 o;
            o.x = pk2(O[dt][qt][4 * g4 + 0] * inv, O[dt][qt][4 * g4 + 1] * inv);
            o.y = pk2(O[dt][qt][4 * g4 + 2] * inv, O[dt][qt][4 * g4 + 3] * inv);
            *(uint2*)(OA + (size_t)(q0 + qt * 32 + r) * 512 + hd * 64 + dt * 32 + 8 * g4 + 4 * h) = o;
          }
      }
    }
  };

  auto gla_out_phase = [&](int l) __attribute__((always_inline)) {
    const int t = opaque_tid();
    const int lane = t & 63, w = t >> 6, r = lane & 31, h = lane >> 5;
    const int wm = w >> 1, wn = w & 1;
    (void)lane; (void)r; (void)h; (void)wm; (void)wn;
    constexpr int QROW = 136;
    u16* sQ = smem;
    u16* sKt = smem + 64 * QROW;
    u16* sVT = smem + 2 * 64 * QROW;
    float* sred = (float*)(smem + 2 * 64 * QROW + 256 * LROW);
    u16* sO = smem;
    constexpr int OROW = 264;
    const float qs = 0.08838834764831845f;
    const int cs = w & 1, vh = w >> 1;
    for (int id = bid; id < NCHUNK * 4; id += G) {
      const int n = id >> 2, hd = id & 3;
      const int t0 = n * 64;
      __syncthreads();
      {
        const int cc = t & 63, part = t >> 6;
#pragma unroll
        for (int q = 0; q < 8; ++q) {
          const int cg8 = (part * 8 + q) * 8;
          uint4 v = *(const uint4*)(Z + (size_t)(t0 + cc) * ZLD + Z_GV + hd * 256 + cg8);
          unsigned u[4] = {v.x, v.y, v.z, v.w};
#pragma unroll
          for (int j = 0; j < 4; ++j) {
            sVT[(cg8 + 2 * j) * LROW + cc] = (u16)(u[j] & 0xffffu);
            sVT[(cg8 + 2 * j + 1) * LROW + cc] = (u16)(u[j] >> 16);
          }
        }
      }
      f32x16 acc[4];
#pragma unroll
      for (int j = 0; j < 4; ++j)
#pragma unroll
        for (int k = 0; k < 16; ++k) acc[j][k] = 0.f;
      for (int dir = 0; dir < 2; ++dir) {
        __syncthreads();
        {
          const int cc = t >> 2, dp = (t & 3) * 32;
          const u16* qp = Z + (size_t)(t0 + cc) * ZLD + Z_GQ + hd * 128 + dp;
          const u16* kp = Z + (size_t)(t0 + cc) * ZLD + Z_GK + hd * 128 + dp;
          const float* gp = GC + (size_t)dir * SEQ * 512 + (size_t)(t0 + cc) * 512 + hd * 128 + dp;
#pragma unroll
          for (int j = 0; j < 4; ++j) {
            uint4 qv = *(const uint4*)(qp + j * 8);
            uint4 kv = *(const uint4*)(kp + j * 8);
            float4 g0 = *(const float4*)(gp + j * 8);
            float4 g1 = *(const float4*)(gp + j * 8 + 4);
            const float gg[8] = {g0.x, g0.y, g0.z, g0.w, g1.x, g1.y, g1.z, g1.w};
            const unsigned qu[4] = {qv.x, qv.y, qv.z, qv.w};
            const unsigned ku[4] = {kv.x, kv.y, kv.z, kv.w};
            unsigned qo[4], ko[4];
#pragma unroll
            for (int k = 0; k < 4; ++k) {
              const float e0 = __expf(gg[2 * k]), e1 = __expf(gg[2 * k + 1]);
              qo[k] = pk2(bflo(qu[k]) * qs * e0, bfhi(qu[k]) * qs * e1);
              ko[k] = pk2(bflo(ku[k]) / e0, bfhi(ku[k]) / e1);
            }
            *(uint4*)(sQ + cc * QROW + dp + j * 8) = make_uint4(qo[0], qo[1], qo[2], qo[3]);
            *(uint4*)(sKt + cc * QROW + dp + j * 8) = make_uint4(ko[0], ko[1], ko[2], ko[3]);
            if (j == 1) __builtin_amdgcn_sched_barrier(0);
          }
        }
        __syncthreads();
        const u16* bqp = sQ + (cs * 32 + r) * QROW + h * 8;
        const u16* stp = ST + ((size_t)(n * 4 + hd) * 2 + dir) * 32768;
        bf16x8 fs[2][4];
#pragma unroll
        for (int ks = 0; ks < 4; ++ks) fs[0][ks] = *(const bf16x8*)(stp + (size_t)(vh * 128 + r) * 128 + ks * 16 + h * 8);
        f32x16 at[2];
#pragma unroll
        for (int et = 0; et < 2; ++et) {
#pragma unroll
          for (int k = 0; k < 16; ++k) at[et][k] = 0.f;
#pragma unroll
          for (int ks = 0; ks < 8; ++ks) {
            bf16x8 fa = *(const bf16x8*)(sKt + (et * 32 + r) * QROW + ks * 16 + h * 8);
            bf16x8 fbq = *(const bf16x8*)(bqp + ks * 16);
            at[et] = MFMA(fa, fbq, at[et]);
          }
          const int cidx = cs * 32 + r;
#pragma unroll
          for (int k = 0; k < 16; ++k) {
            const int e = et * 32 + crow(k, h);
            const bool keep = dir ? (e >= cidx) : (e <= cidx);
            at[et][k] = keep ? at[et][k] : 0.f;
          }
        }
#pragma unroll
        for (int s2 = 0; s2 < 4; ++s2) {
          const int et = s2 >> 1, s = s2 & 1;
          unsigned pw[4];
#pragma unroll
          for (int j = 0; j < 4; ++j) pw[j] = pk2(at[et][8 * s + 2 * j], at[et][8 * s + 2 * j + 1]);
          bf16x8 pf = __builtin_bit_cast(bf16x8, make_uint4(pw[0], pw[1], pw[2], pw[3]));
#pragma unroll
          for (int mt = 0; mt < 4; ++mt) {
            const u16* vp = sVT + (vh * 128 + mt * 32 + r) * LROW + et * 32 + 16 * s + 4 * h;
            uint2 lo = *(const uint2*)(vp);
            uint2 hi = *(const uint2*)(vp + 8);
            bf16x8 fv = __builtin_bit_cast(bf16x8, make_uint4(lo.x, lo.y, hi.x, hi.y));
            acc[mt] = MFMA(fv, pf, acc[mt]);
          }
        }
#pragma unroll
        for (int bb = 0; bb < 8; ++bb) {
          const int mt = bb >> 1, kb = bb & 1;
          if (bb + 1 < 8) {
            const int mt1 = (bb + 1) >> 1, kb1 = (bb + 1) & 1;
#pragma unroll
            for (int ks = 0; ks < 4; ++ks) fs[(bb + 1) & 1][ks] = *(const bf16x8*)(stp + (size_t)(vh * 128 + mt1 * 32 + r) * 128 + (kb1 * 4 + ks) * 16 + h * 8);
          }
          __builtin_amdgcn_sched_barrier(0);
#pragma unroll
          for (int ks = 0; ks < 4; ++ks) { bf16x8 fbq = *(const bf16x8*)(bqp + (kb * 4 + ks) * 16); acc[mt] = MFMA(fs[bb & 1][ks], fbq, acc[mt]); }
          __builtin_amdgcn_sched_barrier(0);
        }
      }
      float ss = 0.f;
#pragma unroll
      for (int mt = 0; mt < 4; ++mt)
#pragma unroll
        for (int k = 0; k < 16; ++k) ss += acc[mt][k] * acc[mt][k];
      ss += __shfl_xor(ss, 32);
      if (h == 0) sred[vh * 64 + cs * 32 + r] = ss;
      __syncthreads();
      const float rs = rsqrtf((sred[cs * 32 + r] + sred[64 + cs * 32 + r]) * (1.f / 256.f) + EPS);
#pragma unroll
      for (int mt = 0; mt < 4; ++mt)
#pragma unroll
        for (int g4 = 0; g4 < 4; ++g4) {
          uint2 o;
          o.x = pk2(acc[mt][4 * g4 + 0] * rs, acc[mt][4 * g4 + 1] * rs);
          o.y = pk2(acc[mt][4 * g4 + 2] * rs, acc[mt][4 * g4 + 3] * rs);
          *(uint2*)(sO + (cs * 32 + r) * OROW + vh * 128 + mt * 32 + 8 * g4 + 4 * h) = o;
        }
      __syncthreads();
      {
        const int t3 = opaque_tid();
        const int cc = t3 >> 2, vp0 = (t3 & 3) * 64;
        const float* ng = in_ptr(p, 17) + (size_t)l * 256;
        u32x4 gvp[8];
#pragma unroll
        for (int j = 0; j < 8; ++j) gvp[j] = *(const u32x4*)(Z + (size_t)(t0 + cc) * ZLD + Z_GOG + hd * 256 + vp0 + j * 8);
        __builtin_amdgcn_sched_barrier(0);
#pragma unroll
        for (int j = 0; j < 8; ++j) {
          const int v0 = vp0 + j * 8;
          uint4 ov = *(const uint4*)(sO + cc * OROW + v0);
          uint4 gv = make_uint4(gvp[j][0], gvp[j][1], gvp[j][2], gvp[j][3]);
          float4 n0 = *(const float4*)(ng + v0), n1 = *(const float4*)(ng + v0 + 4);
          const float nn[8] = {n0.x, n0.y, n0.z, n0.w, n1.x, n1.y, n1.z, n1.w};
          const unsigned ou[4] = {ov.x, ov.y, ov.z, ov.w};
          const unsigned gu[4] = {gv.x, gv.y, gv.z, gv.w};
          unsigned res[4];
#pragma unroll
          for (int k = 0; k < 4; ++k)
            res[k] = pk2(bflo(ou[k]) * nn[2 * k] * siluf_(bflo(gu[k])), bfhi(ou[k]) * nn[2 * k + 1] * siluf_(bfhi(gu[k])));
          *(uint4*)(OG + (size_t)(t0 + cc) * DM + hd * 256 + v0) = make_uint4(res[0], res[1], res[2], res[3]);
        }
      }
    }
  };

  auto merge_phase = [&]() __attribute__((always_inline)) {
    const int t = opaque_tid();
    const int lane = t & 63, w = t >> 6, r = lane & 31, h = lane >> 5;
    const int wm = w >> 1, wn = w & 1;
    (void)lane; (void)r; (void)h; (void)wm; (void)wn;
    const int MT = SEQ / 256, NT = DM / 128;
    for (int id = bid; id < MT * NT; id += G) {
      int tm, tn; tile_coords(id, MT, NT, tm, tn);
      const int m0 = tm * 256, n0 = tn * 128;
      Acc c; acc_zero(c);
      gemm_kloop(OA + (size_t)m0 * 512, 512, Wb + W_OA + (size_t)n0 * 512, 512, 512, smem, c);
      {
        const unsigned zbase = (unsigned)((m0 + wm * 128) * ZLD + Z_BG + n0 + wn * 64);
        const unsigned obase = (unsigned)((m0 + wm * 128) * DM + n0 + wn * 64);
        epi_store_pre<2, 1>(smem,
          [&](int mi, int ni, int i) { return c.a[mi][ni][i]; },
          [&](int row, int col, int q) { return *(const u32x4*)(Z + zbase + (unsigned)(row * ZLD + col)); },
          [&](int row, int col, u32x4 v, const u32x4* pre) {
            const u32x4 g = pre[0];
            u32x4 o;
#pragma unroll
            for (int k = 0; k < 4; ++k) o[k] = pk2(bflo(v[k]) * sigmoidf_(bflo(g[k])), bfhi(v[k]) * sigmoidf_(bfhi(g[k])));
            *(u32x4*)(MG + obase + (unsigned)(row * DM + col)) = o;
          });
      }
      acc_zero(c);
      gemm_kloop(OG + (size_t)m0 * DM, DM, Wb + W_OB + (size_t)n0 * DM, DM, DM, smem, c);
      {
        const int t2 = opaque_tid();
        const int wm2 = t2 >> 7, wn2 = (t2 >> 6) & 1;
        const unsigned zbase = (unsigned)((m0 + wm2 * 128) * ZLD + Z_BG + DM + n0 + wn2 * 64);
        const unsigned obase = (unsigned)((m0 + wm2 * 128) * DM + n0 + wn2 * 64);
        epi_store_pre<2, 2>(smem,
          [&](int mi, int ni, int i) { return c.a[mi][ni][i]; },
          [&](int row, int col, int q) {
            return q == 0 ? *(const u32x4*)(Z + zbase + (unsigned)(row * ZLD + col))
                          : *(const u32x4*)(MG + obase + (unsigned)(row * DM + col));
          },
          [&](int row, int col, u32x4 v, const u32x4* pre) {
            const u32x4 g = pre[0], pm = pre[1];
            u32x4 o;
#pragma unroll
            for (int k = 0; k < 4; ++k)
              o[k] = pk2(bflo(pm[k]) + bflo(v[k]) * sigmoidf_(bflo(g[k])), bfhi(pm[k]) + bfhi(v[k]) * sigmoidf_(bfhi(g[k])));
            *(u32x4*)(MG + obase + (unsigned)(row * DM + col)) = o;
          });
      }
    }
  };

  for (int i = bid * 256 + opaque_tid(); i < SEQ * 16; i += G * 256) {
    const int pos = i >> 4, j = i & 15;
    const float inv_freq = exp2f(-(float)j * 0.8304820237218406f);
    const float angf = (float)pos * inv_freq;
    double a = (double)angf;
    const double twopi = 6.283185307179586476925286766559;
    a -= twopi * rint(a / twopi);
    const float af = (float)a;
    ropec[i] = __cosf(af);
    ropes[i] = __sinf(af);
  }
  convert_weights(0);
  rn_pass(0, 0.f, nullptr, in_ptr(p, 2));
  grid.sync();

  for (int l = 0; l < 4; ++l) {
    asm volatile("" : "+s"(bid));
    ffn_in(W_FFN1_IN);
#ifdef DUP_FFNIN
    xcd_barrier(xb);
    ffn_in(W_FFN1_IN);
#endif
    xcd_barrier(xb);
    gemm_plain(ACT, DFF, DFF, Wb + W_FFN1_OUT, Yb, DM, MALL, DM);
    xcd_barrier(xb);
    rn_pass(1, 0.5f, in_ptr(p, 5) + l * DM, in_ptr(p, 6) + l * DM);
    xcd_barrier(xb);
    for (int s = 0; s < NSEQ; ++s) {
      asm volatile("" : "+s"(bid));
      gemm_plain(Hb + (size_t)s * SEQ * DM, DM, DM, Wb + W_IN, Z, ZLD, SEQ, ZLD);
      xcd_barrier(xb);
      prep_phase(l);
#ifdef DUP_PREP
      xcd_barrier(xb);
      prep_phase(l);
#endif
      xcd_barrier(xb);
      attn_phase(1);
      xcd_barrier(xb);
      int bpar_ = bid; asm volatile("" : "+s"(bpar_));
      if (bpar_ & 1) { attn_phase(2); gla_out_phase(l); }
      else { gla_out_phase(l); attn_phase(2); }
      xcd_barrier(xb);
      merge_phase();
      xcd_barrier(xb);
      gemm_plain(MG, DM, DM, Wb + W_OUT, Yb + (size_t)s * SEQ * DM, DM, SEQ, DM);
      xcd_barrier(xb);
    }
    rn_pass(1, 1.0f, in_ptr(p, 20) + l * DM, in_ptr(p, 21) + l * DM);
    xcd_barrier(xb);
    ffn_in(W_FFN2_IN);
    xcd_barrier(xb);
    gemm_plain(ACT, DFF, DFF, Wb + W_FFN2_OUT, Yb, DM, MALL, DM);
    xcd_barrier(xb);
    rn_pass(1, 0.5f, in_ptr(p, 24) + l * DM, (l < 3) ? (in_ptr(p, 2) + (l + 1) * DM) : nullptr);
    if (l < 3) convert_weights(l + 1);
    xcd_barrier(xb);
  }
}

extern "C" void kernel_launch(void* const* d_in, const int* in_sizes, int n_in, void* d_out,
                              int out_size, void* d_ws, size_t ws_size, hipStream_t stream) {
  static int grid_blocks = 0;
  if (!grid_blocks) {
    int dev = 0, cus = 0, per_cu = 0;
    (void)hipGetDevice(&dev);
    (void)hipDeviceGetAttribute(&cus, hipDeviceAttributeMultiprocessorCount, dev);
    (void)hipOccupancyMaxActiveBlocksPerMultiprocessor(&per_cu, fwd_megakernel, 256, 0);
    if (per_cu > 2) per_cu = 2;
    if (per_cu < 1) per_cu = 1;
    grid_blocks = cus * per_cu;
  }
  Params p{};
  for (int i = 0; i < 25; ++i) p.in[i] = (const float*)d_in[i];
  p.out = (float*)d_out;
  p.ws = (char*)d_ws;
  (void)hipMemsetAsync((char*)d_ws + OFF_BAR, 0, XCD_BAR_WORDS * 4, stream);
  void* args[] = {&p};
  hipError_t e = hipLaunchCooperativeKernel((void*)fwd_megakernel, dim3(grid_blocks), dim3(256), args, 0, stream);
  if (e != hipSuccess) fprintf(stderr, "cooperative launch failed: %s (grid %d)\n", hipGetErrorString(e), grid_blocks);
}
```

```cpp
#include <hip/hip_runtime.h>
#include <hip/hip_cooperative_groups.h>
#include <cstdio>
namespace cg = cooperative_groups;

typedef unsigned short u16;
typedef short bf16x8 __attribute__((ext_vector_type(8)));
typedef short s16x4 __attribute__((ext_vector_type(4)));
typedef float f32x16 __attribute__((ext_vector_type(16)));
typedef __bf16 bf2_t __attribute__((ext_vector_type(2)));
typedef float f2_t __attribute__((ext_vector_type(2)));
typedef unsigned u32x4 __attribute__((ext_vector_type(4)));
#define DI __device__ __forceinline__
#define MFMA(a, b, c) __builtin_amdgcn_mfma_f32_32x32x16_bf16((a), (b), (c), 0, 0, 0)

constexpr int SEQ = 16384;
constexpr int NSEQ = 3;
constexpr int MALL = SEQ * NSEQ;
constexpr int DM = 1024;
constexpr int DFF = 2816;
constexpr int NFF2 = 5632;
constexpr int PIN = 5568;
constexpr int ZLD = 5632;
constexpr int Z_CQ = 0, Z_CKV = 256, Z_KPE = 384, Z_GQ = 416, Z_GK = 928, Z_GV = 1440, Z_GA = 2464, Z_GOG = 2496, Z_BG = 3520;
constexpr float EPS = 1e-6f;
constexpr int NCHUNK = SEQ / 64;

constexpr size_t W_FFN1_IN = 0;
constexpr size_t W_FFN1_OUT = W_FFN1_IN + (size_t)NFF2 * DM;
constexpr size_t W_IN = W_FFN1_OUT + (size_t)DM * DFF;
constexpr size_t W_UQ = W_IN + (size_t)ZLD * DM;
constexpr size_t W_KN = W_UQ + (size_t)768 * 256;
constexpr size_t W_V = W_KN + (size_t)512 * 128;
constexpr size_t W_OA = W_V + (size_t)512 * 128;
constexpr size_t W_OB = W_OA + (size_t)DM * 512;
constexpr size_t W_OUT = W_OB + (size_t)DM * DM;
constexpr size_t W_FFN2_IN = W_OUT + (size_t)DM * DM;
constexpr size_t W_FFN2_OUT = W_FFN2_IN + (size_t)NFF2 * DM;
constexpr size_t W_END = W_FFN2_OUT + (size_t)DM * DFF;

constexpr size_t al256(size_t x) { return (x + 255) & ~(size_t)255; }
constexpr size_t OFF_WB = 0;
constexpr size_t OFF_ROPE = al256(OFF_WB + W_END * 2);
constexpr size_t OFF_H = al256(OFF_ROPE + (size_t)SEQ * 32 * 4);
constexpr size_t OFF_Y = al256(OFF_H + (size_t)MALL * DM * 2);
constexpr size_t OFF_ACT = al256(OFF_Y + (size_t)MALL * DM * 2);
constexpr size_t OFF_Z = OFF_ACT;
constexpr size_t OFF_Q = al256(OFF_Z + (size_t)SEQ * ZLD * 2);
constexpr size_t OFF_KN = al256(OFF_Q + (size_t)SEQ * 768 * 2);
constexpr size_t OFF_VT = al256(OFF_KN + (size_t)SEQ * 512 * 2);
constexpr size_t OFF_KPE = al256(OFF_VT + (size_t)SEQ * 512 * 2);
constexpr size_t OFF_OA = al256(OFF_KPE + (size_t)SEQ * 32 * 2);
constexpr size_t OFF_MIXEND = al256(OFF_OA + (size_t)SEQ * 512 * 2);
constexpr size_t OFF_ACTEND = al256(OFF_ACT + (size_t)MALL * DFF * 2);
static_assert(OFF_MIXEND <= OFF_ACTEND, "mixer scratch must fit in act");
constexpr size_t OFF_ST = OFF_ACTEND;
constexpr size_t OFF_DEC = al256(OFF_ST + (size_t)NCHUNK * 4 * 2 * 256 * 128 * 2);
constexpr size_t OFF_GC = al256(OFF_DEC + (size_t)NCHUNK * 4 * 2 * 128 * 4);
constexpr size_t OFF_OG = al256(OFF_GC + (size_t)2 * SEQ * 512 * 4);
constexpr size_t OFF_MG = al256(OFF_OG + (size_t)SEQ * DM * 2);
constexpr size_t OFF_END = al256(OFF_MG + (size_t)SEQ * DM * 2);
constexpr size_t OFF_BAR = OFF_END;
static_assert(OFF_BAR + 16384 <= (size_t)768 * 1024 * 1024, "workspace overflow");

struct Params {
  const float* in[25];
  float* out;
  char* ws;
};

DI unsigned pk2(float a, float b) { f2_t v = {a, b}; return __builtin_bit_cast(unsigned, __builtin_convertvector(v, bf2_t)); }
DI u16 f2bf(float a) { return (u16)(pk2(a, 0.f) & 0xffffu); }
DI float bf2f(u16 v) { return __uint_as_float(((unsigned)v) << 16); }
DI float bflo(unsigned v) { return __uint_as_float(v << 16); }
DI float bfhi(unsigned v) { return __uint_as_float(v & 0xffff0000u); }
DI float wave_sum(float v) {
#pragma unroll
  for (int o = 32; o >= 1; o >>= 1) v += __shfl_xor(v, o);
  return v;
}
DI int opaque_tid() { int t = threadIdx.x; asm volatile("" : "+v"(t)); return t; }
DI const float* in_ptr(const Params& p, int k) { asm volatile("" : "+s"(k)); return p.in[k]; }
DI char* ws_ptr(const Params& p) { long z = 0; asm volatile("" : "+s"(z)); return p.ws + z; }
DI float* out_ptr(const Params& p) { long z = 0; asm volatile("" : "+s"(z)); return p.out + z; }
DI int crow(int i, int h) { return (i & 3) + 8 * (i >> 2) + 4 * h; }
DI float sigmoidf_(float x) { return 1.f / (1.f + __expf(-x)); }
DI float siluf_(float x) { return x / (1.f + __expf(-x)); }


#define XB_TMO      128
#define XB_XCNT(j)  (256  + 64 * (j))
#define XB_XSUB(j)  (1280 + 64 * (j))
#define XB_XGEN(j)  (2304 + 64 * (j))
#define XB_TOP      3328
#define XB_TOPGEN   3392
#define XCD_BAR_WORDS 3456
#define XB_SPIN_CAP (1u << 18)
#define LAS __attribute__((address_space(3)))

__device__ __forceinline__ unsigned xb_ld(unsigned* p)              { return __hip_atomic_load(p, __ATOMIC_RELAXED, __HIP_MEMORY_SCOPE_AGENT); }
__device__ __forceinline__ unsigned xb_add(unsigned* p, unsigned v) { return __hip_atomic_fetch_add(p, v, __ATOMIC_RELAXED, __HIP_MEMORY_SCOPE_AGENT); }
__device__ __forceinline__ unsigned xb_xcc_id() { return (unsigned)__builtin_amdgcn_s_getreg((3 << 11) | 20) & 0xFu; }
#define XB_SPIN(cond, bar) do { unsigned _sp = 0; while (cond) { __builtin_amdgcn_s_sleep(1); \
    if ((++_sp & 255u) == 0u) { if (xb_ld(&(bar)[XB_TMO])) break; if (_sp > XB_SPIN_CAP) { atomicAdd(&(bar)[XB_TMO], 1u); break; } } } } while (0)

struct XcdBarrier {
    unsigned* bar; unsigned x;
    volatile LAS unsigned* st;
};

__device__ __forceinline__ XcdBarrier xcd_barrier_post(unsigned* bar, volatile LAS unsigned* st) {
    XcdBarrier b; b.bar = bar; b.x = xb_xcc_id(); b.st = st;
    if (threadIdx.x == 0) (void)xb_add(&bar[XB_XCNT(b.x)], 1u);
    return b;
}
__device__ __forceinline__ void xcd_barrier_complete(unsigned* bar, unsigned x, unsigned& nloc, unsigned& nx) {
    const unsigned G = gridDim.x * gridDim.y * gridDim.z;
    unsigned sum, cnt, mine, sp = 0u;
    for (;;) {
        sum = 0u; cnt = 0u; mine = 0u;
#pragma unroll
        for (unsigned j = 0; j < 16; ++j) { const unsigned c = xb_ld(&bar[XB_XCNT(j)]); sum += c; cnt += (c > 0u) ? 1u : 0u; mine = (j == x) ? c : mine; }
        if (sum == G) break;
        __builtin_amdgcn_s_sleep(1);
        if ((++sp & 255u) == 0u) { if (xb_ld(&bar[XB_TMO])) break; if (sp > XB_SPIN_CAP) { atomicAdd(&bar[XB_TMO], 1u); break; } }
    }
    nloc = mine > 0u ? mine : 1u; nx = cnt > 0u ? cnt : 1u;
}

__device__ __forceinline__ void xcd_barrier(const XcdBarrier& b) {
    asm volatile("s_waitcnt vmcnt(0)" ::: "memory");
    __syncthreads();
    int tid0_ = threadIdx.x; asm volatile("" : "+v"(tid0_));
    if (tid0_ == 0) {
        unsigned* bar = b.bar; asm volatile("" : "+s"(bar));
        unsigned bx_ = b.x; asm volatile("" : "+s"(bx_));
        __builtin_amdgcn_s_waitcnt(0);
        unsigned nloc = b.st[0], nx = b.st[1];
        if (nloc == 0u) { xcd_barrier_complete(bar, bx_, nloc, nx); b.st[0] = nloc; b.st[1] = nx; }
        const unsigned old = xb_add(&bar[XB_XSUB(bx_)], 1u);
        const unsigned gen = old / nloc;
        if (old + 1u == (gen + 1u) * nloc) {
            __builtin_amdgcn_fence(__ATOMIC_RELEASE, "agent");
            asm volatile("s_waitcnt vmcnt(0)" ::: "memory");
            const unsigned og = xb_add(&bar[XB_TOP], 1u);
            const unsigned tg = og / nx;
            if (og + 1u == (tg + 1u) * nx) xb_add(&bar[XB_TOPGEN], 1u);
            else XB_SPIN(xb_ld(&bar[XB_TOPGEN]) == tg, bar);
            __builtin_amdgcn_fence(__ATOMIC_ACQUIRE, "agent");
            xb_add(&bar[XB_XGEN(bx_)], 1u);
            asm volatile("s_waitcnt vmcnt(0)" ::: "memory");
        } else {
            XB_SPIN(xb_ld(&bar[XB_XGEN(bx_)]) == gen, bar);
            __builtin_amdgcn_fence(__ATOMIC_ACQUIRE, "agent");
            asm volatile("s_waitcnt vmcnt(0)" ::: "memory");
        }
    }
    __syncthreads();
}

constexpr int LROW = 72;
constexpr int GEMM_LDS = 2 * 128 * LROW * 2;

struct Acc { f32x16 a[4][2]; };

DI void acc_zero(Acc& c) {
#pragma unroll
  for (int i = 0; i < 4; ++i)
#pragma unroll
    for (int j = 0; j < 2; ++j)
#pragma unroll
      for (int k = 0; k < 16; ++k) c.a[i][j][k] = 0.f;
}

DI void gll16(const u16* g, char* l) {
  __builtin_amdgcn_global_load_lds((const __attribute__((address_space(1))) unsigned*)g,
                                   (__attribute__((address_space(3))) unsigned*)l, 16, 0, 0);
}
DI void gemm_kloop(const u16* __restrict__ A, int lda, const u16* __restrict__ B, int ldb, int K, u16* smem, Acc& c) {
  const int t = opaque_tid();
  const int lane = t & 63, w = t >> 6, r = lane & 31, h = lane >> 5;
  const int wm = w >> 1, wn = w & 1;
  char* lds = (char*)smem;
  const int nk = K >> 5;
  const int row0 = t >> 2, c0 = t & 3;
  const int sw0 = (c0 ^ ((row0 >> 2) & 3)) * 8;
  const u16* ga0 = A + (size_t)row0 * lda + sw0;
  const u16* gb0 = B + (size_t)row0 * ldb + sw0;
  const size_t a64 = (size_t)64 * lda, b64 = (size_t)64 * ldb;
  const int loff = t * 16;
#define GEMM_ISSUE(kt_, st_)                                         \
  do {                                                               \
    const int kk_ = ((kt_) < nk ? (kt_) : (nk - 1)) * 32;            \
    char* sp_ = lds + (st_) * 24576 + loff;                          \
    gll16(ga0 + kk_, sp_);                                           \
    gll16(ga0 + a64 + kk_, sp_ + 4096);                              \
    gll16(ga0 + 2 * a64 + kk_, sp_ + 8192);                          \
    gll16(ga0 + 3 * a64 + kk_, sp_ + 12288);                         \
    gll16(gb0 + kk_, sp_ + 16384);                                   \
    gll16(gb0 + b64 + kk_, sp_ + 20480);                             \
  } while (0)
  __syncthreads();
  GEMM_ISSUE(0, 0);
  GEMM_ISSUE(1, 1);
  const int fsw = (r >> 2) & 3;
  const int aoff = (wm * 128 + r) * 64, boff = 16384 + (wn * 64 + r) * 64;
  int scur = 0, snext = 2;
  for (int kt = 0; kt < nk; ++kt) {
    asm volatile("s_waitcnt vmcnt(6)" ::: "memory");
    __builtin_amdgcn_s_barrier();
    asm volatile("" ::: "memory");
    GEMM_ISSUE(kt + 2, snext);
    __builtin_amdgcn_sched_barrier(0);
    const char* st = lds + scur * 24576;
#pragma unroll
    for (int ks = 0; ks < 2; ++ks) {
      const int q = ((ks * 2 + h) ^ fsw) * 16;
      bf16x8 fa[4], fb[2];
#pragma unroll
      for (int i = 0; i < 4; ++i) fa[i] = *(const bf16x8*)(st + aoff + i * 2048 + q);
#pragma unroll
      for (int i = 0; i < 2; ++i) fb[i] = *(const bf16x8*)(st + boff + i * 2048 + q);
#pragma unroll
      for (int i = 0; i < 4; ++i)
#pragma unroll
        for (int j = 0; j < 2; ++j) c.a[i][j] = MFMA(fa[i], fb[j], c.a[i][j]);
    }
    __builtin_amdgcn_sched_barrier(0);
    snext = scur;
    scur = (scur == 2) ? 0 : scur + 1;
  }
  asm volatile("s_waitcnt vmcnt(0)" ::: "memory");
  __builtin_amdgcn_s_barrier();
  asm volatile("" ::: "memory");
#undef GEMM_ISSUE
}

DI void row_scales(const u16* __restrict__ base, int ld, int K, float* sc, int NR) {
  const int t = opaque_tid();
  const int row = (NR == 256) ? t : (t >> 1);
  const int part = (NR == 256) ? 0 : (t & 1);
  const int len = (NR == 256) ? K : (K / 2);
  const u16* p = base + (size_t)row * ld + part * len;
  float ss = 0.f;
  for (int i = 0; i < len / 8; ++i) {
    u32x4 v = *(const u32x4*)(p + i * 8);
#pragma unroll
    for (int j = 0; j < 4; ++j) { float a = bflo(v[j]), b = bfhi(v[j]); ss += a * a + b * b; }
  }
  if (NR != 256) ss += __shfl_xor(ss, 1);
  if (part == 0) sc[row] = rsqrtf(ss / (float)K + EPS);
}


template <int NI, class V, class R>
DI void epi_store(u16* smem, V val, R rowfn) {
  const int t = opaque_tid();
  const int lane = t & 63, w = t >> 6, r = lane & 31, h = lane >> 5;
  char* reg = (char*)smem + w * 18432;
#pragma unroll
  for (int mi = 0; mi < 4; ++mi)
#pragma unroll
    for (int ni = 0; ni < NI; ++ni)
#pragma unroll
      for (int i = 0; i < 16; ++i)
        *(u16*)(reg + (mi * 32 + crow(i, h)) * 144 + (ni * 32 + r) * 2) = f2bf(val(mi, ni, i));
  __builtin_amdgcn_sched_barrier(0);
  constexpr int CPR = NI * 4;
  constexpr int RPI = 64 / CPR;
  const int rr = lane / CPR, ch = lane % CPR;
#pragma unroll
  for (int k = 0; k < 128 / RPI; ++k) {
    const int row = k * RPI + rr;
    u32x4 v = *(const u32x4*)(reg + row * 144 + ch * 16);
    rowfn(row, ch * 8, v);
  }
}


template <int NI, int NPRE, class V, class L, class R>
DI void epi_store_pre(u16* smem, V val, L loadfn, R rowfn) {
  const int t = opaque_tid();
  const int lane = t & 63, w = t >> 6, r = lane & 31, h = lane >> 5;
  char* reg = (char*)smem + w * 18432;
#pragma unroll
  for (int mi = 0; mi < 4; ++mi)
#pragma unroll
    for (int ni = 0; ni < NI; ++ni)
#pragma unroll
      for (int i = 0; i < 16; ++i)
        *(u16*)(reg + (mi * 32 + crow(i, h)) * 144 + (ni * 32 + r) * 2) = f2bf(val(mi, ni, i));
  __builtin_amdgcn_sched_barrier(0);
  constexpr int CPR = NI * 4;
  constexpr int RPI = 64 / CPR;
  constexpr int NK = 128 / RPI;
  const int rr = lane / CPR, ch = lane % CPR;
  u32x4 pre[NK][NPRE];
#pragma unroll
  for (int k = 0; k < NK; ++k)
#pragma unroll
    for (int q = 0; q < NPRE; ++q) pre[k][q] = loadfn(k * RPI + rr, ch * 8, q);
  __builtin_amdgcn_sched_barrier(0);
#pragma unroll
  for (int k = 0; k < NK; ++k) {
    const int row = k * RPI + rr;
    u32x4 v = *(const u32x4*)(reg + row * 144 + ch * 16);
    rowfn(row, ch * 8, v, pre[k]);
  }
}

DI void tile_coords(int id, int MT, int NT, int& tm, int& tn) {
  const int per = 32 * NT;
  const int sr = id / per, rem = id - sr * per;
  tn = rem >> 5;
  tm = sr * 32 + (rem & 31);
}

#define EPI_LOOP                                   \
  _Pragma("unroll") for (int mi = 0; mi < 4; ++mi) \
  _Pragma("unroll") for (int ni = 0; ni < 2; ++ni) \
  _Pragma("unroll") for (int i = (__builtin_amdgcn_sched_barrier(0), 0); i < 16; ++i)

constexpr int SMEM_BYTES = 74752;

__global__ void __launch_bounds__(256, 2) fwd_megakernel(Params p) {
  cg::grid_group grid = cg::this_grid();
  __shared__ __attribute__((aligned(16))) char smem_raw[SMEM_BYTES];
  u16* smem = (u16*)smem_raw;
  const int G = gridDim.x;
  int bid = blockIdx.x;
  __shared__ uint4 xb_words;
  if (threadIdx.x == 0) xb_words = make_uint4(0u, 0u, 0u, 0u);
  __syncthreads();
  XcdBarrier xb = xcd_barrier_post((unsigned*)(p.ws + OFF_BAR), (volatile LAS unsigned*)&xb_words);

  char* ws = p.ws;
#define Wb ((u16*)(ws + OFF_WB))
#define ropec ((float*)(ws + OFF_ROPE))
#define ropes (((float*)(ws + OFF_ROPE)) + SEQ * 16)
#define Hb ((u16*)(ws + OFF_H))
#define Yb ((u16*)(ws + OFF_Y))
#define ACT ((u16*)(ws + OFF_ACT))
#define Z ((u16*)(ws + OFF_Z))
#define Qb ((u16*)(ws + OFF_Q))
#define KN ((u16*)(ws + OFF_KN))
#define VT ((u16*)(ws + OFF_VT))
#define KPE ((u16*)(ws + OFF_KPE))
#define OA ((u16*)(ws + OFF_OA))
#define ST ((u16*)(ws + OFF_ST))
#define DEC ((float*)(ws + OFF_DEC))
#define GC ((float*)(ws + OFF_GC))
#define OG ((u16*)(ws + OFF_OG))
#define MG ((u16*)(ws + OFF_MG))
  float* X = p.out;

  auto convert_weights = [&](int l) __attribute__((always_inline)) {
    char* ws = ws_ptr(p);
    const int t = opaque_tid();
    const int lane = t & 63, w = t >> 6, r = lane & 31, h = lane >> 5;
    const int wm = w >> 1, wn = w & 1;
    (void)lane; (void)r; (void)h; (void)wm; (void)wn;
    float* tile = (float*)smem_raw;
    for (int mat = 0; mat < 11; ++mat) {
      const float* src; int K, N; size_t dst; int map; const float* ksc = nullptr;
      switch (mat) {
        case 0: src = in_ptr(p, 3) + (size_t)l * DM * NFF2; K = DM; N = NFF2; dst = W_FFN1_IN; map = 1; break;
        case 1: src = in_ptr(p, 4) + (size_t)l * DFF * DM; K = DFF; N = DM; dst = W_FFN1_OUT; map = 0; break;
        case 2: src = in_ptr(p, 7) + (size_t)l * DM * PIN; K = DM; N = PIN; dst = W_IN; map = 0; break;
        case 3: src = in_ptr(p, 9) + (size_t)l * 256 * 768; K = 256; N = 768; dst = W_UQ; map = 0; ksc = in_ptr(p, 8) + l * 256; break;
        case 4: src = in_ptr(p, 11) + (size_t)l * 128 * 1024; K = 128; N = 1024; dst = W_KN; map = 2; ksc = in_ptr(p, 10) + l * 128; break;
        case 5: src = in_ptr(p, 12) + (size_t)l * 512 * DM; K = 512; N = DM; dst = W_OA; map = 0; break;
        case 6: src = in_ptr(p, 18) + (size_t)l * DM * DM; K = DM; N = DM; dst = W_OB; map = 0; break;
        case 7: src = in_ptr(p, 19) + (size_t)l * DM * DM; K = DM; N = DM; dst = W_OUT; map = 0; break;
        case 8: src = in_ptr(p, 22) + (size_t)l * DM * NFF2; K = DM; N = NFF2; dst = W_FFN2_IN; map = 1; break;
        case 9: src = in_ptr(p, 23) + (size_t)l * DFF * DM; K = DFF; N = DM; dst = W_FFN2_OUT; map = 0; break;
        default: src = nullptr; K = DM; N = 64; dst = W_IN + (size_t)PIN * DM; map = 3; break;
      }
      const int kt_n = K / 64, nt_n = N / 64;
      for (int id = bid; id < kt_n * nt_n; id += G) {
        const int kt = id % kt_n, nt = id / kt_n;
        const int k0 = kt * 64, n0 = nt * 64;
        __syncthreads();
        if (map != 3) {
#pragma unroll
          for (int i = 0; i < 4; ++i) {
            const int kk = (t >> 4) + 16 * i, nn = (t & 15) * 4;
            float4 v = *(const float4*)(src + (size_t)(k0 + kk) * N + n0 + nn);
            float sc = ksc ? ksc[k0 + kk] : 1.f;
            tile[kk * 65 + nn + 0] = v.x * sc; tile[kk * 65 + nn + 1] = v.y * sc;
            tile[kk * 65 + nn + 2] = v.z * sc; tile[kk * 65 + nn + 3] = v.w * sc;
          }
        }
        __syncthreads();
        const int nl = t >> 2, kc = (t & 3) * 16;
        const int n = n0 + nl;
        size_t drow;
        if (map == 0) drow = dst + (size_t)n * K;
        else if (map == 1) { const int isb = n >= DFF; const int j = n - isb * DFF; drow = dst + (size_t)((j >> 5) * 64 + isb * 32 + (j & 31)) * K; }
        else if (map == 2) { const int hd = n >> 7, cc = n & 127; drow = (cc < 64) ? (W_KN + (size_t)(hd * 64 + cc) * K) : (W_V + (size_t)(hd * 64 + cc - 64) * K); }
        else drow = dst + (size_t)nl * K;
        unsigned o[8];
#pragma unroll
        for (int j = 0; j < 8; ++j) {
          float a = (map == 3) ? 0.f : tile[(kc + 2 * j) * 65 + nl];
          float b = (map == 3) ? 0.f : tile[(kc + 2 * j + 1) * 65 + nl];
          o[j] = pk2(a, b);
        }
        uint4* dp = (uint4*)(Wb + drow + k0 + kc);
        dp[0] = make_uint4(o[0], o[1], o[2], o[3]);
        dp[1] = make_uint4(o[4], o[5], o[6], o[7]);
      }
    }
  };

  auto rn_pass = [&](int mode, float coef, const float* post_g, const float* pre_g, int r0, int r1) __attribute__((always_inline)) {
    char* ws = ws_ptr(p);
    float* X = out_ptr(p);
    const int t = opaque_tid();
    const int lane = t & 63, w = t >> 6, r = lane & 31, h = lane >> 5;
    const int wm = w >> 1, wn = w & 1;
    (void)lane; (void)r; (void)h; (void)wm; (void)wn;
    typedef float f4v __attribute__((ext_vector_type(4)));
    typedef unsigned u2v __attribute__((ext_vector_type(2)));
    const int gw = bid * 4 + w, nw = G * 4;
    constexpr int RB = 4;
    f4v pg[4], qg[4];
#pragma unroll
    for (int i = 0; i < 4; ++i) {
      pg[i] = (mode == 1) ? *(const f4v*)(post_g + lane * 4 + 256 * i) : (f4v){0.f, 0.f, 0.f, 0.f};
      qg[i] = pre_g ? *(const f4v*)(pre_g + lane * 4 + 256 * i) : (f4v){0.f, 0.f, 0.f, 0.f};
    }
    for (int row0 = r0 + gw; row0 < r1; row0 += RB * nw) {
      f4v xv[RB][4];
      u2v yu[RB][4];
#pragma unroll
      for (int j = 0; j < RB; ++j) {
        int row = row0 + j * nw;
        if (row >= r1) row = row0;
        const float* xs;
        if (mode == 0) xs = (row < SEQ) ? (in_ptr(p, 0) + (size_t)row * DM) : (in_ptr(p, 1) + (size_t)(row - SEQ) * DM);
        else xs = X + (size_t)row * DM;
#pragma unroll
        for (int i = 0; i < 4; ++i) xv[j][i] = *(const f4v*)(xs + lane * 4 + 256 * i);
        if (mode == 1) {
#pragma unroll
          for (int i = 0; i < 4; ++i) yu[j][i] = *(const u2v*)(Yb + (size_t)row * DM + lane * 4 + 256 * i);
        }
      }
#pragma unroll
      for (int j = 0; j < RB; ++j) {
        const int row = row0 + j * nw;
        if (row < r1) {
          if (mode == 1) {
            float yv[16];
            float ss = 0.f;
#pragma unroll
            for (int i = 0; i < 4; ++i) {
              yv[4 * i + 0] = bflo(yu[j][i][0]); yv[4 * i + 1] = bfhi(yu[j][i][0]);
              yv[4 * i + 2] = bflo(yu[j][i][1]); yv[4 * i + 3] = bfhi(yu[j][i][1]);
            }
#pragma unroll
            for (int i = 0; i < 16; ++i) ss += yv[i] * yv[i];
            ss = wave_sum(ss);
            const float ry = rsqrtf(ss * (1.f / DM) + EPS) * coef;
#pragma unroll
            for (int i = 0; i < 4; ++i)
#pragma unroll
              for (int k = 0; k < 4; ++k) xv[j][i][k] += yv[4 * i + k] * ry * pg[i][k];
          }
#pragma unroll
          for (int i = 0; i < 4; ++i) *(f4v*)(X + (size_t)row * DM + lane * 4 + 256 * i) = xv[j][i];
          if (pre_g) {
            float ss = 0.f;
#pragma unroll
            for (int i = 0; i < 4; ++i)
#pragma unroll
              for (int k = 0; k < 4; ++k) ss += xv[j][i][k] * xv[j][i][k];
            ss = wave_sum(ss);
            const float rx = rsqrtf(ss * (1.f / DM) + EPS);
#pragma unroll
            for (int i = 0; i < 4; ++i) {
              u2v o;
              o[0] = pk2(xv[j][i][0] * rx * qg[i][0], xv[j][i][1] * rx * qg[i][1]);
              o[1] = pk2(xv[j][i][2] * rx * qg[i][2], xv[j][i][3] * rx * qg[i][3]);
              *(u2v*)(Hb + (size_t)row * DM + lane * 4 + 256 * i) = o;
            }
          }
        }
      }
    }
  };

  auto ffn_in = [&](size_t woff) __attribute__((always_inline)) {
    char* ws = ws_ptr(p);
    const int t = opaque_tid();
    const int lane = t & 63, w = t >> 6, r = lane & 31, h = lane >> 5;
    const int wm = w >> 1, wn = w & 1;
    (void)lane; (void)r; (void)h; (void)wm; (void)wn;
    const int MT = MALL / 256, NT = NFF2 / 128;
    for (int id = bid; id < MT * NT; id += G) {
      int tm, tn; tile_coords(id, MT, NT, tm, tn);
      const int m0 = tm * 256, n0 = tn * 128;
      Acc c; acc_zero(c);
      gemm_kloop(Hb + (size_t)m0 * DM, DM, Wb + woff + (size_t)n0 * DM, DM, DM, smem, c);
#ifdef DUP_KLOOP
      acc_zero(c);
      gemm_kloop(Hb + (size_t)m0 * DM, DM, Wb + woff + (size_t)n0 * DM, DM, DM, smem, c);
#endif
      const int jb0 = ((n0 + wn * 64) >> 6) * 32;
      const unsigned obase = (unsigned)((m0 + wm * 128) * DFF + jb0);
      epi_store<1>(smem,
        [&](int mi, int ni, int i) { return siluf_(c.a[mi][0][i]) * c.a[mi][1][i]; },
        [&](int row, int col, u32x4 v) { *(u32x4*)(ACT + obase + (unsigned)(row * DFF + col)) = v; });
    }
  };
  auto gemm_plain = [&](const u16* A, int lda, int K, const u16* Bt, u16* C, int ldc, int M, int N) __attribute__((always_inline)) {
    char* ws = ws_ptr(p);
    const int t = opaque_tid();
    const int lane = t & 63, w = t >> 6, r = lane & 31, h = lane >> 5;
    const int wm = w >> 1, wn = w & 1;
    (void)lane; (void)r; (void)h; (void)wm; (void)wn;
    const int MT = M / 256, NT = N / 128;
    for (int id = bid; id < MT * NT; id += G) {
      int tm, tn; tile_coords(id, MT, NT, tm, tn);
      const int m0 = tm * 256, n0 = tn * 128;
      Acc c; acc_zero(c);
      gemm_kloop(A + (size_t)m0 * lda, lda, Bt + (size_t)n0 * K, K, K, smem, c);
      const unsigned obase = (unsigned)((m0 + wm * 128) * ldc + n0 + wn * 64);
      epi_store<2>(smem,
        [&](int mi, int ni, int i) { return c.a[mi][ni][i]; },
        [&](int row, int col, u32x4 v) { *(u32x4*)(C + obase + (unsigned)(row * ldc + col)) = v; });
    }
  };

  auto prep_phase = [&](int l) __attribute__((always_inline)) {
    char* ws = ws_ptr(p);
    int pb_ = bid; asm volatile("" : "+s"(pb_));
    const int t = opaque_tid();
    const int lane = t & 63, w = t >> 6, r = lane & 31, h = lane >> 5;
    const int wm = w >> 1, wn = w & 1;
    (void)lane; (void)r; (void)h; (void)wm; (void)wn;
    float* sc = (float*)(smem_raw + 2 * GEMM_LDS);
    const int NQ = 64 * 6, NK = 64 * 4, NV = 2 * 128, NPE = 64, NG1 = NCHUNK * 4;
    const float qscale = 0.10206207261596577f * 1.4426950408889634f;
    {
      for (int id = pb_; id < NG1; id += G) {
        const int t = opaque_tid();
        const int lane = t & 63, w = t >> 6, r = lane & 31, h = lane >> 5;
        const int wm = w >> 1, wn = w & 1;
        (void)lane; (void)r; (void)h; (void)wm; (void)wn;
        const int n = id >> 2, hd = id & 3;
        const int t0 = n * 64;
        u16* ksT = smem;
        u16* vT = smem + 2 * 128 * LROW;
        u16* sk = vT;
        float* sga = (float*)(smem_raw + 55296);
        __syncthreads();
        {
          const int cc = t >> 2, part = t & 3;
          const u16* kp = Z + (size_t)(t0 + cc) * ZLD + Z_GK + hd * 128 + part * 32;
#pragma unroll
          for (int j = 0; j < 4; ++j) *(u32x4*)(sk + cc * 128 + part * 32 + j * 8) = *(const u32x4*)(kp + j * 8);
          u32x4 gv = *(const u32x4*)(Z + (size_t)(t0 + cc) * ZLD + Z_GA + part * 8);
#pragma unroll
          for (int k = 0; k < 4; ++k) { sga[cc * 32 + part * 8 + 2 * k] = bflo(gv[k]); sga[cc * 32 + part * 8 + 2 * k + 1] = bfhi(gv[k]); }
        }
        __syncthreads();
        {
          const int dir = t >> 7, d = t & 127;
          const float* wa2 = (dir ? in_ptr(p, 15) : in_ptr(p, 13)) + (size_t)l * 16 * 512 + hd * 128 + d;
          const float ba = ((dir ? in_ptr(p, 16) : in_ptr(p, 14)) + (size_t)l * 512)[hd * 128 + d];
          float wcol[16];
#pragma unroll
          for (int rr = 0; rr < 16; ++rr) wcol[rr] = wa2[rr * 512];
          const float* gar = sga + dir * 16;
          float tot = 0.f;
          for (int cc = 0; cc < 64; ++cc) {
            float pre = ba;
#pragma unroll
            for (int rr = 0; rr < 16; ++rr) pre += gar[cc * 32 + rr] * wcol[rr];
            tot += (fminf(pre, 0.f) - __logf(1.f + __expf(-fabsf(pre)))) * (1.f / 16.f);
          }
          DEC[((size_t)(n * 4 + hd) * 2 + dir) * 128 + d] = __expf(tot);
          float* gc = GC + (size_t)dir * SEQ * 512 + (size_t)t0 * 512 + hd * 128 + d;
          float cb = 0.f;
          u16* krow_out = ksT + (dir * 128 + d) * LROW;
          for (int ci = 0; ci < 64; ++ci) {
            const int cc = dir ? (63 - ci) : ci;
            float pre = ba;
#pragma unroll
            for (int rr = 0; rr < 16; ++rr) pre += gar[cc * 32 + rr] * wcol[rr];
            cb += (fminf(pre, 0.f) - __logf(1.f + __expf(-fabsf(pre)))) * (1.f / 16.f);
            gc[cc * 512] = cb;
            krow_out[cc] = f2bf(bf2f(sk[cc * 128 + d]) * __expf(tot - cb));
          }
        }
        for (int half = 0; half < 2; ++half) {
          __syncthreads();
          {
            const int cc = t & 63, part = t >> 6;
#pragma unroll
            for (int q = 0; q < 4; ++q) {
              const int cg8 = (part * 4 + q) * 8;
              uint4 v = *(const uint4*)(Z + (size_t)(t0 + cc) * ZLD + Z_GV + hd * 256 + half * 128 + cg8);
              unsigned u[4] = {v.x, v.y, v.z, v.w};
#pragma unroll
              for (int j = 0; j < 4; ++j) {
                vT[(cg8 + 2 * j) * LROW + cc] = (u16)(u[j] & 0xffffu);
                vT[(cg8 + 2 * j + 1) * LROW + cc] = (u16)(u[j] >> 16);
              }
            }
          }
          __syncthreads();
#pragma unroll
          for (int dir = 0; dir < 2; ++dir) {
            f32x16 acc[4];
#pragma unroll
            for (int j = 0; j < 4; ++j)
#pragma unroll
              for (int k = 0; k < 16; ++k) acc[j][k] = 0.f;
#pragma unroll
            for (int ks = 0; ks < 4; ++ks) {
              bf16x8 fa = *(const bf16x8*)(vT + (w * 32 + r) * LROW + ks * 16 + h * 8);
#pragma unroll
              for (int nt = 0; nt < 4; ++nt) {
                bf16x8 fb = *(const bf16x8*)(ksT + (dir * 128 + nt * 32 + r) * LROW + ks * 16 + h * 8);
                acc[nt] = MFMA(fb, fa, acc[nt]);
              }
            }
            u16* stp = ST + ((size_t)(n * 4 + hd) * 2 + dir) * 32768;
#pragma unroll
            for (int nt = 0; nt < 4; ++nt)
#pragma unroll
              for (int g4 = 0; g4 < 4; ++g4) {
                uint2 o;
                o.x = pk2(acc[nt][4 * g4 + 0], acc[nt][4 * g4 + 1]);
                o.y = pk2(acc[nt][4 * g4 + 2], acc[nt][4 * g4 + 3]);
                *(uint2*)(stp + (unsigned)((half * 128 + w * 32 + r) * 128 + nt * 32 + 8 * g4 + 4 * h)) = o;
              }
          }
        }
      }
      for (int q = pb_; q < NQ; q += G) {
        const int t = opaque_tid();
        const int lane = t & 63, w = t >> 6, r = lane & 31, h = lane >> 5;
        const int wm = w >> 1, wn = w & 1;
        (void)lane; (void)r; (void)h; (void)wm; (void)wn;
        const int tm = q / 6, tn = q % 6;
        const int m0 = tm * 256, n0 = tn * 128;
        __syncthreads();
        row_scales(Z + (size_t)m0 * ZLD + Z_CQ, ZLD, 256, sc, 256);
        Acc c; acc_zero(c);
        gemm_kloop(Z + (size_t)m0 * ZLD + Z_CQ, ZLD, Wb + W_UQ + (size_t)n0 * 256, 256, 256, smem, c);
        {
          const unsigned obase = (unsigned)((m0 + wm * 128) * 768 + n0 + wn * 64);
          epi_store<2>(smem,
            [&](int mi, int ni, int i) {
              const int cb0 = n0 + wn * 64 + ni * 32;
              const bool rope = ((cb0 >> 5) % 3) == 2;
              const int rl = wm * 128 + mi * 32 + crow(i, h);
              float v = c.a[mi][ni][i] * sc[rl];
              const float pv = __shfl_xor(v, 16);
              if (rope) {
                const int row = m0 + rl;
                const float cs = ropec[row * 16 + (r & 15)], sn = ropes[row * 16 + (r & 15)];
                v = (r < 16) ? (v * cs - pv * sn) : (v * cs + pv * sn);
              }
              return v * qscale;
            },
            [&](int row, int col, u32x4 v) { *(u32x4*)(Qb + obase + (unsigned)(row * 768 + col)) = v; });
        }
      }
      for (int q = (pb_ + G - (NQ % G)) % G; q < NK; q += G) {
        const int t = opaque_tid();
        const int lane = t & 63, w = t >> 6, r = lane & 31, h = lane >> 5;
        const int wm = w >> 1, wn = w & 1;
        (void)lane; (void)r; (void)h; (void)wm; (void)wn;
        const int tm = q >> 2, tn = q & 3;
        const int m0 = tm * 256, n0 = tn * 128;
        __syncthreads();
        row_scales(Z + (size_t)m0 * ZLD + Z_CKV, ZLD, 128, sc, 256);
        Acc c; acc_zero(c);
        gemm_kloop(Z + (size_t)m0 * ZLD + Z_CKV, ZLD, Wb + W_KN + (size_t)n0 * 128, 128, 128, smem, c);
        {
          const unsigned obase = (unsigned)((m0 + wm * 128) * 512 + n0 + wn * 64);
          epi_store<2>(smem,
            [&](int mi, int ni, int i) { return c.a[mi][ni][i] * sc[wm * 128 + mi * 32 + crow(i, h)]; },
            [&](int row, int col, u32x4 v) { *(u32x4*)(KN + obase + (unsigned)(row * 512 + col)) = v; });
        }
      }
      for (int q = (pb_ + G - ((NQ + NK) % G)) % G; q < NV; q += G) {
        const int t = opaque_tid();
        const int lane = t & 63, w = t >> 6, r = lane & 31, h = lane >> 5;
        const int wm = w >> 1, wn = w & 1;
        (void)lane; (void)r; (void)h; (void)wm; (void)wn;
        const int tm = q & 1, tn = q >> 1;
        const int m0 = tm * 256, n0 = tn * 128;
        __syncthreads();
        row_scales(Z + (size_t)n0 * ZLD + Z_CKV, ZLD, 128, sc, 128);
        Acc c; acc_zero(c);
        gemm_kloop(Wb + W_V + (size_t)m0 * 128, 128, Z + (size_t)n0 * ZLD + Z_CKV, ZLD, 128, smem, c);
        {
          const unsigned obase = (unsigned)((m0 + wm * 128) * SEQ + n0 + wn * 64);
          epi_store<2>(smem,
            [&](int mi, int ni, int i) { return c.a[mi][ni][i] * sc[wn * 64 + ni * 32 + r]; },
            [&](int row, int col, u32x4 v) { *(u32x4*)(VT + obase + (unsigned)(row * SEQ + col)) = v; });
        }
      }
      for (int q = (pb_ + G - ((NQ + NK + NV) % G)) % G; q < NPE; q += G) {
        const int t = opaque_tid();
        const int lane = t & 63, w = t >> 6, r = lane & 31, h = lane >> 5;
        const int wm = w >> 1, wn = w & 1;
        (void)lane; (void)r; (void)h; (void)wm; (void)wn;
        const int tok = q * 256 + t;
        const u16* src = Z + (size_t)tok * ZLD + Z_KPE;
        float v[32];
#pragma unroll
        for (int j = 0; j < 4; ++j) {
          uint4 u = *(const uint4*)(src + j * 8);
          unsigned uu[4] = {u.x, u.y, u.z, u.w};
#pragma unroll
          for (int k = 0; k < 4; ++k) { v[j * 8 + 2 * k] = bflo(uu[k]); v[j * 8 + 2 * k + 1] = bfhi(uu[k]); }
        }
        float o[32];
#pragma unroll
        for (int i = 0; i < 16; ++i) {
          const float cs = ropec[tok * 16 + i], sn = ropes[tok * 16 + i];
          o[i] = v[i] * cs - v[i + 16] * sn;
          o[i + 16] = v[i + 16] * cs + v[i] * sn;
        }
#pragma unroll
        for (int j = 0; j < 4; ++j) {
          uint4 u;
          u.x = pk2(o[j * 8 + 0], o[j * 8 + 1]); u.y = pk2(o[j * 8 + 2], o[j * 8 + 3]);
          u.z = pk2(o[j * 8 + 4], o[j * 8 + 5]); u.w = pk2(o[j * 8 + 6], o[j * 8 + 7]);
          *(uint4*)(KPE + (size_t)tok * 32 + j * 8) = u;
        }
      }
    }
  };

  auto attn_phase = [&](int mode) __attribute__((always_inline)) {
    char* ws = ws_ptr(p);
    const int t = opaque_tid();
    const int lane = t & 63, w = t >> 6, r = lane & 31, h = lane >> 5;
    const int wm = w >> 1, wn = w & 1;
    (void)lane; (void)r; (void)h; (void)wm; (void)wn;
    if (mode & 1) for (int id = bid; id < 512; id += G) {
      const int e = id * 256 + t;
      const int d2 = e & 63, v = (e >> 6) & 255, dir = (e >> 14) & 1, hd = e >> 15;
      float s0 = 0.f, s1 = 0.f;
      const size_t eoff = (size_t)v * 128 + 2 * d2;
      for (int i0 = 0; i0 < NCHUNK; i0 += 16) {
        unsigned uu[16];
        float2 dd[16];
#pragma unroll
        for (int j = 0; j < 16; ++j) {
          const int n = dir ? (NCHUNK - 1 - (i0 + j)) : (i0 + j);
          const size_t base = ((size_t)(n * 4 + hd) * 2 + dir);
          uu[j] = *(const unsigned*)(ST + base * 32768 + eoff);
          dd[j] = *(const float2*)(DEC + base * 128 + 2 * d2);
        }
#pragma unroll
        for (int j = 0; j < 16; ++j) {
          const int n = dir ? (NCHUNK - 1 - (i0 + j)) : (i0 + j);
          const size_t base = ((size_t)(n * 4 + hd) * 2 + dir);
          *(unsigned*)(ST + base * 32768 + eoff) = pk2(s0, s1);
          s0 = dd[j].x * s0 + bflo(uu[j]);
          s1 = dd[j].y * s1 + bfhi(uu[j]);
        }
      }
    }
    constexpr int KROW = 104;
    constexpr int VR = 68;
    constexpr int ABUF = 64 * KROW + 64 * VR;
    u16* sK = smem;
    u16* sV = smem + 64 * KROW;
    if (mode & 2) for (int id = bid; id < 8 * 64; id += G) {
      const int hd = id & 7, qb = id >> 3;
      const int q0 = qb * 256 + w * 64;
      bf16x8 bq[2][6];
#pragma unroll
      for (int qt = 0; qt < 2; ++qt)
#pragma unroll
        for (int ks = 0; ks < 6; ++ks) bq[qt][ks] = *(const bf16x8*)(Qb + (size_t)(q0 + qt * 32 + r) * 768 + hd * 96 + ks * 16 + h * 8);
      f32x16 O[2][2];
#pragma unroll
      for (int j = 0; j < 2; ++j)
#pragma unroll
        for (int qt = 0; qt < 2; ++qt)
#pragma unroll
          for (int k = 0; k < 16; ++k) O[j][qt][k] = 0.f;
      float m[2] = {0.f, 0.f}, lsum[2] = {0.f, 0.f};
      const int kr = t >> 2, kc = t & 3;
      const u16* knp = KN + (size_t)kr * 512 + hd * 64 + kc * 16;
      const u16* kpp = KPE + (size_t)kr * 32 + kc * 8;
      const u16* vpp = VT + (size_t)(hd * 64 + kr) * SEQ + kc * 16;
      u32x4 rk[3], rv[2];
      rk[0] = *(const u32x4*)(knp);
      rk[1] = *(const u32x4*)(knp + 8);
      rk[2] = *(const u32x4*)(kpp);
      rv[0] = *(const u32x4*)(vpp);
      rv[1] = *(const u32x4*)(vpp + 8);
      __syncthreads();
      *(u32x4*)(sK + kr * KROW + kc * 16) = rk[0];
      *(u32x4*)(sK + kr * KROW + kc * 16 + 8) = rk[1];
      *(u32x4*)(sK + kr * KROW + 64 + kc * 8) = rk[2];
      *(uint2*)(sV + kr * VR + kc * 16) = make_uint2(rv[0][0], rv[0][1]);
      *(uint2*)(sV + kr * VR + kc * 16 + 4) = make_uint2(rv[0][2], rv[0][3]);
      *(uint2*)(sV + kr * VR + kc * 16 + 8) = make_uint2(rv[1][0], rv[1][1]);
      *(uint2*)(sV + kr * VR + kc * 16 + 12) = make_uint2(rv[1][2], rv[1][3]);
      rk[0] = *(const u32x4*)(knp + (size_t)64 * 512);
      rk[1] = *(const u32x4*)(knp + (size_t)64 * 512 + 8);
      rk[2] = *(const u32x4*)(kpp + (size_t)64 * 32);
      rv[0] = *(const u32x4*)(vpp + 64);
      rv[1] = *(const u32x4*)(vpp + 64 + 8);
      __syncthreads();
      int cur = 0;
      for (int key0 = 0; key0 < SEQ; key0 += 64) {
        const u16* cK = sK + cur * ABUF;
        const u16* cV = sV + cur * ABUF;
        {
          u16* nK = sK + (cur ^ 1) * ABUF;
          u16* nV = sV + (cur ^ 1) * ABUF;
          *(u32x4*)(nK + kr * KROW + kc * 16) = rk[0];
          *(u32x4*)(nK + kr * KROW + kc * 16 + 8) = rk[1];
          *(u32x4*)(nK + kr * KROW + 64 + kc * 8) = rk[2];
          *(uint2*)(nV + kr * VR + kc * 16) = make_uint2(rv[0][0], rv[0][1]);
          *(uint2*)(nV + kr * VR + kc * 16 + 4) = make_uint2(rv[0][2], rv[0][3]);
          *(uint2*)(nV + kr * VR + kc * 16 + 8) = make_uint2(rv[1][0], rv[1][1]);
          *(uint2*)(nV + kr * VR + kc * 16 + 12) = make_uint2(rv[1][2], rv[1][3]);
          const int kn = (key0 + 128 < SEQ) ? (key0 + 128) : key0;
          rk[0] = *(const u32x4*)(knp + (size_t)kn * 512);
          rk[1] = *(const u32x4*)(knp + (size_t)kn * 512 + 8);
          rk[2] = *(const u32x4*)(kpp + (size_t)kn * 32);
          rv[0] = *(const u32x4*)(vpp + kn);
          rv[1] = *(const u32x4*)(vpp + kn + 8);
        }
        __builtin_amdgcn_sched_barrier(0);
        f32x16 S[2][2];
#pragma unroll
        for (int kt = 0; kt < 2; ++kt)
#pragma unroll
          for (int qt = 0; qt < 2; ++qt)
#pragma unroll
            for (int k = 0; k < 16; ++k) S[kt][qt][k] = -m[qt];
        __builtin_amdgcn_s_setprio(1);
#pragma unroll
        for (int ks = 0; ks < 6; ++ks)
#pragma unroll
          for (int kt = 0; kt < 2; ++kt) {
            bf16x8 fa = *(const bf16x8*)(cK + (kt * 32 + r) * KROW + ks * 16 + h * 8);
            S[kt][0] = MFMA(fa, bq[0][ks], S[kt][0]);
            S[kt][1] = MFMA(fa, bq[1][ks], S[kt][1]);
          }
        __builtin_amdgcn_s_setprio(0);
        bf16x8 pf[2][4];
#pragma unroll
        for (int qt = 0; qt < 2; ++qt) {
          float mloc = S[0][qt][0];
#pragma unroll
          for (int kt = 0; kt < 2; ++kt)
#pragma unroll
            for (int k = 0; k < 16; ++k) mloc = fmaxf(mloc, S[kt][qt][k]);
          {
            auto sw_ = __builtin_amdgcn_permlane32_swap(__float_as_uint(mloc), __float_as_uint(mloc), false, false);
            mloc = fmaxf(__uint_as_float(sw_[0]), __uint_as_float(sw_[1]));
          }
          if (__builtin_amdgcn_ballot_w64(mloc > 6.f) != 0ull) {
            const float delta = fmaxf(mloc, 0.f);
            const float alpha = __builtin_amdgcn_exp2f(-delta);
            m[qt] += delta;
            lsum[qt] *= alpha;
#pragma unroll
            for (int j = 0; j < 2; ++j)
#pragma unroll
              for (int k = 0; k < 16; ++k) O[j][qt][k] *= alpha;
#pragma unroll
            for (int kt = 0; kt < 2; ++kt)
#pragma unroll
              for (int k = 0; k < 16; ++k) S[kt][qt][k] -= delta;
          }
          float ps = 0.f;
#pragma unroll
          for (int kt = 0; kt < 2; ++kt)
#pragma unroll
            for (int k = 0; k < 16; ++k) { S[kt][qt][k] = __builtin_amdgcn_exp2f(S[kt][qt][k]); ps += S[kt][qt][k]; }
          lsum[qt] += ps;
#pragma unroll
          for (int s2 = 0; s2 < 4; ++s2) {
            const int kt = s2 >> 1, sx = s2 & 1;
            unsigned pw[4];
#pragma unroll
            for (int j = 0; j < 4; ++j) pw[j] = pk2(S[kt][qt][8 * sx + 2 * j], S[kt][qt][8 * sx + 2 * j + 1]);
            pf[qt][s2] = __builtin_bit_cast(bf16x8, make_uint4(pw[0], pw[1], pw[2], pw[3]));
          }
        }
#pragma unroll
        for (int s2 = 0; s2 < 4; ++s2) {
          const int kt = s2 >> 1, sx = s2 & 1;
#pragma unroll
          for (int dt = 0; dt < 2; ++dt) {
            const u16* vp = cV + (dt * 32 + r) * VR + kt * 32 + 16 * sx + 4 * h;
            uint2 lo = *(const uint2*)(vp);
            uint2 hi = *(const uint2*)(vp + 8);
            bf16x8 fv = __builtin_bit_cast(bf16x8, make_uint4(lo.x, lo.y, hi.x, hi.y));
            O[dt][0] = MFMA(fv, pf[0][s2], O[dt][0]);
            O[dt][1] = MFMA(fv, pf[1][s2], O[dt][1]);
          }
        }
        cur ^= 1;
        __syncthreads();
      }
#pragma unroll
      for (int qt = 0; qt < 2; ++qt) {
        const float lt = lsum[qt] + __shfl_xor(lsum[qt], 32);
        const float inv = 1.f / lt;
#pragma unroll
        for (int dt = 0; dt < 2; ++dt)
#pragma unroll
          for (int g4 = 0; g4 < 4; ++g4) {
            uint2 o;
            o.x = pk2(O[dt][qt][4 * g4 + 0] * inv, O[dt][qt][4 * g4 + 1] * inv);
            o.y = pk2(O[dt][qt][4 * g4 + 2] * inv, O[dt][qt][4 * g4 + 3] * inv);
            *(uint2*)(OA + (size_t)(q0 + qt * 32 + r) * 512 + hd * 64 + dt * 32 + 8 * g4 + 4 * h) = o;
          }
      }
    }
  };

  auto gla_out_phase = [&](int l) __attribute__((always_inline)) {
    char* ws = ws_ptr(p);
    const int t = opaque_tid();
    const int lane = t & 63, w = t >> 6, r = lane & 31, h = lane >> 5;
    const int wm = w >> 1, wn = w & 1;
    (void)lane; (void)r; (void)h; (void)wm; (void)wn;
    constexpr int QROW = 136;
    u16* sQ = smem;
    u16* sKt = smem + 64 * QROW;
    u16* sVT = smem + 2 * 64 * QROW;
    float* sred = (float*)(smem + 2 * 64 * QROW + 256 * LROW);
    u16* sO = smem;
    constexpr int OROW = 264;
    const float qs = 0.08838834764831845f;
    const int cs = w & 1, vh = w >> 1;
    for (int id = bid; id < NCHUNK * 4; id += G) {
      const int n = id >> 2, hd = id & 3;
      const int t0 = n * 64;
      __syncthreads();
      {
        const int cc = t & 63, part = t >> 6;
#pragma unroll
        for (int q = 0; q < 8; ++q) {
          const int cg8 = (part * 8 + q) * 8;
          uint4 v = *(const uint4*)(Z + (size_t)(t0 + cc) * ZLD + Z_GV + hd * 256 + cg8);
          unsigned u[4] = {v.x, v.y, v.z, v.w};
#pragma unroll
          for (int j = 0; j < 4; ++j) {
            sVT[(cg8 + 2 * j) * LROW + cc] = (u16)(u[j] & 0xffffu);
            sVT[(cg8 + 2 * j + 1) * LROW + cc] = (u16)(u[j] >> 16);
          }
        }
      }
      f32x16 acc[4];
#pragma unroll
      for (int j = 0; j < 4; ++j)
#pragma unroll
        for (int k = 0; k < 16; ++k) acc[j][k] = 0.f;
      for (int dir = 0; dir < 2; ++dir) {
        __syncthreads();
        {
          const int cc = t >> 2, dp = (t & 3) * 32;
          const u16* qp = Z + (size_t)(t0 + cc) * ZLD + Z_GQ + hd * 128 + dp;
          const u16* kp = Z + (size_t)(t0 + cc) * ZLD + Z_GK + hd * 128 + dp;
          const float* gp = GC + (size_t)dir * SEQ * 512 + (size_t)(t0 + cc) * 512 + hd * 128 + dp;
#pragma unroll
          for (int j = 0; j < 4; ++j) {
            uint4 qv = *(const uint4*)(qp + j * 8);
            uint4 kv = *(const uint4*)(kp + j * 8);
            float4 g0 = *(const float4*)(gp + j * 8);
            float4 g1 = *(const float4*)(gp + j * 8 + 4);
            const float gg[8] = {g0.x, g0.y, g0.z, g0.w, g1.x, g1.y, g1.z, g1.w};
            const unsigned qu[4] = {qv.x, qv.y, qv.z, qv.w};
            const unsigned ku[4] = {kv.x, kv.y, kv.z, kv.w};
            unsigned qo[4], ko[4];
#pragma unroll
            for (int k = 0; k < 4; ++k) {
              const float e0 = __expf(gg[2 * k]), e1 = __expf(gg[2 * k + 1]);
              qo[k] = pk2(bflo(qu[k]) * qs * e0, bfhi(qu[k]) * qs * e1);
              ko[k] = pk2(bflo(ku[k]) / e0, bfhi(ku[k]) / e1);
            }
            *(uint4*)(sQ + cc * QROW + dp + j * 8) = make_uint4(qo[0], qo[1], qo[2], qo[3]);
            *(uint4*)(sKt + cc * QROW + dp + j * 8) = make_uint4(ko[0], ko[1], ko[2], ko[3]);
            if (j == 1) __builtin_amdgcn_sched_barrier(0);
          }
        }
        __syncthreads();
        const u16* bqp = sQ + (cs * 32 + r) * QROW + h * 8;
        const u16* stp = ST + ((size_t)(n * 4 + hd) * 2 + dir) * 32768;
        bf16x8 fs[2][4];
#pragma unroll
        for (int ks = 0; ks < 4; ++ks) fs[0][ks] = *(const bf16x8*)(stp + (size_t)(vh * 128 + r) * 128 + ks * 16 + h * 8);
        f32x16 at[2];
#pragma unroll
        for (int et = 0; et < 2; ++et) {
#pragma unroll
          for (int k = 0; k < 16; ++k) at[et][k] = 0.f;
#pragma unroll
          for (int ks = 0; ks < 8; ++ks) {
            bf16x8 fa = *(const bf16x8*)(sKt + (et * 32 + r) * QROW + ks * 16 + h * 8);
            bf16x8 fbq = *(const bf16x8*)(bqp + ks * 16);
            at[et] = MFMA(fa, fbq, at[et]);
          }
          const int cidx = cs * 32 + r;
#pragma unroll
          for (int k = 0; k < 16; ++k) {
            const int e = et * 32 + crow(k, h);
            const bool keep = dir ? (e >= cidx) : (e <= cidx);
            at[et][k] = keep ? at[et][k] : 0.f;
          }
        }
#pragma unroll
        for (int s2 = 0; s2 < 4; ++s2) {
          const int et = s2 >> 1, s = s2 & 1;
          unsigned pw[4];
#pragma unroll
          for (int j = 0; j < 4; ++j) pw[j] = pk2(at[et][8 * s + 2 * j], at[et][8 * s + 2 * j + 1]);
          bf16x8 pf = __builtin_bit_cast(bf16x8, make_uint4(pw[0], pw[1], pw[2], pw[3]));
#pragma unroll
          for (int mt = 0; mt < 4; ++mt) {
            const u16* vp = sVT + (vh * 128 + mt * 32 + r) * LROW + et * 32 + 16 * s + 4 * h;
            uint2 lo = *(const uint2*)(vp);
            uint2 hi = *(const uint2*)(vp + 8);
            bf16x8 fv = __builtin_bit_cast(bf16x8, make_uint4(lo.x, lo.y, hi.x, hi.y));
            acc[mt] = MFMA(fv, pf, acc[mt]);
          }
        }
#pragma unroll
        for (int bb = 0; bb < 8; ++bb) {
          const int mt = bb >> 1, kb = bb & 1;
          if (bb + 1 < 8) {
            const int mt1 = (bb + 1) >> 1, kb1 = (bb + 1) & 1;
#pragma unroll
            for (int ks = 0; ks < 4; ++ks) fs[(bb + 1) & 1][ks] = *(const bf16x8*)(stp + (size_t)(vh * 128 + mt1 * 32 + r) * 128 + (kb1 * 4 + ks) * 16 + h * 8);
          }
          __builtin_amdgcn_sched_barrier(0);
#pragma unroll
          for (int ks = 0; ks < 4; ++ks) { bf16x8 fbq = *(const bf16x8*)(bqp + (kb * 4 + ks) * 16); acc[mt] = MFMA(fs[bb & 1][ks], fbq, acc[mt]); }
          __builtin_amdgcn_sched_barrier(0);
        }
      }
      float ss = 0.f;
#pragma unroll
      for (int mt = 0; mt < 4; ++mt)
#pragma unroll
        for (int k = 0; k < 16; ++k) ss += acc[mt][k] * acc[mt][k];
      ss += __shfl_xor(ss, 32);
      if (h == 0) sred[vh * 64 + cs * 32 + r] = ss;
      __syncthreads();
      const float rs = rsqrtf((sred[cs * 32 + r] + sred[64 + cs * 32 + r]) * (1.f / 256.f) + EPS);
#pragma unroll
      for (int mt = 0; mt < 4; ++mt)
#pragma unroll
        for (int g4 = 0; g4 < 4; ++g4) {
          uint2 o;
          o.x = pk2(acc[mt][4 * g4 + 0] * rs, acc[mt][4 * g4 + 1] * rs);
          o.y = pk2(acc[mt][4 * g4 + 2] * rs, acc[mt][4 * g4 + 3] * rs);
          *(uint2*)(sO + (cs * 32 + r) * OROW + vh * 128 + mt * 32 + 8 * g4 + 4 * h) = o;
        }
      __syncthreads();
      {
        const int t3 = opaque_tid();
        const int cc = t3 >> 2, vp0 = (t3 & 3) * 64;
        const float* ng = in_ptr(p, 17) + (size_t)l * 256;
        u32x4 gvp[8];
#pragma unroll
        for (int j = 0; j < 8; ++j) gvp[j] = *(const u32x4*)(Z + (size_t)(t0 + cc) * ZLD + Z_GOG + hd * 256 + vp0 + j * 8);
        __builtin_amdgcn_sched_barrier(0);
#pragma unroll
        for (int j = 0; j < 8; ++j) {
          const int v0 = vp0 + j * 8;
          uint4 ov = *(const uint4*)(sO + cc * OROW + v0);
          uint4 gv = make_uint4(gvp[j][0], gvp[j][1], gvp[j][2], gvp[j][3]);
          float4 n0 = *(const float4*)(ng + v0), n1 = *(const float4*)(ng + v0 + 4);
          const float nn[8] = {n0.x, n0.y, n0.z, n0.w, n1.x, n1.y, n1.z, n1.w};
          const unsigned ou[4] = {ov.x, ov.y, ov.z, ov.w};
          const unsigned gu[4] = {gv.x, gv.y, gv.z, gv.w};
          unsigned res[4];
#pragma unroll
          for (int k = 0; k < 4; ++k)
            res[k] = pk2(bflo(ou[k]) * nn[2 * k] * siluf_(bflo(gu[k])), bfhi(ou[k]) * nn[2 * k + 1] * siluf_(bfhi(gu[k])));
          *(uint4*)(OG + (size_t)(t0 + cc) * DM + hd * 256 + v0) = make_uint4(res[0], res[1], res[2], res[3]);
        }
      }
    }
  };

  auto merge_phase = [&]() __attribute__((always_inline)) {
    char* ws = ws_ptr(p);
    const int t = opaque_tid();
    const int lane = t & 63, w = t >> 6, r = lane & 31, h = lane >> 5;
    const int wm = w >> 1, wn = w & 1;
    (void)lane; (void)r; (void)h; (void)wm; (void)wn;
    const int MT = SEQ / 256, NT = DM / 128;
    for (int id = bid; id < MT * NT; id += G) {
      int tm, tn; tile_coords(id, MT, NT, tm, tn);
      const int m0 = tm * 256, n0 = tn * 128;
      Acc c; acc_zero(c);
      gemm_kloop(OA + (size_t)m0 * 512, 512, Wb + W_OA + (size_t)n0 * 512, 512, 512, smem, c);
      {
        const unsigned zbase = (unsigned)((m0 + wm * 128) * ZLD + Z_BG + n0 + wn * 64);
        const unsigned obase = (unsigned)((m0 + wm * 128) * DM + n0 + wn * 64);
        epi_store_pre<2, 1>(smem,
          [&](int mi, int ni, int i) { return c.a[mi][ni][i]; },
          [&](int row, int col, int q) { return *(const u32x4*)(Z + zbase + (unsigned)(row * ZLD + col)); },
          [&](int row, int col, u32x4 v, const u32x4* pre) {
            const u32x4 g = pre[0];
            u32x4 o;
#pragma unroll
            for (int k = 0; k < 4; ++k) o[k] = pk2(bflo(v[k]) * sigmoidf_(bflo(g[k])), bfhi(v[k]) * sigmoidf_(bfhi(g[k])));
            *(u32x4*)(MG + obase + (unsigned)(row * DM + col)) = o;
          });
      }
      acc_zero(c);
      gemm_kloop(OG + (size_t)m0 * DM, DM, Wb + W_OB + (size_t)n0 * DM, DM, DM, smem, c);
      {
        const int t2 = opaque_tid();
        const int wm2 = t2 >> 7, wn2 = (t2 >> 6) & 1;
        const unsigned zbase = (unsigned)((m0 + wm2 * 128) * ZLD + Z_BG + DM + n0 + wn2 * 64);
        const unsigned obase = (unsigned)((m0 + wm2 * 128) * DM + n0 + wn2 * 64);
        epi_store_pre<2, 2>(smem,
          [&](int mi, int ni, int i) { return c.a[mi][ni][i]; },
          [&](int row, int col, int q) {
            return q == 0 ? *(const u32x4*)(Z + zbase + (unsigned)(row * ZLD + col))
                          : *(const u32x4*)(MG + obase + (unsigned)(row * DM + col));
          },
          [&](int row, int col, u32x4 v, const u32x4* pre) {
            const u32x4 g = pre[0], pm = pre[1];
            u32x4 o;
#pragma unroll
            for (int k = 0; k < 4; ++k)
              o[k] = pk2(bflo(pm[k]) + bflo(v[k]) * sigmoidf_(bflo(g[k])), bfhi(pm[k]) + bfhi(v[k]) * sigmoidf_(bfhi(g[k])));
            *(u32x4*)(MG + obase + (unsigned)(row * DM + col)) = o;
          });
      }
    }
  };

  for (int i = bid * 256 + opaque_tid(); i < SEQ * 16; i += G * 256) {
    const int pos = i >> 4, j = i & 15;
    const float inv_freq = exp2f(-(float)j * 0.8304820237218406f);
    const float angf = (float)pos * inv_freq;
    double a = (double)angf;
    const double twopi = 6.283185307179586476925286766559;
    a -= twopi * rint(a / twopi);
    const float af = (float)a;
    ropec[i] = __cosf(af);
    ropes[i] = __sinf(af);
  }
  convert_weights(0);
  rn_pass(0, 0.f, nullptr, in_ptr(p, 2), 0, MALL);
  grid.sync();

  for (int l = 0; l < 4; ++l) {
    asm volatile("" : "+s"(bid));
    char* ws = ws_ptr(p);
    ffn_in(W_FFN1_IN);
#ifdef DUP_FFNIN
    xcd_barrier(xb);
    ffn_in(W_FFN1_IN);
#endif
    xcd_barrier(xb);
    gemm_plain(ACT, DFF, DFF, Wb + W_FFN1_OUT, Yb, DM, MALL, DM);
    xcd_barrier(xb);
    rn_pass(1, 0.5f, in_ptr(p, 5) + l * DM, in_ptr(p, 6) + l * DM, 0, SEQ);
    xcd_barrier(xb);
    for (int s = 0; s < NSEQ; ++s) {
      asm volatile("" : "+s"(bid));
      char* ws = ws_ptr(p);
      {
        const float coefx = (s == 0) ? 0.5f : 1.0f;
        const float* postx = ((s == 0) ? in_ptr(p, 5) : in_ptr(p, 20)) + l * DM;
        const float* prex = ((s == 0) ? in_ptr(p, 6) : in_ptr(p, 21)) + l * DM;
        const int r0x = (s == 0) ? SEQ : (s - 1) * SEQ, r1x = (s == 0) ? 3 * SEQ : s * SEQ;
        int bq_ = bid; asm volatile("" : "+s"(bq_));
        for (int step_ = 0; step_ < 2; ++step_) {
          int sel_ = (step_ ^ bq_) & 1; asm volatile("" : "+s"(sel_));
          if (sel_) rn_pass(1, coefx, postx, prex, r0x, r1x);
          else gemm_plain(Hb + (size_t)s * SEQ * DM, DM, DM, Wb + W_IN, Z, ZLD, SEQ, ZLD);
        }
      }
      xcd_barrier(xb);
      prep_phase(l);
#ifdef DUP_PREP
      xcd_barrier(xb);
      prep_phase(l);
#endif
      xcd_barrier(xb);
      attn_phase(1);
      xcd_barrier(xb);
      int bpar_ = bid; asm volatile("" : "+s"(bpar_));
      if (bpar_ & 1) { attn_phase(2); gla_out_phase(l); }
      else { gla_out_phase(l); attn_phase(2); }
      xcd_barrier(xb);
      merge_phase();
      xcd_barrier(xb);
      gemm_plain(MG, DM, DM, Wb + W_OUT, Yb + (size_t)s * SEQ * DM, DM, SEQ, DM);
      xcd_barrier(xb);
    }
    rn_pass(1, 1.0f, in_ptr(p, 20) + l * DM, in_ptr(p, 21) + l * DM, 2 * SEQ, 3 * SEQ);
    xcd_barrier(xb);
    ffn_in(W_FFN2_IN);
    xcd_barrier(xb);
    gemm_plain(ACT, DFF, DFF, Wb + W_FFN2_OUT, Yb, DM, MALL, DM);
    xcd_barrier(xb);
    rn_pass(1, 0.5f, in_ptr(p, 24) + l * DM, (l < 3) ? (in_ptr(p, 2) + (l + 1) * DM) : nullptr, 0, MALL);
    if (l < 3) convert_weights(l + 1);
    xcd_barrier(xb);
  }
}

extern "C" void kernel_launch(void* const* d_in, const int* in_sizes, int n_in, void* d_out,
                              int out_size, void* d_ws, size_t ws_size, hipStream_t stream) {
  static int grid_blocks = 0;
  if (!grid_blocks) {
    int dev = 0, cus = 0, per_cu = 0;
    (void)hipGetDevice(&dev);
    (void)hipDeviceGetAttribute(&cus, hipDeviceAttributeMultiprocessorCount, dev);
    (void)hipOccupancyMaxActiveBlocksPerMultiprocessor(&per_cu, fwd_megakernel, 256, 0);
    if (per_cu > 2) per_cu = 2;
    if (per_cu < 1) per_cu = 1;
    grid_blocks = cus * per_cu;
  }
  Params p{};
  for (int i = 0; i < 25; ++i) p.in[i] = (const float*)d_in[i];
  p.out = (float*)d_out;
  p.ws = (char*)d_ws;
  (void)hipMemsetAsync((char*)d_ws + OFF_BAR, 0, XCD_BAR_WORDS * 4, stream);
  void* args[] = {&p};
  hipError_t e = hipLaunchCooperativeKernel((void*)fwd_megakernel, dim3(grid_blocks), dim3(256), args, 0, stream);
  if (e != hipSuccess) fprintf(stderr, "cooperative launch failed: %s (grid %d)\n", hipGetErrorString(e), grid_blocks);
}
```

```cpp
#include <hip/hip_runtime.h>
#include <hip/hip_cooperative_groups.h>
#include <cstdio>
namespace cg = cooperative_groups;

typedef unsigned short u16;
typedef short bf16x8 __attribute__((ext_vector_type(8)));
typedef short s16x4 __attribute__((ext_vector_type(4)));
typedef float f32x16 __attribute__((ext_vector_type(16)));
typedef __bf16 bf2_t __attribute__((ext_vector_type(2)));
typedef float f2_t __attribute__((ext_vector_type(2)));
typedef unsigned u32x4 __attribute__((ext_vector_type(4)));
#define DI __device__ __forceinline__
#define MFMA(a, b, c) __builtin_amdgcn_mfma_f32_32x32x16_bf16((a), (b), (c), 0, 0, 0)

constexpr int SEQ = 16384;
constexpr int NSEQ = 3;
constexpr int MALL = SEQ * NSEQ;
constexpr int DM = 1024;
constexpr int DFF = 2816;
constexpr int NFF2 = 5632;
constexpr int PIN = 5568;
constexpr int ZLD = 5632;
constexpr int Z_CQ = 0, Z_CKV = 256, Z_KPE = 384, Z_GQ = 416, Z_GK = 928, Z_GV = 1440, Z_GA = 2464, Z_GOG = 2496, Z_BG = 3520;
constexpr float EPS = 1e-6f;
constexpr int NCHUNK = SEQ / 64;

constexpr size_t W_FFN1_IN = 0;
constexpr size_t W_FFN1_OUT = W_FFN1_IN + (size_t)NFF2 * DM;
constexpr size_t W_IN = W_FFN1_OUT + (size_t)DM * DFF;
constexpr size_t W_UQ = W_IN + (size_t)ZLD * DM;
constexpr size_t W_KN = W_UQ + (size_t)768 * 256;
constexpr size_t W_V = W_KN + (size_t)512 * 128;
constexpr size_t W_OA = W_V + (size_t)512 * 128;
constexpr size_t W_OB = W_OA + (size_t)DM * 512;
constexpr size_t W_OUT = W_OB + (size_t)DM * DM;
constexpr size_t W_FFN2_IN = W_OUT + (size_t)DM * DM;
constexpr size_t W_FFN2_OUT = W_FFN2_IN + (size_t)NFF2 * DM;
constexpr size_t W_END = W_FFN2_OUT + (size_t)DM * DFF;

constexpr size_t al256(size_t x) { return (x + 255) & ~(size_t)255; }
constexpr size_t OFF_WB = 0;
constexpr size_t OFF_ROPE = al256(OFF_WB + W_END * 2);
constexpr size_t OFF_H = al256(OFF_ROPE + (size_t)SEQ * 32 * 4);
constexpr size_t OFF_Y = al256(OFF_H + (size_t)MALL * DM * 2);
constexpr size_t OFF_ACT = al256(OFF_Y + (size_t)MALL * DM * 2);
constexpr size_t OFF_Z = OFF_ACT;
constexpr size_t OFF_Q = al256(OFF_Z + (size_t)SEQ * ZLD * 2);
constexpr size_t OFF_KN = al256(OFF_Q + (size_t)SEQ * 768 * 2);
constexpr size_t OFF_VT = al256(OFF_KN + (size_t)SEQ * 512 * 2);
constexpr size_t OFF_KPE = al256(OFF_VT + (size_t)SEQ * 512 * 2);
constexpr size_t OFF_OA = al256(OFF_KPE + (size_t)SEQ * 32 * 2);
constexpr size_t OFF_MIXEND = al256(OFF_OA + (size_t)SEQ * 512 * 2);
constexpr size_t OFF_ACTEND = al256(OFF_ACT + (size_t)MALL * DFF * 2);
static_assert(OFF_MIXEND <= OFF_ACTEND, "mixer scratch must fit in act");
constexpr size_t OFF_ST = OFF_ACTEND;
constexpr size_t OFF_DEC = al256(OFF_ST + (size_t)NCHUNK * 4 * 2 * 256 * 128 * 2);
constexpr size_t OFF_GC = al256(OFF_DEC + (size_t)NCHUNK * 4 * 2 * 128 * 4);
constexpr size_t OFF_OG = al256(OFF_GC + (size_t)2 * SEQ * 512 * 4);
constexpr size_t OFF_MG = al256(OFF_OG + (size_t)SEQ * DM * 2);
constexpr size_t OFF_END = al256(OFF_MG + (size_t)SEQ * DM * 2);
constexpr size_t OFF_BAR = OFF_END;
static_assert(OFF_BAR + 16384 <= (size_t)768 * 1024 * 1024, "workspace overflow");

struct Params {
  const float* in[25];
  float* out;
  char* ws;
};

DI unsigned pk2(float a, float b) { f2_t v = {a, b}; return __builtin_bit_cast(unsigned, __builtin_convertvector(v, bf2_t)); }
DI u16 f2bf(float a) { return (u16)(pk2(a, 0.f) & 0xffffu); }
DI float bf2f(u16 v) { return __uint_as_float(((unsigned)v) << 16); }
DI float bflo(unsigned v) { return __uint_as_float(v << 16); }
DI float bfhi(unsigned v) { return __uint_as_float(v & 0xffff0000u); }
DI float wave_sum(float v) {
#pragma unroll
  for (int o = 32; o >= 1; o >>= 1) v += __shfl_xor(v, o);
  return v;
}
DI int opaque_tid() { int t = threadIdx.x; asm volatile("" : "+v"(t)); return t; }
DI const float* in_ptr(const Params& p, int k) { asm volatile("" : "+s"(k)); return p.in[k]; }
DI char* ws_ptr(const Params& p) { long z = 0; asm volatile("" : "+s"(z)); return p.ws + z; }
DI float* out_ptr(const Params& p) { long z = 0; asm volatile("" : "+s"(z)); return p.out + z; }
DI int crow(int i, int h) { return (i & 3) + 8 * (i >> 2) + 4 * h; }
DI float sigmoidf_(float x) { return 1.f / (1.f + __expf(-x)); }
DI float siluf_(float x) { return x / (1.f + __expf(-x)); }


#define XB_TMO      128
#define XB_XCNT(j)  (256  + 64 * (j))
#define XB_XSUB(j)  (1280 + 64 * (j))
#define XB_XGEN(j)  (2304 + 64 * (j))
#define XB_TOP      3328
#define XB_TOPGEN   3392
#define XCD_BAR_WORDS 3456
#define XB_SPIN_CAP (1u << 18)
#define LAS __attribute__((address_space(3)))

__device__ __forceinline__ unsigned xb_ld(unsigned* p)              { return __hip_atomic_load(p, __ATOMIC_RELAXED, __HIP_MEMORY_SCOPE_AGENT); }
__device__ __forceinline__ unsigned xb_add(unsigned* p, unsigned v) { return __hip_atomic_fetch_add(p, v, __ATOMIC_RELAXED, __HIP_MEMORY_SCOPE_AGENT); }
__device__ __forceinline__ unsigned xb_xcc_id() { return (unsigned)__builtin_amdgcn_s_getreg((3 << 11) | 20) & 0xFu; }
#define XB_SPIN(cond, bar) do { unsigned _sp = 0; while (cond) { __builtin_amdgcn_s_sleep(1); \
    if ((++_sp & 255u) == 0u) { if (xb_ld(&(bar)[XB_TMO])) break; if (_sp > XB_SPIN_CAP) { atomicAdd(&(bar)[XB_TMO], 1u); break; } } } } while (0)

struct XcdBarrier {
    unsigned* bar; unsigned x;
    volatile LAS unsigned* st;
};

__device__ __forceinline__ XcdBarrier xcd_barrier_post(unsigned* bar, volatile LAS unsigned* st) {
    XcdBarrier b; b.bar = bar; b.x = xb_xcc_id(); b.st = st;
    if (threadIdx.x == 0) (void)xb_add(&bar[XB_XCNT(b.x)], 1u);
    return b;
}
__device__ __forceinline__ void xcd_barrier_complete(unsigned* bar, unsigned x, unsigned& nloc, unsigned& nx) {
    const unsigned G = gridDim.x * gridDim.y * gridDim.z;
    unsigned sum, cnt, mine, sp = 0u;
    for (;;) {
        sum = 0u; cnt = 0u; mine = 0u;
#pragma unroll
        for (unsigned j = 0; j < 16; ++j) { const unsigned c = xb_ld(&bar[XB_XCNT(j)]); sum += c; cnt += (c > 0u) ? 1u : 0u; mine = (j == x) ? c : mine; }
        if (sum == G) break;
        __builtin_amdgcn_s_sleep(1);
        if ((++sp & 255u) == 0u) { if (xb_ld(&bar[XB_TMO])) break; if (sp > XB_SPIN_CAP) { atomicAdd(&bar[XB_TMO], 1u); break; } }
    }
    nloc = mine > 0u ? mine : 1u; nx = cnt > 0u ? cnt : 1u;
}

__device__ __forceinline__ void xcd_barrier(const XcdBarrier& b) {
    asm volatile("s_waitcnt vmcnt(0)" ::: "memory");
    __syncthreads();
    int tid0_ = threadIdx.x; asm volatile("" : "+v"(tid0_));
    if (tid0_ == 0) {
        unsigned* bar = b.bar; asm volatile("" : "+s"(bar));
        unsigned bx_ = b.x; asm volatile("" : "+s"(bx_));
        __builtin_amdgcn_s_waitcnt(0);
        unsigned nloc = b.st[0], nx = b.st[1];
        if (nloc == 0u) { xcd_barrier_complete(bar, bx_, nloc, nx); b.st[0] = nloc; b.st[1] = nx; }
        const unsigned old = xb_add(&bar[XB_XSUB(bx_)], 1u);
        const unsigned gen = old / nloc;
        if (old + 1u == (gen + 1u) * nloc) {
            __builtin_amdgcn_fence(__ATOMIC_RELEASE, "agent");
            asm volatile("s_waitcnt vmcnt(0)" ::: "memory");
            const unsigned og = xb_add(&bar[XB_TOP], 1u);
            const unsigned tg = og / nx;
            if (og + 1u == (tg + 1u) * nx) xb_add(&bar[XB_TOPGEN], 1u);
            else XB_SPIN(xb_ld(&bar[XB_TOPGEN]) == tg, bar);
            __builtin_amdgcn_fence(__ATOMIC_ACQUIRE, "agent");
            xb_add(&bar[XB_XGEN(bx_)], 1u);
            asm volatile("s_waitcnt vmcnt(0)" ::: "memory");
        } else {
            XB_SPIN(xb_ld(&bar[XB_XGEN(bx_)]) == gen, bar);
            __builtin_amdgcn_fence(__ATOMIC_ACQUIRE, "agent");
            asm volatile("s_waitcnt vmcnt(0)" ::: "memory");
        }
    }
    __syncthreads();
}

constexpr int LROW = 72;
constexpr int GEMM_LDS = 2 * 128 * LROW * 2;

struct Acc { f32x16 a[4][2]; };

DI void acc_zero(Acc& c) {
#pragma unroll
  for (int i = 0; i < 4; ++i)
#pragma unroll
    for (int j = 0; j < 2; ++j)
#pragma unroll
      for (int k = 0; k < 16; ++k) c.a[i][j][k] = 0.f;
}

DI void gll16_asm(const void* g, unsigned lds_addr) {
  asm volatile("s_mov_b32 m0, %1\n\ts_nop 0\n\tglobal_load_lds_dwordx4 %0, off" :: "v"(g), "s"(lds_addr) : "memory", "m0");
}
DI void gll16(const u16* g, char* l) {
  __builtin_amdgcn_global_load_lds((const __attribute__((address_space(1))) unsigned*)g,
                                   (__attribute__((address_space(3))) unsigned*)l, 16, 0, 0);
}
DI void gemm_kloop(const u16* __restrict__ A, int lda, const u16* __restrict__ B, int ldb, int K, u16* smem, Acc& c) {
  const int t = opaque_tid();
  const int lane = t & 63, w = t >> 6, r = lane & 31, h = lane >> 5;
  const int wm = w >> 1, wn = w & 1;
  char* lds = (char*)smem;
  const int nk = K >> 5;
  const int w_s = __builtin_amdgcn_readfirstlane(w);
  const unsigned ldsw_u = __builtin_amdgcn_readfirstlane((unsigned)(size_t)lds) + (unsigned)w_s * 1024u;
  const int row0 = t >> 2, c0 = t & 3;
  const int sw0 = (c0 ^ ((row0 >> 2) & 3)) * 8;
  const unsigned voa = (unsigned)(row0 * lda + sw0) * 2u;
  const unsigned vob = (unsigned)(row0 * ldb + sw0) * 2u;
  const size_t a64 = (size_t)128 * lda, b64 = (size_t)128 * ldb;
  const char* g0 = (const char*)A + voa;
  const char* g1 = g0 + a64;
  const char* g2 = g1 + a64;
  const char* g3 = g2 + a64;
  const char* g4 = (const char*)B + vob;
  const char* g5 = g4 + b64;
#define GEMM_ISSUE(kt_, st_)                                         \
  do {                                                               \
    const unsigned sp_ = ldsw_u + (unsigned)((st_) * 24576);         \
    gll16_asm(g0, sp_);                                              \
    gll16_asm(g1, sp_ + 4096u);                                      \
    gll16_asm(g2, sp_ + 8192u);                                      \
    gll16_asm(g3, sp_ + 12288u);                                     \
    gll16_asm(g4, sp_ + 16384u);                                     \
    gll16_asm(g5, sp_ + 20480u);                                     \
    const int inc_ = ((kt_) + 1 < nk) ? 64 : 0;                      \
    g0 += inc_; g1 += inc_; g2 += inc_; g3 += inc_; g4 += inc_; g5 += inc_; \
  } while (0)
  __syncthreads();
  GEMM_ISSUE(0, 0);
  GEMM_ISSUE(1, 1);
  const int fsw = (r >> 2) & 3;
  const int aoff = (wm * 128 + r) * 64, boff = 16384 + (wn * 64 + r) * 64;
  const char* pa0 = lds + aoff + ((0 + h) ^ fsw) * 16;
  const char* pa1 = lds + aoff + ((2 + h) ^ fsw) * 16;
  const char* pb0 = lds + boff + ((0 + h) ^ fsw) * 16;
  const char* pb1 = lds + boff + ((2 + h) ^ fsw) * 16;
  int scur = 0, snext = 2;
  for (int kt = 0; kt < nk; ++kt) {
    asm volatile("s_waitcnt vmcnt(6)" ::: "memory");
    __builtin_amdgcn_s_barrier();
    asm volatile("" ::: "memory");
    GEMM_ISSUE(kt + 2, snext);
    __builtin_amdgcn_sched_barrier(0);
    const int so = scur * 24576;
    {
      bf16x8 fa[4], fb[2];
#pragma unroll
      for (int i = 0; i < 4; ++i) fa[i] = *(const bf16x8*)(pa0 + so + i * 2048);
#pragma unroll
      for (int i = 0; i < 2; ++i) fb[i] = *(const bf16x8*)(pb0 + so + i * 2048);
#pragma unroll
      for (int i = 0; i < 4; ++i)
#pragma unroll
        for (int j = 0; j < 2; ++j) c.a[i][j] = MFMA(fa[i], fb[j], c.a[i][j]);
#pragma unroll
      for (int i = 0; i < 4; ++i) fa[i] = *(const bf16x8*)(pa1 + so + i * 2048);
#pragma unroll
      for (int i = 0; i < 2; ++i) fb[i] = *(const bf16x8*)(pb1 + so + i * 2048);
#pragma unroll
      for (int i = 0; i < 4; ++i)
#pragma unroll
        for (int j = 0; j < 2; ++j) c.a[i][j] = MFMA(fa[i], fb[j], c.a[i][j]);
    }
    __builtin_amdgcn_sched_barrier(0);
    snext = scur;
    scur = (scur == 2) ? 0 : scur + 1;
  }
  asm volatile("s_waitcnt vmcnt(0)" ::: "memory");
  __builtin_amdgcn_s_barrier();
  asm volatile("" ::: "memory");
#undef GEMM_ISSUE
}

DI void row_scales(const u16* __restrict__ base, int ld, int K, float* sc, int NR) {
  const int t = opaque_tid();
  const int row = (NR == 256) ? t : (t >> 1);
  const int part = (NR == 256) ? 0 : (t & 1);
  const int len = (NR == 256) ? K : (K / 2);
  const u16* p = base + (size_t)row * ld + part * len;
  float ss = 0.f;
  for (int i = 0; i < len / 8; ++i) {
    u32x4 v = *(const u32x4*)(p + i * 8);
#pragma unroll
    for (int j = 0; j < 4; ++j) { float a = bflo(v[j]), b = bfhi(v[j]); ss += a * a + b * b; }
  }
  if (NR != 256) ss += __shfl_xor(ss, 1);
  if (part == 0) sc[row] = rsqrtf(ss / (float)K + EPS);
}


template <int NI, class V, class R>
DI void epi_store(u16* smem, V val, R rowfn) {
  const int t = opaque_tid();
  const int lane = t & 63, w = t >> 6, r = lane & 31, h = lane >> 5;
  char* reg = (char*)smem + w * 18432;
#pragma unroll
  for (int mi = 0; mi < 4; ++mi)
#pragma unroll
    for (int ni = 0; ni < NI; ++ni)
#pragma unroll
      for (int i = 0; i < 16; ++i)
        *(u16*)(reg + (mi * 32 + crow(i, h)) * 144 + (ni * 32 + r) * 2) = f2bf(val(mi, ni, i));
  __builtin_amdgcn_sched_barrier(0);
  constexpr int CPR = NI * 4;
  constexpr int RPI = 64 / CPR;
  const int rr = lane / CPR, ch = lane % CPR;
#pragma unroll
  for (int k = 0; k < 128 / RPI; ++k) {
    const int row = k * RPI + rr;
    u32x4 v = *(const u32x4*)(reg + row * 144 + ch * 16);
    rowfn(row, ch * 8, v);
  }
}


template <int NI, int NPRE, class V, class L, class R>
DI void epi_store_pre(u16* smem, V val, L loadfn, R rowfn) {
  const int t = opaque_tid();
  const int lane = t & 63, w = t >> 6, r = lane & 31, h = lane >> 5;
  char* reg = (char*)smem + w * 18432;
#pragma unroll
  for (int mi = 0; mi < 4; ++mi)
#pragma unroll
    for (int ni = 0; ni < NI; ++ni)
#pragma unroll
      for (int i = 0; i < 16; ++i)
        *(u16*)(reg + (mi * 32 + crow(i, h)) * 144 + (ni * 32 + r) * 2) = f2bf(val(mi, ni, i));
  __builtin_amdgcn_sched_barrier(0);
  constexpr int CPR = NI * 4;
  constexpr int RPI = 64 / CPR;
  constexpr int NK = 128 / RPI;
  const int rr = lane / CPR, ch = lane % CPR;
  u32x4 pre[NK][NPRE];
#pragma unroll
  for (int k = 0; k < NK; ++k)
#pragma unroll
    for (int q = 0; q < NPRE; ++q) pre[k][q] = loadfn(k * RPI + rr, ch * 8, q);
  __builtin_amdgcn_sched_barrier(0);
#pragma unroll
  for (int k = 0; k < NK; ++k) {
    const int row = k * RPI + rr;
    u32x4 v = *(const u32x4*)(reg + row * 144 + ch * 16);
    rowfn(row, ch * 8, v, pre[k]);
  }
}

DI void tile_coords(int id, int MT, int NT, int& tm, int& tn) {
  const int per = 32 * NT;
  const int sr = id / per, rem = id - sr * per;
  tn = rem >> 5;
  tm = sr * 32 + (rem & 31);
}

#define EPI_LOOP                                   \
  _Pragma("unroll") for (int mi = 0; mi < 4; ++mi) \
  _Pragma("unroll") for (int ni = 0; ni < 2; ++ni) \
  _Pragma("unroll") for (int i = (__builtin_amdgcn_sched_barrier(0), 0); i < 16; ++i)

constexpr int SMEM_BYTES = 74752;

__global__ void __launch_bounds__(256, 2) fwd_megakernel(Params p) {
  cg::grid_group grid = cg::this_grid();
  __shared__ __attribute__((aligned(16))) char smem_raw[SMEM_BYTES];
  u16* smem = (u16*)smem_raw;
  const int G = gridDim.x;
  int bid = blockIdx.x;
  __shared__ uint4 xb_words;
  if (threadIdx.x == 0) xb_words = make_uint4(0u, 0u, 0u, 0u);
  __syncthreads();
  XcdBarrier xb = xcd_barrier_post((unsigned*)(p.ws + OFF_BAR), (volatile LAS unsigned*)&xb_words);

  char* ws = p.ws;
#define Wb ((u16*)(ws + OFF_WB))
#define ropec ((float*)(ws + OFF_ROPE))
#define ropes (((float*)(ws + OFF_ROPE)) + SEQ * 16)
#define Hb ((u16*)(ws + OFF_H))
#define Yb ((u16*)(ws + OFF_Y))
#define ACT ((u16*)(ws + OFF_ACT))
#define Z ((u16*)(ws + OFF_Z))
#define Qb ((u16*)(ws + OFF_Q))
#define KN ((u16*)(ws + OFF_KN))
#define VT ((u16*)(ws + OFF_VT))
#define KPE ((u16*)(ws + OFF_KPE))
#define OA ((u16*)(ws + OFF_OA))
#define ST ((u16*)(ws + OFF_ST))
#define DEC ((float*)(ws + OFF_DEC))
#define GC ((float*)(ws + OFF_GC))
#define OG ((u16*)(ws + OFF_OG))
#define MG ((u16*)(ws + OFF_MG))
  float* X = p.out;

  auto convert_weights = [&](int l) __attribute__((always_inline)) {
    char* ws = ws_ptr(p);
    const int t = opaque_tid();
    const int lane = t & 63, w = t >> 6, r = lane & 31, h = lane >> 5;
    const int wm = w >> 1, wn = w & 1;
    (void)lane; (void)r; (void)h; (void)wm; (void)wn;
    float* tile = (float*)smem_raw;
    for (int mat = 0; mat < 11; ++mat) {
      const float* src; int K, N; size_t dst; int map; const float* ksc = nullptr;
      switch (mat) {
        case 0: src = in_ptr(p, 3) + (size_t)l * DM * NFF2; K = DM; N = NFF2; dst = W_FFN1_IN; map = 1; break;
        case 1: src = in_ptr(p, 4) + (size_t)l * DFF * DM; K = DFF; N = DM; dst = W_FFN1_OUT; map = 0; break;
        case 2: src = in_ptr(p, 7) + (size_t)l * DM * PIN; K = DM; N = PIN; dst = W_IN; map = 0; break;
        case 3: src = in_ptr(p, 9) + (size_t)l * 256 * 768; K = 256; N = 768; dst = W_UQ; map = 0; ksc = in_ptr(p, 8) + l * 256; break;
        case 4: src = in_ptr(p, 11) + (size_t)l * 128 * 1024; K = 128; N = 1024; dst = W_KN; map = 2; ksc = in_ptr(p, 10) + l * 128; break;
        case 5: src = in_ptr(p, 12) + (size_t)l * 512 * DM; K = 512; N = DM; dst = W_OA; map = 0; break;
        case 6: src = in_ptr(p, 18) + (size_t)l * DM * DM; K = DM; N = DM; dst = W_OB; map = 0; break;
        case 7: src = in_ptr(p, 19) + (size_t)l * DM * DM; K = DM; N = DM; dst = W_OUT; map = 0; break;
        case 8: src = in_ptr(p, 22) + (size_t)l * DM * NFF2; K = DM; N = NFF2; dst = W_FFN2_IN; map = 1; break;
        case 9: src = in_ptr(p, 23) + (size_t)l * DFF * DM; K = DFF; N = DM; dst = W_FFN2_OUT; map = 0; break;
        default: src = nullptr; K = DM; N = 64; dst = W_IN + (size_t)PIN * DM; map = 3; break;
      }
      const int kt_n = K / 64, nt_n = N / 64;
      for (int id = bid; id < kt_n * nt_n; id += G) {
        const int kt = id % kt_n, nt = id / kt_n;
        const int k0 = kt * 64, n0 = nt * 64;
        __syncthreads();
        if (map != 3) {
#pragma unroll
          for (int i = 0; i < 4; ++i) {
            const int kk = (t >> 4) + 16 * i, nn = (t & 15) * 4;
            float4 v = *(const float4*)(src + (size_t)(k0 + kk) * N + n0 + nn);
            float sc = ksc ? ksc[k0 + kk] : 1.f;
            tile[kk * 65 + nn + 0] = v.x * sc; tile[kk * 65 + nn + 1] = v.y * sc;
            tile[kk * 65 + nn + 2] = v.z * sc; tile[kk * 65 + nn + 3] = v.w * sc;
          }
        }
        __syncthreads();
        const int nl = t >> 2, kc = (t & 3) * 16;
        const int n = n0 + nl;
        size_t drow;
        if (map == 0) drow = dst + (size_t)n * K;
        else if (map == 1) { const int isb = n >= DFF; const int j = n - isb * DFF; drow = dst + (size_t)((j >> 5) * 64 + isb * 32 + (j & 31)) * K; }
        else if (map == 2) { const int hd = n >> 7, cc = n & 127; drow = (cc < 64) ? (W_KN + (size_t)(hd * 64 + cc) * K) : (W_V + (size_t)(hd * 64 + cc - 64) * K); }
        else drow = dst + (size_t)nl * K;
        unsigned o[8];
#pragma unroll
        for (int j = 0; j < 8; ++j) {
          float a = (map == 3) ? 0.f : tile[(kc + 2 * j) * 65 + nl];
          float b = (map == 3) ? 0.f : tile[(kc + 2 * j + 1) * 65 + nl];
          o[j] = pk2(a, b);
        }
        uint4* dp = (uint4*)(Wb + drow + k0 + kc);
        dp[0] = make_uint4(o[0], o[1], o[2], o[3]);
        dp[1] = make_uint4(o[4], o[5], o[6], o[7]);
      }
    }
  };

  auto rn_pass = [&](int mode, float coef, const float* post_g, const float* pre_g, int r0, int r1) __attribute__((always_inline)) {
    char* ws = ws_ptr(p);
    float* X = out_ptr(p);
    const int t = opaque_tid();
    const int lane = t & 63, w = t >> 6, r = lane & 31, h = lane >> 5;
    const int wm = w >> 1, wn = w & 1;
    (void)lane; (void)r; (void)h; (void)wm; (void)wn;
    typedef float f4v __attribute__((ext_vector_type(4)));
    typedef unsigned u2v __attribute__((ext_vector_type(2)));
    const int gw = bid * 4 + w, nw = G * 4;
    constexpr int RB = 4;
    f4v pg[4], qg[4];
#pragma unroll
    for (int i = 0; i < 4; ++i) {
      pg[i] = (mode == 1) ? *(const f4v*)(post_g + lane * 4 + 256 * i) : (f4v){0.f, 0.f, 0.f, 0.f};
      qg[i] = pre_g ? *(const f4v*)(pre_g + lane * 4 + 256 * i) : (f4v){0.f, 0.f, 0.f, 0.f};
    }
    for (int row0 = r0 + gw; row0 < r1; row0 += RB * nw) {
      f4v xv[RB][4];
      u2v yu[RB][4];
#pragma unroll
      for (int j = 0; j < RB; ++j) {
        int row = row0 + j * nw;
        if (row >= r1) row = row0;
        const float* xs;
        if (mode == 0) xs = (row < SEQ) ? (in_ptr(p, 0) + (size_t)row * DM) : (in_ptr(p, 1) + (size_t)(row - SEQ) * DM);
        else xs = X + (size_t)row * DM;
#pragma unroll
        for (int i = 0; i < 4; ++i) xv[j][i] = *(const f4v*)(xs + lane * 4 + 256 * i);
        if (mode == 1) {
#pragma unroll
          for (int i = 0; i < 4; ++i) yu[j][i] = *(const u2v*)(Yb + (size_t)row * DM + lane * 4 + 256 * i);
        }
      }
#pragma unroll
      for (int j = 0; j < RB; ++j) {
        const int row = row0 + j * nw;
        if (row < r1) {
          if (mode == 1) {
            float yv[16];
            float ss = 0.f;
#pragma unroll
            for (int i = 0; i < 4; ++i) {
              yv[4 * i + 0] = bflo(yu[j][i][0]); yv[4 * i + 1] = bfhi(yu[j][i][0]);
              yv[4 * i + 2] = bflo(yu[j][i][1]); yv[4 * i + 3] = bfhi(yu[j][i][1]);
            }
#pragma unroll
            for (int i = 0; i < 16; ++i) ss += yv[i] * yv[i];
            ss = wave_sum(ss);
            const float ry = rsqrtf(ss * (1.f / DM) + EPS) * coef;
#pragma unroll
            for (int i = 0; i < 4; ++i)
#pragma unroll
              for (int k = 0; k < 4; ++k) xv[j][i][k] += yv[4 * i + k] * ry * pg[i][k];
          }
#pragma unroll
          for (int i = 0; i < 4; ++i) *(f4v*)(X + (size_t)row * DM + lane * 4 + 256 * i) = xv[j][i];
          if (pre_g) {
            float ss = 0.f;
#pragma unroll
            for (int i = 0; i < 4; ++i)
#pragma unroll
              for (int k = 0; k < 4; ++k) ss += xv[j][i][k] * xv[j][i][k];
            ss = wave_sum(ss);
            const float rx = rsqrtf(ss * (1.f / DM) + EPS);
#pragma unroll
            for (int i = 0; i < 4; ++i) {
              u2v o;
              o[0] = pk2(xv[j][i][0] * rx * qg[i][0], xv[j][i][1] * rx * qg[i][1]);
              o[1] = pk2(xv[j][i][2] * rx * qg[i][2], xv[j][i][3] * rx * qg[i][3]);
              *(u2v*)(Hb + (size_t)row * DM + lane * 4 + 256 * i) = o;
            }
          }
        }
      }
    }
  };

  auto ffn_in = [&](size_t woff) __attribute__((always_inline)) {
    char* ws = ws_ptr(p);
    const int t = opaque_tid();
    const int lane = t & 63, w = t >> 6, r = lane & 31, h = lane >> 5;
    const int wm = w >> 1, wn = w & 1;
    (void)lane; (void)r; (void)h; (void)wm; (void)wn;
    const int MT = MALL / 256, NT = NFF2 / 128;
    for (int id = bid; id < MT * NT; id += G) {
      int tm, tn; tile_coords(id, MT, NT, tm, tn);
      const int m0 = tm * 256, n0 = tn * 128;
      Acc c; acc_zero(c);
      gemm_kloop(Hb + (size_t)m0 * DM, DM, Wb + woff + (size_t)n0 * DM, DM, DM, smem, c);
#ifdef DUP_KLOOP
      acc_zero(c);
      gemm_kloop(Hb + (size_t)m0 * DM, DM, Wb + woff + (size_t)n0 * DM, DM, DM, smem, c);
#endif
      const int jb0 = ((n0 + wn * 64) >> 6) * 32;
      const unsigned obase = (unsigned)((m0 + wm * 128) * DFF + jb0);
      epi_store<1>(smem,
        [&](int mi, int ni, int i) { return siluf_(c.a[mi][0][i]) * c.a[mi][1][i]; },
        [&](int row, int col, u32x4 v) { *(u32x4*)(ACT + obase + (unsigned)(row * DFF + col)) = v; });
    }
  };
  auto gemm_plain = [&](const u16* A, int lda, int K, const u16* Bt, u16* C, int ldc, int M, int N) __attribute__((always_inline)) {
    char* ws = ws_ptr(p);
    const int t = opaque_tid();
    const int lane = t & 63, w = t >> 6, r = lane & 31, h = lane >> 5;
    const int wm = w >> 1, wn = w & 1;
    (void)lane; (void)r; (void)h; (void)wm; (void)wn;
    const int MT = M / 256, NT = N / 128;
    for (int id = bid; id < MT * NT; id += G) {
      int tm, tn; tile_coords(id, MT, NT, tm, tn);
      const int m0 = tm * 256, n0 = tn * 128;
      Acc c; acc_zero(c);
      gemm_kloop(A + (size_t)m0 * lda, lda, Bt + (size_t)n0 * K, K, K, smem, c);
      const unsigned obase = (unsigned)((m0 + wm * 128) * ldc + n0 + wn * 64);
      epi_store<2>(smem,
        [&](int mi, int ni, int i) { return c.a[mi][ni][i]; },
        [&](int row, int col, u32x4 v) { *(u32x4*)(C + obase + (unsigned)(row * ldc + col)) = v; });
    }
  };

  auto prep_phase = [&](int l) __attribute__((always_inline)) {
    char* ws = ws_ptr(p);
    int pb_ = bid; asm volatile("" : "+s"(pb_));
    const int t = opaque_tid();
    const int lane = t & 63, w = t >> 6, r = lane & 31, h = lane >> 5;
    const int wm = w >> 1, wn = w & 1;
    (void)lane; (void)r; (void)h; (void)wm; (void)wn;
    float* sc = (float*)(smem_raw + 2 * GEMM_LDS);
    const int NQ = 64 * 6, NK = 64 * 4, NV = 2 * 128, NPE = 64, NG1 = NCHUNK * 4;
    const float qscale = 0.10206207261596577f * 1.4426950408889634f;
    {
      for (int id = pb_; id < NG1; id += G) {
        const int t = opaque_tid();
        const int lane = t & 63, w = t >> 6, r = lane & 31, h = lane >> 5;
        const int wm = w >> 1, wn = w & 1;
        (void)lane; (void)r; (void)h; (void)wm; (void)wn;
        const int n = id >> 2, hd = id & 3;
        const int t0 = n * 64;
        u16* ksT = smem;
        u16* vT = smem + 2 * 128 * LROW;
        u16* sk = vT;
        float* sga = (float*)(smem_raw + 55296);
        __syncthreads();
        {
          const int cc = t >> 2, part = t & 3;
          const u16* kp = Z + (size_t)(t0 + cc) * ZLD + Z_GK + hd * 128 + part * 32;
#pragma unroll
          for (int j = 0; j < 4; ++j) *(u32x4*)(sk + cc * 128 + part * 32 + j * 8) = *(const u32x4*)(kp + j * 8);
          u32x4 gv = *(const u32x4*)(Z + (size_t)(t0 + cc) * ZLD + Z_GA + part * 8);
#pragma unroll
          for (int k = 0; k < 4; ++k) { sga[cc * 32 + part * 8 + 2 * k] = bflo(gv[k]); sga[cc * 32 + part * 8 + 2 * k + 1] = bfhi(gv[k]); }
        }
        __syncthreads();
        {
          const int dir = t >> 7, d = t & 127;
          const float* wa2 = (dir ? in_ptr(p, 15) : in_ptr(p, 13)) + (size_t)l * 16 * 512 + hd * 128 + d;
          const float ba = ((dir ? in_ptr(p, 16) : in_ptr(p, 14)) + (size_t)l * 512)[hd * 128 + d];
          float wcol[16];
#pragma unroll
          for (int rr = 0; rr < 16; ++rr) wcol[rr] = wa2[rr * 512];
          const float* gar = sga + dir * 16;
          float tot = 0.f;
          for (int cc = 0; cc < 64; ++cc) {
            float pre = ba;
#pragma unroll
            for (int rr = 0; rr < 16; ++rr) pre += gar[cc * 32 + rr] * wcol[rr];
            tot += (fminf(pre, 0.f) - __logf(1.f + __expf(-fabsf(pre)))) * (1.f / 16.f);
          }
          DEC[((size_t)(n * 4 + hd) * 2 + dir) * 128 + d] = __expf(tot);
          float* gc = GC + (size_t)dir * SEQ * 512 + (size_t)t0 * 512 + hd * 128 + d;
          float cb = 0.f;
          u16* krow_out = ksT + (dir * 128 + d) * LROW;
          for (int ci = 0; ci < 64; ++ci) {
            const int cc = dir ? (63 - ci) : ci;
            float pre = ba;
#pragma unroll
            for (int rr = 0; rr < 16; ++rr) pre += gar[cc * 32 + rr] * wcol[rr];
            cb += (fminf(pre, 0.f) - __logf(1.f + __expf(-fabsf(pre)))) * (1.f / 16.f);
            gc[cc * 512] = cb;
            krow_out[cc] = f2bf(bf2f(sk[cc * 128 + d]) * __expf(tot - cb));
          }
        }
        for (int half = 0; half < 2; ++half) {
          __syncthreads();
          {
            const int cc = t & 63, part = t >> 6;
#pragma unroll
            for (int q = 0; q < 4; ++q) {
              const int cg8 = (part * 4 + q) * 8;
              uint4 v = *(const uint4*)(Z + (size_t)(t0 + cc) * ZLD + Z_GV + hd * 256 + half * 128 + cg8);
              unsigned u[4] = {v.x, v.y, v.z, v.w};
#pragma unroll
              for (int j = 0; j < 4; ++j) {
                vT[(cg8 + 2 * j) * LROW + cc] = (u16)(u[j] & 0xffffu);
                vT[(cg8 + 2 * j + 1) * LROW + cc] = (u16)(u[j] >> 16);
              }
            }
          }
          __syncthreads();
#pragma unroll
          for (int dir = 0; dir < 2; ++dir) {
            f32x16 acc[4];
#pragma unroll
            for (int j = 0; j < 4; ++j)
#pragma unroll
              for (int k = 0; k < 16; ++k) acc[j][k] = 0.f;
#pragma unroll
            for (int ks = 0; ks < 4; ++ks) {
              bf16x8 fa = *(const bf16x8*)(vT + (w * 32 + r) * LROW + ks * 16 + h * 8);
#pragma unroll
              for (int nt = 0; nt < 4; ++nt) {
                bf16x8 fb = *(const bf16x8*)(ksT + (dir * 128 + nt * 32 + r) * LROW + ks * 16 + h * 8);
                acc[nt] = MFMA(fb, fa, acc[nt]);
              }
            }
            u16* stp = ST + ((size_t)(n * 4 + hd) * 2 + dir) * 32768;
#pragma unroll
            for (int nt = 0; nt < 4; ++nt)
#pragma unroll
              for (int g4 = 0; g4 < 4; ++g4) {
                uint2 o;
                o.x = pk2(acc[nt][4 * g4 + 0], acc[nt][4 * g4 + 1]);
                o.y = pk2(acc[nt][4 * g4 + 2], acc[nt][4 * g4 + 3]);
                *(uint2*)(stp + (unsigned)((half * 128 + w * 32 + r) * 128 + nt * 32 + 8 * g4 + 4 * h)) = o;
              }
          }
        }
      }
      for (int q = pb_; q < NQ; q += G) {
        const int t = opaque_tid();
        const int lane = t & 63, w = t >> 6, r = lane & 31, h = lane >> 5;
        const int wm = w >> 1, wn = w & 1;
        (void)lane; (void)r; (void)h; (void)wm; (void)wn;
        const int tm = q / 6, tn = q % 6;
        const int m0 = tm * 256, n0 = tn * 128;
        __syncthreads();
        row_scales(Z + (size_t)m0 * ZLD + Z_CQ, ZLD, 256, sc, 256);
        Acc c; acc_zero(c);
        gemm_kloop(Z + (size_t)m0 * ZLD + Z_CQ, ZLD, Wb + W_UQ + (size_t)n0 * 256, 256, 256, smem, c);
        {
          const unsigned obase = (unsigned)((m0 + wm * 128) * 768 + n0 + wn * 64);
          epi_store<2>(smem,
            [&](int mi, int ni, int i) {
              const int cb0 = n0 + wn * 64 + ni * 32;
              const bool rope = ((cb0 >> 5) % 3) == 2;
              const int rl = wm * 128 + mi * 32 + crow(i, h);
              float v = c.a[mi][ni][i] * sc[rl];
              const float pv = __shfl_xor(v, 16);
              if (rope) {
                const int row = m0 + rl;
                const float cs = ropec[row * 16 + (r & 15)], sn = ropes[row * 16 + (r & 15)];
                v = (r < 16) ? (v * cs - pv * sn) : (v * cs + pv * sn);
              }
              return v * qscale;
            },
            [&](int row, int col, u32x4 v) { *(u32x4*)(Qb + obase + (unsigned)(row * 768 + col)) = v; });
        }
      }
      for (int q = (pb_ + G - (NQ % G)) % G; q < NK; q += G) {
        const int t = opaque_tid();
        const int lane = t & 63, w = t >> 6, r = lane & 31, h = lane >> 5;
        const int wm = w >> 1, wn = w & 1;
        (void)lane; (void)r; (void)h; (void)wm; (void)wn;
        const int tm = q >> 2, tn = q & 3;
        const int m0 = tm * 256, n0 = tn * 128;
        __syncthreads();
        row_scales(Z + (size_t)m0 * ZLD + Z_CKV, ZLD, 128, sc, 256);
        Acc c; acc_zero(c);
        gemm_kloop(Z + (size_t)m0 * ZLD + Z_CKV, ZLD, Wb + W_KN + (size_t)n0 * 128, 128, 128, smem, c);
        {
          const unsigned obase = (unsigned)((m0 + wm * 128) * 512 + n0 + wn * 64);
          epi_store<2>(smem,
            [&](int mi, int ni, int i) { return c.a[mi][ni][i] * sc[wm * 128 + mi * 32 + crow(i, h)]; },
            [&](int row, int col, u32x4 v) { *(u32x4*)(KN + obase + (unsigned)(row * 512 + col)) = v; });
        }
      }
      for (int q = (pb_ + G - ((NQ + NK) % G)) % G; q < NV; q += G) {
        const int t = opaque_tid();
        const int lane = t & 63, w = t >> 6, r = lane & 31, h = lane >> 5;
        const int wm = w >> 1, wn = w & 1;
        (void)lane; (void)r; (void)h; (void)wm; (void)wn;
        const int tm = q & 1, tn = q >> 1;
        const int m0 = tm * 256, n0 = tn * 128;
        __syncthreads();
        row_scales(Z + (size_t)n0 * ZLD + Z_CKV, ZLD, 128, sc, 128);
        Acc c; acc_zero(c);
        gemm_kloop(Wb + W_V + (size_t)m0 * 128, 128, Z + (size_t)n0 * ZLD + Z_CKV, ZLD, 128, smem, c);
        {
          const unsigned obase = (unsigned)((m0 + wm * 128) * SEQ + n0 + wn * 64);
          epi_store<2>(smem,
            [&](int mi, int ni, int i) { return c.a[mi][ni][i] * sc[wn * 64 + ni * 32 + r]; },
            [&](int row, int col, u32x4 v) { *(u32x4*)(VT + obase + (unsigned)(row * SEQ + col)) = v; });
        }
      }
      for (int q = (pb_ + G - ((NQ + NK + NV) % G)) % G; q < NPE; q += G) {
        const int t = opaque_tid();
        const int lane = t & 63, w = t >> 6, r = lane & 31, h = lane >> 5;
        const int wm = w >> 1, wn = w & 1;
        (void)lane; (void)r; (void)h; (void)wm; (void)wn;
        const int tok = q * 256 + t;
        const u16* src = Z + (size_t)tok * ZLD + Z_KPE;
        float v[32];
#pragma unroll
        for (int j = 0; j < 4; ++j) {
          uint4 u = *(const uint4*)(src + j * 8);
          unsigned uu[4] = {u.x, u.y, u.z, u.w};
#pragma unroll
          for (int k = 0; k < 4; ++k) { v[j * 8 + 2 * k] = bflo(uu[k]); v[j * 8 + 2 * k + 1] = bfhi(uu[k]); }
        }
        float o[32];
#pragma unroll
        for (int i = 0; i < 16; ++i) {
          const float cs = ropec[tok * 16 + i], sn = ropes[tok * 16 + i];
          o[i] = v[i] * cs - v[i + 16] * sn;
          o[i + 16] = v[i + 16] * cs + v[i] * sn;
        }
#pragma unroll
        for (int j = 0; j < 4; ++j) {
          uint4 u;
          u.x = pk2(o[j * 8 + 0], o[j * 8 + 1]); u.y = pk2(o[j * 8 + 2], o[j * 8 + 3]);
          u.z = pk2(o[j * 8 + 4], o[j * 8 + 5]); u.w = pk2(o[j * 8 + 6], o[j * 8 + 7]);
          *(uint4*)(KPE + (size_t)tok * 32 + j * 8) = u;
        }
      }
    }
  };

  auto attn_phase = [&](int mode) __attribute__((always_inline)) {
    char* ws = ws_ptr(p);
    const int t = opaque_tid();
    const int lane = t & 63, w = t >> 6, r = lane & 31, h = lane >> 5;
    const int wm = w >> 1, wn = w & 1;
    (void)lane; (void)r; (void)h; (void)wm; (void)wn;
    if (mode & 1) for (int id = bid; id < 512; id += G) {
      const int e = id * 256 + t;
      const int d2 = e & 63, v = (e >> 6) & 255, dir = (e >> 14) & 1, hd = e >> 15;
      float s0 = 0.f, s1 = 0.f;
      const size_t eoff = (size_t)v * 128 + 2 * d2;
      for (int i0 = 0; i0 < NCHUNK; i0 += 16) {
        unsigned uu[16];
        float2 dd[16];
#pragma unroll
        for (int j = 0; j < 16; ++j) {
          const int n = dir ? (NCHUNK - 1 - (i0 + j)) : (i0 + j);
          const size_t base = ((size_t)(n * 4 + hd) * 2 + dir);
          uu[j] = *(const unsigned*)(ST + base * 32768 + eoff);
          dd[j] = *(const float2*)(DEC + base * 128 + 2 * d2);
        }
#pragma unroll
        for (int j = 0; j < 16; ++j) {
          const int n = dir ? (NCHUNK - 1 - (i0 + j)) : (i0 + j);
          const size_t base = ((size_t)(n * 4 + hd) * 2 + dir);
          *(unsigned*)(ST + base * 32768 + eoff) = pk2(s0, s1);
          s0 = dd[j].x * s0 + bflo(uu[j]);
          s1 = dd[j].y * s1 + bfhi(uu[j]);
        }
      }
    }
    constexpr int KROW = 104;
    constexpr int VR = 68;
    constexpr int ABUF = 64 * KROW + 64 * VR;
    u16* sK = smem;
    u16* sV = smem + 64 * KROW;
    if (mode & 2) for (int id = bid; id < 8 * 64; id += G) {
      const int hd = id & 7, qb = id >> 3;
      const int q0 = qb * 256 + w * 64;
      bf16x8 bq[2][6];
#pragma unroll
      for (int qt = 0; qt < 2; ++qt)
#pragma unroll
        for (int ks = 0; ks < 6; ++ks) bq[qt][ks] = *(const bf16x8*)(Qb + (size_t)(q0 + qt * 32 + r) * 768 + hd * 96 + ks * 16 + h * 8);
      f32x16 O[2][2];
#pragma unroll
      for (int j = 0; j < 2; ++j)
#pragma unroll
        for (int qt = 0; qt < 2; ++qt)
#pragma unroll
          for (int k = 0; k < 16; ++k) O[j][qt][k] = 0.f;
      float m[2] = {0.f, 0.f}, lsum[2] = {0.f, 0.f};
      const int kr = t >> 2, kc = t & 3;
      const u16* knp = KN + (size_t)kr * 512 + hd * 64 + kc * 16;
      const u16* kpp = KPE + (size_t)kr * 32 + kc * 8;
      const u16* vpp = VT + (size_t)(hd * 64 + kr) * SEQ + kc * 16;
      u32x4 rk[3], rv[2];
      rk[0] = *(const u32x4*)(knp);
      rk[1] = *(const u32x4*)(knp + 8);
      rk[2] = *(const u32x4*)(kpp);
      rv[0] = *(const u32x4*)(vpp);
      rv[1] = *(const u32x4*)(vpp + 8);
      __syncthreads();
      *(u32x4*)(sK + kr * KROW + kc * 16) = rk[0];
      *(u32x4*)(sK + kr * KROW + kc * 16 + 8) = rk[1];
      *(u32x4*)(sK + kr * KROW + 64 + kc * 8) = rk[2];
      *(uint2*)(sV + kr * VR + kc * 16) = make_uint2(rv[0][0], rv[0][1]);
      *(uint2*)(sV + kr * VR + kc * 16 + 4) = make_uint2(rv[0][2], rv[0][3]);
      *(uint2*)(sV + kr * VR + kc * 16 + 8) = make_uint2(rv[1][0], rv[1][1]);
      *(uint2*)(sV + kr * VR + kc * 16 + 12) = make_uint2(rv[1][2], rv[1][3]);
      rk[0] = *(const u32x4*)(knp + (size_t)64 * 512);
      rk[1] = *(const u32x4*)(knp + (size_t)64 * 512 + 8);
      rk[2] = *(const u32x4*)(kpp + (size_t)64 * 32);
      rv[0] = *(const u32x4*)(vpp + 64);
      rv[1] = *(const u32x4*)(vpp + 64 + 8);
      __syncthreads();
      int cur = 0;
      for (int key0 = 0; key0 < SEQ; key0 += 64) {
        const u16* cK = sK + cur * ABUF;
        const u16* cV = sV + cur * ABUF;
        {
          u16* nK = sK + (cur ^ 1) * ABUF;
          u16* nV = sV + (cur ^ 1) * ABUF;
          *(u32x4*)(nK + kr * KROW + kc * 16) = rk[0];
          *(u32x4*)(nK + kr * KROW + kc * 16 + 8) = rk[1];
          *(u32x4*)(nK + kr * KROW + 64 + kc * 8) = rk[2];
          *(uint2*)(nV + kr * VR + kc * 16) = make_uint2(rv[0][0], rv[0][1]);
          *(uint2*)(nV + kr * VR + kc * 16 + 4) = make_uint2(rv[0][2], rv[0][3]);
          *(uint2*)(nV + kr * VR + kc * 16 + 8) = make_uint2(rv[1][0], rv[1][1]);
          *(uint2*)(nV + kr * VR + kc * 16 + 12) = make_uint2(rv[1][2], rv[1][3]);
          const int kn = (key0 + 128 < SEQ) ? (key0 + 128) : key0;
          rk[0] = *(const u32x4*)(knp + (size_t)kn * 512);
          rk[1] = *(const u32x4*)(knp + (size_t)kn * 512 + 8);
          rk[2] = *(const u32x4*)(kpp + (size_t)kn * 32);
          rv[0] = *(const u32x4*)(vpp + kn);
          rv[1] = *(const u32x4*)(vpp + kn + 8);
        }
        __builtin_amdgcn_sched_barrier(0);
        f32x16 S[2][2];
#pragma unroll
        for (int kt = 0; kt < 2; ++kt)
#pragma unroll
          for (int qt = 0; qt < 2; ++qt)
#pragma unroll
            for (int k = 0; k < 16; ++k) S[kt][qt][k] = -m[qt];
        __builtin_amdgcn_s_setprio(1);
#pragma unroll
        for (int ks = 0; ks < 6; ++ks)
#pragma unroll
          for (int kt = 0; kt < 2; ++kt) {
            bf16x8 fa = *(const bf16x8*)(cK + (kt * 32 + r) * KROW + ks * 16 + h * 8);
            S[kt][0] = MFMA(fa, bq[0][ks], S[kt][0]);
            S[kt][1] = MFMA(fa, bq[1][ks], S[kt][1]);
          }
        __builtin_amdgcn_s_setprio(0);
        bf16x8 pf[2][4];
#pragma unroll
        for (int qt = 0; qt < 2; ++qt) {
          float mloc = S[0][qt][0];
#pragma unroll
          for (int kt = 0; kt < 2; ++kt)
#pragma unroll
            for (int k = 0; k < 16; ++k) mloc = fmaxf(mloc, S[kt][qt][k]);
          {
            auto sw_ = __builtin_amdgcn_permlane32_swap(__float_as_uint(mloc), __float_as_uint(mloc), false, false);
            mloc = fmaxf(__uint_as_float(sw_[0]), __uint_as_float(sw_[1]));
          }
          if (__builtin_amdgcn_ballot_w64(mloc > 6.f) != 0ull) {
            const float delta = fmaxf(mloc, 0.f);
            const float alpha = __builtin_amdgcn_exp2f(-delta);
            m[qt] += delta;
            lsum[qt] *= alpha;
#pragma unroll
            for (int j = 0; j < 2; ++j)
#pragma unroll
              for (int k = 0; k < 16; ++k) O[j][qt][k] *= alpha;
#pragma unroll
            for (int kt = 0; kt < 2; ++kt)
#pragma unroll
              for (int k = 0; k < 16; ++k) S[kt][qt][k] -= delta;
          }
          float ps = 0.f;
#pragma unroll
          for (int kt = 0; kt < 2; ++kt)
#pragma unroll
            for (int k = 0; k < 16; ++k) { S[kt][qt][k] = __builtin_amdgcn_exp2f(S[kt][qt][k]); ps += S[kt][qt][k]; }
          lsum[qt] += ps;
#pragma unroll
          for (int s2 = 0; s2 < 4; ++s2) {
            const int kt = s2 >> 1, sx = s2 & 1;
            unsigned pw[4];
#pragma unroll
            for (int j = 0; j < 4; ++j) pw[j] = pk2(S[kt][qt][8 * sx + 2 * j], S[kt][qt][8 * sx + 2 * j + 1]);
            pf[qt][s2] = __builtin_bit_cast(bf16x8, make_uint4(pw[0], pw[1], pw[2], pw[3]));
          }
        }
#pragma unroll
        for (int s2 = 0; s2 < 4; ++s2) {
          const int kt = s2 >> 1, sx = s2 & 1;
#pragma unroll
          for (int dt = 0; dt < 2; ++dt) {
            const u16* vp = cV + (dt * 32 + r) * VR + kt * 32 + 16 * sx + 4 * h;
            uint2 lo = *(const uint2*)(vp);
            uint2 hi = *(const uint2*)(vp + 8);
            bf16x8 fv = __builtin_bit_cast(bf16x8, make_uint4(lo.x, lo.y, hi.x, hi.y));
            O[dt][0] = MFMA(fv, pf[0][s2], O[dt][0]);
            O[dt][1] = MFMA(fv, pf[1][s2], O[dt][1]);
          }
        }
        cur ^= 1;
        __syncthreads();
      }
#pragma unroll
      for (int qt = 0; qt < 2; ++qt) {
        const float lt = lsum[qt] + __shfl_xor(lsum[qt], 32);
        const float inv = 1.f / lt;
#pragma unroll
        for (int dt = 0; dt < 2; ++dt)
#pragma unroll
          for (int g4 = 0; g4 < 4; ++g4) {
            uint2 o;
            o.x = pk2(O[dt][qt][4 * g4 + 0] * inv, O[dt][qt][4 * g4 + 1] * inv);
            o.y = pk2(O[dt][qt][4 * g4 + 2] * inv, O[dt][qt][4 * g4 + 3] * inv);
            *(uint2*)(OA + (size_t)(q0 + qt * 32 + r) * 512 + hd * 64 + dt * 32 + 8 * g4 + 4 * h) = o;
          }
      }
    }
  };

  auto gla_out_phase = [&](int l) __attribute__((always_inline)) {
    char* ws = ws_ptr(p);
    const int t = opaque_tid();
    const int lane = t & 63, w = t >> 6, r = lane & 31, h = lane >> 5;
    const int wm = w >> 1, wn = w & 1;
    (void)lane; (void)r; (void)h; (void)wm; (void)wn;
    constexpr int QROW = 136;
    u16* sQ = smem;
    u16* sKt = smem + 64 * QROW;
    u16* sVT = smem + 2 * 64 * QROW;
    float* sred = (float*)(smem + 2 * 64 * QROW + 256 * LROW);
    u16* sO = smem;
    constexpr int OROW = 264;
    const float qs = 0.08838834764831845f;
    const int cs = w & 1, vh = w >> 1;
    for (int id = bid; id < NCHUNK * 4; id += G) {
      const int n = id >> 2, hd = id & 3;
      const int t0 = n * 64;
      __syncthreads();
      {
        const int cc = t & 63, part = t >> 6;
#pragma unroll
        for (int q = 0; q < 8; ++q) {
          const int cg8 = (part * 8 + q) * 8;
          uint4 v = *(const uint4*)(Z + (size_t)(t0 + cc) * ZLD + Z_GV + hd * 256 + cg8);
          unsigned u[4] = {v.x, v.y, v.z, v.w};
#pragma unroll
          for (int j = 0; j < 4; ++j) {
            sVT[(cg8 + 2 * j) * LROW + cc] = (u16)(u[j] & 0xffffu);
            sVT[(cg8 + 2 * j + 1) * LROW + cc] = (u16)(u[j] >> 16);
          }
        }
      }
      f32x16 acc[4];
#pragma unroll
      for (int j = 0; j < 4; ++j)
#pragma unroll
        for (int k = 0; k < 16; ++k) acc[j][k] = 0.f;
      for (int dir = 0; dir < 2; ++dir) {
        __syncthreads();
        {
          const int cc = t >> 2, dp = (t & 3) * 32;
          const u16* qp = Z + (size_t)(t0 + cc) * ZLD + Z_GQ + hd * 128 + dp;
          const u16* kp = Z + (size_t)(t0 + cc) * ZLD + Z_GK + hd * 128 + dp;
          const float* gp = GC + (size_t)dir * SEQ * 512 + (size_t)(t0 + cc) * 512 + hd * 128 + dp;
#pragma unroll
          for (int j = 0; j < 4; ++j) {
            uint4 qv = *(const uint4*)(qp + j * 8);
            uint4 kv = *(const uint4*)(kp + j * 8);
            float4 g0 = *(const float4*)(gp + j * 8);
            float4 g1 = *(const float4*)(gp + j * 8 + 4);
            const float gg[8] = {g0.x, g0.y, g0.z, g0.w, g1.x, g1.y, g1.z, g1.w};
            const unsigned qu[4] = {qv.x, qv.y, qv.z, qv.w};
            const unsigned ku[4] = {kv.x, kv.y, kv.z, kv.w};
            unsigned qo[4], ko[4];
#pragma unroll
            for (int k = 0; k < 4; ++k) {
              const float e0 = __expf(gg[2 * k]), e1 = __expf(gg[2 * k + 1]);
              qo[k] = pk2(bflo(qu[k]) * qs * e0, bfhi(qu[k]) * qs * e1);
              ko[k] = pk2(bflo(ku[k]) / e0, bfhi(ku[k]) / e1);
            }
            *(uint4*)(sQ + cc * QROW + dp + j * 8) = make_uint4(qo[0], qo[1], qo[2], qo[3]);
            *(uint4*)(sKt + cc * QROW + dp + j * 8) = make_uint4(ko[0], ko[1], ko[2], ko[3]);
            if (j == 1) __builtin_amdgcn_sched_barrier(0);
          }
        }
        __syncthreads();
        const u16* bqp = sQ + (cs * 32 + r) * QROW + h * 8;
        const u16* stp = ST + ((size_t)(n * 4 + hd) * 2 + dir) * 32768;
        bf16x8 fs[2][4];
#pragma unroll
        for (int ks = 0; ks < 4; ++ks) fs[0][ks] = *(const bf16x8*)(stp + (size_t)(vh * 128 + r) * 128 + ks * 16 + h * 8);
        f32x16 at[2];
#pragma unroll
        for (int et = 0; et < 2; ++et) {
#pragma unroll
          for (int k = 0; k < 16; ++k) at[et][k] = 0.f;
#pragma unroll
          for (int ks = 0; ks < 8; ++ks) {
            bf16x8 fa = *(const bf16x8*)(sKt + (et * 32 + r) * QROW + ks * 16 + h * 8);
            bf16x8 fbq = *(const bf16x8*)(bqp + ks * 16);
            at[et] = MFMA(fa, fbq, at[et]);
          }
          const int cidx = cs * 32 + r;
#pragma unroll
          for (int k = 0; k < 16; ++k) {
            const int e = et * 32 + crow(k, h);
            const bool keep = dir ? (e >= cidx) : (e <= cidx);
            at[et][k] = keep ? at[et][k] : 0.f;
          }
        }
#pragma unroll
        for (int s2 = 0; s2 < 4; ++s2) {
          const int et = s2 >> 1, s = s2 & 1;
          unsigned pw[4];
#pragma unroll
          for (int j = 0; j < 4; ++j) pw[j] = pk2(at[et][8 * s + 2 * j], at[et][8 * s + 2 * j + 1]);
          bf16x8 pf = __builtin_bit_cast(bf16x8, make_uint4(pw[0], pw[1], pw[2], pw[3]));
#pragma unroll
          for (int mt = 0; mt < 4; ++mt) {
            const u16* vp = sVT + (vh * 128 + mt * 32 + r) * LROW + et * 32 + 16 * s + 4 * h;
            uint2 lo = *(const uint2*)(vp);
            uint2 hi = *(const uint2*)(vp + 8);
            bf16x8 fv = __builtin_bit_cast(bf16x8, make_uint4(lo.x, lo.y, hi.x, hi.y));
            acc[mt] = MFMA(fv, pf, acc[mt]);
          }
        }
#pragma unroll
        for (int bb = 0; bb < 8; ++bb) {
          const int mt = bb >> 1, kb = bb & 1;
          if (bb + 1 < 8) {
            const int mt1 = (bb + 1) >> 1, kb1 = (bb + 1) & 1;
#pragma unroll
            for (int ks = 0; ks < 4; ++ks) fs[(bb + 1) & 1][ks] = *(const bf16x8*)(stp + (size_t)(vh * 128 + mt1 * 32 + r) * 128 + (kb1 * 4 + ks) * 16 + h * 8);
          }
          __builtin_amdgcn_sched_barrier(0);
#pragma unroll
          for (int ks = 0; ks < 4; ++ks) { bf16x8 fbq = *(const bf16x8*)(bqp + (kb * 4 + ks) * 16); acc[mt] = MFMA(fs[bb & 1][ks], fbq, acc[mt]); }
          __builtin_amdgcn_sched_barrier(0);
        }
      }
      float ss = 0.f;
#pragma unroll
      for (int mt = 0; mt < 4; ++mt)
#pragma unroll
        for (int k = 0; k < 16; ++k) ss += acc[mt][k] * acc[mt][k];
      ss += __shfl_xor(ss, 32);
      if (h == 0) sred[vh * 64 + cs * 32 + r] = ss;
      __syncthreads();
      const float rs = rsqrtf((sred[cs * 32 + r] + sred[64 + cs * 32 + r]) * (1.f / 256.f) + EPS);
#pragma unroll
      for (int mt = 0; mt < 4; ++mt)
#pragma unroll
        for (int g4 = 0; g4 < 4; ++g4) {
          uint2 o;
          o.x = pk2(acc[mt][4 * g4 + 0] * rs, acc[mt][4 * g4 + 1] * rs);
          o.y = pk2(acc[mt][4 * g4 + 2] * rs, acc[mt][4 * g4 + 3] * rs);
          *(uint2*)(sO + (cs * 32 + r) * OROW + vh * 128 + mt * 32 + 8 * g4 + 4 * h) = o;
        }
      __syncthreads();
      {
        const int t3 = opaque_tid();
        const int cc = t3 >> 2, vp0 = (t3 & 3) * 64;
        const float* ng = in_ptr(p, 17) + (size_t)l * 256;
        u32x4 gvp[8];
#pragma unroll
        for (int j = 0; j < 8; ++j) gvp[j] = *(const u32x4*)(Z + (size_t)(t0 + cc) * ZLD + Z_GOG + hd * 256 + vp0 + j * 8);
        __builtin_amdgcn_sched_barrier(0);
#pragma unroll
        for (int j = 0; j < 8; ++j) {
          const int v0 = vp0 + j * 8;
          uint4 ov = *(const uint4*)(sO + cc * OROW + v0);
          uint4 gv = make_uint4(gvp[j][0], gvp[j][1], gvp[j][2], gvp[j][3]);
          float4 n0 = *(const float4*)(ng + v0), n1 = *(const float4*)(ng + v0 + 4);
          const float nn[8] = {n0.x, n0.y, n0.z, n0.w, n1.x, n1.y, n1.z, n1.w};
          const unsigned ou[4] = {ov.x, ov.y, ov.z, ov.w};
          const unsigned gu[4] = {gv.x, gv.y, gv.z, gv.w};
          unsigned res[4];
#pragma unroll
          for (int k = 0; k < 4; ++k)
            res[k] = pk2(bflo(ou[k]) * nn[2 * k] * siluf_(bflo(gu[k])), bfhi(ou[k]) * nn[2 * k + 1] * siluf_(bfhi(gu[k])));
          *(uint4*)(OG + (size_t)(t0 + cc) * DM + hd * 256 + v0) = make_uint4(res[0], res[1], res[2], res[3]);
        }
      }
    }
  };

  auto merge_phase = [&]() __attribute__((always_inline)) {
    char* ws = ws_ptr(p);
    const int t = opaque_tid();
    const int lane = t & 63, w = t >> 6, r = lane & 31, h = lane >> 5;
    const int wm = w >> 1, wn = w & 1;
    (void)lane; (void)r; (void)h; (void)wm; (void)wn;
    const int MT = SEQ / 256, NT = DM / 128;
    for (int id = bid; id < MT * NT; id += G) {
      int tm, tn; tile_coords(id, MT, NT, tm, tn);
      const int m0 = tm * 256, n0 = tn * 128;
      Acc c; acc_zero(c);
      gemm_kloop(OA + (size_t)m0 * 512, 512, Wb + W_OA + (size_t)n0 * 512, 512, 512, smem, c);
      {
        const unsigned zbase = (unsigned)((m0 + wm * 128) * ZLD + Z_BG + n0 + wn * 64);
        const unsigned obase = (unsigned)((m0 + wm * 128) * DM + n0 + wn * 64);
        epi_store_pre<2, 1>(smem,
          [&](int mi, int ni, int i) { return c.a[mi][ni][i]; },
          [&](int row, int col, int q) { return *(const u32x4*)(Z + zbase + (unsigned)(row * ZLD + col)); },
          [&](int row, int col, u32x4 v, const u32x4* pre) {
            const u32x4 g = pre[0];
            u32x4 o;
#pragma unroll
            for (int k = 0; k < 4; ++k) o[k] = pk2(bflo(v[k]) * sigmoidf_(bflo(g[k])), bfhi(v[k]) * sigmoidf_(bfhi(g[k])));
            *(u32x4*)(MG + obase + (unsigned)(row * DM + col)) = o;
          });
      }
      acc_zero(c);
      gemm_kloop(OG + (size_t)m0 * DM, DM, Wb + W_OB + (size_t)n0 * DM, DM, DM, smem, c);
      {
        const int t2 = opaque_tid();
        const int wm2 = t2 >> 7, wn2 = (t2 >> 6) & 1;
        const unsigned zbase = (unsigned)((m0 + wm2 * 128) * ZLD + Z_BG + DM + n0 + wn2 * 64);
        const unsigned obase = (unsigned)((m0 + wm2 * 128) * DM + n0 + wn2 * 64);
        epi_store_pre<2, 2>(smem,
          [&](int mi, int ni, int i) { return c.a[mi][ni][i]; },
          [&](int row, int col, int q) {
            return q == 0 ? *(const u32x4*)(Z + zbase + (unsigned)(row * ZLD + col))
                          : *(const u32x4*)(MG + obase + (unsigned)(row * DM + col));
          },
          [&](int row, int col, u32x4 v, const u32x4* pre) {
            const u32x4 g = pre[0], pm = pre[1];
            u32x4 o;
#pragma unroll
            for (int k = 0; k < 4; ++k)
              o[k] = pk2(bflo(pm[k]) + bflo(v[k]) * sigmoidf_(bflo(g[k])), bfhi(pm[k]) + bfhi(v[k]) * sigmoidf_(bfhi(g[k])));
            *(u32x4*)(MG + obase + (unsigned)(row * DM + col)) = o;
          });
      }
    }
  };

  for (int i = bid * 256 + opaque_tid(); i < SEQ * 16; i += G * 256) {
    const int pos = i >> 4, j = i & 15;
    const float inv_freq = exp2f(-(float)j * 0.8304820237218406f);
    const float angf = (float)pos * inv_freq;
    double a = (double)angf;
    const double twopi = 6.283185307179586476925286766559;
    a -= twopi * rint(a / twopi);
    const float af = (float)a;
    ropec[i] = __cosf(af);
    ropes[i] = __sinf(af);
  }
  convert_weights(0);
  rn_pass(0, 0.f, nullptr, in_ptr(p, 2), 0, MALL);
  grid.sync();

  for (int l = 0; l < 4; ++l) {
    asm volatile("" : "+s"(bid));
    char* ws = ws_ptr(p);
    ffn_in(W_FFN1_IN);
#ifdef DUP_FFNIN
    xcd_barrier(xb);
    ffn_in(W_FFN1_IN);
#endif
    xcd_barrier(xb);
    gemm_plain(ACT, DFF, DFF, Wb + W_FFN1_OUT, Yb, DM, MALL, DM);
    xcd_barrier(xb);
    rn_pass(1, 0.5f, in_ptr(p, 5) + l * DM, in_ptr(p, 6) + l * DM, 0, SEQ);
    xcd_barrier(xb);
    for (int s = 0; s < NSEQ; ++s) {
      asm volatile("" : "+s"(bid));
      char* ws = ws_ptr(p);
      {
        const float coefx = (s == 0) ? 0.5f : 1.0f;
        const float* postx = ((s == 0) ? in_ptr(p, 5) : in_ptr(p, 20)) + l * DM;
        const float* prex = ((s == 0) ? in_ptr(p, 6) : in_ptr(p, 21)) + l * DM;
        const int r0x = (s == 0) ? SEQ : (s - 1) * SEQ, r1x = (s == 0) ? 3 * SEQ : s * SEQ;
        int bq_ = bid; asm volatile("" : "+s"(bq_));
        for (int step_ = 0; step_ < 2; ++step_) {
          int sel_ = (step_ ^ bq_) & 1; asm volatile("" : "+s"(sel_));
          if (sel_) rn_pass(1, coefx, postx, prex, r0x, r1x);
          else gemm_plain(Hb + (size_t)s * SEQ * DM, DM, DM, Wb + W_IN, Z, ZLD, SEQ, ZLD);
        }
      }
      xcd_barrier(xb);
      prep_phase(l);
#ifdef DUP_PREP
      xcd_barrier(xb);
      prep_phase(l);
#endif
      xcd_barrier(xb);
      attn_phase(1);
      xcd_barrier(xb);
      int bpar_ = bid; asm volatile("" : "+s"(bpar_));
      if (bpar_ & 1) { attn_phase(2); gla_out_phase(l); }
      else { gla_out_phase(l); attn_phase(2); }
      xcd_barrier(xb);
      merge_phase();
      xcd_barrier(xb);
      gemm_plain(MG, DM, DM, Wb + W_OUT, Yb + (size_t)s * SEQ * DM, DM, SEQ, DM);
      xcd_barrier(xb);
    }
    rn_pass(1, 1.0f, in_ptr(p, 20) + l * DM, in_ptr(p, 21) + l * DM, 2 * SEQ, 3 * SEQ);
    xcd_barrier(xb);
    ffn_in(W_FFN2_IN);
    xcd_barrier(xb);
    gemm_plain(ACT, DFF, DFF, Wb + W_FFN2_OUT, Yb, DM, MALL, DM);
    xcd_barrier(xb);
    rn_pass(1, 0.5f, in_ptr(p, 24) + l * DM, (l < 3) ? (in_ptr(p, 2) + (l + 1) * DM) : nullptr, 0, MALL);
    if (l < 3) convert_weights(l + 1);
    xcd_barrier(xb);
  }
}

extern "C" void kernel_launch(void* const* d_in, const int* in_sizes, int n_in, void* d_out,
                              int out_size, void* d_ws, size_t ws_size, hipStream_t stream) {
  static int grid_blocks = 0;
  if (!grid_blocks) {
    int dev = 0, cus = 0, per_cu = 0;
    (void)hipGetDevice(&dev);
    (void)hipDeviceGetAttribute(&cus, hipDeviceAttributeMultiprocessorCount, dev);
    (void)hipOccupancyMaxActiveBlocksPerMultiprocessor(&per_cu, fwd_megakernel, 256, 0);
    if (per_cu > 2) per_cu = 2;
    if (per_cu < 1) per_cu = 1;
    grid_blocks = cus * per_cu;
  }
  Params p{};
  for (int i = 0; i < 25; ++i) p.in[i] = (const float*)d_in[i];
  p.out = (float*)d_out;
  p.ws = (char*)d_ws;
  (void)hipMemsetAsync((char*)d_ws + OFF_BAR, 0, XCD_BAR_WORDS * 4, stream);
  void* args[] = {&p};
  hipError_t e = hipLaunchCooperativeKernel((void*)fwd_megakernel, dim3(grid_blocks), dim3(256), args, 0, stream);
  if (e != hipSuccess) fprintf(stderr, "cooperative launch failed: %s (grid %d)\n", hipGetErrorString(e), grid_blocks);
}
```

```cpp
#include <hip/hip_runtime.h>
#include <hip/hip_cooperative_groups.h>
#include <cstdio>
namespace cg = cooperative_groups;

typedef unsigned short u16;
typedef short bf16x8 __attribute__((ext_vector_type(8)));
typedef short s16x4 __attribute__((ext_vector_type(4)));
typedef float f32x16 __attribute__((ext_vector_type(16)));
typedef __bf16 bf2_t __attribute__((ext_vector_type(2)));
typedef float f2_t __attribute__((ext_vector_type(2)));
typedef unsigned u32x4 __attribute__((ext_vector_type(4)));
#define DI __device__ __forceinline__
#define MFMA(a, b, c) __builtin_amdgcn_mfma_f32_32x32x16_bf16((a), (b), (c), 0, 0, 0)

constexpr int SEQ = 16384;
constexpr int NSEQ = 3;
constexpr int MALL = SEQ * NSEQ;
constexpr int DM = 1024;
constexpr int DFF = 2816;
constexpr int NFF2 = 5632;
constexpr int PIN = 5568;
constexpr int ZLD = 5632;
constexpr int Z_CQ = 0, Z_CKV = 256, Z_KPE = 384, Z_GQ = 416, Z_GK = 928, Z_GV = 1440, Z_GA = 2464, Z_GOG = 2496, Z_BG = 3520;
constexpr float EPS = 1e-6f;
constexpr int NCHUNK = SEQ / 64;

constexpr size_t W_FFN1_IN = 0;
constexpr size_t W_FFN1_OUT = W_FFN1_IN + (size_t)NFF2 * DM;
constexpr size_t W_IN = W_FFN1_OUT + (size_t)DM * DFF;
constexpr size_t W_UQ = W_IN + (size_t)ZLD * DM;
constexpr size_t W_KN = W_UQ + (size_t)768 * 256;
constexpr size_t W_V = W_KN + (size_t)512 * 128;
constexpr size_t W_OA = W_V + (size_t)512 * 128;
constexpr size_t W_OB = W_OA + (size_t)DM * 512;
constexpr size_t W_OUT = W_OB + (size_t)DM * DM;
constexpr size_t W_FFN2_IN = W_OUT + (size_t)DM * DM;
constexpr size_t W_FFN2_OUT = W_FFN2_IN + (size_t)NFF2 * DM;
constexpr size_t W_END = W_FFN2_OUT + (size_t)DM * DFF;

constexpr size_t al256(size_t x) { return (x + 255) & ~(size_t)255; }
constexpr size_t OFF_WB = 0;
constexpr size_t OFF_ROPE = al256(OFF_WB + W_END * 2);
constexpr size_t OFF_H = al256(OFF_ROPE + (size_t)SEQ * 32 * 4);
constexpr size_t OFF_Y = al256(OFF_H + (size_t)MALL * DM * 2);
constexpr size_t OFF_ACT = al256(OFF_Y + (size_t)MALL * DM * 2);
constexpr size_t OFF_Z = OFF_ACT;
constexpr size_t OFF_Q = al256(OFF_Z + (size_t)SEQ * ZLD * 2);
constexpr size_t OFF_KN = al256(OFF_Q + (size_t)SEQ * 768 * 2);
constexpr size_t OFF_VT = al256(OFF_KN + (size_t)SEQ * 512 * 2);
constexpr size_t OFF_KPE = al256(OFF_VT + (size_t)SEQ * 512 * 2);
constexpr size_t OFF_OA = al256(OFF_KPE + (size_t)SEQ * 32 * 2);
constexpr size_t OFF_MIXEND = al256(OFF_OA + (size_t)SEQ * 512 * 2);
constexpr size_t OFF_ACTEND = al256(OFF_ACT + (size_t)MALL * DFF * 2);
static_assert(OFF_MIXEND <= OFF_ACTEND, "mixer scratch must fit in act");
constexpr size_t OFF_ST = OFF_ACTEND;
constexpr size_t OFF_DEC = al256(OFF_ST + (size_t)NCHUNK * 4 * 2 * 256 * 128 * 2);
constexpr size_t OFF_GC = al256(OFF_DEC + (size_t)NCHUNK * 4 * 2 * 128 * 4);
constexpr size_t OFF_OG = al256(OFF_GC + (size_t)2 * SEQ * 512 * 4);
constexpr size_t OFF_MG = al256(OFF_OG + (size_t)SEQ * DM * 2);
constexpr size_t OFF_END = al256(OFF_MG + (size_t)SEQ * DM * 2);
constexpr size_t OFF_BAR = OFF_END;
static_assert(OFF_BAR + 16384 <= (size_t)768 * 1024 * 1024, "workspace overflow");

struct Params {
  const float* in[25];
  float* out;
  char* ws;
};

DI unsigned pk2(float a, float b) { f2_t v = {a, b}; return __builtin_bit_cast(unsigned, __builtin_convertvector(v, bf2_t)); }
DI u16 f2bf(float a) { return (u16)(pk2(a, 0.f) & 0xffffu); }
DI float bf2f(u16 v) { return __uint_as_float(((unsigned)v) << 16); }
DI float bflo(unsigned v) { return __uint_as_float(v << 16); }
DI float bfhi(unsigned v) { return __uint_as_float(v & 0xffff0000u); }
DI float wave_sum(float v) {
#pragma unroll
  for (int o = 32; o >= 1; o >>= 1) v += __shfl_xor(v, o);
  return v;
}
DI int opaque_tid() { int t = threadIdx.x; asm volatile("" : "+v"(t)); return t; }
DI const float* in_ptr(const Params& p, int k) { asm volatile("" : "+s"(k)); return p.in[k]; }
DI char* ws_ptr(const Params& p) { long z = 0; asm volatile("" : "+s"(z)); return p.ws + z; }
DI float* out_ptr(const Params& p) { long z = 0; asm volatile("" : "+s"(z)); return p.out + z; }
DI int crow(int i, int h) { return (i & 3) + 8 * (i >> 2) + 4 * h; }
DI float sigmoidf_(float x) { return 1.f / (1.f + __expf(-x)); }
DI float siluf_(float x) { return x / (1.f + __expf(-x)); }


#define XB_TMO      128
#define XB_XCNT(j)  (256  + 64 * (j))
#define XB_XSUB(j)  (1280 + 64 * (j))
#define XB_XGEN(j)  (2304 + 64 * (j))
#define XB_TOP      3328
#define XB_TOPGEN   3392
#define XCD_BAR_WORDS 3456
#define XB_SPIN_CAP (1u << 18)
#define LAS __attribute__((address_space(3)))

__device__ __forceinline__ unsigned xb_ld(unsigned* p)              { return __hip_atomic_load(p, __ATOMIC_RELAXED, __HIP_MEMORY_SCOPE_AGENT); }
__device__ __forceinline__ unsigned xb_add(unsigned* p, unsigned v) { return __hip_atomic_fetch_add(p, v, __ATOMIC_RELAXED, __HIP_MEMORY_SCOPE_AGENT); }
__device__ __forceinline__ unsigned xb_xcc_id() { return (unsigned)__builtin_amdgcn_s_getreg((3 << 11) | 20) & 0xFu; }
#define XB_SPIN(cond, bar) do { unsigned _sp = 0; while (cond) { __builtin_amdgcn_s_sleep(1); \
    if ((++_sp & 255u) == 0u) { if (xb_ld(&(bar)[XB_TMO])) break; if (_sp > XB_SPIN_CAP) { atomicAdd(&(bar)[XB_TMO], 1u); break; } } } } while (0)

struct XcdBarrier {
    unsigned* bar; unsigned x;
    volatile LAS unsigned* st;
};

__device__ __forceinline__ XcdBarrier xcd_barrier_post(unsigned* bar, volatile LAS unsigned* st) {
    XcdBarrier b; b.bar = bar; b.x = xb_xcc_id(); b.st = st;
    if (threadIdx.x == 0) (void)xb_add(&bar[XB_XCNT(b.x)], 1u);
    return b;
}
__device__ __forceinline__ void xcd_barrier_complete(unsigned* bar, unsigned x, unsigned& nloc, unsigned& nx) {
    const unsigned G = gridDim.x * gridDim.y * gridDim.z;
    unsigned sum, cnt, mine, sp = 0u;
    for (;;) {
        sum = 0u; cnt = 0u; mine = 0u;
#pragma unroll
        for (unsigned j = 0; j < 16; ++j) { const unsigned c = xb_ld(&bar[XB_XCNT(j)]); sum += c; cnt += (c > 0u) ? 1u : 0u; mine = (j == x) ? c : mine; }
        if (sum == G) break;
        __builtin_amdgcn_s_sleep(1);
        if ((++sp & 255u) == 0u) { if (xb_ld(&bar[XB_TMO])) break; if (sp > XB_SPIN_CAP) { atomicAdd(&bar[XB_TMO], 1u); break; } }
    }
    nloc = mine > 0u ? mine : 1u; nx = cnt > 0u ? cnt : 1u;
}

__device__ __forceinline__ void xcd_barrier(const XcdBarrier& b) {
    asm volatile("s_waitcnt vmcnt(0)" ::: "memory");
    __syncthreads();
    int tid0_ = threadIdx.x; asm volatile("" : "+v"(tid0_));
    if (tid0_ == 0) {
        unsigned* bar = b.bar; asm volatile("" : "+s"(bar));
        unsigned bx_ = b.x; asm volatile("" : "+s"(bx_));
        __builtin_amdgcn_s_waitcnt(0);
        unsigned nloc = b.st[0], nx = b.st[1];
        if (nloc == 0u) { xcd_barrier_complete(bar, bx_, nloc, nx); b.st[0] = nloc; b.st[1] = nx; }
        const unsigned old = xb_add(&bar[XB_XSUB(bx_)], 1u);
        const unsigned gen = old / nloc;
        if (old + 1u == (gen + 1u) * nloc) {
            __builtin_amdgcn_fence(__ATOMIC_RELEASE, "agent");
            asm volatile("s_waitcnt vmcnt(0)" ::: "memory");
            const unsigned og = xb_add(&bar[XB_TOP], 1u);
            const unsigned tg = og / nx;
            if (og + 1u == (tg + 1u) * nx) xb_add(&bar[XB_TOPGEN], 1u);
            else XB_SPIN(xb_ld(&bar[XB_TOPGEN]) == tg, bar);
            __builtin_amdgcn_fence(__ATOMIC_ACQUIRE, "agent");
            xb_add(&bar[XB_XGEN(bx_)], 1u);
            asm volatile("s_waitcnt vmcnt(0)" ::: "memory");
        } else {
            XB_SPIN(xb_ld(&bar[XB_XGEN(bx_)]) == gen, bar);
            __builtin_amdgcn_fence(__ATOMIC_ACQUIRE, "agent");
            asm volatile("s_waitcnt vmcnt(0)" ::: "memory");
        }
    }
    __syncthreads();
}

constexpr int LROW = 72;
constexpr int GEMM_LDS = 2 * 128 * LROW * 2;

struct Acc { f32x16 a[4][2]; };

DI void acc_zero(Acc& c) {
#pragma unroll
  for (int i = 0; i < 4; ++i)
#pragma unroll
    for (int j = 0; j < 2; ++j)
#pragma unroll
      for (int k = 0; k < 16; ++k) c.a[i][j][k] = 0.f;
}

DI void gll16_asm(const void* g, unsigned lds_addr) {
  asm volatile("s_mov_b32 m0, %1\n\ts_nop 0\n\tglobal_load_lds_dwordx4 %0, off" :: "v"(g), "s"(lds_addr) : "memory", "m0");
}
DI void gll16_asm_s(const void* base, unsigned voff, unsigned lds_addr) {
  asm volatile("s_mov_b32 m0, %2\n\ts_nop 0\n\tglobal_load_lds_dwordx4 %1, %0" :: "s"(base), "v"(voff), "s"(lds_addr) : "memory", "m0");
}
DI void gll16(const u16* g, char* l) {
  __builtin_amdgcn_global_load_lds((const __attribute__((address_space(1))) unsigned*)g,
                                   (__attribute__((address_space(3))) unsigned*)l, 16, 0, 0);
}
DI void gemm_kloop(const u16* __restrict__ A, int lda, const u16* __restrict__ B, int ldb, int K, u16* smem, Acc& c) {
  const int t = opaque_tid();
  const int lane = t & 63, w = t >> 6, r = lane & 31, h = lane >> 5;
  const int wm = w >> 1, wn = w & 1;
  char* lds = (char*)smem;
  const int nk = K >> 5;
  const int w_s = __builtin_amdgcn_readfirstlane(w);
  const unsigned ldsw_u = __builtin_amdgcn_readfirstlane((unsigned)(size_t)lds) + (unsigned)w_s * 1024u;
  const int row0 = t >> 2, c0 = t & 3;
  const int sw0 = (c0 ^ ((row0 >> 2) & 3)) * 8;
  const unsigned voa = (unsigned)(row0 * lda + sw0) * 2u;
  const unsigned vob = (unsigned)(row0 * ldb + sw0) * 2u;
  const unsigned a64 = 128u * (unsigned)lda, b64 = 128u * (unsigned)ldb;
  const unsigned vo0 = voa, vo1 = voa + a64, vo2 = voa + 2u * a64, vo3 = voa + 3u * a64, vo4 = vob, vo5 = vob + b64;
  const char* gA = (const char*)A;
  const char* gB = (const char*)B;
#define GEMM_ISSUE(kt_, st_)                                         \
  do {                                                               \
    const unsigned sp_ = ldsw_u + (unsigned)((st_) * 24576);         \
    gll16_asm_s(gA, vo0, sp_);                                       \
    gll16_asm_s(gA, vo1, sp_ + 4096u);                               \
    gll16_asm_s(gA, vo2, sp_ + 8192u);                               \
    gll16_asm_s(gA, vo3, sp_ + 12288u);                              \
    gll16_asm_s(gB, vo4, sp_ + 16384u);                              \
    gll16_asm_s(gB, vo5, sp_ + 20480u);                              \
    const int inc_ = ((kt_) + 1 < nk) ? 64 : 0;                      \
    gA += inc_; gB += inc_;                                          \
  } while (0)
  __syncthreads();
  GEMM_ISSUE(0, 0);
  GEMM_ISSUE(1, 1);
  const int fsw = (r >> 2) & 3;
  const int aoff = (wm * 128 + r) * 64, boff = 16384 + (wn * 64 + r) * 64;
  const char* pa0 = lds + aoff + ((0 + h) ^ fsw) * 16;
  const char* pa1 = lds + aoff + ((2 + h) ^ fsw) * 16;
  const char* pb0 = lds + boff + ((0 + h) ^ fsw) * 16;
  const char* pb1 = lds + boff + ((2 + h) ^ fsw) * 16;
  int scur = 0, snext = 2;
  for (int kt = 0; kt < nk; ++kt) {
    asm volatile("s_waitcnt vmcnt(6)" ::: "memory");
    __builtin_amdgcn_s_barrier();
    asm volatile("" ::: "memory");
    GEMM_ISSUE(kt + 2, snext);
    __builtin_amdgcn_sched_barrier(0);
    const int so = scur * 24576;
    {
      bf16x8 fa[4], fb[2];
#pragma unroll
      for (int i = 0; i < 4; ++i) fa[i] = *(const bf16x8*)(pa0 + so + i * 2048);
#pragma unroll
      for (int i = 0; i < 2; ++i) fb[i] = *(const bf16x8*)(pb0 + so + i * 2048);
#pragma unroll
      for (int i = 0; i < 4; ++i)
#pragma unroll
        for (int j = 0; j < 2; ++j) c.a[i][j] = MFMA(fa[i], fb[j], c.a[i][j]);
#pragma unroll
      for (int i = 0; i < 4; ++i) fa[i] = *(const bf16x8*)(pa1 + so + i * 2048);
#pragma unroll
      for (int i = 0; i < 2; ++i) fb[i] = *(const bf16x8*)(pb1 + so + i * 2048);
#pragma unroll
      for (int i = 0; i < 4; ++i)
#pragma unroll
        for (int j = 0; j < 2; ++j) c.a[i][j] = MFMA(fa[i], fb[j], c.a[i][j]);
    }
    __builtin_amdgcn_sched_barrier(0);
    snext = scur;
    scur = (scur == 2) ? 0 : scur + 1;
  }
  asm volatile("s_waitcnt vmcnt(0)" ::: "memory");
  __builtin_amdgcn_s_barrier();
  asm volatile("" ::: "memory");
#undef GEMM_ISSUE
}

DI void row_scales(const u16* __restrict__ base, int ld, int K, float* sc, int NR) {
  const int t = opaque_tid();
  const int row = (NR == 256) ? t : (t >> 1);
  const int part = (NR == 256) ? 0 : (t & 1);
  const int len = (NR == 256) ? K : (K / 2);
  const u16* p = base + (size_t)row * ld + part * len;
  float ss = 0.f;
  for (int i = 0; i < len / 8; ++i) {
    u32x4 v = *(const u32x4*)(p + i * 8);
#pragma unroll
    for (int j = 0; j < 4; ++j) { float a = bflo(v[j]), b = bfhi(v[j]); ss += a * a + b * b; }
  }
  if (NR != 256) ss += __shfl_xor(ss, 1);
  if (part == 0) sc[row] = rsqrtf(ss / (float)K + EPS);
}


template <int NI, class V, class R>
DI void epi_store(u16* smem, V val, R rowfn) {
  const int t = opaque_tid();
  const int lane = t & 63, w = t >> 6, r = lane & 31, h = lane >> 5;
  char* reg = (char*)smem + w * 18432;
#pragma unroll
  for (int mi = 0; mi < 4; ++mi)
#pragma unroll
    for (int ni = 0; ni < NI; ++ni)
#pragma unroll
      for (int i = 0; i < 16; ++i)
        *(u16*)(reg + (mi * 32 + crow(i, h)) * 144 + (ni * 32 + r) * 2) = f2bf(val(mi, ni, i));
  __builtin_amdgcn_sched_barrier(0);
  constexpr int CPR = NI * 4;
  constexpr int RPI = 64 / CPR;
  const int rr = lane / CPR, ch = lane % CPR;
#pragma unroll
  for (int k = 0; k < 128 / RPI; ++k) {
    const int row = k * RPI + rr;
    u32x4 v = *(const u32x4*)(reg + row * 144 + ch * 16);
    rowfn(row, ch * 8, v);
  }
}


template <int NI, int NPRE, class V, class L, class R>
DI void epi_store_pre(u16* smem, V val, L loadfn, R rowfn) {
  const int t = opaque_tid();
  const int lane = t & 63, w = t >> 6, r = lane & 31, h = lane >> 5;
  char* reg = (char*)smem + w * 18432;
#pragma unroll
  for (int mi = 0; mi < 4; ++mi)
#pragma unroll
    for (int ni = 0; ni < NI; ++ni)
#pragma unroll
      for (int i = 0; i < 16; ++i)
        *(u16*)(reg + (mi * 32 + crow(i, h)) * 144 + (ni * 32 + r) * 2) = f2bf(val(mi, ni, i));
  __builtin_amdgcn_sched_barrier(0);
  constexpr int CPR = NI * 4;
  constexpr int RPI = 64 / CPR;
  constexpr int NK = 128 / RPI;
  const int rr = lane / CPR, ch = lane % CPR;
  u32x4 pre[NK][NPRE];
#pragma unroll
  for (int k = 0; k < NK; ++k)
#pragma unroll
    for (int q = 0; q < NPRE; ++q) pre[k][q] = loadfn(k * RPI + rr, ch * 8, q);
  __builtin_amdgcn_sched_barrier(0);
#pragma unroll
  for (int k = 0; k < NK; ++k) {
    const int row = k * RPI + rr;
    u32x4 v = *(const u32x4*)(reg + row * 144 + ch * 16);
    rowfn(row, ch * 8, v, pre[k]);
  }
}

DI void tile_coords(int id, int MT, int NT, int& tm, int& tn) {
  const int per = 32 * NT;
  const int sr = id / per, rem = id - sr * per;
  tn = rem >> 5;
  tm = sr * 32 + (rem & 31);
}

#define EPI_LOOP                                   \
  _Pragma("unroll") for (int mi = 0; mi < 4; ++mi) \
  _Pragma("unroll") for (int ni = 0; ni < 2; ++ni) \
  _Pragma("unroll") for (int i = (__builtin_amdgcn_sched_barrier(0), 0); i < 16; ++i)

constexpr int SMEM_BYTES = 74752;

__global__ void __launch_bounds__(256, 2) fwd_megakernel(Params p) {
  cg::grid_group grid = cg::this_grid();
  __shared__ __attribute__((aligned(16))) char smem_raw[SMEM_BYTES];
  u16* smem = (u16*)smem_raw;
  const int G = gridDim.x;
  int bid = blockIdx.x;
  __shared__ uint4 xb_words;
  if (threadIdx.x == 0) xb_words = make_uint4(0u, 0u, 0u, 0u);
  __syncthreads();
  XcdBarrier xb = xcd_barrier_post((unsigned*)(p.ws + OFF_BAR), (volatile LAS unsigned*)&xb_words);

  char* ws = p.ws;
#define Wb ((u16*)(ws + OFF_WB))
#define ropec ((float*)(ws + OFF_ROPE))
#define ropes (((float*)(ws + OFF_ROPE)) + SEQ * 16)
#define Hb ((u16*)(ws + OFF_H))
#define Yb ((u16*)(ws + OFF_Y))
#define ACT ((u16*)(ws + OFF_ACT))
#define Z ((u16*)(ws + OFF_Z))
#define Qb ((u16*)(ws + OFF_Q))
#define KN ((u16*)(ws + OFF_KN))
#define VT ((u16*)(ws + OFF_VT))
#define KPE ((u16*)(ws + OFF_KPE))
#define OA ((u16*)(ws + OFF_OA))
#define ST ((u16*)(ws + OFF_ST))
#define DEC ((float*)(ws + OFF_DEC))
#define GC ((float*)(ws + OFF_GC))
#define OG ((u16*)(ws + OFF_OG))
#define MG ((u16*)(ws + OFF_MG))
  float* X = p.out;

  auto convert_weights = [&](int l) __attribute__((always_inline)) {
    char* ws = ws_ptr(p);
    const int t = opaque_tid();
    const int lane = t & 63, w = t >> 6, r = lane & 31, h = lane >> 5;
    const int wm = w >> 1, wn = w & 1;
    (void)lane; (void)r; (void)h; (void)wm; (void)wn;
    float* tile = (float*)smem_raw;
    for (int mat = 0; mat < 11; ++mat) {
      const float* src; int K, N; size_t dst; int map; const float* ksc = nullptr;
      switch (mat) {
        case 0: src = in_ptr(p, 3) + (size_t)l * DM * NFF2; K = DM; N = NFF2; dst = W_FFN1_IN; map = 1; break;
        case 1: src = in_ptr(p, 4) + (size_t)l * DFF * DM; K = DFF; N = DM; dst = W_FFN1_OUT; map = 0; break;
        case 2: src = in_ptr(p, 7) + (size_t)l * DM * PIN; K = DM; N = PIN; dst = W_IN; map = 0; break;
        case 3: src = in_ptr(p, 9) + (size_t)l * 256 * 768; K = 256; N = 768; dst = W_UQ; map = 0; ksc = in_ptr(p, 8) + l * 256; break;
        case 4: src = in_ptr(p, 11) + (size_t)l * 128 * 1024; K = 128; N = 1024; dst = W_KN; map = 2; ksc = in_ptr(p, 10) + l * 128; break;
        case 5: src = in_ptr(p, 12) + (size_t)l * 512 * DM; K = 512; N = DM; dst = W_OA; map = 0; break;
        case 6: src = in_ptr(p, 18) + (size_t)l * DM * DM; K = DM; N = DM; dst = W_OB; map = 0; break;
        case 7: src = in_ptr(p, 19) + (size_t)l * DM * DM; K = DM; N = DM; dst = W_OUT; map = 0; break;
        case 8: src = in_ptr(p, 22) + (size_t)l * DM * NFF2; K = DM; N = NFF2; dst = W_FFN2_IN; map = 1; break;
        case 9: src = in_ptr(p, 23) + (size_t)l * DFF * DM; K = DFF; N = DM; dst = W_FFN2_OUT; map = 0; break;
        default: src = nullptr; K = DM; N = 64; dst = W_IN + (size_t)PIN * DM; map = 3; break;
      }
      const int kt_n = K / 64, nt_n = N / 64;
      for (int id = bid; id < kt_n * nt_n; id += G) {
        const int kt = id % kt_n, nt = id / kt_n;
        const int k0 = kt * 64, n0 = nt * 64;
        __syncthreads();
        if (map != 3) {
#pragma unroll
          for (int i = 0; i < 4; ++i) {
            const int kk = (t >> 4) + 16 * i, nn = (t & 15) * 4;
            float4 v = *(const float4*)(src + (size_t)(k0 + kk) * N + n0 + nn);
            float sc = ksc ? ksc[k0 + kk] : 1.f;
            tile[kk * 65 + nn + 0] = v.x * sc; tile[kk * 65 + nn + 1] = v.y * sc;
            tile[kk * 65 + nn + 2] = v.z * sc; tile[kk * 65 + nn + 3] = v.w * sc;
          }
        }
        __syncthreads();
        const int nl = t >> 2, kc = (t & 3) * 16;
        const int n = n0 + nl;
        size_t drow;
        if (map == 0) drow = dst + (size_t)n * K;
        else if (map == 1) { const int isb = n >= DFF; const int j = n - isb * DFF; drow = dst + (size_t)((j >> 5) * 64 + isb * 32 + (j & 31)) * K; }
        else if (map == 2) { const int hd = n >> 7, cc = n & 127; drow = (cc < 64) ? (W_KN + (size_t)(hd * 64 + cc) * K) : (W_V + (size_t)(hd * 64 + cc - 64) * K); }
        else drow = dst + (size_t)nl * K;
        unsigned o[8];
#pragma unroll
        for (int j = 0; j < 8; ++j) {
          float a = (map == 3) ? 0.f : tile[(kc + 2 * j) * 65 + nl];
          float b = (map == 3) ? 0.f : tile[(kc + 2 * j + 1) * 65 + nl];
          o[j] = pk2(a, b);
        }
        uint4* dp = (uint4*)(Wb + drow + k0 + kc);
        dp[0] = make_uint4(o[0], o[1], o[2], o[3]);
        dp[1] = make_uint4(o[4], o[5], o[6], o[7]);
      }
    }
  };

  auto rn_pass = [&](int mode, float coef, const float* post_g, const float* pre_g, int r0, int r1) __attribute__((always_inline)) {
    char* ws = ws_ptr(p);
    float* X = out_ptr(p);
    const int t = opaque_tid();
    const int lane = t & 63, w = t >> 6, r = lane & 31, h = lane >> 5;
    const int wm = w >> 1, wn = w & 1;
    (void)lane; (void)r; (void)h; (void)wm; (void)wn;
    typedef float f4v __attribute__((ext_vector_type(4)));
    typedef unsigned u2v __attribute__((ext_vector_type(2)));
    const int gw = bid * 4 + w, nw = G * 4;
    constexpr int RB = 4;
    f4v pg[4], qg[4];
#pragma unroll
    for (int i = 0; i < 4; ++i) {
      pg[i] = (mode == 1) ? *(const f4v*)(post_g + lane * 4 + 256 * i) : (f4v){0.f, 0.f, 0.f, 0.f};
      qg[i] = pre_g ? *(const f4v*)(pre_g + lane * 4 + 256 * i) : (f4v){0.f, 0.f, 0.f, 0.f};
    }
    for (int row0 = r0 + gw; row0 < r1; row0 += RB * nw) {
      f4v xv[RB][4];
      u2v yu[RB][4];
#pragma unroll
      for (int j = 0; j < RB; ++j) {
        int row = row0 + j * nw;
        if (row >= r1) row = row0;
        const float* xs;
        if (mode == 0) xs = (row < SEQ) ? (in_ptr(p, 0) + (size_t)row * DM) : (in_ptr(p, 1) + (size_t)(row - SEQ) * DM);
        else xs = X + (size_t)row * DM;
#pragma unroll
        for (int i = 0; i < 4; ++i) xv[j][i] = *(const f4v*)(xs + lane * 4 + 256 * i);
        if (mode == 1) {
#pragma unroll
          for (int i = 0; i < 4; ++i) yu[j][i] = *(const u2v*)(Yb + (size_t)row * DM + lane * 4 + 256 * i);
        }
      }
#pragma unroll
      for (int j = 0; j < RB; ++j) {
        const int row = row0 + j * nw;
        if (row < r1) {
          if (mode == 1) {
            float yv[16];
            float ss = 0.f;
#pragma unroll
            for (int i = 0; i < 4; ++i) {
              yv[4 * i + 0] = bflo(yu[j][i][0]); yv[4 * i + 1] = bfhi(yu[j][i][0]);
              yv[4 * i + 2] = bflo(yu[j][i][1]); yv[4 * i + 3] = bfhi(yu[j][i][1]);
            }
#pragma unroll
            for (int i = 0; i < 16; ++i) ss += yv[i] * yv[i];
            ss = wave_sum(ss);
            const float ry = rsqrtf(ss * (1.f / DM) + EPS) * coef;
#pragma unroll
            for (int i = 0; i < 4; ++i)
#pragma unroll
              for (int k = 0; k < 4; ++k) xv[j][i][k] += yv[4 * i + k] * ry * pg[i][k];
          }
#pragma unroll
          for (int i = 0; i < 4; ++i) *(f4v*)(X + (size_t)row * DM + lane * 4 + 256 * i) = xv[j][i];
          if (pre_g) {
            float ss = 0.f;
#pragma unroll
            for (int i = 0; i < 4; ++i)
#pragma unroll
              for (int k = 0; k < 4; ++k) ss += xv[j][i][k] * xv[j][i][k];
            ss = wave_sum(ss);
            const float rx = rsqrtf(ss * (1.f / DM) + EPS);
#pragma unroll
            for (int i = 0; i < 4; ++i) {
              u2v o;
              o[0] = pk2(xv[j][i][0] * rx * qg[i][0], xv[j][i][1] * rx * qg[i][1]);
              o[1] = pk2(xv[j][i][2] * rx * qg[i][2], xv[j][i][3] * rx * qg[i][3]);
              *(u2v*)(Hb + (size_t)row * DM + lane * 4 + 256 * i) = o;
            }
          }
        }
      }
    }
  };

  auto ffn_in = [&](size_t woff) __attribute__((always_inline)) {
    char* ws = ws_ptr(p);
    const int t = opaque_tid();
    const int lane = t & 63, w = t >> 6, r = lane & 31, h = lane >> 5;
    const int wm = w >> 1, wn = w & 1;
    (void)lane; (void)r; (void)h; (void)wm; (void)wn;
    const int MT = MALL / 256, NT = NFF2 / 128;
    for (int id = bid; id < MT * NT; id += G) {
      int tm, tn; tile_coords(id, MT, NT, tm, tn);
      const int m0 = tm * 256, n0 = tn * 128;
      Acc c; acc_zero(c);
      gemm_kloop(Hb + (size_t)m0 * DM, DM, Wb + woff + (size_t)n0 * DM, DM, DM, smem, c);
#ifdef DUP_KLOOP
      acc_zero(c);
      gemm_kloop(Hb + (size_t)m0 * DM, DM, Wb + woff + (size_t)n0 * DM, DM, DM, smem, c);
#endif
      const int jb0 = ((n0 + wn * 64) >> 6) * 32;
      const unsigned obase = (unsigned)((m0 + wm * 128) * DFF + jb0);
      epi_store<1>(smem,
        [&](int mi, int ni, int i) { return siluf_(c.a[mi][0][i]) * c.a[mi][1][i]; },
        [&](int row, int col, u32x4 v) { *(u32x4*)(ACT + obase + (unsigned)(row * DFF + col)) = v; });
    }
  };
  auto gemm_plain = [&](const u16* A, int lda, int K, const u16* Bt, u16* C, int ldc, int M, int N) __attribute__((always_inline)) {
    char* ws = ws_ptr(p);
    const int t = opaque_tid();
    const int lane = t & 63, w = t >> 6, r = lane & 31, h = lane >> 5;
    const int wm = w >> 1, wn = w & 1;
    (void)lane; (void)r; (void)h; (void)wm; (void)wn;
    const int MT = M / 256, NT = N / 128;
    for (int id = bid; id < MT * NT; id += G) {
      int tm, tn; tile_coords(id, MT, NT, tm, tn);
      const int m0 = tm * 256, n0 = tn * 128;
      Acc c; acc_zero(c);
      gemm_kloop(A + (size_t)m0 * lda, lda, Bt + (size_t)n0 * K, K, K, smem, c);
      const unsigned obase = (unsigned)((m0 + wm * 128) * ldc + n0 + wn * 64);
      epi_store<2>(smem,
        [&](int mi, int ni, int i) { return c.a[mi][ni][i]; },
        [&](int row, int col, u32x4 v) { *(u32x4*)(C + obase + (unsigned)(row * ldc + col)) = v; });
    }
  };

  auto prep_phase = [&](int l) __attribute__((always_inline)) {
    char* ws = ws_ptr(p);
    int pb_ = bid; asm volatile("" : "+s"(pb_));
    const int t = opaque_tid();
    const int lane = t & 63, w = t >> 6, r = lane & 31, h = lane >> 5;
    const int wm = w >> 1, wn = w & 1;
    (void)lane; (void)r; (void)h; (void)wm; (void)wn;
    float* sc = (float*)(smem_raw + 2 * GEMM_LDS);
    const int NQ = 64 * 6, NK = 64 * 4, NV = 2 * 128, NPE = 64, NG1 = NCHUNK * 4;
    const float qscale = 0.10206207261596577f * 1.4426950408889634f;
    {
      for (int id = pb_; id < NG1; id += G) {
        const int t = opaque_tid();
        const int lane = t & 63, w = t >> 6, r = lane & 31, h = lane >> 5;
        const int wm = w >> 1, wn = w & 1;
        (void)lane; (void)r; (void)h; (void)wm; (void)wn;
        const int n = id >> 2, hd = id & 3;
        const int t0 = n * 64;
        u16* ksT = smem;
        u16* vT = smem + 2 * 128 * LROW;
        u16* sk = vT;
        float* sga = (float*)(smem_raw + 55296);
        __syncthreads();
        {
          const int cc = t >> 2, part = t & 3;
          const u16* kp = Z + (size_t)(t0 + cc) * ZLD + Z_GK + hd * 128 + part * 32;
#pragma unroll
          for (int j = 0; j < 4; ++j) *(u32x4*)(sk + cc * 128 + part * 32 + j * 8) = *(const u32x4*)(kp + j * 8);
          u32x4 gv = *(const u32x4*)(Z + (size_t)(t0 + cc) * ZLD + Z_GA + part * 8);
#pragma unroll
          for (int k = 0; k < 4; ++k) { sga[cc * 32 + part * 8 + 2 * k] = bflo(gv[k]); sga[cc * 32 + part * 8 + 2 * k + 1] = bfhi(gv[k]); }
        }
        __syncthreads();
        {
          const int dir = t >> 7, d = t & 127;
          const float* wa2 = (dir ? in_ptr(p, 15) : in_ptr(p, 13)) + (size_t)l * 16 * 512 + hd * 128 + d;
          const float ba = ((dir ? in_ptr(p, 16) : in_ptr(p, 14)) + (size_t)l * 512)[hd * 128 + d];
          float wcol[16];
#pragma unroll
          for (int rr = 0; rr < 16; ++rr) wcol[rr] = wa2[rr * 512];
          const float* gar = sga + dir * 16;
          float tot = 0.f;
          for (int cc = 0; cc < 64; ++cc) {
            float pre = ba;
#pragma unroll
            for (int rr = 0; rr < 16; ++rr) pre += gar[cc * 32 + rr] * wcol[rr];
            tot += (fminf(pre, 0.f) - __logf(1.f + __expf(-fabsf(pre)))) * (1.f / 16.f);
          }
          DEC[((size_t)(n * 4 + hd) * 2 + dir) * 128 + d] = __expf(tot);
          float* gc = GC + (size_t)dir * SEQ * 512 + (size_t)t0 * 512 + hd * 128 + d;
          float cb = 0.f;
          u16* krow_out = ksT + (dir * 128 + d) * LROW;
          for (int ci = 0; ci < 64; ++ci) {
            const int cc = dir ? (63 - ci) : ci;
            float pre = ba;
#pragma unroll
            for (int rr = 0; rr < 16; ++rr) pre += gar[cc * 32 + rr] * wcol[rr];
            cb += (fminf(pre, 0.f) - __logf(1.f + __expf(-fabsf(pre)))) * (1.f / 16.f);
            gc[cc * 512] = cb;
            krow_out[cc] = f2bf(bf2f(sk[cc * 128 + d]) * __expf(tot - cb));
          }
        }
        for (int half = 0; half < 2; ++half) {
          __syncthreads();
          {
            const int cc = t & 63, part = t >> 6;
#pragma unroll
            for (int q = 0; q < 4; ++q) {
              const int cg8 = (part * 4 + q) * 8;
              uint4 v = *(const uint4*)(Z + (size_t)(t0 + cc) * ZLD + Z_GV + hd * 256 + half * 128 + cg8);
              unsigned u[4] = {v.x, v.y, v.z, v.w};
#pragma unroll
              for (int j = 0; j < 4; ++j) {
                vT[(cg8 + 2 * j) * LROW + cc] = (u16)(u[j] & 0xffffu);
                vT[(cg8 + 2 * j + 1) * LROW + cc] = (u16)(u[j] >> 16);
              }
            }
          }
          __syncthreads();
#pragma unroll
          for (int dir = 0; dir < 2; ++dir) {
            f32x16 acc[4];
#pragma unroll
            for (int j = 0; j < 4; ++j)
#pragma unroll
              for (int k = 0; k < 16; ++k) acc[j][k] = 0.f;
#pragma unroll
            for (int ks = 0; ks < 4; ++ks) {
              bf16x8 fa = *(const bf16x8*)(vT + (w * 32 + r) * LROW + ks * 16 + h * 8);
#pragma unroll
              for (int nt = 0; nt < 4; ++nt) {
                bf16x8 fb = *(const bf16x8*)(ksT + (dir * 128 + nt * 32 + r) * LROW + ks * 16 + h * 8);
                acc[nt] = MFMA(fb, fa, acc[nt]);
              }
            }
            u16* stp = ST + ((size_t)(n * 4 + hd) * 2 + dir) * 32768;
#pragma unroll
            for (int nt = 0; nt < 4; ++nt)
#pragma unroll
              for (int g4 = 0; g4 < 4; ++g4) {
                uint2 o;
                o.x = pk2(acc[nt][4 * g4 + 0], acc[nt][4 * g4 + 1]);
                o.y = pk2(acc[nt][4 * g4 + 2], acc[nt][4 * g4 + 3]);
                *(uint2*)(stp + (unsigned)((half * 128 + w * 32 + r) * 128 + nt * 32 + 8 * g4 + 4 * h)) = o;
              }
          }
        }
      }
      for (int q = pb_; q < NQ; q += G) {
        const int t = opaque_tid();
        const int lane = t & 63, w = t >> 6, r = lane & 31, h = lane >> 5;
        const int wm = w >> 1, wn = w & 1;
        (void)lane; (void)r; (void)h; (void)wm; (void)wn;
        const int tm = q / 6, tn = q % 6;
        const int m0 = tm * 256, n0 = tn * 128;
        __syncthreads();
        row_scales(Z + (size_t)m0 * ZLD + Z_CQ, ZLD, 256, sc, 256);
        Acc c; acc_zero(c);
        gemm_kloop(Z + (size_t)m0 * ZLD + Z_CQ, ZLD, Wb + W_UQ + (size_t)n0 * 256, 256, 256, smem, c);
        {
          const unsigned obase = (unsigned)((m0 + wm * 128) * 768 + n0 + wn * 64);
          epi_store<2>(smem,
            [&](int mi, int ni, int i) {
              const int cb0 = n0 + wn * 64 + ni * 32;
              const bool rope = ((cb0 >> 5) % 3) == 2;
              const int rl = wm * 128 + mi * 32 + crow(i, h);
              float v = c.a[mi][ni][i] * sc[rl];
              const float pv = __shfl_xor(v, 16);
              if (rope) {
                const int row = m0 + rl;
                const float cs = ropec[row * 16 + (r & 15)], sn = ropes[row * 16 + (r & 15)];
                v = (r < 16) ? (v * cs - pv * sn) : (v * cs + pv * sn);
              }
              return v * qscale;
            },
            [&](int row, int col, u32x4 v) { *(u32x4*)(Qb + obase + (unsigned)(row * 768 + col)) = v; });
        }
      }
      for (int q = (pb_ + G - (NQ % G)) % G; q < NK; q += G) {
        const int t = opaque_tid();
        const int lane = t & 63, w = t >> 6, r = lane & 31, h = lane >> 5;
        const int wm = w >> 1, wn = w & 1;
        (void)lane; (void)r; (void)h; (void)wm; (void)wn;
        const int tm = q >> 2, tn = q & 3;
        const int m0 = tm * 256, n0 = tn * 128;
        __syncthreads();
        row_scales(Z + (size_t)m0 * ZLD + Z_CKV, ZLD, 128, sc, 256);
        Acc c; acc_zero(c);
        gemm_kloop(Z + (size_t)m0 * ZLD + Z_CKV, ZLD, Wb + W_KN + (size_t)n0 * 128, 128, 128, smem, c);
        {
          const unsigned obase = (unsigned)((m0 + wm * 128) * 512 + n0 + wn * 64);
          epi_store<2>(smem,
            [&](int mi, int ni, int i) { return c.a[mi][ni][i] * sc[wm * 128 + mi * 32 + crow(i, h)]; },
            [&](int row, int col, u32x4 v) { *(u32x4*)(KN + obase + (unsigned)(row * 512 + col)) = v; });
        }
      }
      for (int q = (pb_ + G - ((NQ + NK) % G)) % G; q < NV; q += G) {
        const int t = opaque_tid();
        const int lane = t & 63, w = t >> 6, r = lane & 31, h = lane >> 5;
        const int wm = w >> 1, wn = w & 1;
        (void)lane; (void)r; (void)h; (void)wm; (void)wn;
        const int tm = q & 1, tn = q >> 1;
        const int m0 = tm * 256, n0 = tn * 128;
        __syncthreads();
        row_scales(Z + (size_t)n0 * ZLD + Z_CKV, ZLD, 128, sc, 128);
        Acc c; acc_zero(c);
        gemm_kloop(Wb + W_V + (size_t)m0 * 128, 128, Z + (size_t)n0 * ZLD + Z_CKV, ZLD, 128, smem, c);
        {
          const unsigned obase = (unsigned)((m0 + wm * 128) * SEQ + n0 + wn * 64);
          epi_store<2>(smem,
            [&](int mi, int ni, int i) { return c.a[mi][ni][i] * sc[wn * 64 + ni * 32 + r]; },
            [&](int row, int col, u32x4 v) { *(u32x4*)(VT + obase + (unsigned)(row * SEQ + col)) = v; });
        }
      }
      for (int q = (pb_ + G - ((NQ + NK + NV) % G)) % G; q < NPE; q += G) {
        const int t = opaque_tid();
        const int lane = t & 63, w = t >> 6, r = lane & 31, h = lane >> 5;
        const int wm = w >> 1, wn = w & 1;
        (void)lane; (void)r; (void)h; (void)wm; (void)wn;
        const int tok = q * 256 + t;
        const u16* src = Z + (size_t)tok * ZLD + Z_KPE;
        float v[32];
#pragma unroll
        for (int j = 0; j < 4; ++j) {
          uint4 u = *(const uint4*)(src + j * 8);
          unsigned uu[4] = {u.x, u.y, u.z, u.w};
#pragma unroll
          for (int k = 0; k < 4; ++k) { v[j * 8 + 2 * k] = bflo(uu[k]); v[j * 8 + 2 * k + 1] = bfhi(uu[k]); }
        }
        float o[32];
#pragma unroll
        for (int i = 0; i < 16; ++i) {
          const float cs = ropec[tok * 16 + i], sn = ropes[tok * 16 + i];
          o[i] = v[i] * cs - v[i + 16] * sn;
          o[i + 16] = v[i + 16] * cs + v[i] * sn;
        }
#pragma unroll
        for (int j = 0; j < 4; ++j) {
          uint4 u;
          u.x = pk2(o[j * 8 + 0], o[j * 8 + 1]); u.y = pk2(o[j * 8 + 2], o[j * 8 + 3]);
          u.z = pk2(o[j * 8 + 4], o[j * 8 + 5]); u.w = pk2(o[j * 8 + 6], o[j * 8 + 7]);
          *(uint4*)(KPE + (size_t)tok * 32 + j * 8) = u;
        }
      }
    }
  };

  auto attn_phase = [&](int mode) __attribute__((always_inline)) {
    char* ws = ws_ptr(p);
    const int t = opaque_tid();
    const int lane = t & 63, w = t >> 6, r = lane & 31, h = lane >> 5;
    const int wm = w >> 1, wn = w & 1;
    (void)lane; (void)r; (void)h; (void)wm; (void)wn;
    if (mode & 1) for (int id = bid; id < 512; id += G) {
      const int e = id * 256 + t;
      const int d2 = e & 63, v = (e >> 6) & 255, dir = (e >> 14) & 1, hd = e >> 15;
      float s0 = 0.f, s1 = 0.f;
      const size_t eoff = (size_t)v * 128 + 2 * d2;
      for (int i0 = 0; i0 < NCHUNK; i0 += 16) {
        unsigned uu[16];
        float2 dd[16];
#pragma unroll
        for (int j = 0; j < 16; ++j) {
          const int n = dir ? (NCHUNK - 1 - (i0 + j)) : (i0 + j);
          const size_t base = ((size_t)(n * 4 + hd) * 2 + dir);
          uu[j] = *(const unsigned*)(ST + base * 32768 + eoff);
          dd[j] = *(const float2*)(DEC + base * 128 + 2 * d2);
        }
#pragma unroll
        for (int j = 0; j < 16; ++j) {
          const int n = dir ? (NCHUNK - 1 - (i0 + j)) : (i0 + j);
          const size_t base = ((size_t)(n * 4 + hd) * 2 + dir);
          *(unsigned*)(ST + base * 32768 + eoff) = pk2(s0, s1);
          s0 = dd[j].x * s0 + bflo(uu[j]);
          s1 = dd[j].y * s1 + bfhi(uu[j]);
        }
      }
    }
    constexpr int KROW = 104;
    constexpr int VR = 68;
    constexpr int ABUF = 64 * KROW + 64 * VR;
    u16* sK = smem;
    u16* sV = smem + 64 * KROW;
    if (mode & 2) for (int id = bid; id < 8 * 64; id += G) {
      const int hd = id & 7, qb = id >> 3;
      const int q0 = qb * 256 + w * 64;
      bf16x8 bq[2][6];
#pragma unroll
      for (int qt = 0; qt < 2; ++qt)
#pragma unroll
        for (int ks = 0; ks < 6; ++ks) bq[qt][ks] = *(const bf16x8*)(Qb + (size_t)(q0 + qt * 32 + r) * 768 + hd * 96 + ks * 16 + h * 8);
      f32x16 O[2][2];
#pragma unroll
      for (int j = 0; j < 2; ++j)
#pragma unroll
        for (int qt = 0; qt < 2; ++qt)
#pragma unroll
          for (int k = 0; k < 16; ++k) O[j][qt][k] = 0.f;
      float m[2] = {0.f, 0.f}, lsum[2] = {0.f, 0.f};
      const int kr = t >> 2, kc = t & 3;
      const u16* knp = KN + (size_t)kr * 512 + hd * 64 + kc * 16;
      const u16* kpp = KPE + (size_t)kr * 32 + kc * 8;
      const u16* vpp = VT + (size_t)(hd * 64 + kr) * SEQ + kc * 16;
      u32x4 rk[3], rv[2];
      rk[0] = *(const u32x4*)(knp);
      rk[1] = *(const u32x4*)(knp + 8);
      rk[2] = *(const u32x4*)(kpp);
      rv[0] = *(const u32x4*)(vpp);
      rv[1] = *(const u32x4*)(vpp + 8);
      __syncthreads();
      *(u32x4*)(sK + kr * KROW + kc * 16) = rk[0];
      *(u32x4*)(sK + kr * KROW + kc * 16 + 8) = rk[1];
      *(u32x4*)(sK + kr * KROW + 64 + kc * 8) = rk[2];
      *(uint2*)(sV + kr * VR + kc * 16) = make_uint2(rv[0][0], rv[0][1]);
      *(uint2*)(sV + kr * VR + kc * 16 + 4) = make_uint2(rv[0][2], rv[0][3]);
      *(uint2*)(sV + kr * VR + kc * 16 + 8) = make_uint2(rv[1][0], rv[1][1]);
      *(uint2*)(sV + kr * VR + kc * 16 + 12) = make_uint2(rv[1][2], rv[1][3]);
      rk[0] = *(const u32x4*)(knp + (size_t)64 * 512);
      rk[1] = *(const u32x4*)(knp + (size_t)64 * 512 + 8);
      rk[2] = *(const u32x4*)(kpp + (size_t)64 * 32);
      rv[0] = *(const u32x4*)(vpp + 64);
      rv[1] = *(const u32x4*)(vpp + 64 + 8);
      __syncthreads();
      int cur = 0;
      for (int key0 = 0; key0 < SEQ; key0 += 64) {
        const u16* cK = sK + cur * ABUF;
        const u16* cV = sV + cur * ABUF;
        {
          u16* nK = sK + (cur ^ 1) * ABUF;
          u16* nV = sV + (cur ^ 1) * ABUF;
          *(u32x4*)(nK + kr * KROW + kc * 16) = rk[0];
          *(u32x4*)(nK + kr * KROW + kc * 16 + 8) = rk[1];
          *(u32x4*)(nK + kr * KROW + 64 + kc * 8) = rk[2];
          *(uint2*)(nV + kr * VR + kc * 16) = make_uint2(rv[0][0], rv[0][1]);
          *(uint2*)(nV + kr * VR + kc * 16 + 4) = make_uint2(rv[0][2], rv[0][3]);
          *(uint2*)(nV + kr * VR + kc * 16 + 8) = make_uint2(rv[1][0], rv[1][1]);
          *(uint2*)(nV + kr * VR + kc * 16 + 12) = make_uint2(rv[1][2], rv[1][3]);
          const int kn = (key0 + 128 < SEQ) ? (key0 + 128) : key0;
          rk[0] = *(const u32x4*)(knp + (size_t)kn * 512);
          rk[1] = *(const u32x4*)(knp + (size_t)kn * 512 + 8);
          rk[2] = *(const u32x4*)(kpp + (size_t)kn * 32);
          rv[0] = *(const u32x4*)(vpp + kn);
          rv[1] = *(const u32x4*)(vpp + kn + 8);
        }
        __builtin_amdgcn_sched_barrier(0);
        f32x16 S[2][2];
#pragma unroll
        for (int kt = 0; kt < 2; ++kt)
#pragma unroll
          for (int qt = 0; qt < 2; ++qt)
#pragma unroll
            for (int k = 0; k < 16; ++k) S[kt][qt][k] = -m[qt];
        __builtin_amdgcn_s_setprio(1);
#pragma unroll
        for (int ks = 0; ks < 6; ++ks)
#pragma unroll
          for (int kt = 0; kt < 2; ++kt) {
            bf16x8 fa = *(const bf16x8*)(cK + (kt * 32 + r) * KROW + ks * 16 + h * 8);
            S[kt][0] = MFMA(fa, bq[0][ks], S[kt][0]);
            S[kt][1] = MFMA(fa, bq[1][ks], S[kt][1]);
          }
        __builtin_amdgcn_s_setprio(0);
        bf16x8 pf[2][4];
#pragma unroll
        for (int qt = 0; qt < 2; ++qt) {
          float mloc = S[0][qt][0];
#pragma unroll
          for (int kt = 0; kt < 2; ++kt)
#pragma unroll
            for (int k = 0; k < 16; ++k) mloc = fmaxf(mloc, S[kt][qt][k]);
          {
            auto sw_ = __builtin_amdgcn_permlane32_swap(__float_as_uint(mloc), __float_as_uint(mloc), false, false);
            mloc = fmaxf(__uint_as_float(sw_[0]), __uint_as_float(sw_[1]));
          }
          if (__builtin_amdgcn_ballot_w64(mloc > 6.f) != 0ull) {
            const float delta = fmaxf(mloc, 0.f);
            const float alpha = __builtin_amdgcn_exp2f(-delta);
            m[qt] += delta;
            lsum[qt] *= alpha;
#pragma unroll
            for (int j = 0; j < 2; ++j)
#pragma unroll
              for (int k = 0; k < 16; ++k) O[j][qt][k] *= alpha;
#pragma unroll
            for (int kt = 0; kt < 2; ++kt)
#pragma unroll
              for (int k = 0; k < 16; ++k) S[kt][qt][k] -= delta;
          }
          float ps = 0.f;
#pragma unroll
          for (int kt = 0; kt < 2; ++kt)
#pragma unroll
            for (int k = 0; k < 16; ++k) { S[kt][qt][k] = __builtin_amdgcn_exp2f(S[kt][qt][k]); ps += S[kt][qt][k]; }
          lsum[qt] += ps;
#pragma unroll
          for (int s2 = 0; s2 < 4; ++s2) {
            const int kt = s2 >> 1, sx = s2 & 1;
            unsigned pw[4];
#pragma unroll
            for (int j = 0; j < 4; ++j) pw[j] = pk2(S[kt][qt][8 * sx + 2 * j], S[kt][qt][8 * sx + 2 * j + 1]);
            pf[qt][s2] = __builtin_bit_cast(bf16x8, make_uint4(pw[0], pw[1], pw[2], pw[3]));
          }
        }
#pragma unroll
        for (int s2 = 0; s2 < 4; ++s2) {
          const int kt = s2 >> 1, sx = s2 & 1;
#pragma unroll
          for (int dt = 0; dt < 2; ++dt) {
            const u16* vp = cV + (dt * 32 + r) * VR + kt * 32 + 16 * sx + 4 * h;
            uint2 lo = *(const uint2*)(vp);
            uint2 hi = *(const uint2*)(vp + 8);
            bf16x8 fv = __builtin_bit_cast(bf16x8, make_uint4(lo.x, lo.y, hi.x, hi.y));
            O[dt][0] = MFMA(fv, pf[0][s2], O[dt][0]);
            O[dt][1] = MFMA(fv, pf[1][s2], O[dt][1]);
          }
        }
        cur ^= 1;
        __syncthreads();
      }
#pragma unroll
      for (int qt = 0; qt < 2; ++qt) {
        const float lt = lsum[qt] + __shfl_xor(lsum[qt], 32);
        const float inv = 1.f / lt;
#pragma unroll
        for (int dt = 0; dt < 2; ++dt)
#pragma unroll
          for (int g4 = 0; g4 < 4; ++g4) {
            uint2 o;
            o.x = pk2(O[dt][qt][4 * g4 + 0] * inv, O[dt][qt][4 * g4 + 1] * inv);
            o.y = pk2(O[dt][qt][4 * g4 + 2] * inv, O[dt][qt][4 * g4 + 3] * inv);
            *(uint2*)(OA + (size_t)(q0 + qt * 32 + r) * 512 + hd * 64 + dt * 32 + 8 * g4 + 4 * h) = o;
          }
      }
    }
  };

  auto gla_out_phase = [&](int l) __attribute__((always_inline)) {
    char* ws = ws_ptr(p);
    const int t = opaque_tid();
    const int lane = t & 63, w = t >> 6, r = lane & 31, h = lane >> 5;
    const int wm = w >> 1, wn = w & 1;
    (void)lane; (void)r; (void)h; (void)wm; (void)wn;
    constexpr int QROW = 136;
    u16* sQ = smem;
    u16* sKt = smem + 64 * QROW;
    u16* sVT = smem + 2 * 64 * QROW;
    float* sred = (float*)(smem + 2 * 64 * QROW + 256 * LROW);
    u16* sO = smem;
    constexpr int OROW = 264;
    const float qs = 0.08838834764831845f;
    const int cs = w & 1, vh = w >> 1;
    for (int id = bid; id < NCHUNK * 4; id += G) {
      const int n = id >> 2, hd = id & 3;
      const int t0 = n * 64;
      __syncthreads();
      {
        const int cc = t & 63, part = t >> 6;
#pragma unroll
        for (int q = 0; q < 8; ++q) {
          const int cg8 = (part * 8 + q) * 8;
          uint4 v = *(const uint4*)(Z + (size_t)(t0 + cc) * ZLD + Z_GV + hd * 256 + cg8);
          unsigned u[4] = {v.x, v.y, v.z, v.w};
#pragma unroll
          for (int j = 0; j < 4; ++j) {
            sVT[(cg8 + 2 * j) * LROW + cc] = (u16)(u[j] & 0xffffu);
            sVT[(cg8 + 2 * j + 1) * LROW + cc] = (u16)(u[j] >> 16);
          }
        }
      }
      f32x16 acc[4];
#pragma unroll
      for (int j = 0; j < 4; ++j)
#pragma unroll
        for (int k = 0; k < 16; ++k) acc[j][k] = 0.f;
      for (int dir = 0; dir < 2; ++dir) {
        __syncthreads();
        {
          const int cc = t >> 2, dp = (t & 3) * 32;
          const u16* qp = Z + (size_t)(t0 + cc) * ZLD + Z_GQ + hd * 128 + dp;
          const u16* kp = Z + (size_t)(t0 + cc) * ZLD + Z_GK + hd * 128 + dp;
          const float* gp = GC + (size_t)dir * SEQ * 512 + (size_t)(t0 + cc) * 512 + hd * 128 + dp;
#pragma unroll
          for (int j = 0; j < 4; ++j) {
            uint4 qv = *(const uint4*)(qp + j * 8);
            uint4 kv = *(const uint4*)(kp + j * 8);
            float4 g0 = *(const float4*)(gp + j * 8);
            float4 g1 = *(const float4*)(gp + j * 8 + 4);
            const float gg[8] = {g0.x, g0.y, g0.z, g0.w, g1.x, g1.y, g1.z, g1.w};
            const unsigned qu[4] = {qv.x, qv.y, qv.z, qv.w};
            const unsigned ku[4] = {kv.x, kv.y, kv.z, kv.w};
            unsigned qo[4], ko[4];
#pragma unroll
            for (int k = 0; k < 4; ++k) {
              const float e0 = __expf(gg[2 * k]), e1 = __expf(gg[2 * k + 1]);
              qo[k] = pk2(bflo(qu[k]) * qs * e0, bfhi(qu[k]) * qs * e1);
              ko[k] = pk2(bflo(ku[k]) / e0, bfhi(ku[k]) / e1);
            }
            *(uint4*)(sQ + cc * QROW + dp + j * 8) = make_uint4(qo[0], qo[1], qo[2], qo[3]);
            *(uint4*)(sKt + cc * QROW + dp + j * 8) = make_uint4(ko[0], ko[1], ko[2], ko[3]);
            if (j == 1) __builtin_amdgcn_sched_barrier(0);
          }
        }
        __syncthreads();
        const u16* bqp = sQ + (cs * 32 + r) * QROW + h * 8;
        const u16* stp = ST + ((size_t)(n * 4 + hd) * 2 + dir) * 32768;
        bf16x8 fs[2][4];
#pragma unroll
        for (int ks = 0; ks < 4; ++ks) fs[0][ks] = *(const bf16x8*)(stp + (size_t)(vh * 128 + r) * 128 + ks * 16 + h * 8);
        f32x16 at[2];
#pragma unroll
        for (int et = 0; et < 2; ++et) {
#pragma unroll
          for (int k = 0; k < 16; ++k) at[et][k] = 0.f;
#pragma unroll
          for (int ks = 0; ks < 8; ++ks) {
            bf16x8 fa = *(const bf16x8*)(sKt + (et * 32 + r) * QROW + ks * 16 + h * 8);
            bf16x8 fbq = *(const bf16x8*)(bqp + ks * 16);
            at[et] = MFMA(fa, fbq, at[et]);
          }
          const int cidx = cs * 32 + r;
#pragma unroll
          for (int k = 0; k < 16; ++k) {
            const int e = et * 32 + crow(k, h);
            const bool keep = dir ? (e >= cidx) : (e <= cidx);
            at[et][k] = keep ? at[et][k] : 0.f;
          }
        }
#pragma unroll
        for (int s2 = 0; s2 < 4; ++s2) {
          const int et = s2 >> 1, s = s2 & 1;
          unsigned pw[4];
#pragma unroll
          for (int j = 0; j < 4; ++j) pw[j] = pk2(at[et][8 * s + 2 * j], at[et][8 * s + 2 * j + 1]);
          bf16x8 pf = __builtin_bit_cast(bf16x8, make_uint4(pw[0], pw[1], pw[2], pw[3]));
#pragma unroll
          for (int mt = 0; mt < 4; ++mt) {
            const u16* vp = sVT + (vh * 128 + mt * 32 + r) * LROW + et * 32 + 16 * s + 4 * h;
            uint2 lo = *(const uint2*)(vp);
            uint2 hi = *(const uint2*)(vp + 8);
            bf16x8 fv = __builtin_bit_cast(bf16x8, make_uint4(lo.x, lo.y, hi.x, hi.y));
            acc[mt] = MFMA(fv, pf, acc[mt]);
          }
        }
#pragma unroll
        for (int bb = 0; bb < 8; ++bb) {
          const int mt = bb >> 1, kb = bb & 1;
          if (bb + 1 < 8) {
            const int mt1 = (bb + 1) >> 1, kb1 = (bb + 1) & 1;
#pragma unroll
            for (int ks = 0; ks < 4; ++ks) fs[(bb + 1) & 1][ks] = *(const bf16x8*)(stp + (size_t)(vh * 128 + mt1 * 32 + r) * 128 + (kb1 * 4 + ks) * 16 + h * 8);
          }
          __builtin_amdgcn_sched_barrier(0);
#pragma unroll
          for (int ks = 0; ks < 4; ++ks) { bf16x8 fbq = *(const bf16x8*)(bqp + (kb * 4 + ks) * 16); acc[mt] = MFMA(fs[bb & 1][ks], fbq, acc[mt]); }
          __builtin_amdgcn_sched_barrier(0);
        }
      }
      float ss = 0.f;
#pragma unroll
      for (int mt = 0; mt < 4; ++mt)
#pragma unroll
        for (int k = 0; k < 16; ++k) ss += acc[mt][k] * acc[mt][k];
      ss += __shfl_xor(ss, 32);
      if (h == 0) sred[vh * 64 + cs * 32 + r] = ss;
      __syncthreads();
      const float rs = rsqrtf((sred[cs * 32 + r] + sred[64 + cs * 32 + r]) * (1.f / 256.f) + EPS);
#pragma unroll
      for (int mt = 0; mt < 4; ++mt)
#pragma unroll
        for (int g4 = 0; g4 < 4; ++g4) {
          uint2 o;
          o.x = pk2(acc[mt][4 * g4 + 0] * rs, acc[mt][4 * g4 + 1] * rs);
          o.y = pk2(acc[mt][4 * g4 + 2] * rs, acc[mt][4 * g4 + 3] * rs);
          *(uint2*)(sO + (cs * 32 + r) * OROW + vh * 128 + mt * 32 + 8 * g4 + 4 * h) = o;
        }
      __syncthreads();
      {
        const int t3 = opaque_tid();
        const int cc = t3 >> 2, vp0 = (t3 & 3) * 64;
        const float* ng = in_ptr(p, 17) + (size_t)l * 256;
        u32x4 gvp[8];
#pragma unroll
        for (int j = 0; j < 8; ++j) gvp[j] = *(const u32x4*)(Z + (size_t)(t0 + cc) * ZLD + Z_GOG + hd * 256 + vp0 + j * 8);
        __builtin_amdgcn_sched_barrier(0);
#pragma unroll
        for (int j = 0; j < 8; ++j) {
          const int v0 = vp0 + j * 8;
          uint4 ov = *(const uint4*)(sO + cc * OROW + v0);
          uint4 gv = make_uint4(gvp[j][0], gvp[j][1], gvp[j][2], gvp[j][3]);
          float4 n0 = *(const float4*)(ng + v0), n1 = *(const float4*)(ng + v0 + 4);
          const float nn[8] = {n0.x, n0.y, n0.z, n0.w, n1.x, n1.y, n1.z, n1.w};
          const unsigned ou[4] = {ov.x, ov.y, ov.z, ov.w};
          const unsigned gu[4] = {gv.x, gv.y, gv.z, gv.w};
          unsigned res[4];
#pragma unroll
          for (int k = 0; k < 4; ++k)
            res[k] = pk2(bflo(ou[k]) * nn[2 * k] * siluf_(bflo(gu[k])), bfhi(ou[k]) * nn[2 * k + 1] * siluf_(bfhi(gu[k])));
          *(uint4*)(OG + (size_t)(t0 + cc) * DM + hd * 256 + v0) = make_uint4(res[0], res[1], res[2], res[3]);
        }
      }
    }
  };

  auto merge_phase = [&]() __attribute__((always_inline)) {
    char* ws = ws_ptr(p);
    const int t = opaque_tid();
    const int lane = t & 63, w = t >> 6, r = lane & 31, h = lane >> 5;
    const int wm = w >> 1, wn = w & 1;
    (void)lane; (void)r; (void)h; (void)wm; (void)wn;
    const int MT = SEQ / 256, NT = DM / 128;
    for (int id = bid; id < MT * NT; id += G) {
      int tm, tn; tile_coords(id, MT, NT, tm, tn);
      const int m0 = tm * 256, n0 = tn * 128;
      Acc c; acc_zero(c);
      gemm_kloop(OA + (size_t)m0 * 512, 512, Wb + W_OA + (size_t)n0 * 512, 512, 512, smem, c);
      {
        const unsigned zbase = (unsigned)((m0 + wm * 128) * ZLD + Z_BG + n0 + wn * 64);
        const unsigned obase = (unsigned)((m0 + wm * 128) * DM + n0 + wn * 64);
        epi_store_pre<2, 1>(smem,
          [&](int mi, int ni, int i) { return c.a[mi][ni][i]; },
          [&](int row, int col, int q) { return *(const u32x4*)(Z + zbase + (unsigned)(row * ZLD + col)); },
          [&](int row, int col, u32x4 v, const u32x4* pre) {
            const u32x4 g = pre[0];
            u32x4 o;
#pragma unroll
            for (int k = 0; k < 4; ++k) o[k] = pk2(bflo(v[k]) * sigmoidf_(bflo(g[k])), bfhi(v[k]) * sigmoidf_(bfhi(g[k])));
            *(u32x4*)(MG + obase + (unsigned)(row * DM + col)) = o;
          });
      }
      acc_zero(c);
      gemm_kloop(OG + (size_t)m0 * DM, DM, Wb + W_OB + (size_t)n0 * DM, DM, DM, smem, c);
      {
        const int t2 = opaque_tid();
        const int wm2 = t2 >> 7, wn2 = (t2 >> 6) & 1;
        const unsigned zbase = (unsigned)((m0 + wm2 * 128) * ZLD + Z_BG + DM + n0 + wn2 * 64);
        const unsigned obase = (unsigned)((m0 + wm2 * 128) * DM + n0 + wn2 * 64);
        epi_store_pre<2, 2>(smem,
          [&](int mi, int ni, int i) { return c.a[mi][ni][i]; },
          [&](int row, int col, int q) {
            return q == 0 ? *(const u32x4*)(Z + zbase + (unsigned)(row * ZLD + col))
                          : *(const u32x4*)(MG + obase + (unsigned)(row * DM + col));
          },
          [&](int row, int col, u32x4 v, const u32x4* pre) {
            const u32x4 g = pre[0], pm = pre[1];
            u32x4 o;
#pragma unroll
            for (int k = 0; k < 4; ++k)
              o[k] = pk2(bflo(pm[k]) + bflo(v[k]) * sigmoidf_(bflo(g[k])), bfhi(pm[k]) + bfhi(v[k]) * sigmoidf_(bfhi(g[k])));
            *(u32x4*)(MG + obase + (unsigned)(row * DM + col)) = o;
          });
      }
    }
  };

  for (int i = bid * 256 + opaque_tid(); i < SEQ * 16; i += G * 256) {
    const int pos = i >> 4, j = i & 15;
    const float inv_freq = exp2f(-(float)j * 0.8304820237218406f);
    const float angf = (float)pos * inv_freq;
    double a = (double)angf;
    const double twopi = 6.283185307179586476925286766559;
    a -= twopi * rint(a / twopi);
    const float af = (float)a;
    ropec[i] = __cosf(af);
    ropes[i] = __sinf(af);
  }
  convert_weights(0);
  rn_pass(0, 0.f, nullptr, in_ptr(p, 2), 0, MALL);
  grid.sync();

  for (int l = 0; l < 4; ++l) {
    asm volatile("" : "+s"(bid));
    char* ws = ws_ptr(p);
    ffn_in(W_FFN1_IN);
#ifdef DUP_FFNIN
    xcd_barrier(xb);
    ffn_in(W_FFN1_IN);
#endif
    xcd_barrier(xb);
    gemm_plain(ACT, DFF, DFF, Wb + W_FFN1_OUT, Yb, DM, MALL, DM);
    xcd_barrier(xb);
    rn_pass(1, 0.5f, in_ptr(p, 5) + l * DM, in_ptr(p, 6) + l * DM, 0, SEQ);
    xcd_barrier(xb);
    for (int s = 0; s < NSEQ; ++s) {
      asm volatile("" : "+s"(bid));
      char* ws = ws_ptr(p);
      {
        const float coefx = (s == 0) ? 0.5f : 1.0f;
        const float* postx = ((s == 0) ? in_ptr(p, 5) : in_ptr(p, 20)) + l * DM;
        const float* prex = ((s == 0) ? in_ptr(p, 6) : in_ptr(p, 21)) + l * DM;
        const int r0x = (s == 0) ? SEQ : (s - 1) * SEQ, r1x = (s == 0) ? 3 * SEQ : s * SEQ;
        int bq_ = bid; asm volatile("" : "+s"(bq_));
        for (int step_ = 0; step_ < 2; ++step_) {
          int sel_ = (step_ ^ bq_) & 1; asm volatile("" : "+s"(sel_));
          if (sel_) rn_pass(1, coefx, postx, prex, r0x, r1x);
          else gemm_plain(Hb + (size_t)s * SEQ * DM, DM, DM, Wb + W_IN, Z, ZLD, SEQ, ZLD);
        }
      }
      xcd_barrier(xb);
      prep_phase(l);
#ifdef DUP_PREP
      xcd_barrier(xb);
      prep_phase(l);
#endif
      xcd_barrier(xb);
      attn_phase(1);
      xcd_barrier(xb);
      int bpar_ = bid; asm volatile("" : "+s"(bpar_));
      if (bpar_ & 1) { attn_phase(2); gla_out_phase(l); }
      else { gla_out_phase(l); attn_phase(2); }
      xcd_barrier(xb);
      merge_phase();
      xcd_barrier(xb);
      gemm_plain(MG, DM, DM, Wb + W_OUT, Yb + (size_t)s * SEQ * DM, DM, SEQ, DM);
      xcd_barrier(xb);
    }
    rn_pass(1, 1.0f, in_ptr(p, 20) + l * DM, in_ptr(p, 21) + l * DM, 2 * SEQ, 3 * SEQ);
    xcd_barrier(xb);
    ffn_in(W_FFN2_IN);
    xcd_barrier(xb);
    gemm_plain(ACT, DFF, DFF, Wb + W_FFN2_OUT, Yb, DM, MALL, DM);
    xcd_barrier(xb);
    rn_pass(1, 0.5f, in_ptr(p, 24) + l * DM, (l < 3) ? (in_ptr(p, 2) + (l + 1) * DM) : nullptr, 0, MALL);
    if (l < 3) convert_weights(l + 1);
    xcd_barrier(xb);
  }
}

extern "C" void kernel_launch(void* const* d_in, const int* in_sizes, int n_in, void* d_out,
                              int out_size, void* d_ws, size_t ws_size, hipStream_t stream) {
  static int grid_blocks = 0;
  if (!grid_blocks) {
    int dev = 0, cus = 0, per_cu = 0;
    (void)hipGetDevice(&dev);
    (void)hipDeviceGetAttribute(&cus, hipDeviceAttributeMultiprocessorCount, dev);
    (void)hipOccupancyMaxActiveBlocksPerMultiprocessor(&per_cu, fwd_megakernel, 256, 0);
    if (per_cu > 2) per_cu = 2;
    if (per_cu < 1) per_cu = 1;
    grid_blocks = cus * per_cu;
  }
  Params p{};
  for (int i = 0; i < 25; ++i) p.in[i] = (const float*)d_in[i];
  p.out = (float*)d_out;
  p.ws = (char*)d_ws;
  (void)hipMemsetAsync((char*)d_ws + OFF_BAR, 0, XCD_BAR_WORDS * 4, stream);
  void* args[] = {&p};
  hipError_t e = hipLaunchCooperativeKernel((void*)fwd_megakernel, dim3(grid_blocks), dim3(256), args, 0, stream);
  if (e != hipSuccess) fprintf(stderr, "cooperative launch failed: %s (grid %d)\n", hipGetErrorString(e), grid_blocks);
}
```

```cpp
#include <hip/hip_runtime.h>
#include <hip/hip_cooperative_groups.h>
#include <cstdio>
namespace cg = cooperative_groups;

typedef unsigned short u16;
typedef short bf16x8 __attribute__((ext_vector_type(8)));
typedef short s16x4 __attribute__((ext_vector_type(4)));
typedef float f32x16 __attribute__((ext_vector_type(16)));
typedef __bf16 bf2_t __attribute__((ext_vector_type(2)));
typedef float f2_t __attribute__((ext_vector_type(2)));
typedef unsigned u32x4 __attribute__((ext_vector_type(4)));
#define DI __device__ __forceinline__
#define MFMA(a, b, c) __builtin_amdgcn_mfma_f32_32x32x16_bf16((a), (b), (c), 0, 0, 0)

constexpr int SEQ = 16384;
constexpr int NSEQ = 3;
constexpr int MALL = SEQ * NSEQ;
constexpr int DM = 1024;
constexpr int DFF = 2816;
constexpr int NFF2 = 5632;
constexpr int PIN = 5568;
constexpr int ZLD = 5632;
constexpr int Z_CQ = 0, Z_CKV = 256, Z_KPE = 384, Z_GQ = 416, Z_GK = 928, Z_GV = 1440, Z_GA = 2464, Z_GOG = 2496, Z_BG = 3520;
constexpr float EPS = 1e-6f;
constexpr int NCHUNK = SEQ / 64;

constexpr size_t W_FFN1_IN = 0;
constexpr size_t W_FFN1_OUT = W_FFN1_IN + (size_t)NFF2 * DM;
constexpr size_t W_IN = W_FFN1_OUT + (size_t)DM * DFF;
constexpr size_t W_UQ = W_IN + (size_t)ZLD * DM;
constexpr size_t W_KN = W_UQ + (size_t)768 * 256;
constexpr size_t W_V = W_KN + (size_t)512 * 128;
constexpr size_t W_OA = W_V + (size_t)512 * 128;
constexpr size_t W_OB = W_OA + (size_t)DM * 512;
constexpr size_t W_OUT = W_OB + (size_t)DM * DM;
constexpr size_t W_FFN2_IN = W_OUT + (size_t)DM * DM;
constexpr size_t W_FFN2_OUT = W_FFN2_IN + (size_t)NFF2 * DM;
constexpr size_t W_END = W_FFN2_OUT + (size_t)DM * DFF;

constexpr size_t al256(size_t x) { return (x + 255) & ~(size_t)255; }
constexpr size_t OFF_WB = 0;
constexpr size_t OFF_ROPE = al256(OFF_WB + W_END * 2);
constexpr size_t OFF_H = al256(OFF_ROPE + (size_t)SEQ * 32 * 4);
constexpr size_t OFF_Y = al256(OFF_H + (size_t)MALL * DM * 2);
constexpr size_t OFF_ACT = al256(OFF_Y + (size_t)MALL * DM * 2);
constexpr size_t OFF_Z = OFF_ACT;
constexpr size_t OFF_Q = al256(OFF_Z + (size_t)SEQ * ZLD * 2);
constexpr size_t OFF_KN = al256(OFF_Q + (size_t)SEQ * 768 * 2);
constexpr size_t OFF_VT = al256(OFF_KN + (size_t)SEQ * 512 * 2);
constexpr size_t OFF_KPE = al256(OFF_VT + (size_t)SEQ * 512 * 2);
constexpr size_t OFF_OA = al256(OFF_KPE + (size_t)SEQ * 32 * 2);
constexpr size_t OFF_MIXEND = al256(OFF_OA + (size_t)SEQ * 512 * 2);
constexpr size_t OFF_ACTEND = al256(OFF_ACT + (size_t)MALL * DFF * 2);
static_assert(OFF_MIXEND <= OFF_ACTEND, "mixer scratch must fit in act");
constexpr size_t OFF_ST = OFF_ACTEND;
constexpr size_t OFF_DEC = al256(OFF_ST + (size_t)NCHUNK * 4 * 2 * 256 * 128 * 2);
constexpr size_t OFF_GC = al256(OFF_DEC + (size_t)NCHUNK * 4 * 2 * 128 * 4);
constexpr size_t OFF_OG = al256(OFF_GC + (size_t)2 * SEQ * 512 * 4);
constexpr size_t OFF_MG = al256(OFF_OG + (size_t)SEQ * DM * 2);
constexpr size_t OFF_END = al256(OFF_MG + (size_t)SEQ * DM * 2);
constexpr size_t OFF_BAR = OFF_END;
static_assert(OFF_BAR + 16384 <= (size_t)768 * 1024 * 1024, "workspace overflow");

struct Params {
  const float* in[25];
  float* out;
  char* ws;
};

DI unsigned pk2(float a, float b) { f2_t v = {a, b}; return __builtin_bit_cast(unsigned, __builtin_convertvector(v, bf2_t)); }
DI u16 f2bf(float a) { return (u16)(pk2(a, 0.f) & 0xffffu); }
DI float bf2f(u16 v) { return __uint_as_float(((unsigned)v) << 16); }
DI float bflo(unsigned v) { return __uint_as_float(v << 16); }
DI float bfhi(unsigned v) { return __uint_as_float(v & 0xffff0000u); }
DI float wave_sum(float v) {
#pragma unroll
  for (int o = 32; o >= 1; o >>= 1) v += __shfl_xor(v, o);
  return v;
}
DI int opaque_tid() { int t = threadIdx.x; asm volatile("" : "+v"(t)); return t; }
DI const float* in_ptr(const Params& p, int k) { asm volatile("" : "+s"(k)); return p.in[k]; }
DI char* ws_ptr(const Params& p) { long z = 0; asm volatile("" : "+s"(z)); return p.ws + z; }
DI float* out_ptr(const Params& p) { long z = 0; asm volatile("" : "+s"(z)); return p.out + z; }
DI int crow(int i, int h) { return (i & 3) + 8 * (i >> 2) + 4 * h; }
DI float sigmoidf_(float x) { return 1.f / (1.f + __expf(-x)); }
DI float siluf_(float x) { return x / (1.f + __expf(-x)); }


#define XB_TMO      128
#define XB_XCNT(j)  (256  + 64 * (j))
#define XB_XSUB(j)  (1280 + 64 * (j))
#define XB_XGEN(j)  (2304 + 64 * (j))
#define XB_TOP      3328
#define XB_TOPGEN   3392
#define XCD_BAR_WORDS 3456
#define XB_SPIN_CAP (1u << 18)
#define LAS __attribute__((address_space(3)))

__device__ __forceinline__ unsigned xb_ld(unsigned* p)              { return __hip_atomic_load(p, __ATOMIC_RELAXED, __HIP_MEMORY_SCOPE_AGENT); }
__device__ __forceinline__ unsigned xb_add(unsigned* p, unsigned v) { return __hip_atomic_fetch_add(p, v, __ATOMIC_RELAXED, __HIP_MEMORY_SCOPE_AGENT); }
__device__ __forceinline__ unsigned xb_xcc_id() { return (unsigned)__builtin_amdgcn_s_getreg((3 << 11) | 20) & 0xFu; }
#define XB_SPIN(cond, bar) do { unsigned _sp = 0; while (cond) { __builtin_amdgcn_s_sleep(1); \
    if ((++_sp & 255u) == 0u) { if (xb_ld(&(bar)[XB_TMO])) break; if (_sp > XB_SPIN_CAP) { atomicAdd(&(bar)[XB_TMO], 1u); break; } } } } while (0)

struct XcdBarrier {
    unsigned* bar; unsigned x;
    volatile LAS unsigned* st;
};

__device__ __forceinline__ XcdBarrier xcd_barrier_post(unsigned* bar, volatile LAS unsigned* st) {
    XcdBarrier b; b.bar = bar; b.x = xb_xcc_id(); b.st = st;
    if (threadIdx.x == 0) (void)xb_add(&bar[XB_XCNT(b.x)], 1u);
    return b;
}
__device__ __forceinline__ void xcd_barrier_complete(unsigned* bar, unsigned x, unsigned& nloc, unsigned& nx) {
    const unsigned G = gridDim.x * gridDim.y * gridDim.z;
    unsigned sum, cnt, mine, sp = 0u;
    for (;;) {
        sum = 0u; cnt = 0u; mine = 0u;
#pragma unroll
        for (unsigned j = 0; j < 16; ++j) { const unsigned c = xb_ld(&bar[XB_XCNT(j)]); sum += c; cnt += (c > 0u) ? 1u : 0u; mine = (j == x) ? c : mine; }
        if (sum == G) break;
        __builtin_amdgcn_s_sleep(1);
        if ((++sp & 255u) == 0u) { if (xb_ld(&bar[XB_TMO])) break; if (sp > XB_SPIN_CAP) { atomicAdd(&bar[XB_TMO], 1u); break; } }
    }
    nloc = mine > 0u ? mine : 1u; nx = cnt > 0u ? cnt : 1u;
}

__device__ __forceinline__ void xcd_barrier(const XcdBarrier& b) {
    asm volatile("s_waitcnt vmcnt(0)" ::: "memory");
    __syncthreads();
    int tid0_ = threadIdx.x; asm volatile("" : "+v"(tid0_));
    if (tid0_ == 0) {
        unsigned* bar = b.bar; asm volatile("" : "+s"(bar));
        unsigned bx_ = b.x; asm volatile("" : "+s"(bx_));
        __builtin_amdgcn_s_waitcnt(0);
        unsigned nloc = b.st[0], nx = b.st[1];
        if (nloc == 0u) { xcd_barrier_complete(bar, bx_, nloc, nx); b.st[0] = nloc; b.st[1] = nx; }
        const unsigned old = xb_add(&bar[XB_XSUB(bx_)], 1u);
        const unsigned gen = old / nloc;
        if (old + 1u == (gen + 1u) * nloc) {
            __builtin_amdgcn_fence(__ATOMIC_RELEASE, "agent");
            asm volatile("s_waitcnt vmcnt(0)" ::: "memory");
            const unsigned og = xb_add(&bar[XB_TOP], 1u);
            const unsigned tg = og / nx;
            if (og + 1u == (tg + 1u) * nx) xb_add(&bar[XB_TOPGEN], 1u);
            else XB_SPIN(xb_ld(&bar[XB_TOPGEN]) == tg, bar);
            __builtin_amdgcn_fence(__ATOMIC_ACQUIRE, "agent");
            xb_add(&bar[XB_XGEN(bx_)], 1u);
            asm volatile("s_waitcnt vmcnt(0)" ::: "memory");
        } else {
            XB_SPIN(xb_ld(&bar[XB_XGEN(bx_)]) == gen, bar);
            __builtin_amdgcn_fence(__ATOMIC_ACQUIRE, "agent");
            asm volatile("s_waitcnt vmcnt(0)" ::: "memory");
        }
    }
    __syncthreads();
}

constexpr int LROW = 72;
constexpr int GEMM_LDS = 2 * 128 * LROW * 2;

struct Acc { f32x16 a[4][2]; };

DI void acc_zero(Acc& c) {
#pragma unroll
  for (int i = 0; i < 4; ++i)
#pragma unroll
    for (int j = 0; j < 2; ++j)
#pragma unroll
      for (int k = 0; k < 16; ++k) c.a[i][j][k] = 0.f;
}

DI void gll16_asm(const void* g, unsigned lds_addr) {
  asm volatile("s_mov_b32 m0, %1\n\ts_nop 0\n\tglobal_load_lds_dwordx4 %0, off" :: "v"(g), "s"(lds_addr) : "memory", "m0");
}
DI void gll16_asm_s(const void* base, unsigned voff, unsigned lds_addr) {
  asm volatile("s_mov_b32 m0, %2\n\ts_nop 0\n\tglobal_load_lds_dwordx4 %1, %0" :: "s"(base), "v"(voff), "s"(lds_addr) : "memory", "m0");
}
DI void gll16(const u16* g, char* l) {
  __builtin_amdgcn_global_load_lds((const __attribute__((address_space(1))) unsigned*)g,
                                   (__attribute__((address_space(3))) unsigned*)l, 16, 0, 0);
}
DI void gemm_kloop(const u16* __restrict__ A, int lda, const u16* __restrict__ B, int ldb, int K, u16* smem, Acc& c) {
  const int t = opaque_tid();
  const int lane = t & 63, w = t >> 6, r = lane & 31, h = lane >> 5;
  const int wm = w >> 1, wn = w & 1;
  char* lds = (char*)smem;
  const int nk = K >> 5;
  const int w_s = __builtin_amdgcn_readfirstlane(w);
  const unsigned ldsw_u = __builtin_amdgcn_readfirstlane((unsigned)(size_t)lds) + (unsigned)w_s * 1024u;
  const int row0 = t >> 2, c0 = t & 3;
  const int sw0 = (c0 ^ ((row0 >> 2) & 3)) * 8;
  const unsigned voa = (unsigned)(row0 * lda + sw0) * 2u;
  const unsigned vob = (unsigned)(row0 * ldb + sw0) * 2u;
  const unsigned a64 = 128u * (unsigned)lda, b64 = 128u * (unsigned)ldb;
  const unsigned vo0 = voa, vo1 = voa + a64, vo2 = voa + 2u * a64, vo3 = voa + 3u * a64, vo4 = vob, vo5 = vob + b64;
  const char* gA = (const char*)A;
  const char* gB = (const char*)B;
#define GEMM_ISSUE(kt_, st_)                                         \
  do {                                                               \
    const unsigned sp_ = ldsw_u + (unsigned)((st_) * 24576);         \
    gll16_asm_s(gA, vo0, sp_);                                       \
    gll16_asm_s(gA, vo1, sp_ + 4096u);                               \
    gll16_asm_s(gA, vo2, sp_ + 8192u);                               \
    gll16_asm_s(gA, vo3, sp_ + 12288u);                              \
    gll16_asm_s(gB, vo4, sp_ + 16384u);                              \
    gll16_asm_s(gB, vo5, sp_ + 20480u);                              \
    const int inc_ = ((kt_) + 1 < nk) ? 64 : 0;                      \
    gA += inc_; gB += inc_;                                          \
  } while (0)
  __syncthreads();
  GEMM_ISSUE(0, 0);
  GEMM_ISSUE(1, 1);
  const int fsw = (r >> 2) & 3;
  const int aoff = (wm * 128 + r) * 64, boff = 16384 + (wn * 64 + r) * 64;
  const char* pa0 = lds + aoff + ((0 + h) ^ fsw) * 16;
  const char* pa1 = lds + aoff + ((2 + h) ^ fsw) * 16;
  const char* pb0 = lds + boff + ((0 + h) ^ fsw) * 16;
  const char* pb1 = lds + boff + ((2 + h) ^ fsw) * 16;
  int scur = 0, snext = 2;
  for (int kt = 0; kt < nk; ++kt) {
    asm volatile("s_waitcnt vmcnt(6)" ::: "memory");
    __builtin_amdgcn_s_barrier();
    asm volatile("" ::: "memory");
    const int so = scur * 24576;
    {
      bf16x8 fa[4], fb[2], ga[4], gb[2];
#pragma unroll
      for (int i = 0; i < 4; ++i) fa[i] = *(const bf16x8*)(pa0 + so + i * 2048);
#pragma unroll
      for (int i = 0; i < 2; ++i) fb[i] = *(const bf16x8*)(pb0 + so + i * 2048);
#pragma unroll
      for (int i = 0; i < 4; ++i)
#pragma unroll
        for (int j = 0; j < 2; ++j) c.a[i][j] = MFMA(fa[i], fb[j], c.a[i][j]);
#pragma unroll
      for (int i = 0; i < 4; ++i) ga[i] = *(const bf16x8*)(pa1 + so + i * 2048);
#pragma unroll
      for (int i = 0; i < 2; ++i) gb[i] = *(const bf16x8*)(pb1 + so + i * 2048);
      __builtin_amdgcn_sched_barrier(0);
      GEMM_ISSUE(kt + 2, snext);
      __builtin_amdgcn_sched_barrier(0);
#pragma unroll
      for (int i = 0; i < 4; ++i)
#pragma unroll
        for (int j = 0; j < 2; ++j) c.a[i][j] = MFMA(ga[i], gb[j], c.a[i][j]);
    }
    __builtin_amdgcn_sched_barrier(0);
    snext = scur;
    scur = (scur == 2) ? 0 : scur + 1;
  }
  asm volatile("s_waitcnt vmcnt(0)" ::: "memory");
  __builtin_amdgcn_s_barrier();
  asm volatile("" ::: "memory");
#undef GEMM_ISSUE
}

DI void row_scales(const u16* __restrict__ base, int ld, int K, float* sc, int NR) {
  const int t = opaque_tid();
  const int row = (NR == 256) ? t : (t >> 1);
  const int part = (NR == 256) ? 0 : (t & 1);
  const int len = (NR == 256) ? K : (K / 2);
  const u16* p = base + (size_t)row * ld + part * len;
  float ss = 0.f;
  for (int i = 0; i < len / 8; ++i) {
    u32x4 v = *(const u32x4*)(p + i * 8);
#pragma unroll
    for (int j = 0; j < 4; ++j) { float a = bflo(v[j]), b = bfhi(v[j]); ss += a * a + b * b; }
  }
  if (NR != 256) ss += __shfl_xor(ss, 1);
  if (part == 0) sc[row] = rsqrtf(ss / (float)K + EPS);
}


template <int NI, class V, class R>
DI void epi_store(u16* smem, V val, R rowfn) {
  const int t = opaque_tid();
  const int lane = t & 63, w = t >> 6, r = lane & 31, h = lane >> 5;
  char* reg = (char*)smem + w * 18432;
#pragma unroll
  for (int mi = 0; mi < 4; ++mi)
#pragma unroll
    for (int ni = 0; ni < NI; ++ni)
#pragma unroll
      for (int i = 0; i < 16; ++i)
        *(u16*)(reg + (mi * 32 + crow(i, h)) * 144 + (ni * 32 + r) * 2) = f2bf(val(mi, ni, i));
  __builtin_amdgcn_sched_barrier(0);
  constexpr int CPR = NI * 4;
  constexpr int RPI = 64 / CPR;
  const int rr = lane / CPR, ch = lane % CPR;
#pragma unroll
  for (int k = 0; k < 128 / RPI; ++k) {
    const int row = k * RPI + rr;
    u32x4 v = *(const u32x4*)(reg + row * 144 + ch * 16);
    rowfn(row, ch * 8, v);
  }
}


template <int NI, int NPRE, class V, class L, class R>
DI void epi_store_pre(u16* smem, V val, L loadfn, R rowfn) {
  const int t = opaque_tid();
  const int lane = t & 63, w = t >> 6, r = lane & 31, h = lane >> 5;
  char* reg = (char*)smem + w * 18432;
#pragma unroll
  for (int mi = 0; mi < 4; ++mi)
#pragma unroll
    for (int ni = 0; ni < NI; ++ni)
#pragma unroll
      for (int i = 0; i < 16; ++i)
        *(u16*)(reg + (mi * 32 + crow(i, h)) * 144 + (ni * 32 + r) * 2) = f2bf(val(mi, ni, i));
  __builtin_amdgcn_sched_barrier(0);
  constexpr int CPR = NI * 4;
  constexpr int RPI = 64 / CPR;
  constexpr int NK = 128 / RPI;
  const int rr = lane / CPR, ch = lane % CPR;
  u32x4 pre[NK][NPRE];
#pragma unroll
  for (int k = 0; k < NK; ++k)
#pragma unroll
    for (int q = 0; q < NPRE; ++q) pre[k][q] = loadfn(k * RPI + rr, ch * 8, q);
  __builtin_amdgcn_sched_barrier(0);
#pragma unroll
  for (int k = 0; k < NK; ++k) {
    const int row = k * RPI + rr;
    u32x4 v = *(const u32x4*)(reg + row * 144 + ch * 16);
    rowfn(row, ch * 8, v, pre[k]);
  }
}

DI void tile_coords(int id, int MT, int NT, int& tm, int& tn) {
  const int per = 32 * NT;
  const int sr = id / per, rem = id - sr * per;
  tn = rem >> 5;
  tm = sr * 32 + (rem & 31);
}

#define EPI_LOOP                                   \
  _Pragma("unroll") for (int mi = 0; mi < 4; ++mi) \
  _Pragma("unroll") for (int ni = 0; ni < 2; ++ni) \
  _Pragma("unroll") for (int i = (__builtin_amdgcn_sched_barrier(0), 0); i < 16; ++i)

constexpr int SMEM_BYTES = 74752;

__global__ void __launch_bounds__(256, 2) fwd_megakernel(Params p) {
  cg::grid_group grid = cg::this_grid();
  __shared__ __attribute__((aligned(16))) char smem_raw[SMEM_BYTES];
  u16* smem = (u16*)smem_raw;
  const int G = gridDim.x;
  int bid = blockIdx.x;
  __shared__ uint4 xb_words;
  if (threadIdx.x == 0) xb_words = make_uint4(0u, 0u, 0u, 0u);
  __syncthreads();
  XcdBarrier xb = xcd_barrier_post((unsigned*)(p.ws + OFF_BAR), (volatile LAS unsigned*)&xb_words);

  char* ws = p.ws;
#define Wb ((u16*)(ws + OFF_WB))
#define ropec ((float*)(ws + OFF_ROPE))
#define ropes (((float*)(ws + OFF_ROPE)) + SEQ * 16)
#define Hb ((u16*)(ws + OFF_H))
#define Yb ((u16*)(ws + OFF_Y))
#define ACT ((u16*)(ws + OFF_ACT))
#define Z ((u16*)(ws + OFF_Z))
#define Qb ((u16*)(ws + OFF_Q))
#define KN ((u16*)(ws + OFF_KN))
#define VT ((u16*)(ws + OFF_VT))
#define KPE ((u16*)(ws + OFF_KPE))
#define OA ((u16*)(ws + OFF_OA))
#define ST ((u16*)(ws + OFF_ST))
#define DEC ((float*)(ws + OFF_DEC))
#define GC ((float*)(ws + OFF_GC))
#define OG ((u16*)(ws + OFF_OG))
#define MG ((u16*)(ws + OFF_MG))
  float* X = p.out;

  auto convert_weights = [&](int l) __attribute__((always_inline)) {
    char* ws = ws_ptr(p);
    const int t = opaque_tid();
    const int lane = t & 63, w = t >> 6, r = lane & 31, h = lane >> 5;
    const int wm = w >> 1, wn = w & 1;
    (void)lane; (void)r; (void)h; (void)wm; (void)wn;
    float* tile = (float*)smem_raw;
    for (int mat = 0; mat < 11; ++mat) {
      const float* src; int K, N; size_t dst; int map; const float* ksc = nullptr;
      switch (mat) {
        case 0: src = in_ptr(p, 3) + (size_t)l * DM * NFF2; K = DM; N = NFF2; dst = W_FFN1_IN; map = 1; break;
        case 1: src = in_ptr(p, 4) + (size_t)l * DFF * DM; K = DFF; N = DM; dst = W_FFN1_OUT; map = 0; break;
        case 2: src = in_ptr(p, 7) + (size_t)l * DM * PIN; K = DM; N = PIN; dst = W_IN; map = 0; break;
        case 3: src = in_ptr(p, 9) + (size_t)l * 256 * 768; K = 256; N = 768; dst = W_UQ; map = 0; ksc = in_ptr(p, 8) + l * 256; break;
        case 4: src = in_ptr(p, 11) + (size_t)l * 128 * 1024; K = 128; N = 1024; dst = W_KN; map = 2; ksc = in_ptr(p, 10) + l * 128; break;
        case 5: src = in_ptr(p, 12) + (size_t)l * 512 * DM; K = 512; N = DM; dst = W_OA; map = 0; break;
        case 6: src = in_ptr(p, 18) + (size_t)l * DM * DM; K = DM; N = DM; dst = W_OB; map = 0; break;
        case 7: src = in_ptr(p, 19) + (size_t)l * DM * DM; K = DM; N = DM; dst = W_OUT; map = 0; break;
        case 8: src = in_ptr(p, 22) + (size_t)l * DM * NFF2; K = DM; N = NFF2; dst = W_FFN2_IN; map = 1; break;
        case 9: src = in_ptr(p, 23) + (size_t)l * DFF * DM; K = DFF; N = DM; dst = W_FFN2_OUT; map = 0; break;
        default: src = nullptr; K = DM; N = 64; dst = W_IN + (size_t)PIN * DM; map = 3; break;
      }
      const int kt_n = K / 64, nt_n = N / 64;
      for (int id = bid; id < kt_n * nt_n; id += G) {
        const int kt = id % kt_n, nt = id / kt_n;
        const int k0 = kt * 64, n0 = nt * 64;
        __syncthreads();
        if (map != 3) {
#pragma unroll
          for (int i = 0; i < 4; ++i) {
            const int kk = (t >> 4) + 16 * i, nn = (t & 15) * 4;
            float4 v = *(const float4*)(src + (size_t)(k0 + kk) * N + n0 + nn);
            float sc = ksc ? ksc[k0 + kk] : 1.f;
            tile[kk * 65 + nn + 0] = v.x * sc; tile[kk * 65 + nn + 1] = v.y * sc;
            tile[kk * 65 + nn + 2] = v.z * sc; tile[kk * 65 + nn + 3] = v.w * sc;
          }
        }
        __syncthreads();
        const int nl = t >> 2, kc = (t & 3) * 16;
        const int n = n0 + nl;
        size_t drow;
        if (map == 0) drow = dst + (size_t)n * K;
        else if (map == 1) { const int isb = n >= DFF; const int j = n - isb * DFF; drow = dst + (size_t)((j >> 5) * 64 + isb * 32 + (j & 31)) * K; }
        else if (map == 2) { const int hd = n >> 7, cc = n & 127; drow = (cc < 64) ? (W_KN + (size_t)(hd * 64 + cc) * K) : (W_V + (size_t)(hd * 64 + cc - 64) * K); }
        else drow = dst + (size_t)nl * K;
        unsigned o[8];
#pragma unroll
        for (int j = 0; j < 8; ++j) {
          float a = (map == 3) ? 0.f : tile[(kc + 2 * j) * 65 + nl];
          float b = (map == 3) ? 0.f : tile[(kc + 2 * j + 1) * 65 + nl];
          o[j] = pk2(a, b);
        }
        uint4* dp = (uint4*)(Wb + drow + k0 + kc);
        dp[0] = make_uint4(o[0], o[1], o[2], o[3]);
        dp[1] = make_uint4(o[4], o[5], o[6], o[7]);
      }
    }
  };

  auto rn_pass = [&](int mode, float coef, const float* post_g, const float* pre_g, int r0, int r1) __attribute__((always_inline)) {
    char* ws = ws_ptr(p);
    float* X = out_ptr(p);
    const int t = opaque_tid();
    const int lane = t & 63, w = t >> 6, r = lane & 31, h = lane >> 5;
    const int wm = w >> 1, wn = w & 1;
    (void)lane; (void)r; (void)h; (void)wm; (void)wn;
    typedef float f4v __attribute__((ext_vector_type(4)));
    typedef unsigned u2v __attribute__((ext_vector_type(2)));
    const int gw = bid * 4 + w, nw = G * 4;
    constexpr int RB = 4;
    f4v pg[4], qg[4];
#pragma unroll
    for (int i = 0; i < 4; ++i) {
      pg[i] = (mode == 1) ? *(const f4v*)(post_g + lane * 4 + 256 * i) : (f4v){0.f, 0.f, 0.f, 0.f};
      qg[i] = pre_g ? *(const f4v*)(pre_g + lane * 4 + 256 * i) : (f4v){0.f, 0.f, 0.f, 0.f};
    }
    for (int row0 = r0 + gw; row0 < r1; row0 += RB * nw) {
      f4v xv[RB][4];
      u2v yu[RB][4];
#pragma unroll
      for (int j = 0; j < RB; ++j) {
        int row = row0 + j * nw;
        if (row >= r1) row = row0;
        const float* xs;
        if (mode == 0) xs = (row < SEQ) ? (in_ptr(p, 0) + (size_t)row * DM) : (in_ptr(p, 1) + (size_t)(row - SEQ) * DM);
        else xs = X + (size_t)row * DM;
#pragma unroll
        for (int i = 0; i < 4; ++i) xv[j][i] = *(const f4v*)(xs + lane * 4 + 256 * i);
        if (mode == 1) {
#pragma unroll
          for (int i = 0; i < 4; ++i) yu[j][i] = *(const u2v*)(Yb + (size_t)row * DM + lane * 4 + 256 * i);
        }
      }
#pragma unroll
      for (int j = 0; j < RB; ++j) {
        const int row = row0 + j * nw;
        if (row < r1) {
          if (mode == 1) {
            float yv[16];
            float ss = 0.f;
#pragma unroll
            for (int i = 0; i < 4; ++i) {
              yv[4 * i + 0] = bflo(yu[j][i][0]); yv[4 * i + 1] = bfhi(yu[j][i][0]);
              yv[4 * i + 2] = bflo(yu[j][i][1]); yv[4 * i + 3] = bfhi(yu[j][i][1]);
            }
#pragma unroll
            for (int i = 0; i < 16; ++i) ss += yv[i] * yv[i];
            ss = wave_sum(ss);
            const float ry = rsqrtf(ss * (1.f / DM) + EPS) * coef;
#pragma unroll
            for (int i = 0; i < 4; ++i)
#pragma unroll
              for (int k = 0; k < 4; ++k) xv[j][i][k] += yv[4 * i + k] * ry * pg[i][k];
          }
#pragma unroll
          for (int i = 0; i < 4; ++i) *(f4v*)(X + (size_t)row * DM + lane * 4 + 256 * i) = xv[j][i];
          if (pre_g) {
            float ss = 0.f;
#pragma unroll
            for (int i = 0; i < 4; ++i)
#pragma unroll
              for (int k = 0; k < 4; ++k) ss += xv[j][i][k] * xv[j][i][k];
            ss = wave_sum(ss);
            const float rx = rsqrtf(ss * (1.f / DM) + EPS);
#pragma unroll
            for (int i = 0; i < 4; ++i) {
              u2v o;
              o[0] = pk2(xv[j][i][0] * rx * qg[i][0], xv[j][i][1] * rx * qg[i][1]);
              o[1] = pk2(xv[j][i][2] * rx * qg[i][2], xv[j][i][3] * rx * qg[i][3]);
              *(u2v*)(Hb + (size_t)row * DM + lane * 4 + 256 * i) = o;
            }
          }
        }
      }
    }
  };

  auto ffn_in = [&](size_t woff) __attribute__((always_inline)) {
    char* ws = ws_ptr(p);
    const int t = opaque_tid();
    const int lane = t & 63, w = t >> 6, r = lane & 31, h = lane >> 5;
    const int wm = w >> 1, wn = w & 1;
    (void)lane; (void)r; (void)h; (void)wm; (void)wn;
    const int MT = MALL / 256, NT = NFF2 / 128;
    for (int id = bid; id < MT * NT; id += G) {
      int tm, tn; tile_coords(id, MT, NT, tm, tn);
      const int m0 = tm * 256, n0 = tn * 128;
      Acc c; acc_zero(c);
      gemm_kloop(Hb + (size_t)m0 * DM, DM, Wb + woff + (size_t)n0 * DM, DM, DM, smem, c);
#ifdef DUP_KLOOP
      acc_zero(c);
      gemm_kloop(Hb + (size_t)m0 * DM, DM, Wb + woff + (size_t)n0 * DM, DM, DM, smem, c);
#endif
      const int jb0 = ((n0 + wn * 64) >> 6) * 32;
      const unsigned obase = (unsigned)((m0 + wm * 128) * DFF + jb0);
      epi_store<1>(smem,
        [&](int mi, int ni, int i) { return siluf_(c.a[mi][0][i]) * c.a[mi][1][i]; },
        [&](int row, int col, u32x4 v) { *(u32x4*)(ACT + obase + (unsigned)(row * DFF + col)) = v; });
    }
  };
  auto gemm_plain = [&](const u16* A, int lda, int K, const u16* Bt, u16* C, int ldc, int M, int N) __attribute__((always_inline)) {
    char* ws = ws_ptr(p);
    const int t = opaque_tid();
    const int lane = t & 63, w = t >> 6, r = lane & 31, h = lane >> 5;
    const int wm = w >> 1, wn = w & 1;
    (void)lane; (void)r; (void)h; (void)wm; (void)wn;
    const int MT = M / 256, NT = N / 128;
    for (int id = bid; id < MT * NT; id += G) {
      int tm, tn; tile_coords(id, MT, NT, tm, tn);
      const int m0 = tm * 256, n0 = tn * 128;
      Acc c; acc_zero(c);
      gemm_kloop(A + (size_t)m0 * lda, lda, Bt + (size_t)n0 * K, K, K, smem, c);
      const unsigned obase = (unsigned)((m0 + wm * 128) * ldc + n0 + wn * 64);
      epi_store<2>(smem,
        [&](int mi, int ni, int i) { return c.a[mi][ni][i]; },
        [&](int row, int col, u32x4 v) { *(u32x4*)(C + obase + (unsigned)(row * ldc + col)) = v; });
    }
  };

  auto prep_phase = [&](int l) __attribute__((always_inline)) {
    char* ws = ws_ptr(p);
    int pb_ = bid; asm volatile("" : "+s"(pb_));
    const int t = opaque_tid();
    const int lane = t & 63, w = t >> 6, r = lane & 31, h = lane >> 5;
    const int wm = w >> 1, wn = w & 1;
    (void)lane; (void)r; (void)h; (void)wm; (void)wn;
    float* sc = (float*)(smem_raw + 2 * GEMM_LDS);
    const int NQ = 64 * 6, NK = 64 * 4, NV = 2 * 128, NPE = 64, NG1 = NCHUNK * 4;
    const float qscale = 0.10206207261596577f * 1.4426950408889634f;
    {
      for (int id = pb_; id < NG1; id += G) {
        const int t = opaque_tid();
        const int lane = t & 63, w = t >> 6, r = lane & 31, h = lane >> 5;
        const int wm = w >> 1, wn = w & 1;
        (void)lane; (void)r; (void)h; (void)wm; (void)wn;
        const int n = id >> 2, hd = id & 3;
        const int t0 = n * 64;
        u16* ksT = smem;
        u16* vT = smem + 2 * 128 * LROW;
        u16* sk = vT;
        float* sga = (float*)(smem_raw + 55296);
        __syncthreads();
        {
          const int cc = t >> 2, part = t & 3;
          const u16* kp = Z + (size_t)(t0 + cc) * ZLD + Z_GK + hd * 128 + part * 32;
#pragma unroll
          for (int j = 0; j < 4; ++j) *(u32x4*)(sk + cc * 128 + part * 32 + j * 8) = *(const u32x4*)(kp + j * 8);
          u32x4 gv = *(const u32x4*)(Z + (size_t)(t0 + cc) * ZLD + Z_GA + part * 8);
#pragma unroll
          for (int k = 0; k < 4; ++k) { sga[cc * 32 + part * 8 + 2 * k] = bflo(gv[k]); sga[cc * 32 + part * 8 + 2 * k + 1] = bfhi(gv[k]); }
        }
        __syncthreads();
        {
          const int dir = t >> 7, d = t & 127;
          const float* wa2 = (dir ? in_ptr(p, 15) : in_ptr(p, 13)) + (size_t)l * 16 * 512 + hd * 128 + d;
          const float ba = ((dir ? in_ptr(p, 16) : in_ptr(p, 14)) + (size_t)l * 512)[hd * 128 + d];
          float wcol[16];
#pragma unroll
          for (int rr = 0; rr < 16; ++rr) wcol[rr] = wa2[rr * 512];
          const float* gar = sga + dir * 16;
          float tot = 0.f;
          for (int cc = 0; cc < 64; ++cc) {
            float pre = ba;
#pragma unroll
            for (int rr = 0; rr < 16; ++rr) pre += gar[cc * 32 + rr] * wcol[rr];
            tot += (fminf(pre, 0.f) - __logf(1.f + __expf(-fabsf(pre)))) * (1.f / 16.f);
          }
          DEC[((size_t)(n * 4 + hd) * 2 + dir) * 128 + d] = __expf(tot);
          float* gc = GC + (size_t)dir * SEQ * 512 + (size_t)t0 * 512 + hd * 128 + d;
          float cb = 0.f;
          u16* krow_out = ksT + (dir * 128 + d) * LROW;
          for (int ci = 0; ci < 64; ++ci) {
            const int cc = dir ? (63 - ci) : ci;
            float pre = ba;
#pragma unroll
            for (int rr = 0; rr < 16; ++rr) pre += gar[cc * 32 + rr] * wcol[rr];
            cb += (fminf(pre, 0.f) - __logf(1.f + __expf(-fabsf(pre)))) * (1.f / 16.f);
            gc[cc * 512] = cb;
            krow_out[cc] = f2bf(bf2f(sk[cc * 128 + d]) * __expf(tot - cb));
          }
        }
        for (int half = 0; half < 2; ++half) {
          __syncthreads();
          {
            const int cc = t & 63, part = t >> 6;
#pragma unroll
            for (int q = 0; q < 4; ++q) {
              const int cg8 = (part * 4 + q) * 8;
              uint4 v = *(const uint4*)(Z + (size_t)(t0 + cc) * ZLD + Z_GV + hd * 256 + half * 128 + cg8);
              unsigned u[4] = {v.x, v.y, v.z, v.w};
#pragma unroll
              for (int j = 0; j < 4; ++j) {
                vT[(cg8 + 2 * j) * LROW + cc] = (u16)(u[j] & 0xffffu);
                vT[(cg8 + 2 * j + 1) * LROW + cc] = (u16)(u[j] >> 16);
              }
            }
          }
          __syncthreads();
#pragma unroll
          for (int dir = 0; dir < 2; ++dir) {
            f32x16 acc[4];
#pragma unroll
            for (int j = 0; j < 4; ++j)
#pragma unroll
              for (int k = 0; k < 16; ++k) acc[j][k] = 0.f;
#pragma unroll
            for (int ks = 0; ks < 4; ++ks) {
              bf16x8 fa = *(const bf16x8*)(vT + (w * 32 + r) * LROW + ks * 16 + h * 8);
#pragma unroll
              for (int nt = 0; nt < 4; ++nt) {
                bf16x8 fb = *(const bf16x8*)(ksT + (dir * 128 + nt * 32 + r) * LROW + ks * 16 + h * 8);
                acc[nt] = MFMA(fb, fa, acc[nt]);
              }
            }
            u16* stp = ST + ((size_t)(n * 4 + hd) * 2 + dir) * 32768;
#pragma unroll
            for (int nt = 0; nt < 4; ++nt)
#pragma unroll
              for (int g4 = 0; g4 < 4; ++g4) {
                uint2 o;
                o.x = pk2(acc[nt][4 * g4 + 0], acc[nt][4 * g4 + 1]);
                o.y = pk2(acc[nt][4 * g4 + 2], acc[nt][4 * g4 + 3]);
                *(uint2*)(stp + (unsigned)((half * 128 + w * 32 + r) * 128 + nt * 32 + 8 * g4 + 4 * h)) = o;
              }
          }
        }
      }
      for (int q = pb_; q < NQ; q += G) {
        const int t = opaque_tid();
        const int lane = t & 63, w = t >> 6, r = lane & 31, h = lane >> 5;
        const int wm = w >> 1, wn = w & 1;
        (void)lane; (void)r; (void)h; (void)wm; (void)wn;
        const int tm = q / 6, tn = q % 6;
        const int m0 = tm * 256, n0 = tn * 128;
        __syncthreads();
        row_scales(Z + (size_t)m0 * ZLD + Z_CQ, ZLD, 256, sc, 256);
        Acc c; acc_zero(c);
        gemm_kloop(Z + (size_t)m0 * ZLD + Z_CQ, ZLD, Wb + W_UQ + (size_t)n0 * 256, 256, 256, smem, c);
        {
          const unsigned obase = (unsigned)((m0 + wm * 128) * 768 + n0 + wn * 64);
          epi_store<2>(smem,
            [&](int mi, int ni, int i) {
              const int cb0 = n0 + wn * 64 + ni * 32;
              const bool rope = ((cb0 >> 5) % 3) == 2;
              const int rl = wm * 128 + mi * 32 + crow(i, h);
              float v = c.a[mi][ni][i] * sc[rl];
              const float pv = __shfl_xor(v, 16);
              if (rope) {
                const int row = m0 + rl;
                const float cs = ropec[row * 16 + (r & 15)], sn = ropes[row * 16 + (r & 15)];
                v = (r < 16) ? (v * cs - pv * sn) : (v * cs + pv * sn);
              }
              return v * qscale;
            },
            [&](int row, int col, u32x4 v) { *(u32x4*)(Qb + obase + (unsigned)(row * 768 + col)) = v; });
        }
      }
      for (int q = (pb_ + G - (NQ % G)) % G; q < NK; q += G) {
        const int t = opaque_tid();
        const int lane = t & 63, w = t >> 6, r = lane & 31, h = lane >> 5;
        const int wm = w >> 1, wn = w & 1;
        (void)lane; (void)r; (void)h; (void)wm; (void)wn;
        const int tm = q >> 2, tn = q & 3;
        const int m0 = tm * 256, n0 = tn * 128;
        __syncthreads();
        row_scales(Z + (size_t)m0 * ZLD + Z_CKV, ZLD, 128, sc, 256);
        Acc c; acc_zero(c);
        gemm_kloop(Z + (size_t)m0 * ZLD + Z_CKV, ZLD, Wb + W_KN + (size_t)n0 * 128, 128, 128, smem, c);
        {
          const unsigned obase = (unsigned)((m0 + wm * 128) * 512 + n0 + wn * 64);
          epi_store<2>(smem,
            [&](int mi, int ni, int i) { return c.a[mi][ni][i] * sc[wm * 128 + mi * 32 + crow(i, h)]; },
            [&](int row, int col, u32x4 v) { *(u32x4*)(KN + obase + (unsigned)(row * 512 + col)) = v; });
        }
      }
      for (int q = (pb_ + G - ((NQ + NK) % G)) % G; q < NV; q += G) {
        const int t = opaque_tid();
        const int lane = t & 63, w = t >> 6, r = lane & 31, h = lane >> 5;
        const int wm = w >> 1, wn = w & 1;
        (void)lane; (void)r; (void)h; (void)wm; (void)wn;
        const int tm = q & 1, tn = q >> 1;
        const int m0 = tm * 256, n0 = tn * 128;
        __syncthreads();
        row_scales(Z + (size_t)n0 * ZLD + Z_CKV, ZLD, 128, sc, 128);
        Acc c; acc_zero(c);
        gemm_kloop(Wb + W_V + (size_t)m0 * 128, 128, Z + (size_t)n0 * ZLD + Z_CKV, ZLD, 128, smem, c);
        {
          const unsigned obase = (unsigned)((m0 + wm * 128) * SEQ + n0 + wn * 64);
          epi_store<2>(smem,
            [&](int mi, int ni, int i) { return c.a[mi][ni][i] * sc[wn * 64 + ni * 32 + r]; },
            [&](int row, int col, u32x4 v) { *(u32x4*)(VT + obase + (unsigned)(row * SEQ + col)) = v; });
        }
      }
      for (int q = (pb_ + G - ((NQ + NK + NV) % G)) % G; q < NPE; q += G) {
        const int t = opaque_tid();
        const int lane = t & 63, w = t >> 6, r = lane & 31, h = lane >> 5;
        const int wm = w >> 1, wn = w & 1;
        (void)lane; (void)r; (void)h; (void)wm; (void)wn;
        const int tok = q * 256 + t;
        const u16* src = Z + (size_t)tok * ZLD + Z_KPE;
        float v[32];
#pragma unroll
        for (int j = 0; j < 4; ++j) {
          uint4 u = *(const uint4*)(src + j * 8);
          unsigned uu[4] = {u.x, u.y, u.z, u.w};
#pragma unroll
          for (int k = 0; k < 4; ++k) { v[j * 8 + 2 * k] = bflo(uu[k]); v[j * 8 + 2 * k + 1] = bfhi(uu[k]); }
        }
        float o[32];
#pragma unroll
        for (int i = 0; i < 16; ++i) {
          const float cs = ropec[tok * 16 + i], sn = ropes[tok * 16 + i];
          o[i] = v[i] * cs - v[i + 16] * sn;
          o[i + 16] = v[i + 16] * cs + v[i] * sn;
        }
#pragma unroll
        for (int j = 0; j < 4; ++j) {
          uint4 u;
          u.x = pk2(o[j * 8 + 0], o[j * 8 + 1]); u.y = pk2(o[j * 8 + 2], o[j * 8 + 3]);
          u.z = pk2(o[j * 8 + 4], o[j * 8 + 5]); u.w = pk2(o[j * 8 + 6], o[j * 8 + 7]);
          *(uint4*)(KPE + (size_t)tok * 32 + j * 8) = u;
        }
      }
    }
  };

  auto attn_phase = [&](int mode) __attribute__((always_inline)) {
    char* ws = ws_ptr(p);
    const int t = opaque_tid();
    const int lane = t & 63, w = t >> 6, r = lane & 31, h = lane >> 5;
    const int wm = w >> 1, wn = w & 1;
    (void)lane; (void)r; (void)h; (void)wm; (void)wn;
    if (mode & 1) for (int id = bid; id < 512; id += G) {
      const int e = id * 256 + t;
      const int d2 = e & 63, v = (e >> 6) & 255, dir = (e >> 14) & 1, hd = e >> 15;
      float s0 = 0.f, s1 = 0.f;
      const size_t eoff = (size_t)v * 128 + 2 * d2;
      for (int i0 = 0; i0 < NCHUNK; i0 += 16) {
        unsigned uu[16];
        float2 dd[16];
#pragma unroll
        for (int j = 0; j < 16; ++j) {
          const int n = dir ? (NCHUNK - 1 - (i0 + j)) : (i0 + j);
          const size_t base = ((size_t)(n * 4 + hd) * 2 + dir);
          uu[j] = *(const unsigned*)(ST + base * 32768 + eoff);
          dd[j] = *(const float2*)(DEC + base * 128 + 2 * d2);
        }
#pragma unroll
        for (int j = 0; j < 16; ++j) {
          const int n = dir ? (NCHUNK - 1 - (i0 + j)) : (i0 + j);
          const size_t base = ((size_t)(n * 4 + hd) * 2 + dir);
          *(unsigned*)(ST + base * 32768 + eoff) = pk2(s0, s1);
          s0 = dd[j].x * s0 + bflo(uu[j]);
          s1 = dd[j].y * s1 + bfhi(uu[j]);
        }
      }
    }
    constexpr int KROW = 104;
    constexpr int VR = 68;
    constexpr int ABUF = 64 * KROW + 64 * VR;
    u16* sK = smem;
    u16* sV = smem + 64 * KROW;
    if (mode & 2) for (int id = bid; id < 8 * 64; id += G) {
      const int hd = id & 7, qb = id >> 3;
      const int q0 = qb * 256 + w * 64;
      bf16x8 bq[2][6];
#pragma unroll
      for (int qt = 0; qt < 2; ++qt)
#pragma unroll
        for (int ks = 0; ks < 6; ++ks) bq[qt][ks] = *(const bf16x8*)(Qb + (size_t)(q0 + qt * 32 + r) * 768 + hd * 96 + ks * 16 + h * 8);
      f32x16 O[2][2];
#pragma unroll
      for (int j = 0; j < 2; ++j)
#pragma unroll
        for (int qt = 0; qt < 2; ++qt)
#pragma unroll
          for (int k = 0; k < 16; ++k) O[j][qt][k] = 0.f;
      float m[2] = {0.f, 0.f}, lsum[2] = {0.f, 0.f};
      const int kr = t >> 2, kc = t & 3;
      const u16* knp = KN + (size_t)kr * 512 + hd * 64 + kc * 16;
      const u16* kpp = KPE + (size_t)kr * 32 + kc * 8;
      const u16* vpp = VT + (size_t)(hd * 64 + kr) * SEQ + kc * 16;
      u32x4 rk[3], rv[2];
      rk[0] = *(const u32x4*)(knp);
      rk[1] = *(const u32x4*)(knp + 8);
      rk[2] = *(const u32x4*)(kpp);
      rv[0] = *(const u32x4*)(vpp);
      rv[1] = *(const u32x4*)(vpp + 8);
      __syncthreads();
      *(u32x4*)(sK + kr * KROW + kc * 16) = rk[0];
      *(u32x4*)(sK + kr * KROW + kc * 16 + 8) = rk[1];
      *(u32x4*)(sK + kr * KROW + 64 + kc * 8) = rk[2];
      *(uint2*)(sV + kr * VR + kc * 16) = make_uint2(rv[0][0], rv[0][1]);
      *(uint2*)(sV + kr * VR + kc * 16 + 4) = make_uint2(rv[0][2], rv[0][3]);
      *(uint2*)(sV + kr * VR + kc * 16 + 8) = make_uint2(rv[1][0], rv[1][1]);
      *(uint2*)(sV + kr * VR + kc * 16 + 12) = make_uint2(rv[1][2], rv[1][3]);
      rk[0] = *(const u32x4*)(knp + (size_t)64 * 512);
      rk[1] = *(const u32x4*)(knp + (size_t)64 * 512 + 8);
      rk[2] = *(const u32x4*)(kpp + (size_t)64 * 32);
      rv[0] = *(const u32x4*)(vpp + 64);
      rv[1] = *(const u32x4*)(vpp + 64 + 8);
      __syncthreads();
      int cur = 0;
      for (int key0 = 0; key0 < SEQ; key0 += 64) {
        const u16* cK = sK + cur * ABUF;
        const u16* cV = sV + cur * ABUF;
        {
          u16* nK = sK + (cur ^ 1) * ABUF;
          u16* nV = sV + (cur ^ 1) * ABUF;
          *(u32x4*)(nK + kr * KROW + kc * 16) = rk[0];
          *(u32x4*)(nK + kr * KROW + kc * 16 + 8) = rk[1];
          *(u32x4*)(nK + kr * KROW + 64 + kc * 8) = rk[2];
          *(uint2*)(nV + kr * VR + kc * 16) = make_uint2(rv[0][0], rv[0][1]);
          *(uint2*)(nV + kr * VR + kc * 16 + 4) = make_uint2(rv[0][2], rv[0][3]);
          *(uint2*)(nV + kr * VR + kc * 16 + 8) = make_uint2(rv[1][0], rv[1][1]);
          *(uint2*)(nV + kr * VR + kc * 16 + 12) = make_uint2(rv[1][2], rv[1][3]);
          const int kn = (key0 + 128 < SEQ) ? (key0 + 128) : key0;
          rk[0] = *(const u32x4*)(knp + (size_t)kn * 512);
          rk[1] = *(const u32x4*)(knp + (size_t)kn * 512 + 8);
          rk[2] = *(const u32x4*)(kpp + (size_t)kn * 32);
          rv[0] = *(const u32x4*)(vpp + kn);
          rv[1] = *(const u32x4*)(vpp + kn + 8);
        }
        __builtin_amdgcn_sched_barrier(0);
        f32x16 S[2][2];
#pragma unroll
        for (int kt = 0; kt < 2; ++kt)
#pragma unroll
          for (int qt = 0; qt < 2; ++qt)
#pragma unroll
            for (int k = 0; k < 16; ++k) S[kt][qt][k] = -m[qt];
        __builtin_amdgcn_s_setprio(1);
#pragma unroll
        for (int ks = 0; ks < 6; ++ks)
#pragma unroll
          for (int kt = 0; kt < 2; ++kt) {
            bf16x8 fa = *(const bf16x8*)(cK + (kt * 32 + r) * KROW + ks * 16 + h * 8);
            S[kt][0] = MFMA(fa, bq[0][ks], S[kt][0]);
            S[kt][1] = MFMA(fa, bq[1][ks], S[kt][1]);
          }
        __builtin_amdgcn_s_setprio(0);
        bf16x8 pf[2][4];
#pragma unroll
        for (int qt = 0; qt < 2; ++qt) {
          float mloc = S[0][qt][0];
#pragma unroll
          for (int kt = 0; kt < 2; ++kt)
#pragma unroll
            for (int k = 0; k < 16; ++k) mloc = fmaxf(mloc, S[kt][qt][k]);
          {
            auto sw_ = __builtin_amdgcn_permlane32_swap(__float_as_uint(mloc), __float_as_uint(mloc), false, false);
            mloc = fmaxf(__uint_as_float(sw_[0]), __uint_as_float(sw_[1]));
          }
          if (__builtin_amdgcn_ballot_w64(mloc > 6.f) != 0ull) {
            const float delta = fmaxf(mloc, 0.f);
            const float alpha = __builtin_amdgcn_exp2f(-delta);
            m[qt] += delta;
            lsum[qt] *= alpha;
#pragma unroll
            for (int j = 0; j < 2; ++j)
#pragma unroll
              for (int k = 0; k < 16; ++k) O[j][qt][k] *= alpha;
#pragma unroll
            for (int kt = 0; kt < 2; ++kt)
#pragma unroll
              for (int k = 0; k < 16; ++k) S[kt][qt][k] -= delta;
          }
          float ps = 0.f;
#pragma unroll
          for (int kt = 0; kt < 2; ++kt)
#pragma unroll
            for (int k = 0; k < 16; ++k) { S[kt][qt][k] = __builtin_amdgcn_exp2f(S[kt][qt][k]); ps += S[kt][qt][k]; }
          lsum[qt] += ps;
#pragma unroll
          for (int s2 = 0; s2 < 4; ++s2) {
            const int kt = s2 >> 1, sx = s2 & 1;
            unsigned pw[4];
#pragma unroll
            for (int j = 0; j < 4; ++j) pw[j] = pk2(S[kt][qt][8 * sx + 2 * j], S[kt][qt][8 * sx + 2 * j + 1]);
            pf[qt][s2] = __builtin_bit_cast(bf16x8, make_uint4(pw[0], pw[1], pw[2], pw[3]));
          }
        }
#pragma unroll
        for (int s2 = 0; s2 < 4; ++s2) {
          const int kt = s2 >> 1, sx = s2 & 1;
#pragma unroll
          for (int dt = 0; dt < 2; ++dt) {
            const u16* vp = cV + (dt * 32 + r) * VR + kt * 32 + 16 * sx + 4 * h;
            uint2 lo = *(const uint2*)(vp);
            uint2 hi = *(const uint2*)(vp + 8);
            bf16x8 fv = __builtin_bit_cast(bf16x8, make_uint4(lo.x, lo.y, hi.x, hi.y));
            O[dt][0] = MFMA(fv, pf[0][s2], O[dt][0]);
            O[dt][1] = MFMA(fv, pf[1][s2], O[dt][1]);
          }
        }
        cur ^= 1;
        __syncthreads();
      }
#pragma unroll
      for (int qt = 0; qt < 2; ++qt) {
        const float lt = lsum[qt] + __shfl_xor(lsum[qt], 32);
        const float inv = 1.f / lt;
#pragma unroll
        for (int dt = 0; dt < 2; ++dt)
#pragma unroll
          for (int g4 = 0; g4 < 4; ++g4) {
            uint2 o;
            o.x = pk2(O[dt][qt][4 * g4 + 0] * inv, O[dt][qt][4 * g4 + 1] * inv);
            o.y = pk2(O[dt][qt][4 * g4 + 2] * inv, O[dt][qt][4 * g4 + 3] * inv);
            *(uint2*)(OA + (size_t)(q0 + qt * 32 + r) * 512 + hd * 64 + dt * 32 + 8 * g4 + 4 * h) = o;
          }
      }
    }
  };

  auto gla_out_phase = [&](int l) __attribute__((always_inline)) {
    char* ws = ws_ptr(p);
    const int t = opaque_tid();
    const int lane = t & 63, w = t >> 6, r = lane & 31, h = lane >> 5;
    const int wm = w >> 1, wn = w & 1;
    (void)lane; (void)r; (void)h; (void)wm; (void)wn;
    constexpr int QROW = 136;
    u16* sQ = smem;
    u16* sKt = smem + 64 * QROW;
    u16* sVT = smem + 2 * 64 * QROW;
    float* sred = (float*)(smem + 2 * 64 * QROW + 256 * LROW);
    u16* sO = smem;
    constexpr int OROW = 264;
    const float qs = 0.08838834764831845f;
    const int cs = w & 1, vh = w >> 1;
    for (int id = bid; id < NCHUNK * 4; id += G) {
      const int n = id >> 2, hd = id & 3;
      const int t0 = n * 64;
      __syncthreads();
      {
        const int cc = t & 63, part = t >> 6;
#pragma unroll
        for (int q = 0; q < 8; ++q) {
          const int cg8 = (part * 8 + q) * 8;
          uint4 v = *(const uint4*)(Z + (size_t)(t0 + cc) * ZLD + Z_GV + hd * 256 + cg8);
          unsigned u[4] = {v.x, v.y, v.z, v.w};
#pragma unroll
          for (int j = 0; j < 4; ++j) {
            sVT[(cg8 + 2 * j) * LROW + cc] = (u16)(u[j] & 0xffffu);
            sVT[(cg8 + 2 * j + 1) * LROW + cc] = (u16)(u[j] >> 16);
          }
        }
      }
      f32x16 acc[4];
#pragma unroll
      for (int j = 0; j < 4; ++j)
#pragma unroll
        for (int k = 0; k < 16; ++k) acc[j][k] = 0.f;
      for (int dir = 0; dir < 2; ++dir) {
        __syncthreads();
        {
          const int cc = t >> 2, dp = (t & 3) * 32;
          const u16* qp = Z + (size_t)(t0 + cc) * ZLD + Z_GQ + hd * 128 + dp;
          const u16* kp = Z + (size_t)(t0 + cc) * ZLD + Z_GK + hd * 128 + dp;
          const float* gp = GC + (size_t)dir * SEQ * 512 + (size_t)(t0 + cc) * 512 + hd * 128 + dp;
#pragma unroll
          for (int j = 0; j < 4; ++j) {
            uint4 qv = *(const uint4*)(qp + j * 8);
            uint4 kv = *(const uint4*)(kp + j * 8);
            float4 g0 = *(const float4*)(gp + j * 8);
            float4 g1 = *(const float4*)(gp + j * 8 + 4);
            const float gg[8] = {g0.x, g0.y, g0.z, g0.w, g1.x, g1.y, g1.z, g1.w};
            const unsigned qu[4] = {qv.x, qv.y, qv.z, qv.w};
            const unsigned ku[4] = {kv.x, kv.y, kv.z, kv.w};
            unsigned qo[4], ko[4];
#pragma unroll
            for (int k = 0; k < 4; ++k) {
              const float e0 = __expf(gg[2 * k]), e1 = __expf(gg[2 * k + 1]);
              qo[k] = pk2(bflo(qu[k]) * qs * e0, bfhi(qu[k]) * qs * e1);
              ko[k] = pk2(bflo(ku[k]) / e0, bfhi(ku[k]) / e1);
            }
            *(uint4*)(sQ + cc * QROW + dp + j * 8) = make_uint4(qo[0], qo[1], qo[2], qo[3]);
            *(uint4*)(sKt + cc * QROW + dp + j * 8) = make_uint4(ko[0], ko[1], ko[2], ko[3]);
            if (j == 1) __builtin_amdgcn_sched_barrier(0);
          }
        }
        __syncthreads();
        const u16* bqp = sQ + (cs * 32 + r) * QROW + h * 8;
        const u16* stp = ST + ((size_t)(n * 4 + hd) * 2 + dir) * 32768;
        bf16x8 fs[2][4];
#pragma unroll
        for (int ks = 0; ks < 4; ++ks) fs[0][ks] = *(const bf16x8*)(stp + (size_t)(vh * 128 + r) * 128 + ks * 16 + h * 8);
        f32x16 at[2];
#pragma unroll
        for (int et = 0; et < 2; ++et) {
#pragma unroll
          for (int k = 0; k < 16; ++k) at[et][k] = 0.f;
#pragma unroll
          for (int ks = 0; ks < 8; ++ks) {
            bf16x8 fa = *(const bf16x8*)(sKt + (et * 32 + r) * QROW + ks * 16 + h * 8);
            bf16x8 fbq = *(const bf16x8*)(bqp + ks * 16);
            at[et] = MFMA(fa, fbq, at[et]);
          }
          const int cidx = cs * 32 + r;
#pragma unroll
          for (int k = 0; k < 16; ++k) {
            const int e = et * 32 + crow(k, h);
            const bool keep = dir ? (e >= cidx) : (e <= cidx);
            at[et][k] = keep ? at[et][k] : 0.f;
          }
        }
#pragma unroll
        for (int s2 = 0; s2 < 4; ++s2) {
          const int et = s2 >> 1, s = s2 & 1;
          unsigned pw[4];
#pragma unroll
          for (int j = 0; j < 4; ++j) pw[j] = pk2(at[et][8 * s + 2 * j], at[et][8 * s + 2 * j + 1]);
          bf16x8 pf = __builtin_bit_cast(bf16x8, make_uint4(pw[0], pw[1], pw[2], pw[3]));
#pragma unroll
          for (int mt = 0; mt < 4; ++mt) {
            const u16* vp = sVT + (vh * 128 + mt * 32 + r) * LROW + et * 32 + 16 * s + 4 * h;
            uint2 lo = *(const uint2*)(vp);
            uint2 hi = *(const uint2*)(vp + 8);
            bf16x8 fv = __builtin_bit_cast(bf16x8, make_uint4(lo.x, lo.y, hi.x, hi.y));
            acc[mt] = MFMA(fv, pf, acc[mt]);
          }
        }
#pragma unroll
        for (int bb = 0; bb < 8; ++bb) {
          const int mt = bb >> 1, kb = bb & 1;
          if (bb + 1 < 8) {
            const int mt1 = (bb + 1) >> 1, kb1 = (bb + 1) & 1;
#pragma unroll
            for (int ks = 0; ks < 4; ++ks) fs[(bb + 1) & 1][ks] = *(const bf16x8*)(stp + (size_t)(vh * 128 + mt1 * 32 + r) * 128 + (kb1 * 4 + ks) * 16 + h * 8);
          }
          __builtin_amdgcn_sched_barrier(0);
#pragma unroll
          for (int ks = 0; ks < 4; ++ks) { bf16x8 fbq = *(const bf16x8*)(bqp + (kb * 4 + ks) * 16); acc[mt] = MFMA(fs[bb & 1][ks], fbq, acc[mt]); }
          __builtin_amdgcn_sched_barrier(0);
        }
      }
      float ss = 0.f;
#pragma unroll
      for (int mt = 0; mt < 4; ++mt)
#pragma unroll
        for (int k = 0; k < 16; ++k) ss += acc[mt][k] * acc[mt][k];
      ss += __shfl_xor(ss, 32);
      if (h == 0) sred[vh * 64 + cs * 32 + r] = ss;
      __syncthreads();
      const float rs = rsqrtf((sred[cs * 32 + r] + sred[64 + cs * 32 + r]) * (1.f / 256.f) + EPS);
#pragma unroll
      for (int mt = 0; mt < 4; ++mt)
#pragma unroll
        for (int g4 = 0; g4 < 4; ++g4) {
          uint2 o;
          o.x = pk2(acc[mt][4 * g4 + 0] * rs, acc[mt][4 * g4 + 1] * rs);
          o.y = pk2(acc[mt][4 * g4 + 2] * rs, acc[mt][4 * g4 + 3] * rs);
          *(uint2*)(sO + (cs * 32 + r) * OROW + vh * 128 + mt * 32 + 8 * g4 + 4 * h) = o;
        }
      __syncthreads();
      {
        const int t3 = opaque_tid();
        const int cc = t3 >> 2, vp0 = (t3 & 3) * 64;
        const float* ng = in_ptr(p, 17) + (size_t)l * 256;
        u32x4 gvp[8];
#pragma unroll
        for (int j = 0; j < 8; ++j) gvp[j] = *(const u32x4*)(Z + (size_t)(t0 + cc) * ZLD + Z_GOG + hd * 256 + vp0 + j * 8);
        __builtin_amdgcn_sched_barrier(0);
#pragma unroll
        for (int j = 0; j < 8; ++j) {
          const int v0 = vp0 + j * 8;
          uint4 ov = *(const uint4*)(sO + cc * OROW + v0);
          uint4 gv = make_uint4(gvp[j][0], gvp[j][1], gvp[j][2], gvp[j][3]);
          float4 n0 = *(const float4*)(ng + v0), n1 = *(const float4*)(ng + v0 + 4);
          const float nn[8] = {n0.x, n0.y, n0.z, n0.w, n1.x, n1.y, n1.z, n1.w};
          const unsigned ou[4] = {ov.x, ov.y, ov.z, ov.w};
          const unsigned gu[4] = {gv.x, gv.y, gv.z, gv.w};
          unsigned res[4];
#pragma unroll
          for (int k = 0; k < 4; ++k)
            res[k] = pk2(bflo(ou[k]) * nn[2 * k] * siluf_(bflo(gu[k])), bfhi(ou[k]) * nn[2 * k + 1] * siluf_(bfhi(gu[k])));
          *(uint4*)(OG + (size_t)(t0 + cc) * DM + hd * 256 + v0) = make_uint4(res[0], res[1], res[2], res[3]);
        }
      }
    }
  };

  auto merge_phase = [&]() __attribute__((always_inline)) {
    char* ws = ws_ptr(p);
    const int t = opaque_tid();
    const int lane = t & 63, w = t >> 6, r = lane & 31, h = lane >> 5;
    const int wm = w >> 1, wn = w & 1;
    (void)lane; (void)r; (void)h; (void)wm; (void)wn;
    const int MT = SEQ / 256, NT = DM / 128;
    for (int id = bid; id < MT * NT; id += G) {
      int tm, tn; tile_coords(id, MT, NT, tm, tn);
      const int m0 = tm * 256, n0 = tn * 128;
      Acc c; acc_zero(c);
      gemm_kloop(OA + (size_t)m0 * 512, 512, Wb + W_OA + (size_t)n0 * 512, 512, 512, smem, c);
      {
        const unsigned zbase = (unsigned)((m0 + wm * 128) * ZLD + Z_BG + n0 + wn * 64);
        const unsigned obase = (unsigned)((m0 + wm * 128) * DM + n0 + wn * 64);
        epi_store_pre<2, 1>(smem,
          [&](int mi, int ni, int i) { return c.a[mi][ni][i]; },
          [&](int row, int col, int q) { return *(const u32x4*)(Z + zbase + (unsigned)(row * ZLD + col)); },
          [&](int row, int col, u32x4 v, const u32x4* pre) {
            const u32x4 g = pre[0];
            u32x4 o;
#pragma unroll
            for (int k = 0; k < 4; ++k) o[k] = pk2(bflo(v[k]) * sigmoidf_(bflo(g[k])), bfhi(v[k]) * sigmoidf_(bfhi(g[k])));
            *(u32x4*)(MG + obase + (unsigned)(row * DM + col)) = o;
          });
      }
      acc_zero(c);
      gemm_kloop(OG + (size_t)m0 * DM, DM, Wb + W_OB + (size_t)n0 * DM, DM, DM, smem, c);
      {
        const int t2 = opaque_tid();
        const int wm2 = t2 >> 7, wn2 = (t2 >> 6) & 1;
        const unsigned zbase = (unsigned)((m0 + wm2 * 128) * ZLD + Z_BG + DM + n0 + wn2 * 64);
        const unsigned obase = (unsigned)((m0 + wm2 * 128) * DM + n0 + wn2 * 64);
        epi_store_pre<2, 2>(smem,
          [&](int mi, int ni, int i) { return c.a[mi][ni][i]; },
          [&](int row, int col, int q) {
            return q == 0 ? *(const u32x4*)(Z + zbase + (unsigned)(row * ZLD + col))
                          : *(const u32x4*)(MG + obase + (unsigned)(row * DM + col));
          },
          [&](int row, int col, u32x4 v, const u32x4* pre) {
            const u32x4 g = pre[0], pm = pre[1];
            u32x4 o;
#pragma unroll
            for (int k = 0; k < 4; ++k)
              o[k] = pk2(bflo(pm[k]) + bflo(v[k]) * sigmoidf_(bflo(g[k])), bfhi(pm[k]) + bfhi(v[k]) * sigmoidf_(bfhi(g[k])));
            *(u32x4*)(MG + obase + (unsigned)(row * DM + col)) = o;
          });
      }
    }
  };

  for (int i = bid * 256 + opaque_tid(); i < SEQ * 16; i += G * 256) {
    const int pos = i >> 4, j = i & 15;
    const float inv_freq = exp2f(-(float)j * 0.8304820237218406f);
    const float angf = (float)pos * inv_freq;
    double a = (double)angf;
    const double twopi = 6.283185307179586476925286766559;
    a -= twopi * rint(a / twopi);
    const float af = (float)a;
    ropec[i] = __cosf(af);
    ropes[i] = __sinf(af);
  }
  convert_weights(0);
  rn_pass(0, 0.f, nullptr, in_ptr(p, 2), 0, MALL);
  grid.sync();

  for (int l = 0; l < 4; ++l) {
    asm volatile("" : "+s"(bid));
    char* ws = ws_ptr(p);
    ffn_in(W_FFN1_IN);
#ifdef DUP_FFNIN
    xcd_barrier(xb);
    ffn_in(W_FFN1_IN);
#endif
    xcd_barrier(xb);
    gemm_plain(ACT, DFF, DFF, Wb + W_FFN1_OUT, Yb, DM, MALL, DM);
    xcd_barrier(xb);
    rn_pass(1, 0.5f, in_ptr(p, 5) + l * DM, in_ptr(p, 6) + l * DM, 0, SEQ);
    xcd_barrier(xb);
    for (int s = 0; s < NSEQ; ++s) {
      asm volatile("" : "+s"(bid));
      char* ws = ws_ptr(p);
      {
        const float coefx = (s == 0) ? 0.5f : 1.0f;
        const float* postx = ((s == 0) ? in_ptr(p, 5) : in_ptr(p, 20)) + l * DM;
        const float* prex = ((s == 0) ? in_ptr(p, 6) : in_ptr(p, 21)) + l * DM;
        const int r0x = (s == 0) ? SEQ : (s - 1) * SEQ, r1x = (s == 0) ? 3 * SEQ : s * SEQ;
        int bq_ = bid; asm volatile("" : "+s"(bq_));
        for (int step_ = 0; step_ < 2; ++step_) {
          int sel_ = (step_ ^ bq_) & 1; asm volatile("" : "+s"(sel_));
          if (sel_) rn_pass(1, coefx, postx, prex, r0x, r1x);
          else gemm_plain(Hb + (size_t)s * SEQ * DM, DM, DM, Wb + W_IN, Z, ZLD, SEQ, ZLD);
        }
      }
      xcd_barrier(xb);
      prep_phase(l);
#ifdef DUP_PREP
      xcd_barrier(xb);
      prep_phase(l);
#endif
      xcd_barrier(xb);
      attn_phase(1);
      xcd_barrier(xb);
      int bpar_ = bid; asm volatile("" : "+s"(bpar_));
      if (bpar_ & 1) { attn_phase(2); gla_out_phase(l); }
      else { gla_out_phase(l); attn_phase(2); }
      xcd_barrier(xb);
      merge_phase();
      xcd_barrier(xb);
      gemm_plain(MG, DM, DM, Wb + W_OUT, Yb + (size_t)s * SEQ * DM, DM, SEQ, DM);
      xcd_barrier(xb);
    }
    rn_pass(1, 1.0f, in_ptr(p, 20) + l * DM, in_ptr(p, 21) + l * DM, 2 * SEQ, 3 * SEQ);
    xcd_barrier(xb);
    ffn_in(W_FFN2_IN);
    xcd_barrier(xb);
    gemm_plain(ACT, DFF, DFF, Wb + W_FFN2_OUT, Yb, DM, MALL, DM);
    xcd_barrier(xb);
    rn_pass(1, 0.5f, in_ptr(p, 24) + l * DM, (l < 3) ? (in_ptr(p, 2) + (l + 1) * DM) : nullptr, 0, MALL);
    if (l < 3) convert_weights(l + 1);
    xcd_barrier(xb);
  }
}

extern "C" void kernel_launch(void* const* d_in, const int* in_sizes, int n_in, void* d_out,
                              int out_size, void* d_ws, size_t ws_size, hipStream_t stream) {
  static int grid_blocks = 0;
  if (!grid_blocks) {
    int dev = 0, cus = 0, per_cu = 0;
    (void)hipGetDevice(&dev);
    (void)hipDeviceGetAttribute(&cus, hipDeviceAttributeMultiprocessorCount, dev);
    (void)hipOccupancyMaxActiveBlocksPerMultiprocessor(&per_cu, fwd_megakernel, 256, 0);
    if (per_cu > 2) per_cu = 2;
    if (per_cu < 1) per_cu = 1;
    grid_blocks = cus * per_cu;
  }
  Params p{};
  for (int i = 0; i < 25; ++i) p.in[i] = (const float*)d_in[i];
  p.out = (float*)d_out;
  p.ws = (char*)d_ws;
  (void)hipMemsetAsync((char*)d_ws + OFF_BAR, 0, XCD_BAR_WORDS * 4, stream);
  void* args[] = {&p};
  hipError_t e = hipLaunchCooperativeKernel((void*)fwd_megakernel, dim3(grid_blocks), dim3(256), args, 0, stream);
  if (e != hipSuccess) fprintf(stderr, "cooperative launch failed: %s (grid %d)\n", hipGetErrorString(e), grid_blocks);
}
```
